# Optimizing an MI355X kernel written in HIP

```python
import math
import jax, jax.numpy as jnp
from jax import lax
import numpy as np

D_MODEL = 1024
BATCH = 4
SEQ = 8192
DEPTH = 1

D_MIX = D_MODEL
D_ATTN = D_MIX // 2
D_SSM = D_MIX - D_ATTN
ATTN_HEADS = 4
ATTN_VDIM = D_ATTN // ATTN_HEADS
ATTN_QKDIM = ATTN_VDIM // 2
ROPE_DIM = ATTN_QKDIM // 4
ROPE_THETA = 500000.0
Q_BLOCK = 128
SSM_GROUP = 16
SSM_GROUPS = D_SSM // SSM_GROUP
SSM_STATE = 64
DT_MIN = 1e-3
DT_MAX = 1e-1
N_EXPERTS = 32
TOP_K = 4
D_FF = D_MODEL
SWIGLU_LIMIT = 7.0
SWIGLU_ALPHA = 1.702
MOE_BLOCK = 128
RMS_EPS = 1e-6

kernel_name = "hybrid_diffattn_s5_moe_layer"


def rmsnorm(x, g):
    xf = x.astype(jnp.float32)
    y = xf * lax.rsqrt(jnp.mean(xf * xf, axis=-1, keepdims=True) + RMS_EPS)
    return (y * g.astype(jnp.float32)).astype(x.dtype)


def partial_rope(t, positions):
    half = ROPE_DIM // 2
    inv_freq = ROPE_THETA ** (-jnp.arange(0, ROPE_DIM, 2, dtype=jnp.float32) / ROPE_DIM)
    ang = positions.astype(jnp.float32)[..., None] * inv_freq
    cos = jnp.cos(ang)[:, :, None, None, :]
    sin = jnp.sin(ang)[:, :, None, None, :]
    tf = t.astype(jnp.float32)
    t1 = tf[..., :half]
    t2 = tf[..., half:ROPE_DIM]
    rot = jnp.concatenate([t1 * cos - t2 * sin, t2 * cos + t1 * sin], axis=-1)
    return jnp.concatenate([rot, tf[..., ROPE_DIM:]], axis=-1)


def diff_attention(q, k, v, lam_q1, lam_k1, lam_q2, lam_k2, norm_g, lambda_init):
    bsz, s_len = q.shape[0], q.shape[1]
    scale = ATTN_QKDIM ** -0.5
    qf = jnp.transpose(q, (0, 2, 3, 1, 4)) * scale
    kf = jnp.transpose(k, (0, 2, 3, 1, 4))
    vf = jnp.transpose(v.astype(jnp.float32), (0, 2, 1, 3))
    lam = (jnp.exp(jnp.sum(lam_q1.astype(jnp.float32) * lam_k1.astype(jnp.float32)))
           - jnp.exp(jnp.sum(lam_q2.astype(jnp.float32) * lam_k2.astype(jnp.float32)))
           + lambda_init)
    outs = []
    for blk in range(s_len // Q_BLOCK):
        q0 = blk * Q_BLOCK
        kv_end = q0 + Q_BLOCK
        qb = qf[:, :, :, q0:kv_end]
        kb = kf[:, :, :, :kv_end]
        vb = vf[:, :, :kv_end]
        sc = jnp.einsum('bhmqd,bhmkd->bhmqk', qb, kb)
        mask = jnp.arange(kv_end)[None, :] <= (q0 + jnp.arange(Q_BLOCK))[:, None]
        sc = jnp.where(mask, sc, -jnp.inf)
        p = jax.nn.softmax(sc, axis=-1)
        w = p[:, :, 0] - lam * p[:, :, 1]
        outs.append(jnp.einsum('bhqk,bhkd->bhqd', w, vb))
    o = jnp.concatenate(outs, axis=2)
    o = rmsnorm(o, norm_g) * (1.0 - lambda_init)
    return jnp.transpose(o, (0, 2, 1, 3)).reshape(bsz, s_len, D_ATTN)


def s5_branch(u, lam_re, lam_im, b_re, b_im, c_re, c_im, d_skip, log_dt, w_glu, b_glu, norm_g):
    bsz, s_len, _ = u.shape
    uf = u.astype(jnp.float32)
    ug = uf.reshape(bsz, s_len, SSM_GROUPS, SSM_GROUP)
    dt = jnp.exp(log_dt.astype(jnp.float32))[:, None]
    lam = lax.complex(lam_re.astype(jnp.float32), lam_im.astype(jnp.float32))
    a_bar = jnp.exp(lam * dt)
    b_cplx = lax.complex(b_re.astype(jnp.float32), b_im.astype(jnp.float32))
    b_bar = ((a_bar - 1.0) / lam)[..., None] * b_cplx
    bu = jnp.einsum('bsgc,gnc->bsgn', ug.astype(jnp.complex64), b_bar)
    a_seq = jnp.broadcast_to(a_bar, (1, s_len) + a_bar.shape)

    def combine(left, right):
        a_l, b_l = left
        a_r, b_r = right
        return a_r * a_l, a_r * b_l + b_r

    _, states = lax.associative_scan(combine, (a_seq, bu), axis=1)
    y = (jnp.einsum('bsgn,gcn->bsgc', jnp.real(states), c_re.astype(jnp.float32))
         - jnp.einsum('bsgn,gcn->bsgc', jnp.imag(states), c_im.astype(jnp.float32)))
    y = y.reshape(bsz, s_len, D_SSM) + d_skip.astype(jnp.float32) * uf
    y = jax.nn.gelu(y, approximate=False)
    y = y * jax.nn.sigmoid(y @ w_glu.astype(jnp.float32) + b_glu.astype(jnp.float32))
    return rmsnorm(y, norm_g).astype(u.dtype)


def moe_ffn(h, w_router, b_router, w_gate_up, b_gate_up, w_down, b_down):
    bsz, s_len, d = h.shape
    n_tok = bsz * s_len
    xf = h.reshape(n_tok, d)
    logits = xf.astype(jnp.float32) @ w_router.astype(jnp.float32) + b_router.astype(jnp.float32)
    top_val, top_idx = lax.top_k(logits, TOP_K)
    gates = jax.nn.softmax(top_val, axis=-1)
    n_assign = n_tok * TOP_K
    e_flat = top_idx.reshape(-1)
    tok_flat = jnp.arange(n_assign, dtype=jnp.int32) // TOP_K
    order = jnp.argsort(e_flat)
    e_sorted = e_flat[order]
    tok_sorted = tok_flat[order]
    gate_sorted = gates.reshape(-1)[order]
    counts = jnp.bincount(e_flat, length=N_EXPERTS)
    starts = jnp.cumsum(counts) - counts
    padded = (counts + MOE_BLOCK - 1) // MOE_BLOCK * MOE_BLOCK
    pad_ends = jnp.cumsum(padded)
    pad_starts = pad_ends - padded
    dest = pad_starts[e_sorted] + (jnp.arange(n_assign, dtype=jnp.int32) - starts[e_sorted])
    n_rows = n_assign + N_EXPERTS * MOE_BLOCK
    n_blocks = n_rows // MOE_BLOCK
    x_pad = jnp.zeros((n_rows, d), h.dtype).at[dest].set(xf[tok_sorted])
    blk_expert = jnp.minimum(
        jnp.searchsorted(pad_ends, jnp.arange(n_blocks, dtype=jnp.int32) * MOE_BLOCK, side='right'),
        N_EXPERTS - 1)

    def expert_block(args):
        xb, e = args
        gu = xb @ w_gate_up[e] + b_gate_up[e]
        gate = jnp.minimum(gu[:, 0::2], SWIGLU_LIMIT)
        up = jnp.clip(gu[:, 1::2], -SWIGLU_LIMIT, SWIGLU_LIMIT)
        act = gate * jax.nn.sigmoid(SWIGLU_ALPHA * gate) * (up + 1.0)
        return act @ w_down[e] + b_down[e]

    y_pad = lax.map(expert_block, (x_pad.reshape(n_blocks, MOE_BLOCK, d), blk_expert))
    y_rows = y_pad.reshape(n_rows, d)[dest]
    out = jnp.zeros((n_tok, d), jnp.float32).at[tok_sorted].add(
        y_rows.astype(jnp.float32) * gate_sorted[:, None])
    return out.reshape(bsz, s_len, d).astype(h.dtype)


def setup_inputs(seed: int = 0) -> dict:
    key = jax.random.key(seed)
    ks = jax.random.split(key, 32)
    f32 = jnp.float32
    L, D, G, N, C = DEPTH, D_MODEL, SSM_GROUPS, SSM_STATE, SSM_GROUP
    nrm = lambda k, shp, s: jax.random.normal(k, shp, f32) * s
    x = jax.random.normal(ks[0], (BATCH, SEQ, D), f32)
    offsets = jax.random.randint(ks[1], (BATCH, 1), 0, 1024, dtype=jnp.int32)
    positions = jnp.arange(SEQ, dtype=jnp.int32)[None, :] + offsets
    n_in = 3 * D_ATTN + D_SSM
    lam_im = jnp.broadcast_to(jnp.pi * jnp.arange(N, dtype=f32), (L, G, N))
    return {
        "x": x,
        "positions": positions,
        "ln_mix_g": 1.0 + nrm(ks[2], (L, D), 0.02),
        "w_in": nrm(ks[3], (L, D, n_in), D ** -0.5),
        "lam_q1": nrm(ks[4], (L, ATTN_QKDIM), 0.1),
        "lam_k1": nrm(ks[5], (L, ATTN_QKDIM), 0.1),
        "lam_q2": nrm(ks[6], (L, ATTN_QKDIM), 0.1),
        "lam_k2": nrm(ks[7], (L, ATTN_QKDIM), 0.1),
        "diff_norm_g": 1.0 + nrm(ks[8], (L, ATTN_VDIM), 0.02),
        "ssm_lam_re": -0.5 + nrm(ks[9], (L, G, N), 0.01),
        "ssm_lam_im": lam_im + nrm(ks[10], (L, G, N), 0.01),
        "ssm_b_re": nrm(ks[11], (L, G, N, C), (0.5 / C) ** 0.5),
        "ssm_b_im": nrm(ks[12], (L, G, N, C), (0.5 / C) ** 0.5),
        "ssm_c_re": nrm(ks[13], (L, G, C, N), (0.5 / N) ** 0.5),
        "ssm_c_im": nrm(ks[14], (L, G, C, N), (0.5 / N) ** 0.5),
        "ssm_d": nrm(ks[15], (L, D_SSM), 1.0),
        "ssm_log_dt": jax.random.uniform(ks[16], (L, G), f32, math.log(DT_MIN), math.log(DT_MAX)),
        "ssm_w_glu": nrm(ks[17], (L, D_SSM, D_SSM), D_SSM ** -0.5),
        "ssm_b_glu": nrm(ks[18], (L, D_SSM), 0.01),
        "ssm_norm_g": 1.0 + nrm(ks[19], (L, D_SSM), 0.02),
        "w_out": nrm(ks[20], (L, D_MIX, D), D_MIX ** -0.5),
        "ln_ffn_g": 1.0 + nrm(ks[21], (L, D), 0.02),
        "w_router": nrm(ks[22], (L, D, N_EXPERTS), D ** -0.5),
        "b_router": nrm(ks[23], (L, N_EXPERTS), 0.01),
        "w_gate_up": nrm(ks[24], (L, N_EXPERTS, D, 2 * D_FF), D ** -0.5),
        "b_gate_up": nrm(ks[25], (L, N_EXPERTS, 2 * D_FF), 0.01),
        "w_down": nrm(ks[26], (L, N_EXPERTS, D_FF, D), D_FF ** -0.5),
        "b_down": nrm(ks[27], (L, N_EXPERTS, D), 0.01),
        "final_norm_g": 1.0 + nrm(ks[28], (D,), 0.02),
    }


def reference(x, positions, ln_mix_g, w_in, lam_q1, lam_k1, lam_q2, lam_k2, diff_norm_g,
              ssm_lam_re, ssm_lam_im, ssm_b_re, ssm_b_im, ssm_c_re, ssm_c_im, ssm_d,
              ssm_log_dt, ssm_w_glu, ssm_b_glu, ssm_norm_g, w_out, ln_ffn_g,
              w_router, b_router, w_gate_up, b_gate_up, w_down, b_down, final_norm_g):
    bsz, s_len, _ = x.shape
    h = x
    for li in range(DEPTH):
        lambda_init = 0.8 - 0.6 * math.exp(-0.3 * li)
        n = rmsnorm(h, ln_mix_g[li])
        proj = n @ w_in[li]
        q, k, v, u = jnp.split(proj, [D_ATTN, 2 * D_ATTN, 3 * D_ATTN], axis=-1)
        q = partial_rope(q.reshape(bsz, s_len, ATTN_HEADS, 2, ATTN_QKDIM), positions)
        k = partial_rope(k.reshape(bsz, s_len, ATTN_HEADS, 2, ATTN_QKDIM), positions)
        v = v.reshape(bsz, s_len, ATTN_HEADS, ATTN_VDIM)
        a_out = diff_attention(q, k, v, lam_q1[li], lam_k1[li], lam_q2[li], lam_k2[li],
                               diff_norm_g[li], lambda_init).astype(x.dtype)
        s_out = s5_branch(u, ssm_lam_re[li], ssm_lam_im[li], ssm_b_re[li], ssm_b_im[li],
                          ssm_c_re[li], ssm_c_im[li], ssm_d[li], ssm_log_dt[li],
                          ssm_w_glu[li], ssm_b_glu[li], ssm_norm_g[li])
        h = h + jnp.concatenate([a_out, s_out], axis=-1) @ w_out[li]
        h = h + moe_ffn(rmsnorm(h, ln_ffn_g[li]), w_router[li], b_router[li],
                        w_gate_up[li], b_gate_up[li], w_down[li], b_down[li])
    return rmsnorm(h, final_norm_g)
```

```cpp
#include <hip/hip_runtime.h>
#include <hip/hip_bf16.h>
#include <cstdio>
#include <cstdint>
#include <cmath>
namespace pg8 {
#define PG8_LAS __attribute__((address_space(3)))
typedef unsigned short bf16_t;
typedef short bf16x8 __attribute__((ext_vector_type(8)));
typedef float f32x4 __attribute__((ext_vector_type(4)));
typedef float f32x2 __attribute__((ext_vector_type(2)));
typedef unsigned u32x4 __attribute__((ext_vector_type(4)));
typedef unsigned u32x2 __attribute__((ext_vector_type(2)));
constexpr int BM = 256, BK = 64, HALF = 128, HTB = HALF * BK * 2  , STAGE_BYTES = 8 * HTB, NXCD = 8, WGM = 8;

__host__ __device__ __forceinline__ int lds_byte(int r, int c) { const int st = (r >> 4) * 2 + (c >> 5), rr = r & 15, cc = c & 31, ob = rr * 64 + cc * 2; return st * 1024 + (ob ^ (((ob >> 9) & 1) << 5)); }
__host__ __device__ __forceinline__ void stage_rc(int b, int& R, int& C) { const int st = b / 1024, sb = b % 1024, swz = sb ^ (((sb >> 9) & 1) << 5); R = (st >> 1) * 16 + swz / 64; C = (st & 1) * 32 + (swz % 64) / 2; }
__host__ __device__ __forceinline__ int perm32(int rho) { const int n = rho >> 4, i = rho & 15; return 8 * (i >> 2) + 4 * n + (i & 3); }

struct Unit { int pm, pn; const char* a; const char* b; int nt; int x0, x1; };

struct ALinear {
    static constexpr bool PER_UNIT = false;
    int lda;
    __device__ __forceinline__ void get(const Unit&, unsigned (&v)[2][2], const int (&R)[2], const int (&C)[2]) const {
#pragma unroll
        for (int h = 0; h < 2; ++h)
#pragma unroll
            for (int i = 0; i < 2; ++i) v[h][i] = (unsigned)((h * HALF + R[i]) * lda + C[i]) * 2u;
    }
};

__device__ __forceinline__ unsigned cvt_pk_bf16(float lo, float hi) { unsigned r; asm volatile("v_cvt_pk_bf16_f32 %0, %1, %2" : "=v"(r) : "v"(lo), "v"(hi)); return r; }
__device__ __forceinline__ f32x2 gelu_pk(f32x2 v) {
    const f32x2 av = __builtin_elementwise_abs(v), d = av * 0.2316418882f + 1.0f;
    f32x2 t; t.x = __builtin_amdgcn_rcpf(d.x); t.y = __builtin_amdgcn_rcpf(d.y);
    f32x2 q = t * 0.5307027145f + (-0.7265760135f); q = q * t + 0.7107068705f; q = q * t + (-0.142248368f); q = q * t + 0.127414796f; q = q * t;
    const f32x2 s = (v * v) * (-0.72134752044f);
    f32x2 e; e.x = __builtin_amdgcn_exp2f(s.x); e.y = __builtin_amdgcn_exp2f(s.y);
    const f32x2 m = v * (q * e), r = v - m;
    f32x2 o; o.x = v.x < 0.f ? m.x : r.x; o.y = v.y < 0.f ? m.y : r.y; return o;
}

template <class Epi, class Sched, class AOff, bool ALIGN_EPI = true>
__device__ __forceinline__ void gemm_phase(PG8_LAS unsigned char* lds, const int ldb, const Sched& S, const AOff& AO, const Epi& E) {
    const int tid = threadIdx.x, wid = __builtin_amdgcn_readfirstlane(tid >> 6), lane = tid & 63, wr = wid >> 2, wc = wid & 3, fr = lane & 15, fq = lane >> 4;
    unsigned voffB[2]; int RR[2], CC[2];
#pragma unroll
    for (int i = 0; i < 2; ++i) { int R, C; stage_rc(tid * 16 + i * 8192, R, C); RR[i] = R; CC[i] = C; const int Rb = Epi::PERM ? ((R & ~31) + perm32(R & 31)) : R;
        voffB[i] = (unsigned)(Rb * ldb + C) * 2u; }
    const size_t kstep = (size_t)(BK * 2);
    const size_t hstepB = (size_t)HALF * ldb * 2;
    const unsigned ldsw = (unsigned)wid * 1024u;
    const int aoff = lds_byte(wr * 64 + fr, fq * 8), boff = lds_byte(wc * 32 + fr, fq * 8);
#define PG8_SA(b, h) (((b) * 2 + (h)) * HTB)
#define PG8_SB(b, h) ((4 + (b) * 2 + (h)) * HTB)
#define PG8_STAGE(bufoff, gbase, voff) do { _Pragma("unroll") for (int _i = 0; _i < 2; ++_i) \
        __builtin_amdgcn_global_load_lds((const unsigned*)((const char*)(gbase) + (voff)[_i]), (PG8_LAS unsigned*)(lds + (bufoff) + ldsw + _i * 8192), 16, 0, 0); } while (0)
#define PG8_LDA(dst, b, h) do { _Pragma("unroll") for (int m = 0; m < 4; ++m) _Pragma("unroll") for (int k = 0; k < 2; ++k) dst[m][k] = *(const PG8_LAS bf16x8*)(lds + PG8_SA(b, h) + aoff + m * 2048 + k * 1024); } while (0)
#define PG8_LDB(dst, b, h) do { _Pragma("unroll") for (int n = 0; n < 2; ++n) _Pragma("unroll") for (int k = 0; k < 2; ++k) dst[n][k] = *(const PG8_LAS bf16x8*)(lds + PG8_SB(b, h) + boff + n * 2048 + k * 1024); } while (0)
#define PG8_MMA(ai, bj, At, Bt) do { __builtin_amdgcn_s_setprio(1); _Pragma("unroll") for (int m = 0; m < 4; ++m) _Pragma("unroll") for (int n = 0; n < 2; ++n) _Pragma("unroll") for (int k = 0; k < 2; ++k) \
        acc[ai][bj][m][n] = __builtin_amdgcn_mfma_f32_16x16x32_bf16(Bt[n][k], At[m][k], acc[ai][bj][m][n], 0, 0, 0); __builtin_amdgcn_s_setprio(0); } while (0)
#define PG8_WAIT_V(n) asm volatile("s_waitcnt vmcnt(" #n ")" ::: "memory")
#define PG8_WAIT_L(n) asm volatile("s_waitcnt lgkmcnt(" #n ")" ::: "memory")
#define PG8_BAR __builtin_amdgcn_s_barrier()
#define PG8_SCHED __builtin_amdgcn_sched_barrier(0)
    Unit cur, nxt; int ui = 0;
    if (!S.next(0, cur)) return;
    unsigned vAc[2][2], vAn[2][2];
    AO.get(cur, vAc, RR, CC);
    f32x4 acc[2][2][4][2];
#pragma unroll
    for (int a = 0; a < 2; ++a)
#pragma unroll
        for (int b = 0; b < 2; ++b)
#pragma unroll
            for (int m = 0; m < 4; ++m)
#pragma unroll
                for (int n = 0; n < 2; ++n) acc[a][b][m][n] = (f32x4){0.f, 0.f, 0.f, 0.f};
    bf16x8 At[4][2], B0[2][2], B1[2][2];
    const char* cA = cur.a; const char* cB = cur.b; int nt = cur.nt;
    PG8_STAGE(PG8_SB(0, 0), cB, voffB); PG8_STAGE(PG8_SB(0, 1), cB + hstepB, voffB); PG8_STAGE(PG8_SA(0, 0), cA, vAc[0]); PG8_STAGE(PG8_SA(0, 1), cA, vAc[1]);
    if (wr == 1) PG8_BAR;
    PG8_WAIT_V(2); PG8_BAR;
    PG8_STAGE(PG8_SB(1, 0), cB + kstep, voffB); PG8_STAGE(PG8_SA(1, 0), cA + kstep, vAc[0]); PG8_STAGE(PG8_SB(1, 1), cB + hstepB + kstep, voffB);
    PG8_WAIT_V(6); PG8_BAR;
    for (;;) {
        const bool has_next = S.next(ui + 1, nxt);
        if (AOff::PER_UNIT && has_next) AO.get(nxt, vAn, RR, CC);
        else {
#pragma unroll
            for (int h = 0; h < 2; ++h)
#pragma unroll
                for (int i = 0; i < 2; ++i) vAn[h][i] = vAc[h][i]; }
        const char* nA = has_next ? nxt.a : cA; const char* nB = has_next ? nxt.b : cB;
        for (int t = 0; t < nt; t += 2) {
            const bool last = (t == nt - 2);
            const char* a1 = cA + (size_t)(t + 1) * kstep;
            const char* a2 = last ? nA : cA + (size_t)(t + 2) * kstep; const char* b2 = last ? nB : cB + (size_t)(t + 2) * kstep;
            const char* a3 = a2 + kstep; const char* b3 = b2 + kstep;
            unsigned v2[2][2];
#pragma unroll
            for (int h = 0; h < 2; ++h)
#pragma unroll
                for (int i = 0; i < 2; ++i) v2[h][i] = last ? vAn[h][i] : vAc[h][i];
            PG8_LDB(B0, 0, 0); PG8_LDB(B1, 0, 1); PG8_SCHED; PG8_LDA(At, 0, 0); PG8_STAGE(PG8_SA(1, 1), a1, vAc[1]);
            PG8_WAIT_V(8); PG8_WAIT_L(0); PG8_BAR; PG8_MMA(0, 0, At, B0); PG8_MMA(0, 1, At, B1); PG8_BAR; PG8_SCHED;
            PG8_LDA(At, 0, 1); PG8_STAGE(PG8_SB(0, 0), b2, voffB); PG8_STAGE(PG8_SB(0, 1), b2 + hstepB, voffB); PG8_STAGE(PG8_SA(0, 0), a2, v2[0]);
            PG8_WAIT_V(8); PG8_WAIT_L(0); PG8_BAR; PG8_MMA(1, 0, At, B0); PG8_MMA(1, 1, At, B1); PG8_BAR; PG8_SCHED;
            PG8_LDB(B0, 1, 0); PG8_LDB(B1, 1, 1); PG8_SCHED; PG8_LDA(At, 1, 0); PG8_STAGE(PG8_SA(0, 1), a2, v2[1]);
            PG8_WAIT_V(8); PG8_WAIT_L(0); PG8_BAR; PG8_MMA(0, 0, At, B0); PG8_MMA(0, 1, At, B1); PG8_BAR; PG8_SCHED;
            PG8_LDA(At, 1, 1); PG8_STAGE(PG8_SB(1, 0), b3, voffB); PG8_STAGE(PG8_SB(1, 1), b3 + hstepB, voffB); PG8_STAGE(PG8_SA(1, 0), a3, v2[0]);
            PG8_WAIT_V(8); PG8_WAIT_L(0); PG8_BAR; PG8_MMA(1, 0, At, B0); PG8_MMA(1, 1, At, B1); PG8_BAR; PG8_SCHED;
        }
        if constexpr (ALIGN_EPI) { if (wr == 0) PG8_BAR; }
        E(acc, cur, wr, wc, fr, fq);
        if (!has_next) break;
#pragma unroll
        for (int a = 0; a < 2; ++a)
#pragma unroll
            for (int b = 0; b < 2; ++b)
#pragma unroll
                for (int m = 0; m < 4; ++m)
#pragma unroll
                    for (int n = 0; n < 2; ++n) acc[a][b][m][n] = (f32x4){0.f, 0.f, 0.f, 0.f};
        cur = nxt; cA = nA; cB = nB; nt = cur.nt; ++ui;
#pragma unroll
        for (int h = 0; h < 2; ++h)
#pragma unroll
            for (int i = 0; i < 2; ++i) vAc[h][i] = vAn[h][i];
        if constexpr (ALIGN_EPI) { if (wr == 1) PG8_BAR; }
    }
    PG8_WAIT_V(0);
    if constexpr (!ALIGN_EPI) { if (wr == 0) PG8_BAR; }
    PG8_BAR;
#undef PG8_SA
#undef PG8_SB
#undef PG8_STAGE
#undef PG8_LDA
#undef PG8_LDB
#undef PG8_MMA
#undef PG8_WAIT_V
#undef PG8_WAIT_L
#undef PG8_BAR
#undef PG8_SCHED
}
}
namespace attn_body {
using bf16=__hip_bfloat16;
using bf16x8=__attribute__((ext_vector_type(8)))short;
using s16x4=__attribute__((ext_vector_type(4)))short;
using f32x16=__attribute__((ext_vector_type(16)))float;
using u32x4=__attribute__((ext_vector_type(4)))unsigned;
constexpr int SEQ=8192,D=64;
constexpr int PQ=512,PK=512,PV=512,PO=1024;
constexpr int NW=8,QBLK=32,QB=QBLK*NW,KVBLK=64,NQB=SEQ/QB;
constexpr int ATTN_UNIT_ROWS=QB;
__device__ __forceinline__ int crow(int r,int hi){return (r&3)+8*(r>>2)+4*hi;}
#define SBAR() __builtin_amdgcn_sched_barrier(0)
__device__ __forceinline__ void cmask(f32x16&p0,f32x16&p1,int jb,int qrel,int hi){
  const float NEG=-INFINITY; int kb=64*jb+4*hi;
  #pragma unroll
  for(int r=0;r<16;++r){int kv=kb+(r&3)+8*(r>>2); if(kv>qrel)p0[r]=NEG; if(kv+32>qrel)p1[r]=NEG;}
}

constexpr int NSLOT=3, SLOTB=8192;
constexpr int LDS_K=0, LDS_V=NSLOT*SLOTB, LDS_WS=2*NSLOT*SLOTB, LDS_OST=LDS_WS+NW*64*4, LDS_BYTES=LDS_OST+NW*4096;
constexpr float C2=0.125f*1.4426950408889634f;
__device__ __forceinline__ void glds16(const void*gsrc,unsigned lds_dst){unsigned keep;
  asm volatile("s_mov_b32 %0, m0\n\ts_mov_b32 m0, %2\n\ts_nop 0\n\tglobal_load_lds_dwordx4 %1, off\n\ts_mov_b32 m0, %0":"=&s"(keep):"v"(gsrc),"s"(lds_dst):"memory");}
__device__ __forceinline__ float max3f(float a,float b,float c){float r;asm("v_max3_f32 %0, %1, %2, %3":"=v"(r):"v"(a),"v"(b),"v"(c));return r;}
__device__ __forceinline__ float max2f(float a,float b){float r;asm("v_max_f32_e32 %0, %1, %2":"=v"(r):"v"(a),"v"(b));return r;}
__device__ __forceinline__ float fadd_s(float a,float b){float r;asm("v_add_f32_e32 %0, %1, %2":"=v"(r):"v"(a),"v"(b));return r;}
__device__ __forceinline__ float fsub_s(float a,float b){float r;asm("v_sub_f32_e32 %0, %1, %2":"=v"(r):"v"(a),"v"(b));return r;}
typedef float f32x2_t __attribute__((ext_vector_type(2))); typedef __bf16 bf16x2_t __attribute__((ext_vector_type(2)));
__device__ __forceinline__ unsigned cvtpk_s(float lo,float hi){f32x2_t v={lo,hi};bf16x2_t b=__builtin_convertvector(v,bf16x2_t);return __builtin_bit_cast(unsigned,b);}
#define WAIT_BAR(N) asm volatile("s_waitcnt vmcnt(" #N ") lgkmcnt(0)\n\ts_barrier":::"memory")

__device__ __forceinline__ void qkt(f32x16&p0,f32x16&p1,const char*Kslot,const bf16x8*qr,const f32x16&negm,int r32,int hi){
  const char*kb=Kslot+hi*1024+r32*16;
  #pragma unroll
  for(int d0=0;d0<4;++d0){
    const bf16x8 b0=*reinterpret_cast<const bf16x8*>(kb+d0*2048);
    const bf16x8 b1=*reinterpret_cast<const bf16x8*>(kb+d0*2048+512);
    if(d0==0){p0=__builtin_amdgcn_mfma_f32_32x32x16_bf16(b0,qr[0],negm,0,0,0);p1=__builtin_amdgcn_mfma_f32_32x32x16_bf16(b1,qr[0],negm,0,0,0);}
    else{p0=__builtin_amdgcn_mfma_f32_32x32x16_bf16(b0,qr[d0],p0,0,0,0);p1=__builtin_amdgcn_mfma_f32_32x32x16_bf16(b1,qr[d0],p1,0,0,0);}}
}
typedef __attribute__((address_space(3))) const char* lds_cptr;
typedef short v4i16_t __attribute__((ext_vector_type(4)));
__device__ __forceinline__ void kload8(bf16x8*kf,lds_cptr kp){
  kf[0]=*(const __attribute__((address_space(3))) bf16x8*)(kp);      kf[1]=*(const __attribute__((address_space(3))) bf16x8*)(kp+512);
  kf[2]=*(const __attribute__((address_space(3))) bf16x8*)(kp+2048); kf[3]=*(const __attribute__((address_space(3))) bf16x8*)(kp+2560);
  kf[4]=*(const __attribute__((address_space(3))) bf16x8*)(kp+4096); kf[5]=*(const __attribute__((address_space(3))) bf16x8*)(kp+4608);
  kf[6]=*(const __attribute__((address_space(3))) bf16x8*)(kp+6144); kf[7]=*(const __attribute__((address_space(3))) bf16x8*)(kp+6656);
}
__device__ __forceinline__ void kload2(bf16x8*kf,lds_cptr kp,int j){ kf[2*j]=*(const __attribute__((address_space(3))) bf16x8*)(kp+j*2048); kf[2*j+1]=*(const __attribute__((address_space(3))) bf16x8*)(kp+j*2048+512); }
__device__ __forceinline__ s16x4 vtr(lds_cptr p){ return __builtin_bit_cast(s16x4,__builtin_amdgcn_ds_read_tr16_b64_v4i16((__attribute__((address_space(3))) v4i16_t*)p)); }
__device__ __forceinline__ float rowmax(const f32x16&p0,const f32x16&p1){
  float a=max3f(p0[0],p0[1],p1[0]),b=max3f(p0[2],p0[3],p1[1]);a=max3f(a,p1[2],p1[3]);
  #pragma unroll
  for(int r=4;r<16;r+=4){a=max3f(a,p0[r],p0[r+1]);b=max3f(b,p0[r+2],p0[r+3]);a=max3f(a,p1[r],p1[r+1]);b=max3f(b,p1[r+2],p1[r+3]);}
  const float m=max2f(a,b);
  auto rr=__builtin_amdgcn_permlane32_swap(__float_as_uint(m),__float_as_uint(m),false,false);
  return max2f(__uint_as_float(rr[0]),__uint_as_float(rr[1]));
}
__device__ __forceinline__ void pv(f32x16*o,int vb,bf16x8 pa0,bf16x8 pa1,bf16x8 pa2,bf16x8 pa3){
  #pragma unroll
  for(int d0=0;d0<2;++d0){s16x4 lo[4],hi[4];
    #pragma unroll
    for(int ks=0;ks<4;++ks){
      asm volatile("ds_read_b64_tr_b16 %0,%1 offset:%c2":"=&v"(lo[ks]):"v"(vb),"i"(d0*4096+ks*1024):"memory");
      asm volatile("ds_read_b64_tr_b16 %0,%1 offset:%c2":"=&v"(hi[ks]):"v"(vb),"i"(d0*4096+ks*1024+512):"memory");}
    asm volatile("s_waitcnt lgkmcnt(0)":::"memory");SBAR();
    #define PK(k) (bf16x8){lo[k][0],lo[k][1],lo[k][2],lo[k][3],hi[k][0],hi[k][1],hi[k][2],hi[k][3]}
    o[d0]=__builtin_amdgcn_mfma_f32_32x32x16_bf16(pa0,PK(0),o[d0],0,0,0);
    o[d0]=__builtin_amdgcn_mfma_f32_32x32x16_bf16(pa1,PK(1),o[d0],0,0,0);
    o[d0]=__builtin_amdgcn_mfma_f32_32x32x16_bf16(pa2,PK(2),o[d0],0,0,0);
    o[d0]=__builtin_amdgcn_mfma_f32_32x32x16_bf16(pa3,PK(3),o[d0],0,0,0);
    #undef PK
  }
}

#ifndef ATTN_STORE16
#define ATTN_STORE16(p,v) (*(u32x4*)(p)=(v))
#endif
template<int THRL> __device__ __forceinline__ void attn_unit(int b,int qoff,int koff,int voff,int ooff,int qb,const bf16*Q,const bf16*__restrict__ K,const bf16*__restrict__ V,bf16*O,char*shm){
  const int tid=threadIdx.x,lane=tid&63,r32=lane&31,hi=lane>>5; const int wid=__builtin_amdgcn_readfirstlane(tid>>6);
  const long rowbase=(long)b*SEQ; const int q0=qb*QB;
  const bf16*Qw=Q+(rowbase+q0+wid*QBLK)*PQ+qoff;
  const bf16*Kh=K+rowbase*PK+koff,*Vh=V+rowbase*PV+voff;
  const unsigned lds0=(unsigned)(uintptr_t)shm;
  float*wsf=(float*)(shm+LDS_WS)+wid*64;
  const bf16*ksrc=Kh+(long)lane*PK+wid*8;
  const bf16*vsrc=Vh+(long)(16*(wid&3)+(lane>>2))*PV+(wid>>2)*32+(lane&3)*8;
  const unsigned kdst=lds0+LDS_K+wid*1024, vdst=lds0+LDS_V+wid*1024;
  #define DMA_K(t,slot) glds16(ksrc+(long)(t)*KVBLK*PK,(unsigned)__builtin_amdgcn_readfirstlane(kdst+(slot)))
  #define DMA_V(t,slot) glds16(vsrc+(long)(t)*KVBLK*PV,(unsigned)__builtin_amdgcn_readfirstlane(vdst+(slot)))
  const int vb0=(int)(lds0+LDS_V)+((lane>>4)&1)*32+(lane&3)*8+(4*hi+((lane&15)>>2))*64;
  const char*Kbase=shm+LDS_K; bf16x8 kf[8];
  const lds_cptr shm3=(lds_cptr)shm; const lds_cptr kp0=shm3+LDS_K+hi*1024+r32*16; const lds_cptr vp0=shm3+LDS_V+((lane>>4)&1)*32+(lane&3)*8+(4*hi+((lane&15)>>2))*64;
  const int NT=(q0+QB)/KVBLK;
  DMA_K(0,0);DMA_V(0,0);DMA_K(1,SLOTB);
  bf16x8 qr[4];
  #pragma unroll
  for(int d0=0;d0<4;++d0)qr[d0]=*reinterpret_cast<const bf16x8*>(&Qw[(long)r32*PQ+d0*16+hi*8]);
  float mhat=0.f,l_reg=0.f;f32x16 o[2];o[0]=f32x16{};o[1]=f32x16{};f32x16 negm=f32x16{};asm volatile("":"+v"(negm));
  const int qrel=wid*QBLK+r32;
  #define CMASK(P0,P1,t) do{int jb_=(t)-(NT-4); if(jb_>=0)cmask(P0,P1,jb_,qrel,hi);}while(0)
  bool resc=false;
  #define START(P0,P1) do{ const float rm=rowmax(P0,P1); resc=false; \
    { const float dl=rm; mhat=fadd_s(mhat,dl); \
      _Pragma("unroll") for(int r=0;r<16;++r){P0[r]=fsub_s(P0[r],dl);P1[r]=fsub_s(P1[r],dl);} \
      _Pragma("unroll") for(int r=0;r<16;++r)negm[r]=-mhat; asm volatile("":"+v"(negm)); } \
    _Pragma("unroll") for(int r=0;r<16;++r)P0[r]=__builtin_amdgcn_exp2f(P0[r]); }while(0)
  #define RESC() do{ if(resc){ asm volatile("s_waitcnt lgkmcnt(0)":::"memory"); \
      _Pragma("unroll") for(int d_=0;d_<2;++d_) _Pragma("unroll") for(int r=0;r<16;++r)o[d_][r]*=wsf[crow(r,hi)]; } }while(0)
  f32x16 pA0,pA1,pB0,pB1;
  int sl_prev=0,sl_cur=0,sl_next=SLOTB;
  #define ROT() do{sl_prev=sl_cur;sl_cur=sl_next;sl_next=(sl_next==(NSLOT-1)*SLOTB)?0:sl_next+SLOTB;}while(0)
  DMA_K(2,2*SLOTB);
  WAIT_BAR(3);
  qkt(pA0,pA1,Kbase,qr,negm,r32,hi);asm volatile("s_nop 15\n\ts_nop 7":"+v"(pA0),"+v"(pA1));CMASK(pA0,pA1,0);
  START(pA0,pA1);
  _Pragma("unroll") for(int r=0;r<16;++r)pA1[r]=__builtin_amdgcn_exp2f(pA1[r]);
  WAIT_BAR(0);
  DMA_K(3,0);DMA_V(1,SLOTB);
  ROT();
  kload8(kf,kp0+sl_cur);
  WAIT_BAR(2);
  s16x4 vlo[8],vhi[8]; u32x4 pw0,pw1,pw2,pw3;
  #define PKW(P,B) cvtpk_s(P[B],P[B+1])
  #define PAF(k) __builtin_bit_cast(bf16x8,pw##k)
  #define VFR(i) (bf16x8){vlo[i][0],vlo[i][1],vlo[i][2],vlo[i][3],vhi[i][0],vhi[i][1],vhi[i][2],vhi[i][3]}
  #define PIN(x) asm volatile("":"+v"(x))
  #define MX3(a,b,c) __builtin_fmaxf(__builtin_fmaxf((a),(b)),(c))
  #define GAPA(MF,A0,A1,A2,A3,W0,W1,PW) do{ MF; sacc+=A0; sacc+=A1; sacc+=A2; sacc+=A3; PIN(sacc); W0; W1; PIN(PW); SBAR(); }while(0)
  #define EX(v) __builtin_amdgcn_exp2f(v)
  #define GAPB(MF,X,B) do{ MF; X[B]=EX(X[B]); X[B+1]=EX(X[B+1]); X[B+2]=EX(X[B+2]); X[B+3]=EX(X[B+3]); PIN(X); SBAR(); }while(0)
  #define VRD(i) do{ vlo[i]=vtr(vp_+(((i)>>2)*4096+((i)&3)*1024)); vhi[i]=vtr(vp_+(((i)>>2)*4096+((i)&3)*1024+512)); }while(0)
  #define KRD(G,j) do{ if(G){ kload2(kf,kp0+sl_next,j); SBAR(); } }while(0)
  #define STEP(C0,C1,P0,P1,t,GK,GV,GL) do{ SBAR(); \
    const lds_cptr vp_=vp0+sl_prev; \
    VRD(0); SBAR(); float sacc=(P0[0]+P0[1]); \
    GAPA(C0=__builtin_amdgcn_mfma_f32_32x32x16_bf16(kf[0],qr[0],negm,0,0,0), P0[2],P0[3],P0[4],P0[5],     pw0[0]=PKW(P0,0), pw0[1]=PKW(P0,2), pw0); \
    VRD(4); SBAR(); GAPA(C1=__builtin_amdgcn_mfma_f32_32x32x16_bf16(kf[1],qr[0],negm,0,0,0), P0[6],P0[7],P0[8],P0[9],     pw0[2]=PKW(P0,4), pw0[3]=PKW(P0,6), pw0); \
    VRD(1); SBAR(); GAPA(C0=__builtin_amdgcn_mfma_f32_32x32x16_bf16(kf[2],qr[1],C0,0,0,0),   P0[10],P0[11],P0[12],P0[13], pw1[0]=PKW(P0,8), pw1[1]=PKW(P0,10), pw1); \
    VRD(5); SBAR(); GAPA(C1=__builtin_amdgcn_mfma_f32_32x32x16_bf16(kf[3],qr[1],C1,0,0,0),   P0[14],P0[15],P1[0],P1[1],   pw1[2]=PKW(P0,12),pw1[3]=PKW(P0,14), pw1); \
    VRD(2); SBAR(); GAPA(C0=__builtin_amdgcn_mfma_f32_32x32x16_bf16(kf[4],qr[2],C0,0,0,0),   P1[2],P1[3],P1[4],P1[5],     pw2[0]=PKW(P1,0), pw2[1]=PKW(P1,2), pw2); \
    VRD(6); SBAR(); GAPA(C1=__builtin_amdgcn_mfma_f32_32x32x16_bf16(kf[5],qr[2],C1,0,0,0),   P1[6],P1[7],P1[8],P1[9],     pw2[2]=PKW(P1,4), pw2[3]=PKW(P1,6), pw2); \
    VRD(3); SBAR(); GAPA(C0=__builtin_amdgcn_mfma_f32_32x32x16_bf16(kf[6],qr[3],C0,0,0,0),   P1[10],P1[11],P1[12],P1[13], pw3[0]=PKW(P1,8), pw3[1]=PKW(P1,10), pw3); \
    VRD(7); SBAR(); GAPA(C1=__builtin_amdgcn_mfma_f32_32x32x16_bf16(kf[7],qr[3],C1,0,0,0),   P1[14],P1[15],0.f,0.f,       pw3[2]=PKW(P1,12),pw3[3]=PKW(P1,14), pw3); \
    l_reg+=sacc; \
    if(GK){DMA_K((t)+3,sl_cur);} if(GV){DMA_V((t)+1,sl_next);} \
    CMASK(C0,C1,t); \
    { float a=MX3(C0[0],C0[1],C1[0]),b=MX3(C0[2],C0[3],C1[1]); a=MX3(a,C1[2],C1[3]); \
      _Pragma("unroll") for(int r=4;r<16;r+=4){a=MX3(a,C0[r],C0[r+1]);b=MX3(b,C0[r+2],C0[r+3]);a=MX3(a,C1[r],C1[r+1]);b=MX3(b,C1[r+2],C1[r+3]);} \
      float rm=__builtin_fmaxf(a,b); { auto rr=__builtin_amdgcn_permlane32_swap(__float_as_uint(rm),__float_as_uint(rm),false,false); rm=__builtin_fmaxf(__uint_as_float(rr[0]),__uint_as_float(rr[1])); } \
      resc=false; \
      if(__builtin_expect(__any(rm>(float)THRL),0)){ const float dl=__builtin_fmaxf(rm,0.f); mhat+=dl; \
        _Pragma("unroll") for(int r=0;r<16;++r){C0[r]-=dl;C1[r]-=dl;} \
        _Pragma("unroll") for(int r=0;r<16;++r)negm[r]=-mhat; asm volatile("":"+v"(negm)); \
        const float f=__builtin_amdgcn_exp2f(-dl); l_reg*=f; if(hi==0)wsf[r32]=f; resc=true; } } \
    SBAR(); \
    GAPB(o[0]=__builtin_amdgcn_mfma_f32_32x32x16_bf16(PAF(0),VFR(0),o[0],0,0,0), C0,0); \
    GAPB(o[1]=__builtin_amdgcn_mfma_f32_32x32x16_bf16(PAF(0),VFR(4),o[1],0,0,0), C0,4); \
    KRD(GL,0); GAPB(o[0]=__builtin_amdgcn_mfma_f32_32x32x16_bf16(PAF(1),VFR(1),o[0],0,0,0), C0,8); \
    KRD(GL,1); GAPB(o[1]=__builtin_amdgcn_mfma_f32_32x32x16_bf16(PAF(1),VFR(5),o[1],0,0,0), C0,12); \
    KRD(GL,2); GAPB(o[0]=__builtin_amdgcn_mfma_f32_32x32x16_bf16(PAF(2),VFR(2),o[0],0,0,0), C1,0); \
    KRD(GL,3); GAPB(o[1]=__builtin_amdgcn_mfma_f32_32x32x16_bf16(PAF(2),VFR(6),o[1],0,0,0), C1,4); \
    GAPB(o[0]=__builtin_amdgcn_mfma_f32_32x32x16_bf16(PAF(3),VFR(3),o[0],0,0,0), C1,8); \
    GAPB(o[1]=__builtin_amdgcn_mfma_f32_32x32x16_bf16(PAF(3),VFR(7),o[1],0,0,0), C1,12); \
    }while(0)
  int t=1;
  #undef CMASK
  #define CMASK(P0,P1,t) do{}while(0)
  for(;t+5<NT;t+=2){
    STEP(pB0,pB1,pA0,pA1,t,true,true,true);     WAIT_BAR(2); RESC(); ROT();
    STEP(pA0,pA1,pB0,pB1,t+1,true,true,true);   WAIT_BAR(2); RESC(); ROT();
  }
  #undef CMASK
  #define CMASK(P0,P1,t) do{int jb_=(t)-(NT-4); if(jb_>=0)cmask(P0,P1,jb_,qrel,hi);}while(0)
  #define ENDW(tt) do{ if((tt)+3<NT){WAIT_BAR(2);} else if((tt)+2<NT){WAIT_BAR(1);} else {WAIT_BAR(0);} }while(0)
  for(;t+1<NT;t+=2){
    STEP(pB0,pB1,pA0,pA1,t,(t+3<NT),(t+1<NT),(t+1<NT));       ENDW(t);   RESC(); ROT();
    STEP(pA0,pA1,pB0,pB1,t+1,(t+4<NT),(t+2<NT),(t+2<NT));     ENDW(t+1); RESC(); ROT();
  }
  STEP(pB0,pB1,pA0,pA1,NT-1,false,false,false); RESC();
  { float sacc=pB0[0]+pB0[1]; _Pragma("unroll") for(int r=2;r<16;++r)sacc+=pB0[r]; _Pragma("unroll") for(int r=0;r<16;++r)sacc+=pB1[r]; l_reg+=sacc;
    pw0=(u32x4){PKW(pB0,0),PKW(pB0,2),PKW(pB0,4),PKW(pB0,6)};pw1=(u32x4){PKW(pB0,8),PKW(pB0,10),PKW(pB0,12),PKW(pB0,14)};pw2=(u32x4){PKW(pB1,0),PKW(pB1,2),PKW(pB1,4),PKW(pB1,6)};pw3=(u32x4){PKW(pB1,8),PKW(pB1,10),PKW(pB1,12),PKW(pB1,14)};
    SBAR(); pv(o,vb0+sl_cur,PAF(0),PAF(1),PAF(2),PAF(3)); }
  #undef PKW
  #undef PAF
  #undef VFR
  #undef PIN
  #undef MX3
  #undef GAPA
  #undef GAPB
  #undef EX
  #undef VRD
  #undef KRD
  #undef STEP
  #undef ENDW
  {auto rr=__builtin_amdgcn_permlane32_swap(__float_as_uint(l_reg),__float_as_uint(l_reg),false,false);l_reg=__uint_as_float(rr[0])+__uint_as_float(rr[1]);}
  if(hi==0)wsf[32+r32]=l_reg;asm volatile("s_waitcnt lgkmcnt(0)":::"memory");
  float rli[16];
  #pragma unroll
  for(int r=0;r<16;++r)rli[r]=__builtin_amdgcn_rcpf(wsf[32+crow(r,hi)]);
  bf16*Ow=O+(rowbase+q0+wid*QBLK)*PO+ooff;
  { bf16*stg=(bf16*)(shm+LDS_OST)+wid*2048;
    #pragma unroll
    for(int r=0;r<16;++r){const int orow=crow(r,hi);
      #pragma unroll
      for(int d0=0;d0<2;++d0)stg[orow*64+d0*32+r32]=__float2bfloat16(o[d0][r]*rli[r]);}
    asm volatile("s_waitcnt lgkmcnt(0)":::"memory");
    #pragma unroll
    for(int i=0;i<4;++i){const int row=i*8+(lane>>3),ch=lane&7; const u32x4 v=*(const u32x4*)(stg+row*64+ch*8); ATTN_STORE16(Ow+(long)row*PO+ch*8,v);} }
  asm volatile("s_waitcnt lgkmcnt(0)\n\ts_barrier":::"memory");
  #undef DMA_K
  #undef DMA_V
  #undef CMASK
  #undef START
  #undef RESC
  #undef ROT
}
constexpr int ATTN_LDS_BYTES=LDS_BYTES;
#undef SBAR
#undef WAIT_BAR
}
#define GAS __attribute__((address_space(1)))
#define LAS __attribute__((address_space(3)))
typedef unsigned short bf16;
typedef unsigned v4u __attribute__((ext_vector_type(4)));
typedef float f32x4 __attribute__((ext_vector_type(4)));
typedef short bf16x8 __attribute__((ext_vector_type(8)));
typedef GAS unsigned gu32;
typedef GAS unsigned long long gu64;
#define RLX_AGENT __ATOMIC_RELAXED, __HIP_MEMORY_SCOPE_AGENT
#define LDS_WAIT() asm volatile("s_waitcnt lgkmcnt(0)" ::: "memory")
#define VM_WAIT() asm volatile("s_waitcnt vmcnt(0)" ::: "memory")
__device__ __forceinline__ unsigned long long rt() { return __builtin_amdgcn_s_memrealtime(); }
__device__ __forceinline__ unsigned f2bf(float f) { unsigned u = __builtin_bit_cast(unsigned, f); return (u + 0x7fffu + ((u >> 16) & 1u)) >> 16; }
__device__ __forceinline__ unsigned pk2(float lo, float hi) { return f2bf(lo) | (f2bf(hi) << 16); }

#define XB_TMO      128
#define XB_XCNT(j)  (256  + 64 * (j))
#define XB_XSUB(j)  (1280 + 64 * (j))
#define XB_XGEN(j)  (2304 + 64 * (j))
#define XB_TOP      3328
#define XB_TOPGEN   3392
#define XCD_BAR_WORDS 3456
#define XB_SPIN_CAP (1u << 18)

__device__ __forceinline__ unsigned xb_ld(unsigned* p)              { return __hip_atomic_load(p, __ATOMIC_RELAXED, __HIP_MEMORY_SCOPE_AGENT); }
__device__ __forceinline__ unsigned xb_add(unsigned* p, unsigned v) { return __hip_atomic_fetch_add(p, v, __ATOMIC_RELAXED, __HIP_MEMORY_SCOPE_AGENT); }
__device__ __forceinline__ unsigned xb_xcc_id() { return (unsigned)__builtin_amdgcn_s_getreg((3 << 11) | 20) & 0xFu; }
#define XB_SPIN(cond, bar) do { unsigned _sp = 0; while (cond) { __builtin_amdgcn_s_sleep(1); \
    if ((++_sp & 255u) == 0u) { if (xb_ld(&(bar)[XB_TMO])) break; if (_sp > XB_SPIN_CAP) { atomicAdd(&(bar)[XB_TMO], 1u); break; } } } } while (0)

struct XcdBarrier {
    unsigned* bar; unsigned x;
    volatile LAS unsigned* st;
};

__device__ __forceinline__ XcdBarrier xcd_barrier_post(unsigned* bar, volatile LAS unsigned* st) {
    XcdBarrier b; b.bar = bar; b.x = xb_xcc_id(); b.st = st;
    if (threadIdx.x == 0) (void)xb_add(&bar[XB_XCNT(b.x)], 1u);
    return b;
}
__device__ __forceinline__ void xcd_barrier_complete(unsigned* bar, unsigned x, unsigned& nloc, unsigned& nx) {
    const unsigned G = gridDim.x * gridDim.y * gridDim.z;
    unsigned sum, cnt, mine, sp = 0u;
    for (;;) {
        sum = 0u; cnt = 0u; mine = 0u;
#pragma unroll
        for (unsigned j = 0; j < 16; ++j) { const unsigned c = xb_ld(&bar[XB_XCNT(j)]); sum += c; cnt += (c > 0u) ? 1u : 0u; mine = (j == x) ? c : mine; }
        if (sum == G) break;
        __builtin_amdgcn_s_sleep(1);
        if ((++sp & 255u) == 0u) { if (xb_ld(&bar[XB_TMO])) break; if (sp > XB_SPIN_CAP) { atomicAdd(&bar[XB_TMO], 1u); break; } }
    }
    nloc = mine > 0u ? mine : 1u; nx = cnt > 0u ? cnt : 1u;
}

__device__ __forceinline__ void xcd_barrier(const XcdBarrier& b) {
    asm volatile("s_waitcnt vmcnt(0)" ::: "memory");
    __syncthreads();
    if (threadIdx.x == 0) {
        unsigned* bar = b.bar;
        __builtin_amdgcn_s_waitcnt(0);
        unsigned nloc = b.st[0], nx = b.st[1];
        if (nloc == 0u) { xcd_barrier_complete(bar, b.x, nloc, nx); b.st[0] = nloc; b.st[1] = nx; }
        const unsigned old = xb_add(&bar[XB_XSUB(b.x)], 1u);
        const unsigned gen = old / nloc;
        if (old + 1u == (gen + 1u) * nloc) {
            __builtin_amdgcn_fence(__ATOMIC_RELEASE, "agent");
            asm volatile("s_waitcnt vmcnt(0)" ::: "memory");
            const unsigned og = xb_add(&bar[XB_TOP], 1u);
            const unsigned tg = og / nx;
            if (og + 1u == (tg + 1u) * nx) xb_add(&bar[XB_TOPGEN], 1u);
            else XB_SPIN(xb_ld(&bar[XB_TOPGEN]) == tg, bar);
            __builtin_amdgcn_fence(__ATOMIC_ACQUIRE, "agent");
            xb_add(&bar[XB_XGEN(b.x)], 1u);
            asm volatile("s_waitcnt vmcnt(0)" ::: "memory");
        } else {
            XB_SPIN(xb_ld(&bar[XB_XGEN(b.x)]) == gen, bar);
            __builtin_amdgcn_fence(__ATOMIC_ACQUIRE, "agent");
            asm volatile("s_waitcnt vmcnt(0)" ::: "memory");
        }
    }
    __syncthreads();
}
constexpr int NWAVES = 8;
#ifndef MK_N_LAUNCHES
#define MK_N_LAUNCHES 12
#endif
constexpr int NPH = 12;
constexpr int N_LAUNCHES = MK_N_LAUNCHES;
static_assert(N_LAUNCHES == 1 || N_LAUNCHES == NPH, "MK_N_LAUNCHES is 1 or 12");

constexpr int NB = 4, SEQ = 8192, T = NB * SEQ, D = 1024;
constexpr int NE = 32, TOPK = 4, NA = T * TOPK;
constexpr int SG = 32, SL = 32, AROW_P = 640;
constexpr float RMS_EPS = 1e-6f;
constexpr float SW_LIMIT = 7.0f, SW_ALPHA = 1.702f;
constexpr float LAMBDA_INIT = 0.2f;

constexpr size_t MiB = 1u << 20;
constexpr size_t WS_CTL = 0, CTL_ZERO_BYTES = 1 * MiB;
constexpr size_t WS_ROPE = 2 * MiB;
constexpr size_t WS_WIN = 4 * MiB;
constexpr size_t WS_WOUT = 8 * MiB;
constexpr size_t WS_WGLU = 10 * MiB;
constexpr size_t WS_SMALL = 11 * MiB;
constexpr size_t SM_AL = 1024, SM_WR = 32768;
constexpr size_t WS_BTY = 12 * MiB;
constexpr size_t WS_BTX = 32 * MiB;
constexpr size_t WS_WGU = 40 * MiB;
constexpr size_t WS_WD = 168 * MiB;
constexpr size_t WS_XN = 232 * MiB;
constexpr size_t WS_Q = 296 * MiB, WS_K = 328 * MiB, WS_V = 360 * MiB;
constexpr size_t WS_AROW = 392 * MiB;
constexpr size_t WS_XLOC = 432 * MiB;
constexpr size_t WS_O = 464 * MiB;
constexpr size_t WS_ACAT = 528 * MiB;
constexpr size_t WS_YG = 592 * MiB;
constexpr size_t WS_GLU = 624 * MiB;
constexpr size_t WS_LIST = 656 * MiB;
constexpr size_t WS_GATES = 660 * MiB;
constexpr size_t WS_ACT = 296 * MiB;
constexpr size_t WS_YBUF = 664 * MiB;
constexpr size_t WS_END = 920 * MiB;
static_assert(WS_ACT + (size_t)(NA + 8192) * 1024 * 2 <= WS_YG, "Act overlay");
constexpr int CW_TMO = 0, CW_CODE = 1;
constexpr int CW_BAR = 4096;
constexpr int CW_ECNT = 16384;

constexpr int RING_OFF = 0, RING_BYTES = 131072;
constexpr int WRT_BYTES = 1024 * 36 * 4;
constexpr int LDSCTL_OFF = 147456, MISC_OFF = LDSCTL_OFF;
constexpr int MOE_OFF = LDSCTL_OFF + 256;
constexpr int RT_OFF = LDSCTL_OFF + 640;
constexpr int ST_OFF = LDSCTL_OFF + 1024;
constexpr int LDS_BYTES = 155648;
static_assert(ST_OFF + 3 * 2048 <= LDS_BYTES, "LDS map");

struct Args { const void* in[29]; float* out; unsigned char* ws; int ph_lo, ph_hi, li, pad; };
struct Frame {
    LAS unsigned char* lds;
    volatile LAS unsigned* MISC;
    gu32* ctl;
    int tid, lane, wave;
    int vcu, G;
};
#define INF(a, k) ((const float*)(a).in[k])

__device__ __forceinline__ float wave_sum(float v) {
#pragma unroll
    for (int o = 1; o < 64; o <<= 1) v += __shfl_xor(v, o);
    return v;
}
__device__ __forceinline__ void p0_transpose_item(const float* W, int K, int N, bf16* WT, LAS float* scr, int item, int lane) {
    const int nblk = N / 32, kb = item / nblk, nb = item % nblk, k0 = 64 * kb, n0 = 32 * nb;
#pragma unroll 8
    for (int i = 0; i < 32; ++i) { const int kk = 2 * i + (lane >> 5); scr[kk * 33 + (lane & 31)] = W[(size_t)(k0 + kk) * N + n0 + (lane & 31)]; }
    LDS_WAIT(); asm volatile("" ::: "memory");
    const int c = lane & 7;
#pragma unroll
    for (int j = 0; j < 4; ++j) { const int n = (lane >> 3) + 8 * j; const LAS float* s = scr + (8 * c) * 33 + n;
        v4u o; o.x = pk2(s[0 * 33], s[1 * 33]); o.y = pk2(s[2 * 33], s[3 * 33]); o.z = pk2(s[4 * 33], s[5 * 33]); o.w = pk2(s[6 * 33], s[7 * 33]);
        *(GAS v4u*)(WT + (size_t)(n0 + n) * K + k0 + 8 * c) = o; }
    LDS_WAIT(); asm volatile("" ::: "memory");
}
__device__ __forceinline__ void rms_row_to_bf16(int lane, const float* xrow, const float* g, bf16* orow) {
    const GAS f32x4* xr = (const GAS f32x4*)xrow + lane; const GAS f32x4* gr = (const GAS f32x4*)g + lane;
    f32x4 v[4]; float s = 0.f;
#pragma unroll
    for (int j = 0; j < 4; ++j) { v[j] = xr[64 * j]; s += (v[j].x * v[j].x + v[j].y * v[j].y) + (v[j].z * v[j].z + v[j].w * v[j].w); }
    const float rstd = 1.f / sqrtf(wave_sum(s) * (1.f / D) + RMS_EPS);
    GAS unsigned long long* o8 = (GAS unsigned long long*)orow + lane;
#pragma unroll
    for (int j = 0; j < 4; ++j) { const f32x4 gg = gr[64 * j];
        o8[64 * j] = (unsigned long long)pk2(v[j].x * rstd * gg.x, v[j].y * rstd * gg.y) | ((unsigned long long)pk2(v[j].z * rstd * gg.z, v[j].w * rstd * gg.w) << 32); }
}

__device__ __forceinline__ void s5_setup(Frame& F, const Args& a, int g, int sp) {
    LAS float* L = (LAS float*)F.lds;
    LAS float* APr = L, *APi = L + 2112, *BBr = L + 4224, *BBi = L + 5248, *CCr = L + 6272, *CCi = L + 7296, *KT = L + 8320;
    const int tid = F.tid;
    const float* dsk = INF(a, 15);
    if (tid < 64) {
        const int n = tid;
        const float dt = expf(INF(a, 16)[g]);
        const float lre = INF(a, 9)[g * 64 + n], lim = INF(a, 10)[g * 64 + n];
        const float mag = expf(lre * dt); float sn, cs; sincosf(lim * dt, &sn, &cs);
        const float ar = mag * cs, ai = mag * sn;
        const float nr = ar - 1.f, ni = ai, den = lre * lre + lim * lim;
        const float cr = (nr * lre + ni * lim) / den, ci = (ni * lre - nr * lim) / den;
        float pr = 1.f, pi = 0.f;
        for (int tau = 0; tau <= 32; ++tau) { APr[tau * 64 + n] = pr; APi[tau * 64 + n] = pi; const float t0 = pr * ar - pi * ai, t1 = pr * ai + pi * ar; pr = t0; pi = t1; }
        const float* bre = INF(a, 11) + (size_t)(g * 64 + n) * 16; const float* bim = INF(a, 12) + (size_t)(g * 64 + n) * 16;
        for (int c = 0; c < 16; ++c) { const float br = bre[c], bi = bim[c]; BBr[n * 16 + c] = cr * br - ci * bi; BBi[n * 16 + c] = cr * bi + ci * br; }
    }
    for (int i = tid; i < 1024; i += 512) { CCr[i] = INF(a, 13)[g * 1024 + i]; CCi[i] = INF(a, 14)[g * 1024 + i]; }
    __syncthreads();
    for (int idx = tid; idx < 8192; idx += 512) {
        const int tau = idx >> 8, c = (idx >> 4) & 15, cp = idx & 15; float s = 0.f;
        for (int n = 0; n < 64; ++n) { const float apr = APr[tau * 64 + n], api = APi[tau * 64 + n], br = BBr[n * 16 + cp], bi = BBi[n * 16 + cp];
            const float mr = apr * br - api * bi, mi = apr * bi + api * br; s += CCr[c * 64 + n] * mr - CCi[c * 64 + n] * mi; }
        KT[idx] = s;
    }
    __syncthreads();
    bf16* BtY = (bf16*)(a.ws + WS_BTY); bf16* BtX = (bf16*)(a.ws + WS_BTX);
    for (int p = tid; p < 20480; p += 512) {
        const int rl = p / 320, kp = (p % 320) * 2, t = 4 * sp + (rl >> 4), c = rl & 15; float v[2];
#pragma unroll
        for (int q = 0; q < 2; ++q) { const int k = kp + q; float r;
            if (k < 64) r = CCr[c * 64 + k] * APr[(t + 1) * 64 + k] - CCi[c * 64 + k] * APi[(t + 1) * 64 + k];
            else if (k < 128) { const int n = k - 64; r = -(CCr[c * 64 + n] * APi[(t + 1) * 64 + n] + CCi[c * 64 + n] * APr[(t + 1) * 64 + n]); }
            else { const int s = (k - 128) >> 4, cp = (k - 128) & 15; r = 0.f; if (s <= t) { r = KT[(t - s) * 256 + c * 16 + cp]; if (s == t && c == cp) r += dsk[g * 16 + c]; } }
            v[q] = r; }
        *(GAS unsigned*)(BtY + ((size_t)(g * 512 + t * 16 + c) * 640 + kp)) = pk2(v[0], v[1]);
    }
    for (int p = tid; p < 8192; p += 512) {
        const int rl = p >> 8, kp = (p & 255) * 2, j = 32 * sp + rl; float v[2];
#pragma unroll
        for (int q = 0; q < 2; ++q) { const int k = kp + q, s = k >> 4, cp = k & 15; float r = 0.f;
            if (j < 128) { const int n = j & 63; const float apr = APr[(31 - s) * 64 + n], api = APi[(31 - s) * 64 + n], br = BBr[n * 16 + cp], bi = BBi[n * 16 + cp];
                r = (j < 64) ? (apr * br - api * bi) : (apr * bi + api * br); }
            v[q] = r; }
        *(GAS unsigned*)(BtX + ((size_t)(g * 256 + j) * 512 + kp)) = pk2(v[0], v[1]);
    }
    if (sp == 0 && tid < 64) { float* AL = (float*)(a.ws + WS_SMALL + SM_AL); AL[(g * 64 + tid) * 2] = APr[32 * 64 + tid]; AL[(g * 64 + tid) * 2 + 1] = APi[32 * 64 + tid]; }
    __syncthreads();
}

__device__ __forceinline__ void p0_prologue(Frame& F, const Args& a) {
    for (int item = blockIdx.x; item < 256; item += F.G) s5_setup(F, a, item & 31, item >> 5);
    const int gt = blockIdx.x * (NWAVES * 64) + F.tid, NGT = F.G * NWAVES * 64;
    if (blockIdx.x == 0 && F.wave == 0) {
        const float p1 = wave_sum(INF(a, 4)[F.lane] * INF(a, 5)[F.lane]), p2 = wave_sum(INF(a, 6)[F.lane] * INF(a, 7)[F.lane]);
        if (F.lane == 0) *(float*)(a.ws + WS_SMALL) = expf(p1) - expf(p2) + LAMBDA_INIT;
    }
    { float* WR = (float*)(a.ws + WS_SMALL + SM_WR);
      for (int i = gt; i < 1024 * 36; i += NGT) { const int k = i / 36, e = i % 36; WR[i] = e < 32 ? INF(a, 21)[k] * INF(a, 22)[k * 32 + e] : 0.f; } }
    { float* RP = (float*)(a.ws + WS_ROPE); const int* pos = (const int*)a.in[1];
      for (int i = gt; i < T * 8; i += NGT) { const int m = i >> 3, j = i & 7;
          const float invf = j == 0 ? 1.0f : j == 1 ? 1.9392274e-01f : j == 2 ? 3.7606031e-02f : j == 3 ? 7.2926646e-03f : j == 4 ? 1.4142136e-03f : j == 5 ? 2.7424819e-04f : j == 6 ? 5.3182961e-05f : 1.0313386e-05f;
          const float ang = (float)pos[m] * invf; float sn, cs; sincosf(ang, &sn, &cs); RP[m * 16 + j] = cs; RP[m * 16 + 8 + j] = sn; } }
    LAS float* scr = (LAS float*)(F.lds + RING_OFF + F.wave * 16384);
    const int gw = F.vcu * NWAVES + F.wave, NGW = F.G * NWAVES;
    constexpr int I_IN = 16 * 64, I_OUT = 16 * 32, I_GLU = 8 * 16, I_GU = 16 * 64, I_D = 16 * 32;
    constexpr int NITEMS = I_IN + I_OUT + I_GLU + 32 * I_GU + 32 * I_D;
    for (int it = gw; it < NITEMS; it += NGW) {
        int r = it;
        if (r < I_IN) { p0_transpose_item(INF(a, 3), 1024, 2048, (bf16*)(a.ws + WS_WIN), scr, r, F.lane); continue; } r -= I_IN;
        if (r < I_OUT) { p0_transpose_item(INF(a, 20), 1024, 1024, (bf16*)(a.ws + WS_WOUT), scr, r, F.lane); continue; } r -= I_OUT;
        if (r < I_GLU) { p0_transpose_item(INF(a, 17), 512, 512, (bf16*)(a.ws + WS_WGLU), scr, r, F.lane); continue; } r -= I_GLU;
        if (r < 32 * I_GU) { const int e = r / I_GU; p0_transpose_item(INF(a, 24) + (size_t)e * 1024 * 2048, 1024, 2048, (bf16*)(a.ws + WS_WGU) + (size_t)e * 2048 * 1024, scr, r % I_GU, F.lane); continue; } r -= 32 * I_GU;
        { const int e = r / I_D; p0_transpose_item(INF(a, 26) + (size_t)e * 1024 * 1024, 1024, 1024, (bf16*)(a.ws + WS_WD) + (size_t)e * 1024 * 1024, scr, r % I_D, F.lane); }
    }
    for (int m = gw; m < T; m += NGW) rms_row_to_bf16(F.lane, INF(a, 0) + (size_t)m * D, INF(a, 2), (bf16*)(a.ws + WS_XN) + (size_t)m * D);
}

struct DenseOrder {
    int nM, nN, nwg, G, c, nt; const char* A; const char* B; size_t strA, strB;
    __device__ __forceinline__ void init(int M, int N, int K, int lda, int ldb, const void* A_, const void* B_, int G_, int c_) {
        nM = M / 256; nN = N / 256; nwg = nM * nN; G = G_; c = c_; nt = K / 64; A = (const char*)A_; B = (const char*)B_; strA = (size_t)256 * lda * 2; strB = (size_t)256 * ldb * 2; }
    __device__ __forceinline__ bool next(int i, pg8::Unit& u) const {
        const long L = (long)i * G + c; if (L >= nwg) return false;
        int wgid = (int)L; { const int q = nwg / 8, r = nwg % 8, xcd = wgid % 8, off = wgid / 8; wgid = (xcd < r ? xcd * (q + 1) : r * (q + 1) + (xcd - r) * q) + off; }
        const int nig = 8 * nN, gid = wgid / nig, fm = gid * 8, gsz = (nM - fm) < 8 ? (nM - fm) : 8;
        u.pm = fm + ((wgid % nig) % gsz); u.pn = (wgid % nig) / gsz; u.a = A + (size_t)u.pm * strA; u.b = B + (size_t)u.pn * strB; u.nt = nt; u.x0 = 0; u.x1 = 0; return true;
    }
};
struct XOrder {
    int G, c; const char* AROW; const char* BTX;
    __device__ __forceinline__ bool next(int i, pg8::Unit& u) const {
        const int L = i * G + c; if (L >= 256) return false;
        const int g = L >> 3, pm = (L >> 1) & 3, kh = L & 1;
        u.pm = pm; u.pn = 0; u.x0 = g; u.x1 = kh; u.nt = 4;
        u.a = AROW + ((size_t)(g * 1024 + pm * 256) * AROW_P + 128 + kh * 256) * 2; u.b = BTX + ((size_t)g * 256 * 512 + kh * 256) * 2; return true;
    }
};
struct YOrder {
    int G, c; const char* AROW; const char* BTY;
    __device__ __forceinline__ bool next(int i, pg8::Unit& u) const {
        const int L = i * G + c; if (L >= 256) return false;
        const int g = L >> 3, pm = (L >> 1) & 3, pn = L & 1;
        u.pm = pm; u.pn = pn; u.x0 = g; u.x1 = 0; u.nt = (128 + 256 * (pn + 1)) / 64;
        u.a = AROW + ((size_t)(g * 1024 + pm * 256) * AROW_P) * 2; u.b = BTY + ((size_t)(g * 512 + pn * 256) * AROW_P) * 2; return true;
    }
};
template <int RG  , int NC  >
struct MoeOrder {
    int G, c; const LAS int* tpre; const LAS int* cntE; const char* A; const char* B; size_t strBe;
    bool gatherA;
    __device__ __forceinline__ bool next(int i, pg8::Unit& u) const {
        const int L = i * G + c, grp = L >> 5, w = L & 31, tt = grp * RG + (w % RG), pn = w / RG;
        const int NT = __builtin_amdgcn_readfirstlane(tpre[32]);
        if (tt >= NT) return false;
        int e = 0; while (__builtin_amdgcn_readfirstlane(tpre[e + 1]) <= tt) ++e;
        const int cnt = __builtin_amdgcn_readfirstlane(cntE[e]), t0 = __builtin_amdgcn_readfirstlane(tpre[e]);
        u.pm = tt; u.pn = pn; u.x0 = (tt - t0) * 256; u.x1 = e | (cnt << 8); u.nt = 16;
        u.a = gatherA ? A : A + (size_t)tt * 256 * 1024 * 2; u.b = B + (size_t)e * strBe + (size_t)pn * 256 * 1024 * 2; return true;
    }
};
struct AGather {
    static constexpr bool PER_UNIT = true;
    const int* list;
    __device__ __forceinline__ void get(const pg8::Unit& u, unsigned (&v)[2][2], const int (&R)[2], const int (&C)[2]) const {
        const int e = u.x1 & 255, cnt = u.x1 >> 8;
#pragma unroll
        for (int h = 0; h < 2; ++h)
#pragma unroll
            for (int i = 0; i < 2; ++i) { const int slot = u.x0 + h * 128 + R[i]; const int tok = slot < cnt ? (list[(size_t)e * T + slot] >> 2) : 0; v[h][i] = (unsigned)(tok * 1024 + C[i]) * 2u; }
    }
};

using pg8::f32x2; using pg8::u32x4; using pg8::u32x2; using pg8::cvt_pk_bf16; using pg8::gelu_pk;
#define EPI_ARGS const f32x4 (&acc)[2][2][4][2], const pg8::Unit& u, int wr, int wc, int fr, int fq
__device__ __forceinline__ u32x4 pack8(const f32x4 v0, const f32x4 v1) { u32x4 w; w.x = cvt_pk_bf16(v0[0], v0[1]); w.y = cvt_pk_bf16(v0[2], v0[3]); w.z = cvt_pk_bf16(v1[0], v1[1]); w.w = cvt_pk_bf16(v1[2], v1[3]); return w; }
__device__ __forceinline__ float bf_lo(unsigned w) { return __uint_as_float(w << 16); }
__device__ __forceinline__ float bf_hi(unsigned w) { return __uint_as_float(w & 0xffff0000u); }

struct EpiInProj {
    static constexpr bool PERM = true;
    bf16 *Q, *K, *V, *AROW; const float* rope; float c2;
    __device__ __forceinline__ void operator()(EPI_ARGS) const {
        const int region = u.pn >> 1; const int colr = (u.pn & 1) * 256 + wc * 32 + 8 * fq;
        const bool dorope = (region <= 1) && ((wc & 1) == 0);
#pragma unroll
        for (int ai = 0; ai < 2; ++ai)
#pragma unroll
            for (int m = 0; m < 4; ++m) {
                const int row = u.pm * 256 + ai * 128 + wr * 64 + m * 16 + fr;
                f32x4 cs0 = {1.f, 1.f, 1.f, 1.f}, cs1 = cs0, sn0 = {0.f, 0.f, 0.f, 0.f}, sn1 = sn0;
                if (dorope && fq < 2) { const f32x4* rp = (const f32x4*)(rope + (size_t)row * 16); cs0 = rp[0]; cs1 = rp[1]; sn0 = rp[2]; sn1 = rp[3]; if (fq == 0) { sn0 = -sn0; sn1 = -sn1; } }
#pragma unroll
                for (int bj = 0; bj < 2; ++bj) {
                    f32x4 v0 = acc[ai][bj][m][0], v1 = acc[ai][bj][m][1]; const int c = colr + bj * 128;
                    if (region <= 1) {
                        if (dorope) { f32x4 p0, p1;
#pragma unroll
                            for (int q = 0; q < 4; ++q) { p0[q] = __shfl_xor(v0[q], 16); p1[q] = __shfl_xor(v1[q], 16); }
                            v0 = v0 * cs0 + p0 * sn0; v1 = v1 * cs1 + p1 * sn1; }
                        if (region == 0) { v0 = v0 * c2; v1 = v1 * c2; }
                        *(u32x4*)((region == 0 ? Q : K) + (size_t)row * 512 + c) = pack8(v0, v1);
                    } else if (region == 2) {
                        *(u32x4*)(V + (size_t)row * 512 + c) = pack8(v0, v1);
                    } else {
                        const int g = c >> 4, cc = c & 15;
                        *(u32x4*)(AROW + ((size_t)(g * 1024 + (row >> 5)) * AROW_P + 128 + (row & 31) * 16 + cc)) = pack8(v0, v1);
                    }
                }
            }
    }
};
struct EpiX {
    static constexpr bool PERM = false;
    float* X;
    __device__ __forceinline__ void operator()(EPI_ARGS) const {
        float* base = X + ((size_t)(u.x1 * 32 + u.x0) * 1024 + u.pm * 256) * 128;
#pragma unroll
        for (int ai = 0; ai < 2; ++ai)
#pragma unroll
            for (int m = 0; m < 4; ++m) { const int row = ai * 128 + wr * 64 + m * 16 + fr;
#pragma unroll
                for (int n = 0; n < 2; ++n) *(f32x4*)(base + (size_t)row * 128 + wc * 32 + 16 * n + 4 * fq) = acc[ai][0][m][n]; }
    }
};
struct EpiY {
    static constexpr bool PERM = true;
    bf16* YG;
    __device__ __forceinline__ void operator()(EPI_ARGS) const {
        const int g = u.x0;
#pragma unroll
        for (int ai = 0; ai < 2; ++ai)
#pragma unroll
            for (int m = 0; m < 4; ++m) { const int jj = u.pm * 256 + ai * 128 + wr * 64 + m * 16 + fr;
#pragma unroll
                for (int bj = 0; bj < 2; ++bj) { const int n0 = u.pn * 256 + bj * 128 + wc * 32 + 8 * fq, t = n0 >> 4, cc = n0 & 15;
                    const f32x4 v0 = acc[ai][bj][m][0], v1 = acc[ai][bj][m][1];
                    const f32x2 a = gelu_pk((f32x2){v0[0], v0[1]}), b = gelu_pk((f32x2){v0[2], v0[3]}), c = gelu_pk((f32x2){v1[0], v1[1]}), d = gelu_pk((f32x2){v1[2], v1[3]});
                    u32x4 w; w.x = cvt_pk_bf16(a.x, a.y); w.y = cvt_pk_bf16(b.x, b.y); w.z = cvt_pk_bf16(c.x, c.y); w.w = cvt_pk_bf16(d.x, d.y);
                    *(u32x4*)(YG + (size_t)(jj * 32 + t) * 512 + g * 16 + cc) = w; } }
    }
};
__device__ __forceinline__ float sigmoidf_(float z) { return __builtin_amdgcn_rcpf(1.f + __builtin_amdgcn_exp2f(-1.4426950408889634f * z)); }
struct EpiGlu {
    static constexpr bool PERM = true;
    const bf16* YG; bf16* GLU; const float* bias;
    __device__ __forceinline__ void operator()(EPI_ARGS) const {
        const int c00 = u.pn * 256 + wc * 32 + 8 * fq;
        f32x4 bv[2][2];
#pragma unroll
        for (int bj = 0; bj < 2; ++bj) { bv[bj][0] = *(const f32x4*)(bias + c00 + bj * 128); bv[bj][1] = *(const f32x4*)(bias + c00 + bj * 128 + 4); }
#pragma unroll
        for (int ai = 0; ai < 2; ++ai)
#pragma unroll
            for (int m = 0; m < 4; ++m) { const int row = u.pm * 256 + ai * 128 + wr * 64 + m * 16 + fr;
#pragma unroll
                for (int bj = 0; bj < 2; ++bj) { const int c = c00 + bj * 128;
                    const f32x4 z0 = acc[ai][bj][m][0] + bv[bj][0], z1 = acc[ai][bj][m][1] + bv[bj][1];
                    const u32x4 y = *(const u32x4*)(YG + (size_t)row * 512 + c);
                    f32x4 o0, o1;
                    o0[0] = bf_lo(y.x) * sigmoidf_(z0[0]); o0[1] = bf_hi(y.x) * sigmoidf_(z0[1]); o0[2] = bf_lo(y.y) * sigmoidf_(z0[2]); o0[3] = bf_hi(y.y) * sigmoidf_(z0[3]);
                    o1[0] = bf_lo(y.z) * sigmoidf_(z1[0]); o1[1] = bf_hi(y.z) * sigmoidf_(z1[1]); o1[2] = bf_lo(y.w) * sigmoidf_(z1[2]); o1[3] = bf_hi(y.w) * sigmoidf_(z1[3]);
                    *(u32x4*)(GLU + (size_t)row * 512 + c) = pack8(o0, o1); } }
    }
};
struct EpiOut {
    static constexpr bool PERM = false;
    const float* X; float* H;
    __device__ __forceinline__ void operator()(EPI_ARGS) const {
#pragma unroll
        for (int ai = 0; ai < 2; ++ai)
#pragma unroll
            for (int m = 0; m < 4; ++m) { const size_t off = (size_t)(u.pm * 256 + ai * 128 + wr * 64 + m * 16 + fr) * 1024 + u.pn * 256 + wc * 32 + 4 * fq;
#pragma unroll
                for (int bj = 0; bj < 2; ++bj)
#pragma unroll
                    for (int n = 0; n < 2; ++n) { const size_t o = off + bj * 128 + n * 16; *(f32x4*)(H + o) = *(const f32x4*)(X + o) + acc[ai][bj][m][n]; }
                if (m & 1) asm volatile("" ::: "memory"); }
    }
};
__device__ __forceinline__ float swiglu_(float g, float up) { const float gc = fminf(g, SW_LIMIT), uc = fminf(fmaxf(up, -SW_LIMIT), SW_LIMIT); return gc * sigmoidf_(SW_ALPHA * gc) * (uc + 1.f); }
struct EpiGU {
    static constexpr bool PERM = true;
    bf16* ACT; const float* bias;
    __device__ __forceinline__ void operator()(EPI_ARGS) const {
        const int e = u.x1 & 255, c00 = u.pn * 256 + wc * 32 + 8 * fq;
        f32x4 bv[2][2];
#pragma unroll
        for (int bj = 0; bj < 2; ++bj) { bv[bj][0] = *(const f32x4*)(bias + e * 2048 + c00 + bj * 128); bv[bj][1] = *(const f32x4*)(bias + e * 2048 + c00 + bj * 128 + 4); }
#pragma unroll
        for (int ai = 0; ai < 2; ++ai)
#pragma unroll
            for (int m = 0; m < 4; ++m) { const size_t row = (size_t)u.pm * 256 + ai * 128 + wr * 64 + m * 16 + fr;
#pragma unroll
                for (int bj = 0; bj < 2; ++bj) { const int c = c00 + bj * 128;
                    const f32x4 z0 = acc[ai][bj][m][0] + bv[bj][0], z1 = acc[ai][bj][m][1] + bv[bj][1];
                    u32x2 w; w.x = cvt_pk_bf16(swiglu_(z0[0], z0[1]), swiglu_(z0[2], z0[3])); w.y = cvt_pk_bf16(swiglu_(z1[0], z1[1]), swiglu_(z1[2], z1[3]));
                    *(u32x2*)(ACT + row * 1024 + (c >> 1)) = w; } }
    }
};
struct EpiDown {
    static constexpr bool PERM = true;
    bf16* YB; const float* bias; const int* list; const float* gates;
    __device__ __forceinline__ void operator()(EPI_ARGS) const {
        const int e = u.x1 & 255, cnt = u.x1 >> 8, c00 = u.pn * 256 + wc * 32 + 8 * fq;
        f32x4 bv[2][2];
#pragma unroll
        for (int bj = 0; bj < 2; ++bj) { bv[bj][0] = *(const f32x4*)(bias + e * 1024 + c00 + bj * 128); bv[bj][1] = *(const f32x4*)(bias + e * 1024 + c00 + bj * 128 + 4); }
#pragma unroll
        for (int ai = 0; ai < 2; ++ai)
#pragma unroll
            for (int m = 0; m < 4; ++m) { const int slot = u.x0 + ai * 128 + wr * 64 + m * 16 + fr;
                if (slot < cnt) { const int aid = list[(size_t)e * T + slot]; const float gt = gates[aid];
#pragma unroll
                    for (int bj = 0; bj < 2; ++bj) { const int c = c00 + bj * 128;
                        const f32x4 z0 = (acc[ai][bj][m][0] + bv[bj][0]) * gt, z1 = (acc[ai][bj][m][1] + bv[bj][1]) * gt;
                        *(u32x4*)(YB + (size_t)aid * 1024 + c) = pack8(z0, z1); } } }
    }
};

__device__ __forceinline__ void p3_post_scan(Frame& F, const Args& a) {
    const int gw = F.vcu * NWAVES + F.wave, NGW = F.G * NWAVES, lane = F.lane;
    if (gw < 128) {
        const int g = gw >> 2, b = gw & 3, n = lane;
        const float* AL = (const float*)(a.ws + WS_SMALL + SM_AL); const float ar = AL[(g * 64 + n) * 2], ai = AL[(g * 64 + n) * 2 + 1];
        const float* X0 = (const float*)(a.ws + WS_XLOC) + ((size_t)(0 * 32 + g) * 1024 + b * 256) * 128;
        const float* X1 = (const float*)(a.ws + WS_XLOC) + ((size_t)(1 * 32 + g) * 1024 + b * 256) * 128;
        bf16* AR = (bf16*)(a.ws + WS_AROW) + (size_t)(g * 1024 + b * 256) * AROW_P;
        float xr = 0.f, xi = 0.f;
        for (int j0 = 0; j0 < 256; j0 += 16) {
            float lr[16], li[16];
#pragma unroll
            for (int q = 0; q < 16; ++q) { const size_t o = (size_t)(j0 + q) * 128 + n; lr[q] = X0[o] + X1[o]; li[q] = X0[o + 64] + X1[o + 64]; }
#pragma unroll
            for (int q = 0; q < 16; ++q) { bf16* row = AR + (size_t)(j0 + q) * AROW_P; row[n] = (bf16)f2bf(xr); row[64 + n] = (bf16)f2bf(xi);
                const float nr = ar * xr - ai * xi + lr[q], ni = ar * xi + ai * xr + li[q]; xr = nr; xi = ni; }
        }
    }
    const float lam = *(const float*)(a.ws + WS_SMALL);
    const bf16* O = (const bf16*)(a.ws + WS_O); bf16* AC = (bf16*)(a.ws + WS_ACAT); const float* ng = INF(a, 8);
    const int h = lane >> 4, d0 = (lane & 15) * 8, vh = d0 >> 6, dd = d0 & 63;
    const f32x4 g0 = *(const f32x4*)(ng + d0), g1 = *(const f32x4*)(ng + d0 + 4);
    for (int m = gw; m < T; m += NGW) {
        const bf16* orow = O + (size_t)m * 1024;
        const v4u p1 = *(const GAS v4u*)(orow + ((h * 2 + 0) * 2 + vh) * 64 + dd), p2 = *(const GAS v4u*)(orow + ((h * 2 + 1) * 2 + vh) * 64 + dd);
        float o[8];
        o[0] = bf_lo(p1.x) - lam * bf_lo(p2.x); o[1] = bf_hi(p1.x) - lam * bf_hi(p2.x); o[2] = bf_lo(p1.y) - lam * bf_lo(p2.y); o[3] = bf_hi(p1.y) - lam * bf_hi(p2.y);
        o[4] = bf_lo(p1.z) - lam * bf_lo(p2.z); o[5] = bf_hi(p1.z) - lam * bf_hi(p2.z); o[6] = bf_lo(p1.w) - lam * bf_lo(p2.w); o[7] = bf_hi(p1.w) - lam * bf_hi(p2.w);
        float s = 0.f;
#pragma unroll
        for (int q = 0; q < 8; ++q) s += o[q] * o[q];
        s += __shfl_xor(s, 1); s += __shfl_xor(s, 2); s += __shfl_xor(s, 4); s += __shfl_xor(s, 8);
        const float sc = (1.f - LAMBDA_INIT) / sqrtf(s * (1.f / 128.f) + RMS_EPS);
        v4u w; w.x = pk2(o[0] * sc * g0[0], o[1] * sc * g0[1]); w.y = pk2(o[2] * sc * g0[2], o[3] * sc * g0[3]); w.z = pk2(o[4] * sc * g1[0], o[5] * sc * g1[1]); w.w = pk2(o[6] * sc * g1[2], o[7] * sc * g1[3]);
        *(GAS v4u*)(AC + (size_t)m * 1024 + h * 128 + d0) = w;
    }
}
__device__ __forceinline__ void pn_glunorm(Frame& F, const Args& a) {
    const int gw = F.vcu * NWAVES + F.wave, NGW = F.G * NWAVES, lane = F.lane;
    const bf16* GL = (const bf16*)(a.ws + WS_GLU); bf16* AC = (bf16*)(a.ws + WS_ACAT); const float* ng = INF(a, 19);
    const f32x4 g0 = *(const f32x4*)(ng + lane * 8), g1 = *(const f32x4*)(ng + lane * 8 + 4);
    for (int m = gw; m < T; m += NGW) {
        const v4u p = *(const GAS v4u*)(GL + (size_t)m * 512 + lane * 8);
        float o[8] = {bf_lo(p.x), bf_hi(p.x), bf_lo(p.y), bf_hi(p.y), bf_lo(p.z), bf_hi(p.z), bf_lo(p.w), bf_hi(p.w)};
        float s = 0.f;
#pragma unroll
        for (int q = 0; q < 8; ++q) s += o[q] * o[q];
        const float sc = 1.f / sqrtf(wave_sum(s) * (1.f / 512.f) + RMS_EPS);
        v4u w; w.x = pk2(o[0] * sc * g0[0], o[1] * sc * g0[1]); w.y = pk2(o[2] * sc * g0[2], o[3] * sc * g0[3]); w.z = pk2(o[4] * sc * g1[0], o[5] * sc * g1[1]); w.w = pk2(o[6] * sc * g1[2], o[7] * sc * g1[3]);
        *(GAS v4u*)(AC + (size_t)m * 1024 + 512 + lane * 8) = w;
    }
}
__device__ __forceinline__ void pr_router(Frame& F, const Args& a) {
    LAS float* WP = (LAS float*)F.lds;
    { const GAS f32x4* src = (const GAS f32x4*)(a.ws + WS_SMALL + SM_WR); for (int i = F.tid; i < 1024 * 36 / 4; i += NWAVES * 64) ((LAS f32x4*)WP)[i] = src[i]; }
    LAS int* cntL = (LAS int*)(F.lds + RT_OFF); LAS int* baseL = cntL + 32;
    LAS int* stA = (LAS int*)(F.lds + ST_OFF); LAS int* stE = stA + 512; LAS float* stG = (LAS float*)(stE + 512);
    if (F.tid < 32) cntL[F.tid] = 0;
    __syncthreads();
    const int gw = F.vcu * NWAVES + F.wave, lane = F.lane;
    const float* H = a.out; bf16* XN = (bf16*)(a.ws + WS_XN); const float* gf = INF(a, 21);
    const int e_me = lane >> 1; const float brt = INF(a, 23)[e_me];
    for (int it = 0; it < 16; ++it) {
        const int m = gw + it * (256 * NWAVES);
        const float* hrow = H + (size_t)m * 1024;
        float x[16]; float ss = 0.f;
#pragma unroll
        for (int i = 0; i < 16; ++i) { x[i] = hrow[lane + 64 * i]; ss += x[i] * x[i]; }
        const float rstd = 1.f / sqrtf(wave_sum(ss) * (1.f / D) + RMS_EPS);
        float p[32];
#pragma unroll
        for (int e = 0; e < 32; ++e) p[e] = 0.f;
#pragma unroll
        for (int i = 0; i < 16; ++i) { const LAS float* wrow = WP + (lane + 64 * i) * 36;
#pragma unroll
            for (int e4 = 0; e4 < 8; ++e4) { const f32x4 w = *(const LAS f32x4*)(wrow + 4 * e4); p[4 * e4] += x[i] * w[0]; p[4 * e4 + 1] += x[i] * w[1]; p[4 * e4 + 2] += x[i] * w[2]; p[4 * e4 + 3] += x[i] * w[3]; } }
        float q16[16], q8[8], q4[4], q2[2];
        { const bool up = (lane & 32) != 0;
#pragma unroll
          for (int i = 0; i < 16; ++i) { const float keep = up ? p[16 + i] : p[i], send = up ? p[i] : p[16 + i]; q16[i] = keep + __shfl_xor(send, 32); } }
        { const bool up = (lane & 16) != 0;
#pragma unroll
          for (int i = 0; i < 8; ++i) { const float keep = up ? q16[8 + i] : q16[i], send = up ? q16[i] : q16[8 + i]; q8[i] = keep + __shfl_xor(send, 16); } }
        { const bool up = (lane & 8) != 0;
#pragma unroll
          for (int i = 0; i < 4; ++i) { const float keep = up ? q8[4 + i] : q8[i], send = up ? q8[i] : q8[4 + i]; q4[i] = keep + __shfl_xor(send, 8); } }
        { const bool up = (lane & 4) != 0;
#pragma unroll
          for (int i = 0; i < 2; ++i) { const float keep = up ? q4[2 + i] : q4[i], send = up ? q4[i] : q4[2 + i]; q2[i] = keep + __shfl_xor(send, 4); } }
        float q1; { const bool up = (lane & 2) != 0; const float keep = up ? q2[1] : q2[0], send = up ? q2[0] : q2[1]; q1 = keep + __shfl_xor(send, 2); }
        const float raw = q1 + __shfl_xor(q1, 1);
        const float v = raw * rstd + brt;
        int rank = 0;
#pragma unroll
        for (int j = 0; j < 32; ++j) { const float vj = __int_as_float(__builtin_amdgcn_readlane(__float_as_int(v), 2 * j)); rank += (vj > v || (vj == v && j < e_me)) ? 1 : 0; }
        float vk[4]; int ek[4];
#pragma unroll
        for (int k = 0; k < 4; ++k) { const unsigned long long mk = __ballot(rank == k); const int lk = (int)__builtin_ctzll(mk); ek[k] = lk >> 1; vk[k] = __int_as_float(__builtin_amdgcn_readlane(__float_as_int(v), lk)); }
        float ex[4]; float den = 0.f;
#pragma unroll
        for (int k = 0; k < 4; ++k) { ex[k] = __expf(vk[k] - vk[0]); den += ex[k]; }
        const float rden = 1.f / den;
        if (lane < 4) {
            const int e = lane == 0 ? ek[0] : lane == 1 ? ek[1] : lane == 2 ? ek[2] : ek[3];
            const float gt = (lane == 0 ? ex[0] : lane == 1 ? ex[1] : lane == 2 ? ex[2] : ex[3]) * rden;
            const int sl = __hip_atomic_fetch_add(cntL + e, 1, __ATOMIC_RELAXED, __HIP_MEMORY_SCOPE_WORKGROUP);
            const int pos = F.wave * 64 + it * 4 + lane;
            stA[pos] = m * 4 + lane; stE[pos] = e | (sl << 8); stG[pos] = gt;
        }
        { const GAS f32x4* xr = (const GAS f32x4*)hrow + lane; const GAS f32x4* gr = (const GAS f32x4*)gf + lane; GAS unsigned long long* o8 = (GAS unsigned long long*)(XN + (size_t)m * 1024) + lane;
#pragma unroll
          for (int j = 0; j < 4; ++j) { const f32x4 hv = xr[64 * j], gg = gr[64 * j];
              o8[64 * j] = (unsigned long long)pk2(hv.x * rstd * gg.x, hv.y * rstd * gg.y) | ((unsigned long long)pk2(hv.z * rstd * gg.z, hv.w * rstd * gg.w) << 32); } }
    }
    __syncthreads();
    if (F.tid < 32) baseL[F.tid] = (int)__hip_atomic_fetch_add(F.ctl + CW_ECNT + 16 * F.tid, (unsigned)cntL[F.tid], __ATOMIC_RELAXED, __HIP_MEMORY_SCOPE_AGENT);
    __syncthreads();
    { const int pos = F.tid; const int aid = stA[pos], ee = stE[pos], e = ee & 255, sl = ee >> 8;
      int* list = (int*)(a.ws + WS_LIST); float* gates = (float*)(a.ws + WS_GATES);
      list[(size_t)e * T + baseL[e] + sl] = aid; gates[aid] = stG[pos]; }
}
__device__ __forceinline__ void moe_tables(Frame& F) {
    LAS int* tpre = (LAS int*)(F.lds + MOE_OFF); LAS int* cntE = tpre + 40;
    __syncthreads();
    if (F.tid < 32) cntE[F.tid] = (int)__hip_atomic_load(F.ctl + CW_ECNT + 16 * F.tid, RLX_AGENT);
    __syncthreads();
    if (F.tid == 0) { int acc = 0; for (int e = 0; e < 32; ++e) { tpre[e] = acc; acc += (cntE[e] + 255) >> 8; } tpre[32] = acc; }
    __syncthreads();
}
__device__ __forceinline__ void pf_final(Frame& F, const Args& a) {
    const int gw = F.vcu * NWAVES + F.wave, NGW = F.G * NWAVES, lane = F.lane;
    const bf16* YB = (const bf16*)(a.ws + WS_YBUF); const float* gfin = INF(a, 28);
    for (int m = gw; m < T; m += NGW) {
        GAS f32x4* hr = (GAS f32x4*)(a.out + (size_t)m * 1024) + lane;
        f32x4 v[4];
#pragma unroll
        for (int j = 0; j < 4; ++j) v[j] = hr[64 * j];
#pragma unroll
        for (int k = 0; k < 4; ++k) { const GAS unsigned long long* yr = (const GAS unsigned long long*)(YB + ((size_t)m * 4 + k) * 1024) + lane;
#pragma unroll
            for (int j = 0; j < 4; ++j) { const unsigned long long w = yr[64 * j]; const unsigned lo = (unsigned)w, hi = (unsigned)(w >> 32);
                v[j].x += bf_lo(lo); v[j].y += bf_hi(lo); v[j].z += bf_lo(hi); v[j].w += bf_hi(hi); } }
        float s = 0.f;
#pragma unroll
        for (int j = 0; j < 4; ++j) s += (v[j].x * v[j].x + v[j].y * v[j].y) + (v[j].z * v[j].z + v[j].w * v[j].w);
        const float rstd = 1.f / sqrtf(wave_sum(s) * (1.f / D) + RMS_EPS);
        const GAS f32x4* gr = (const GAS f32x4*)gfin + lane;
#pragma unroll
        for (int j = 0; j < 4; ++j) { const f32x4 gg = gr[64 * j]; hr[64 * j] = v[j] * rstd * gg; }
    }
}

__global__ void __launch_bounds__(NWAVES * 64, 2) mk_fwd(Args args) {
    extern __shared__ __attribute__((aligned(16))) unsigned char lds[];
    Frame F;
    F.lds = (LAS unsigned char*)lds;
    F.MISC = (volatile LAS unsigned*)(F.lds + MISC_OFF);
    F.tid = threadIdx.x; F.lane = F.tid & 63; F.wave = __builtin_amdgcn_readfirstlane(F.tid >> 6);
    F.G = gridDim.x; { const int bx = blockIdx.x; F.vcu = (F.G % 8 == 0) ? (bx % 8) * (F.G / 8) + bx / 8 : bx; }
    unsigned char* ws = args.ws;
    F.ctl = (gu32*)(ws + WS_CTL);
    for (int u = F.tid; u < (LDS_BYTES - LDSCTL_OFF) / 4; u += NWAVES * 64) ((LAS unsigned*)(F.lds + LDSCTL_OFF))[u] = 0u;
    __syncthreads();
    XcdBarrier bar; bar.bar = (unsigned*)(F.ctl + CW_BAR); bar.x = 0; bar.st = nullptr;
    if (N_LAUNCHES == 1) bar = xcd_barrier_post((unsigned*)(F.ctl + CW_BAR), F.MISC + 8);
#define GRID_BAR() do { if (N_LAUNCHES == 1) xcd_barrier(bar); } while (0)
    const int lo = args.ph_lo, hi = args.ph_hi;
#define IN(k) (lo <= (k) && (k) < hi)
#define BOTH(k) (IN(k) && IN((k) + 1))
    LAS unsigned char* ring = F.lds + RING_OFF;

    if (IN(0)) { p0_prologue(F, args); if (BOTH(0)) GRID_BAR(); }
    if (IN(1)) {
        DenseOrder S; S.init(T, 2048, 1024, 1024, 1024, ws + WS_XN, ws + WS_WIN, F.G, (int)blockIdx.x);
        EpiInProj E{(bf16*)(ws + WS_Q), (bf16*)(ws + WS_K), (bf16*)(ws + WS_V), (bf16*)(ws + WS_AROW), (const float*)(ws + WS_ROPE), attn_body::C2};
        pg8::ALinear AO{1024};
        pg8::gemm_phase<EpiInProj, DenseOrder, pg8::ALinear, true>(ring, 1024, S, AO, E);
        if (BOTH(1)) GRID_BAR();
    }
    if (IN(2)) {
        { XOrder S{F.G, F.vcu, (const char*)(ws + WS_AROW), (const char*)(ws + WS_BTX)}; EpiX E{(float*)(ws + WS_XLOC)}; pg8::ALinear AO{AROW_P};
          pg8::gemm_phase<EpiX, XOrder, pg8::ALinear, true>(ring, 512, S, AO, E); }
        if (F.G == 256) {
            const int s = F.vcu & 3, bh = F.vcu >> 2, b = bh >> 4, hh = bh & 15;
            for (int i = 0; i < 8; ++i) {
                const int qb = (i & 1) ? (8 * (i >> 1) + 7 - s) : (8 * (i >> 1) + s);
                attn_body::attn_unit<8>(b, (hh >> 1) * 64, (hh >> 1) * 64, (hh >> 2) * 128 + (hh & 1) * 64, hh * 64, qb,
                    (const attn_body::bf16*)(ws + WS_Q), (const attn_body::bf16*)(ws + WS_K), (const attn_body::bf16*)(ws + WS_V), (attn_body::bf16*)(ws + WS_O), (char*)lds + RING_OFF);
            }
        }
        if (BOTH(2)) GRID_BAR();
    }
    if (IN(3)) { p3_post_scan(F, args); if (BOTH(3)) GRID_BAR(); }
    if (IN(4)) {
        YOrder S{F.G, F.vcu, (const char*)(ws + WS_AROW), (const char*)(ws + WS_BTY)}; EpiY E{(bf16*)(ws + WS_YG)}; pg8::ALinear AO{AROW_P};
        pg8::gemm_phase<EpiY, YOrder, pg8::ALinear, true>(ring, AROW_P, S, AO, E);
        if (BOTH(4)) GRID_BAR();
    }
    if (IN(5)) {
        DenseOrder S; S.init(T, 512, 512, 512, 512, ws + WS_YG, ws + WS_WGLU, F.G, (int)blockIdx.x);
        EpiGlu E{(const bf16*)(ws + WS_YG), (bf16*)(ws + WS_GLU), INF(args, 18)}; pg8::ALinear AO{512};
        pg8::gemm_phase<EpiGlu, DenseOrder, pg8::ALinear, true>(ring, 512, S, AO, E);
        if (BOTH(5)) GRID_BAR();
    }
    if (IN(6)) { pn_glunorm(F, args); if (BOTH(6)) GRID_BAR(); }
    if (IN(7)) {
        DenseOrder S; S.init(T, 1024, 1024, 1024, 1024, ws + WS_ACAT, ws + WS_WOUT, F.G, (int)blockIdx.x);
        EpiOut E{INF(args, 0), args.out}; pg8::ALinear AO{1024};
        pg8::gemm_phase<EpiOut, DenseOrder, pg8::ALinear, true>(ring, 1024, S, AO, E);
        if (BOTH(7)) GRID_BAR();
    }
    if (IN(8)) { if (F.G == 256) pr_router(F, args); if (BOTH(8)) GRID_BAR(); }
    if (IN(9)) {
        moe_tables(F);
        const LAS int* tpre = (const LAS int*)(F.lds + MOE_OFF);
        MoeOrder<4, 8> S{F.G, F.vcu, tpre, tpre + 40, (const char*)(ws + WS_XN), (const char*)(ws + WS_WGU), (size_t)2048 * 1024 * 2, true};
        EpiGU E{(bf16*)(ws + WS_ACT), INF(args, 25)}; AGather AO{(const int*)(ws + WS_LIST)};
        pg8::gemm_phase<EpiGU, MoeOrder<4, 8>, AGather, true>(ring, 1024, S, AO, E);
        if (BOTH(9)) GRID_BAR();
    }
    if (IN(10)) {
        moe_tables(F);
        const LAS int* tpre = (const LAS int*)(F.lds + MOE_OFF);
        MoeOrder<8, 4> S{F.G, F.vcu, tpre, tpre + 40, (const char*)(ws + WS_ACT), (const char*)(ws + WS_WD), (size_t)1024 * 1024 * 2, false};
        EpiDown E{(bf16*)(ws + WS_YBUF), INF(args, 27), (const int*)(ws + WS_LIST), (const float*)(ws + WS_GATES)}; pg8::ALinear AO{1024};
        pg8::gemm_phase<EpiDown, MoeOrder<8, 4>, pg8::ALinear, true>(ring, 1024, S, AO, E);
        if (BOTH(10)) GRID_BAR();
    }
    if (IN(11)) { pf_final(F, args); }
#undef IN
#undef BOTH
}

extern "C" void kernel_launch(void* const* d_in, const int* in_sizes, int n_in, void* d_out, int out_size, void* d_ws, size_t ws_size, hipStream_t stream) {
    static int grid = 0;
    if (grid == 0) {
        if (n_in != 29 || in_sizes[0] != T * D || out_size != T * D || ws_size < WS_END) { fprintf(stderr, "kernel_launch: unexpected shapes / workspace (n_in %d, ws %zu)\n", n_in, ws_size); grid = -1; return; }
        int dev = 0, cus = 0, per_cu = 0;
        if (hipGetDevice(&dev) != hipSuccess || hipDeviceGetAttribute(&cus, hipDeviceAttributeMultiprocessorCount, dev) != hipSuccess) { grid = -1; return; }
        if (hipFuncSetAttribute((const void*)mk_fwd, hipFuncAttributeMaxDynamicSharedMemorySize, LDS_BYTES) != hipSuccess) { fprintf(stderr, "kernel_launch: hipFuncSetAttribute failed\n"); grid = -1; return; }
        if (hipOccupancyMaxActiveBlocksPerMultiprocessor(&per_cu, (const void*)mk_fwd, NWAVES * 64, LDS_BYTES) != hipSuccess || per_cu < 1) { fprintf(stderr, "kernel_launch: occupancy query says %d\n", per_cu); }
        (void)hipGetLastError();
        if (cus < 256) { fprintf(stderr, "kernel_launch: needs 256 CUs, device has %d\n", cus); grid = -1; return; }
        grid = 256;
    }
    if (grid < 0) return;
    if (hipMemsetAsync((char*)d_ws + WS_CTL, 0, CTL_ZERO_BYTES, stream) != hipSuccess) return;
    Args a{};
    for (int i = 0; i < 29; ++i) a.in[i] = d_in[i];
    a.out = (float*)d_out; a.ws = (unsigned char*)d_ws; a.pad = 0;
    for (int li = 0; li < N_LAUNCHES; ++li) {
        a.ph_lo = (N_LAUNCHES == NPH) ? li : 0; a.ph_hi = (N_LAUNCHES == NPH) ? li + 1 : NPH; a.li = li;
        hipLaunchKernelGGL(mk_fwd, dim3(grid), dim3(NWAVES * 64), LDS_BYTES, stream, a);
    }
}
```

```cpp
#include <hip/hip_runtime.h>
#include <hip/hip_bf16.h>
#include <cstdio>
#include <cstdint>
#include <cmath>
__device__ __forceinline__ int mk_lane() { int l; asm volatile("v_mbcnt_lo_u32_b32 %0, -1, 0\n\tv_mbcnt_hi_u32_b32 %0, -1, %0" : "=v"(l)); return l; }
namespace pg8 {
#define PG8_LAS __attribute__((address_space(3)))
typedef unsigned short bf16_t;
typedef short bf16x8 __attribute__((ext_vector_type(8)));
typedef float f32x4 __attribute__((ext_vector_type(4)));
typedef float f32x2 __attribute__((ext_vector_type(2)));
typedef unsigned u32x4 __attribute__((ext_vector_type(4)));
typedef unsigned u32x2 __attribute__((ext_vector_type(2)));
constexpr int BM = 256, BK = 64, HALF = 128, HTB = HALF * BK * 2  , STAGE_BYTES = 8 * HTB, NXCD = 8, WGM = 8;

__host__ __device__ __forceinline__ int lds_byte(int r, int c) { const int st = (r >> 4) * 2 + (c >> 5), rr = r & 15, cc = c & 31, ob = rr * 64 + cc * 2; return st * 1024 + (ob ^ (((ob >> 9) & 1) << 5)); }
__host__ __device__ __forceinline__ void stage_rc(int b, int& R, int& C) { const int st = b / 1024, sb = b % 1024, swz = sb ^ (((sb >> 9) & 1) << 5); R = (st >> 1) * 16 + swz / 64; C = (st & 1) * 32 + (swz % 64) / 2; }
__host__ __device__ __forceinline__ int perm32(int rho) { const int n = rho >> 4, i = rho & 15; return 8 * (i >> 2) + 4 * n + (i & 3); }

struct Unit { int pm, pn; const char* a; const char* b; int nt; int x0, x1; };

struct ALinear {
    static constexpr bool PER_UNIT = false;
    int lda;
    __device__ __forceinline__ void get(const Unit&, unsigned (&v)[2][2], const int (&R)[2], const int (&C)[2]) const {
#pragma unroll
        for (int h = 0; h < 2; ++h)
#pragma unroll
            for (int i = 0; i < 2; ++i) v[h][i] = (unsigned)(R[i] * lda + C[i] * 2);
    }
    __device__ __forceinline__ size_t hstep() const { return (size_t)HALF * lda; }
    __device__ __forceinline__ void issue_dma(const Unit&, const int (&)[2], unsigned) const {}
    __device__ __forceinline__ void finish(const int (&)[4], unsigned (&)[2][2], const int (&)[2]) const {}
};

__device__ __forceinline__ unsigned cvt_pk_bf16(float lo, float hi) { unsigned r; asm volatile("v_cvt_pk_bf16_f32 %0, %1, %2" : "=v"(r) : "v"(lo), "v"(hi)); return r; }
__device__ __forceinline__ f32x2 gelu_pk(f32x2 v) {
    const f32x2 av = __builtin_elementwise_abs(v), d = av * 0.2316418882f + 1.0f;
    f32x2 t; t.x = __builtin_amdgcn_rcpf(d.x); t.y = __builtin_amdgcn_rcpf(d.y);
    f32x2 q = t * 0.5307027145f + (-0.7265760135f); q = q * t + 0.7107068705f; q = q * t + (-0.142248368f); q = q * t + 0.127414796f; q = q * t;
    const f32x2 s = (v * v) * (-0.72134752044f);
    f32x2 e; e.x = __builtin_amdgcn_exp2f(s.x); e.y = __builtin_amdgcn_exp2f(s.y);
    const f32x2 m = v * (q * e), r = v - m;
    f32x2 o; o.x = v.x < 0.f ? m.x : r.x; o.y = v.y < 0.f ? m.y : r.y; return o;
}

typedef int v4i_t __attribute__((ext_vector_type(4)));
typedef int v8i_t __attribute__((ext_vector_type(8)));
template <int OFF> __device__ __forceinline__ void glds_sv(const char* sbase, unsigned voff, unsigned lds_w0) { unsigned keep;
    asm volatile("s_mov_b32 %0, m0\n\ts_add_u32 m0, %3, %4\n\ts_nop 0\n\tglobal_load_lds_dwordx4 %1, %2\n\ts_mov_b32 m0, %0" : "=&s"(keep) : "v"(voff), "s"(sbase), "s"(lds_w0), "i"(OFF) : "memory", "scc"); }
__device__ __forceinline__ void glds4_sv(const void* sbase, unsigned voff, unsigned lds_dst) { unsigned keep;
    asm volatile("s_mov_b32 %0, m0\n\ts_mov_b32 m0, %3\n\ts_nop 0\n\tglobal_load_lds_dword %1, %2\n\ts_mov_b32 m0, %0" : "=&s"(keep) : "v"(voff), "s"(sbase), "s"(lds_dst) : "memory"); }
template <int N> __device__ __forceinline__ void wait_vm_sel(int sel) { asm volatile("v_cmp_ne_u32_e32 vcc, 0, %0\n\ts_cbranch_vccz .Lw8_%=\n\ts_waitcnt vmcnt(%1)\n\ts_branch .Lwe_%=\n.Lw8_%=:\n\ts_waitcnt vmcnt(8)\n.Lwe_%=:" :: "v"(sel), "n"(N) : "memory", "vcc"); }
template <bool FP8> struct FragT;
template <> struct FragT<false> { struct A4 { bf16x8 v[4][2]; }; struct B2 { bf16x8 v[2][2]; }; };
template <> struct FragT<true> { struct A4 { v8i_t v[4]; }; struct B2 { v8i_t v[2]; }; };
template <class Epi, class Sched, class AOff, bool ALIGN_EPI = true, bool FP8 = false>
__device__ __forceinline__ void gemm_phase(PG8_LAS unsigned char* lds, const int ldb  , const Sched& S, const AOff& AO, const Epi& E, const int wave_  , PG8_LAS unsigned char* xlds = nullptr  ) {
    int tid_ = wave_ * 64 + mk_lane(); asm volatile("" : "+v"(tid_));
    const int tid = tid_, wid = __builtin_amdgcn_readfirstlane(tid >> 6), lane = tid & 63, wr = wid >> 2, wc = wid & 3, fr = lane & 15, fq = lane >> 4;
    unsigned voffB[2]; int RR[2], CC[2];
#pragma unroll
    for (int i = 0; i < 2; ++i) { int R, C; stage_rc(tid * 16 + i * 8192, R, C); RR[i] = R; CC[i] = C; const int Rp = (R & ~31) + perm32(R & 31); const int P32 = perm32(R & 31); const int Rb = Epi::BMODE == 0 ? R : Epi::BMODE == 1 ? Rp : Epi::BMODE == 2 ? 2 * Rp : 64 * (R >> 5) + 16 * (P32 >> 3) + (P32 & 7);
        voffB[i] = (unsigned)(Rb * ldb + C * 2); }
    const size_t kstep = (size_t)(BK * 2);
    const size_t hstepB = Epi::BMODE == 2 ? (size_t)ldb : Epi::BMODE == 3 ? (size_t)8 * ldb : (size_t)HALF * ldb;
    const size_t hstepA = AO.hstep();
    constexpr int AH1 = AOff::PER_UNIT ? 1 : 0;
    const unsigned ldsw0 = (unsigned)__builtin_amdgcn_readfirstlane((int)((unsigned)(uintptr_t)lds + (unsigned)wid * 1024u));
    const int aoff = lds_byte(wr * 64 + fr, fq * 8), boff = lds_byte(wc * 32 + fr, fq * 8);
#define PG8_SA(b, h) (((b) * 2 + (h)) * HTB)
#define PG8_SB(b, h) ((4 + (b) * 2 + (h)) * HTB)
#define PG8_STAGE(bufoff, gbase, voff) do { glds_sv<(bufoff)>((const char*)(gbase), (voff)[0], ldsw0); glds_sv<(bufoff) + 8192>((const char*)(gbase), (voff)[1], ldsw0); } while (0)
#define PG8_LD8(p) __builtin_shufflevector(*(const PG8_LAS v4i_t*)(p), *(const PG8_LAS v4i_t*)((p) + 1024), 0, 1, 2, 3, 4, 5, 6, 7)
#define PG8_LDA(dst, b, h) do { if constexpr (FP8) { _Pragma("unroll") for (int m = 0; m < 4; ++m) dst.v[m] = PG8_LD8(lds + PG8_SA(b, h) + aoff + m * 2048); } \
        else { _Pragma("unroll") for (int m = 0; m < 4; ++m) _Pragma("unroll") for (int k = 0; k < 2; ++k) dst.v[m][k] = *(const PG8_LAS bf16x8*)(lds + PG8_SA(b, h) + aoff + m * 2048 + k * 1024); } } while (0)
#define PG8_LDB(dst, b, h) do { if constexpr (FP8) { _Pragma("unroll") for (int n = 0; n < 2; ++n) dst.v[n] = PG8_LD8(lds + PG8_SB(b, h) + boff + n * 2048); } \
        else { _Pragma("unroll") for (int n = 0; n < 2; ++n) _Pragma("unroll") for (int k = 0; k < 2; ++k) dst.v[n][k] = *(const PG8_LAS bf16x8*)(lds + PG8_SB(b, h) + boff + n * 2048 + k * 1024); } } while (0)
#define PG8_MMA(ai, bj, At, Bt) do { __builtin_amdgcn_s_setprio(1); \
        if constexpr (FP8) { _Pragma("unroll") for (int m = 0; m < 4; ++m) _Pragma("unroll") for (int n = 0; n < 2; ++n) \
            acc[ai][bj][m][n] = __builtin_amdgcn_mfma_scale_f32_16x16x128_f8f6f4(Bt.v[n], At.v[m], acc[ai][bj][m][n], 0, 0, 0, 0, 0, 0); } \
        else { _Pragma("unroll") for (int m = 0; m < 4; ++m) _Pragma("unroll") for (int n = 0; n < 2; ++n) _Pragma("unroll") for (int k = 0; k < 2; ++k) \
            acc[ai][bj][m][n] = __builtin_amdgcn_mfma_f32_16x16x32_bf16(Bt.v[n][k], At.v[m][k], acc[ai][bj][m][n], 0, 0, 0); } \
        __builtin_amdgcn_s_setprio(0); } while (0)
#define PG8_WAIT_V(n) asm volatile("s_waitcnt vmcnt(" #n ")" ::: "memory")
#define PG8_WAIT_L(n) asm volatile("s_waitcnt lgkmcnt(" #n ")" ::: "memory")
#define PG8_BAR __builtin_amdgcn_s_barrier()
#define PG8_SCHED __builtin_amdgcn_sched_barrier(0)
    Unit cur, nxt; int ui = 0;
    if (!S.next(0, cur)) return;
    unsigned vAc[2][2];
    AO.get(cur, vAc, RR, CC);
    PG8_LAS unsigned* const xw = (PG8_LAS unsigned*)xlds + wid * 256 + lane;
    const unsigned xdst = (unsigned)__builtin_amdgcn_readfirstlane((int)((unsigned)(uintptr_t)xlds + (unsigned)wid * 1024u));
    f32x4 acc[2][2][4][2];
#pragma unroll
    for (int a = 0; a < 2; ++a)
#pragma unroll
        for (int b = 0; b < 2; ++b)
#pragma unroll
            for (int m = 0; m < 4; ++m)
#pragma unroll
                for (int n = 0; n < 2; ++n) acc[a][b][m][n] = (f32x4){0.f, 0.f, 0.f, 0.f};
    typedef typename FragT<FP8>::A4 FragA; typedef typename FragT<FP8>::B2 FragB;
    FragA At; FragB B0, B1;
    const char* cA = cur.a; const char* cB = cur.b; int nt = cur.nt; asm volatile("" : "+s"(nt));
    PG8_STAGE(PG8_SB(0, 0), cB, voffB); PG8_STAGE(PG8_SB(0, 1), cB + hstepB, voffB); PG8_STAGE(PG8_SA(0, 0), cA, vAc[0]); PG8_STAGE(PG8_SA(0, 1), cA + hstepA, vAc[AH1]);
    if (wr == 1) PG8_BAR;
    PG8_WAIT_V(2); PG8_BAR;
    PG8_STAGE(PG8_SB(1, 0), cB + kstep, voffB); PG8_STAGE(PG8_SA(1, 0), cA + kstep, vAc[0]); PG8_STAGE(PG8_SB(1, 1), cB + hstepB + kstep, voffB);
    PG8_WAIT_V(6); PG8_BAR;
    for (;;) {
        const bool has_next = S.next(ui + 1, nxt);
        if constexpr (AOff::PER_UNIT) { if (has_next) AO.issue_dma(nxt, RR, xdst); }
        if constexpr (Epi::PREFETCH) E.prefetch(cur, wid, wr, lane);
        const char* nA = has_next ? nxt.a : cA; const char* nB = has_next ? nxt.b : cB;
        for (int t = 0; t < nt; t += 2) {
            const bool last = (t == nt - 2);
            const int rlx = ((t == 0) && (ui > 0)) ? 1 : 0;
            const char* a1 = cA + (size_t)(t + 1) * kstep;
            const char* a2 = last ? nA : cA + (size_t)(t + 2) * kstep; const char* b2 = last ? nB : cB + (size_t)(t + 2) * kstep;
            const char* a3 = a2 + kstep; const char* b3 = b2 + kstep;

            PG8_LDB(B0, 0, 0); PG8_LDB(B1, 0, 1); PG8_SCHED; PG8_LDA(At, 0, 0); PG8_STAGE(PG8_SA(1, 1), a1 + hstepA, vAc[AH1]);
            if constexpr (AOff::PER_UNIT) { if (last && has_next) { int raw[4]; raw[0] = (int)xw[0]; raw[1] = (int)xw[64]; raw[2] = (int)xw[128]; raw[3] = (int)xw[192]; AO.finish(raw, vAc, CC); } }
            if constexpr (Epi::NSTORE + Epi::NPRE > 0) wait_vm_sel<8 + Epi::NSTORE + Epi::NPRE>(rlx); else PG8_WAIT_V(8);
            PG8_WAIT_L(0); PG8_BAR; PG8_MMA(0, 0, At, B0); PG8_MMA(0, 1, At, B1); PG8_BAR; PG8_SCHED;
            PG8_LDA(At, 0, 1); PG8_STAGE(PG8_SB(0, 0), b2, voffB); PG8_STAGE(PG8_SB(0, 1), b2 + hstepB, voffB); PG8_STAGE(PG8_SA(0, 0), a2, vAc[0]);
            if constexpr (Epi::NSTORE + Epi::NPRE > 0) wait_vm_sel<8 + Epi::NSTORE + Epi::NPRE>(rlx); else PG8_WAIT_V(8);
            PG8_WAIT_L(0); PG8_BAR; PG8_MMA(1, 0, At, B0); PG8_MMA(1, 1, At, B1); PG8_BAR; PG8_SCHED;
            PG8_LDB(B0, 1, 0); PG8_LDB(B1, 1, 1); PG8_SCHED; PG8_LDA(At, 1, 0); PG8_STAGE(PG8_SA(0, 1), a2 + hstepA, vAc[AH1]);
            PG8_WAIT_V(8); PG8_WAIT_L(0); PG8_BAR; PG8_MMA(0, 0, At, B0); PG8_MMA(0, 1, At, B1); PG8_BAR; PG8_SCHED;
            PG8_LDA(At, 1, 1); PG8_STAGE(PG8_SB(1, 0), b3, voffB); PG8_STAGE(PG8_SB(1, 1), b3 + hstepB, voffB); PG8_STAGE(PG8_SA(1, 0), a3, vAc[0]);
            PG8_WAIT_V(8); PG8_WAIT_L(0); PG8_BAR; PG8_MMA(1, 0, At, B0); PG8_MMA(1, 1, At, B1); PG8_BAR; PG8_SCHED;
        }
        if constexpr (ALIGN_EPI) { if (wr == 0) PG8_BAR; }
        { const int el = mk_lane(); const int efr = el & 15, efq = el >> 4;
          E(acc, cur, wr, wc, efr, efq); }
        if (!has_next) break;
#pragma unroll
        for (int a = 0; a < 2; ++a)
#pragma unroll
            for (int b = 0; b < 2; ++b)
#pragma unroll
                for (int m = 0; m < 4; ++m)
#pragma unroll
                    for (int n = 0; n < 2; ++n) acc[a][b][m][n] = (f32x4){0.f, 0.f, 0.f, 0.f};
        cur = nxt; cA = nA; cB = nB; nt = cur.nt; asm volatile("" : "+s"(nt)); ++ui;

        if constexpr (ALIGN_EPI) { if (wr == 1) PG8_BAR; }
    }
    PG8_WAIT_V(0);
    if constexpr (!ALIGN_EPI) { if (wr == 0) PG8_BAR; }
    PG8_BAR;
#undef PG8_SA
#undef PG8_SB
#undef PG8_STAGE
#undef PG8_LDA
#undef PG8_LDB
#undef PG8_MMA
#undef PG8_LD8
#undef PG8_WAIT_V
#undef PG8_WAIT_L
#undef PG8_BAR
#undef PG8_SCHED
}
}
namespace attn_body {
using bf16=__hip_bfloat16;
using bf16x8=__attribute__((ext_vector_type(8)))short;
using s16x4=__attribute__((ext_vector_type(4)))short;
using f32x16=__attribute__((ext_vector_type(16)))float;
using u32x4=__attribute__((ext_vector_type(4)))unsigned;
constexpr int SEQ=8192,D=64;
constexpr int PQ=512,PK=512,PV=512,PO=512,PA=1024;
constexpr int NW=8,QBLK=32,QB=QBLK*NW,KVBLK=64,NQB=SEQ/QB;
constexpr int ATTN_UNIT_ROWS=QB;
__device__ __forceinline__ int crow(int r,int hi){return (r&3)+8*(r>>2)+4*hi;}
#define SBAR() __builtin_amdgcn_sched_barrier(0)
__device__ __forceinline__ void cmask(f32x16&p0,f32x16&p1,int jb,int qrel,int hi){
  const float NEG=-INFINITY; int kb=64*jb+4*hi;
  #pragma unroll
  for(int r=0;r<16;++r){int kv=kb+(r&3)+8*(r>>2); if(kv>qrel)p0[r]=NEG; if(kv+32>qrel)p1[r]=NEG;}
}

constexpr int NSLOT=3, SLOTB=8192;
constexpr int LDS_K=0, LDS_V=NSLOT*SLOTB, LDS_WS=3*NSLOT*SLOTB, LDS_OST=LDS_WS+NW*64*4, LDS_BYTES=LDS_OST+NW*8192;
constexpr float C2=0.125f*1.4426950408889634f;
__device__ __forceinline__ void glds16(const void*sbase,unsigned voff,unsigned lds_dst){unsigned keep;
  asm volatile("s_mov_b32 %0, m0\n\ts_mov_b32 m0, %3\n\ts_nop 0\n\tglobal_load_lds_dwordx4 %1, %2\n\ts_mov_b32 m0, %0":"=&s"(keep):"v"(voff),"s"(sbase),"s"(lds_dst):"memory");}
__device__ __forceinline__ float max3f(float a,float b,float c){float r;asm("v_max3_f32 %0, %1, %2, %3":"=v"(r):"v"(a),"v"(b),"v"(c));return r;}
__device__ __forceinline__ float max2f(float a,float b){float r;asm("v_max_f32_e32 %0, %1, %2":"=v"(r):"v"(a),"v"(b));return r;}
__device__ __forceinline__ float fadd_s(float a,float b){float r;asm("v_add_f32_e32 %0, %1, %2":"=v"(r):"v"(a),"v"(b));return r;}
__device__ __forceinline__ float fsub_s(float a,float b){float r;asm("v_sub_f32_e32 %0, %1, %2":"=v"(r):"v"(a),"v"(b));return r;}
typedef float f32x2_t __attribute__((ext_vector_type(2))); typedef __bf16 bf16x2_t __attribute__((ext_vector_type(2)));
__device__ __forceinline__ unsigned cvtpk_s(float lo,float hi){f32x2_t v={lo,hi};bf16x2_t b=__builtin_convertvector(v,bf16x2_t);return __builtin_bit_cast(unsigned,b);}
#define WAIT_BAR(N) asm volatile("s_waitcnt vmcnt(" #N ") lgkmcnt(0)\n\ts_barrier":::"memory")

__device__ __forceinline__ void qkt(f32x16&p0,f32x16&p1,const char*Kslot,const bf16x8*qr,const f32x16&negm,int r32,int hi){
  const char*kb=Kslot+hi*1024+r32*16;
  #pragma unroll
  for(int d0=0;d0<4;++d0){
    const bf16x8 b0=*reinterpret_cast<const bf16x8*>(kb+d0*2048);
    const bf16x8 b1=*reinterpret_cast<const bf16x8*>(kb+d0*2048+512);
    if(d0==0){p0=__builtin_amdgcn_mfma_f32_32x32x16_bf16(b0,qr[0],negm,0,0,0);p1=__builtin_amdgcn_mfma_f32_32x32x16_bf16(b1,qr[0],negm,0,0,0);}
    else{p0=__builtin_amdgcn_mfma_f32_32x32x16_bf16(b0,qr[d0],p0,0,0,0);p1=__builtin_amdgcn_mfma_f32_32x32x16_bf16(b1,qr[d0],p1,0,0,0);}}
}
typedef __attribute__((address_space(3))) const char* lds_cptr;
typedef short v4i16_t __attribute__((ext_vector_type(4)));
__device__ __forceinline__ void kload8(bf16x8*kf,lds_cptr kp){
  kf[0]=*(const __attribute__((address_space(3))) bf16x8*)(kp);      kf[1]=*(const __attribute__((address_space(3))) bf16x8*)(kp+512);
  kf[2]=*(const __attribute__((address_space(3))) bf16x8*)(kp+2048); kf[3]=*(const __attribute__((address_space(3))) bf16x8*)(kp+2560);
  kf[4]=*(const __attribute__((address_space(3))) bf16x8*)(kp+4096); kf[5]=*(const __attribute__((address_space(3))) bf16x8*)(kp+4608);
  kf[6]=*(const __attribute__((address_space(3))) bf16x8*)(kp+6144); kf[7]=*(const __attribute__((address_space(3))) bf16x8*)(kp+6656);
}
__device__ __forceinline__ void kload2(bf16x8*kf,lds_cptr kp,int j){ kf[2*j]=*(const __attribute__((address_space(3))) bf16x8*)(kp+j*2048); kf[2*j+1]=*(const __attribute__((address_space(3))) bf16x8*)(kp+j*2048+512); }
__device__ __forceinline__ s16x4 vtr(lds_cptr p){ return __builtin_bit_cast(s16x4,__builtin_amdgcn_ds_read_tr16_b64_v4i16((__attribute__((address_space(3))) v4i16_t*)p)); }
__device__ __forceinline__ float rowmax(const f32x16&p0,const f32x16&p1){
  float a=max3f(p0[0],p0[1],p1[0]),b=max3f(p0[2],p0[3],p1[1]);a=max3f(a,p1[2],p1[3]);
  #pragma unroll
  for(int r=4;r<16;r+=4){a=max3f(a,p0[r],p0[r+1]);b=max3f(b,p0[r+2],p0[r+3]);a=max3f(a,p1[r],p1[r+1]);b=max3f(b,p1[r+2],p1[r+3]);}
  const float m=max2f(a,b);
  auto rr=__builtin_amdgcn_permlane32_swap(__float_as_uint(m),__float_as_uint(m),false,false);
  return max2f(__uint_as_float(rr[0]),__uint_as_float(rr[1]));
}
__device__ __forceinline__ void pv(f32x16*o,int vb,bf16x8 pa0,bf16x8 pa1,bf16x8 pa2,bf16x8 pa3){
  #pragma unroll
  for(int d0=0;d0<4;++d0){s16x4 lo[4],hi[4];
    #pragma unroll
    for(int ks=0;ks<4;++ks){
      asm volatile("ds_read_b64_tr_b16 %0,%1 offset:%c2":"=&v"(lo[ks]):"v"(vb),"i"(d0*4096+ks*1024):"memory");
      asm volatile("ds_read_b64_tr_b16 %0,%1 offset:%c2":"=&v"(hi[ks]):"v"(vb),"i"(d0*4096+ks*1024+512):"memory");}
    asm volatile("s_waitcnt lgkmcnt(0)":::"memory");SBAR();
    #define PK(k) (bf16x8){lo[k][0],lo[k][1],lo[k][2],lo[k][3],hi[k][0],hi[k][1],hi[k][2],hi[k][3]}
    o[d0]=__builtin_amdgcn_mfma_f32_32x32x16_bf16(pa0,PK(0),o[d0],0,0,0);
    o[d0]=__builtin_amdgcn_mfma_f32_32x32x16_bf16(pa1,PK(1),o[d0],0,0,0);
    o[d0]=__builtin_amdgcn_mfma_f32_32x32x16_bf16(pa2,PK(2),o[d0],0,0,0);
    o[d0]=__builtin_amdgcn_mfma_f32_32x32x16_bf16(pa3,PK(3),o[d0],0,0,0);
    #undef PK
  }
}

#ifndef ATTN_STORE16
#define ATTN_STORE16(p,v) (*(u32x4*)(p)=(v))
#endif
template<int THRL> __device__ __forceinline__ void attn_unit(int b,int qoff,int koff,int voff,int ooff,int qb,const bf16*Q,const bf16*__restrict__ K,const bf16*__restrict__ V,bf16*O,char*shm,const int wave_,const int map,bf16*AOUT,const float lam,const float*ng){
  const int lane=mk_lane(),r32=lane&31,hi=lane>>5; const int wid=__builtin_amdgcn_readfirstlane(wave_);
  const long rowbase=(long)b*SEQ; const int q0=qb*QB;
  const bf16*Qw=Q+(rowbase+q0+wid*QBLK)*PQ+qoff;
  const bf16*Kh=K+rowbase*PK+koff,*Vh=V+rowbase*PV+voff;
  const unsigned lds0=(unsigned)(uintptr_t)shm;
  float*wsf=(float*)(shm+LDS_WS)+wid*64;
  const unsigned kofs=(unsigned)(lane*PK+wid*8)*2u;
  const unsigned voffs=(unsigned)((16*(wid&3)+(lane>>2))*PV+(wid>>2)*32+(lane&3)*8)*2u;
  const unsigned kdst=lds0+LDS_K+wid*1024, vdst=lds0+LDS_V+wid*1024;
  #define DMA_K(t,slot) glds16(Kh+(long)(t)*KVBLK*PK,kofs,(unsigned)__builtin_amdgcn_readfirstlane(kdst+(slot)))
  #define DMA_V(t,slot) do{ glds16(Vh+(long)(t)*KVBLK*PV,voffs,(unsigned)__builtin_amdgcn_readfirstlane(vdst+2*(slot))); glds16(Vh+(long)(t)*KVBLK*PV+64,voffs,(unsigned)__builtin_amdgcn_readfirstlane(vdst+2*(slot)+8192)); }while(0)
  const int vb0=(int)(lds0+LDS_V)+((lane>>4)&1)*32+(lane&3)*8+(4*hi+((lane&15)>>2))*64;
  const char*Kbase=shm+LDS_K; bf16x8 kf[8];
  const lds_cptr shm3=(lds_cptr)shm; const lds_cptr kp0=shm3+LDS_K+hi*1024+r32*16; const lds_cptr vp0=shm3+LDS_V+((lane>>4)&1)*32+(lane&3)*8+(4*hi+((lane&15)>>2))*64;
  const int NT=(q0+QB)/KVBLK;
  DMA_K(0,0);DMA_V(0,0);DMA_K(1,SLOTB);
  bf16x8 qr[4];
  #pragma unroll
  for(int d0=0;d0<4;++d0)qr[d0]=*reinterpret_cast<const bf16x8*>(&Qw[(long)r32*PQ+d0*16+hi*8]);
  typedef __attribute__((address_space(3))) char* lds_wptr;
  const lds_cptr qp0=shm3+LDS_OST+wid*8192+hi*512+r32*16;
  { lds_wptr qw=(lds_wptr)shm+LDS_OST+wid*8192+hi*512+r32*16;
    _Pragma("unroll") for(int d0=0;d0<4;++d0)*(__attribute__((address_space(3))) bf16x8*)(qw+d0*1024)=qr[d0]; }
  float mhat=0.f,l_reg=0.f;f32x16 o[4];o[0]=f32x16{};o[1]=f32x16{};o[2]=f32x16{};o[3]=f32x16{};const f32x16 zero16=f32x16{};
  const int qrel=wid*QBLK+r32;
  #define CMASK(P0,P1,t) do{int jb_=(t)-(NT-4); if(jb_>=0)cmask(P0,P1,jb_,qrel,hi);}while(0)
  bool resc=false;
  #define START(P0,P1) do{ const float rm=rowmax(P0,P1); resc=false; mhat=rm; \
    _Pragma("unroll") for(int r=0;r<16;++r)P0[r]=__builtin_amdgcn_exp2f(P0[r]-mhat); }while(0)
  #define RESC() do{ if(resc){ asm volatile("s_waitcnt lgkmcnt(0)":::"memory"); \
      _Pragma("unroll") for(int d_=0;d_<4;++d_) _Pragma("unroll") for(int r=0;r<16;++r)o[d_][r]*=wsf[crow(r,hi)]; } }while(0)
  f32x16 pA0,pA1,pB0,pB1;
  int sl_prev=0,sl_cur=0,sl_next=SLOTB;
  #define ROT() do{sl_prev=sl_cur;sl_cur=sl_next;sl_next=(sl_next==(NSLOT-1)*SLOTB)?0:sl_next+SLOTB;}while(0)
  DMA_K(2,2*SLOTB);
  WAIT_BAR(4);
  qkt(pA0,pA1,Kbase,qr,zero16,r32,hi);asm volatile("s_nop 15\n\ts_nop 7":"+v"(pA0),"+v"(pA1));CMASK(pA0,pA1,0);
  START(pA0,pA1);
  _Pragma("unroll") for(int r=0;r<16;++r)pA1[r]=__builtin_amdgcn_exp2f(pA1[r]-mhat);
  WAIT_BAR(0);
  DMA_K(3,0);DMA_V(1,SLOTB);
  ROT();
  kload8(kf,kp0+sl_cur);
  WAIT_BAR(3);
  s16x4 vlo[3],vhi[3]; u32x4 pw0,pw1,pw2,pw3;
  #define PKW(P,B) cvtpk_s(P[B],P[B+1])
  #define PAF(k) __builtin_bit_cast(bf16x8,pw##k)
  #define VFS(s) (bf16x8){vlo[s][0],vlo[s][1],vlo[s][2],vlo[s][3],vhi[s][0],vhi[s][1],vhi[s][2],vhi[s][3]}
  #define PIN(x) asm volatile("":"+v"(x))
  #define MX3(a,b,c) __builtin_fmaxf(__builtin_fmaxf((a),(b)),(c))
  #define GAPA(MF,A0,A1,A2,A3,W0,W1,PW) do{ MF; sacc+=A0; sacc+=A1; sacc+=A2; sacc+=A3; PIN(sacc); W0; W1; PIN(PW); SBAR(); }while(0)
  #define EX(v) __builtin_amdgcn_exp2f(v)
  #define GAPB(MF,X,B) do{ MF; X[B]=EX(X[B]-mhat); X[B+1]=EX(X[B+1]-mhat); PIN(X); SBAR(); }while(0)
  #define VRDG(g) do{ vlo[(g)%3]=vtr(vp_+(((g)&3)*4096+((g)>>2)*1024)); vhi[(g)%3]=vtr(vp_+(((g)&3)*4096+((g)>>2)*1024+512)); SBAR(); }while(0)
  #define QRD(d0) (*(const __attribute__((address_space(3))) bf16x8*)(qp0+(d0)*1024))
  #define KRD(G,j) do{ if(G){ kload2(kf,kp0+sl_next,j); SBAR(); } }while(0)
  #define PVG(g,PF,X,B) GAPB(o[(g)&3]=__builtin_amdgcn_mfma_f32_32x32x16_bf16(PF,VFS((g)%3),o[(g)&3],0,0,0), X,B)
  #define STEP(C0,C1,P0,P1,t,GK,GV,GL) do{ SBAR(); \
    const lds_cptr vp_=vp0+2*sl_prev; \
    bf16x8 qa=QRD(0), qb=QRD(1); SBAR(); float sacc=(P0[0]+P0[1]); \
    GAPA(C0=__builtin_amdgcn_mfma_f32_32x32x16_bf16(kf[0],qa,zero16,0,0,0), P0[2],P0[3],P0[4],P0[5],     pw0[0]=PKW(P0,0), pw0[1]=PKW(P0,2), pw0); \
    GAPA(C1=__builtin_amdgcn_mfma_f32_32x32x16_bf16(kf[1],qa,zero16,0,0,0), P0[6],P0[7],P0[8],P0[9],     pw0[2]=PKW(P0,4), pw0[3]=PKW(P0,6), pw0); \
    qa=QRD(2); SBAR(); \
    GAPA(C0=__builtin_amdgcn_mfma_f32_32x32x16_bf16(kf[2],qb,C0,0,0,0),   P0[10],P0[11],P0[12],P0[13], pw1[0]=PKW(P0,8), pw1[1]=PKW(P0,10), pw1); \
    GAPA(C1=__builtin_amdgcn_mfma_f32_32x32x16_bf16(kf[3],qb,C1,0,0,0),   P0[14],P0[15],P1[0],P1[1],   pw1[2]=PKW(P0,12),pw1[3]=PKW(P0,14), pw1); \
    qb=QRD(3); SBAR(); \
    GAPA(C0=__builtin_amdgcn_mfma_f32_32x32x16_bf16(kf[4],qa,C0,0,0,0),   P1[2],P1[3],P1[4],P1[5],     pw2[0]=PKW(P1,0), pw2[1]=PKW(P1,2), pw2); \
    GAPA(C1=__builtin_amdgcn_mfma_f32_32x32x16_bf16(kf[5],qa,C1,0,0,0),   P1[6],P1[7],P1[8],P1[9],     pw2[2]=PKW(P1,4), pw2[3]=PKW(P1,6), pw2); \
    GAPA(C0=__builtin_amdgcn_mfma_f32_32x32x16_bf16(kf[6],qb,C0,0,0,0),   P1[10],P1[11],P1[12],P1[13], pw3[0]=PKW(P1,8), pw3[1]=PKW(P1,10), pw3); \
    GAPA(C1=__builtin_amdgcn_mfma_f32_32x32x16_bf16(kf[7],qb,C1,0,0,0),   P1[14],P1[15],0.f,0.f,       pw3[2]=PKW(P1,12),pw3[3]=PKW(P1,14), pw3); \
    l_reg+=sacc; \
    if(GK){DMA_K((t)+3,sl_cur);} if(GV){DMA_V((t)+1,sl_next);} \
    VRDG(0); VRDG(1); \
    CMASK(C0,C1,t); \
    { float a=MX3(C0[0],C0[1],C1[0]),b=MX3(C0[2],C0[3],C1[1]); a=MX3(a,C1[2],C1[3]); \
      _Pragma("unroll") for(int r=4;r<16;r+=4){a=MX3(a,C0[r],C0[r+1]);b=MX3(b,C0[r+2],C0[r+3]);a=MX3(a,C1[r],C1[r+1]);b=MX3(b,C1[r+2],C1[r+3]);} \
      float rm=__builtin_fmaxf(a,b); { auto rr=__builtin_amdgcn_permlane32_swap(__float_as_uint(rm),__float_as_uint(rm),false,false); rm=__builtin_fmaxf(__uint_as_float(rr[0]),__uint_as_float(rr[1])); } \
      rm-=mhat; resc=false; \
      if(__builtin_expect(__any(rm>(float)THRL),0)){ const float dl=__builtin_fmaxf(rm,0.f); mhat+=dl; \
        const float f=__builtin_amdgcn_exp2f(-dl); l_reg*=f; if(hi==0)wsf[r32]=f; resc=true; } } \
    SBAR(); \
    PVG(0,PAF(0),C0,0);  VRDG(2); \
    PVG(1,PAF(0),C0,2);  VRDG(3); \
    PVG(2,PAF(0),C0,4);  VRDG(4); \
    PVG(3,PAF(0),C0,6);  VRDG(5); \
    PVG(4,PAF(1),C0,8);  VRDG(6); \
    PVG(5,PAF(1),C0,10); VRDG(7); \
    PVG(6,PAF(1),C0,12); VRDG(8); \
    PVG(7,PAF(1),C0,14); VRDG(9); \
    PVG(8,PAF(2),C1,0);  VRDG(10); \
    PVG(9,PAF(2),C1,2);  VRDG(11); \
    PVG(10,PAF(2),C1,4); VRDG(12); \
    PVG(11,PAF(2),C1,6); VRDG(13); \
    PVG(12,PAF(3),C1,8); VRDG(14); KRD(GL,0); \
    PVG(13,PAF(3),C1,10); VRDG(15); KRD(GL,1); \
    PVG(14,PAF(3),C1,12); KRD(GL,2); \
    PVG(15,PAF(3),C1,14); KRD(GL,3); \
    }while(0)
  int t=1;
  #undef CMASK
  #define CMASK(P0,P1,t) do{}while(0)
  for(;t+5<NT;t+=2){
    STEP(pB0,pB1,pA0,pA1,t,true,true,true);     WAIT_BAR(3); RESC(); ROT();
    STEP(pA0,pA1,pB0,pB1,t+1,true,true,true);   WAIT_BAR(3); RESC(); ROT();
  }
  #undef CMASK
  #define CMASK(P0,P1,t) do{int jb_=(t)-(NT-4); if(jb_>=0)cmask(P0,P1,jb_,qrel,hi);}while(0)
  #define ENDW(tt) do{ if((tt)+3<NT){WAIT_BAR(3);} else if((tt)+2<NT){WAIT_BAR(2);} else {WAIT_BAR(0);} }while(0)
  for(;t+1<NT;t+=2){
    STEP(pB0,pB1,pA0,pA1,t,(t+3<NT),(t+1<NT),(t+1<NT));       ENDW(t);   RESC(); ROT();
    STEP(pA0,pA1,pB0,pB1,t+1,(t+4<NT),(t+2<NT),(t+2<NT));     ENDW(t+1); RESC(); ROT();
  }
  STEP(pB0,pB1,pA0,pA1,NT-1,false,false,false); RESC();
  { float sacc=pB0[0]+pB0[1]; _Pragma("unroll") for(int r=2;r<16;++r)sacc+=pB0[r]; _Pragma("unroll") for(int r=0;r<16;++r)sacc+=pB1[r]; l_reg+=sacc;
    pw0=(u32x4){PKW(pB0,0),PKW(pB0,2),PKW(pB0,4),PKW(pB0,6)};pw1=(u32x4){PKW(pB0,8),PKW(pB0,10),PKW(pB0,12),PKW(pB0,14)};pw2=(u32x4){PKW(pB1,0),PKW(pB1,2),PKW(pB1,4),PKW(pB1,6)};pw3=(u32x4){PKW(pB1,8),PKW(pB1,10),PKW(pB1,12),PKW(pB1,14)};
    SBAR(); pv(o,vb0+2*sl_cur,PAF(0),PAF(1),PAF(2),PAF(3)); }
  #undef PKW
  #undef PAF
  #undef VFS
  #undef VRDG
  #undef QRD
  #undef PVG
  #undef PIN
  #undef MX3
  #undef GAPA
  #undef GAPB
  #undef EX
  #undef KRD
  #undef STEP
  #undef ENDW
  { int lane_e=mk_lane(); asm volatile("":"+v"(lane_e)); const int lane=lane_e,r32=lane&31,hi=lane>>5;
  {auto rr=__builtin_amdgcn_permlane32_swap(__float_as_uint(l_reg),__float_as_uint(l_reg),false,false);l_reg=__uint_as_float(rr[0])+__uint_as_float(rr[1]);}
  if(hi==0)wsf[32+r32]=l_reg;asm volatile("s_waitcnt lgkmcnt(0)":::"memory");
  float rli[16];
  #pragma unroll
  for(int r=0;r<16;++r)rli[r]=__builtin_amdgcn_rcpf(wsf[32+crow(r,hi)]);
  bf16*Ow=O+(rowbase+q0+wid*QBLK)*PO+ooff;
  { bf16*stg=(bf16*)(shm+LDS_OST)+wid*4096;
    #pragma unroll
    for(int r=0;r<16;++r){const int orow=crow(r,hi);
      #pragma unroll
      for(int d0=0;d0<4;++d0)stg[orow*128+d0*32+r32]=__float2bfloat16(o[d0][r]*rli[r]);}
    asm volatile("s_waitcnt lgkmcnt(0)":::"memory");
    if(map==0){
      #pragma unroll
      for(int i=0;i<8;++i){const int row=i*4+(lane>>4),ch=lane&15; const u32x4 v=*(const u32x4*)(stg+row*128+ch*8); ATTN_STORE16(Ow+(long)row*PO+ch*8,v);}
    }else{
      const int ch=lane&15; const float4 g0=*reinterpret_cast<const float4*>(ng+ch*8),g1=*reinterpret_cast<const float4*>(ng+ch*8+4);
      bf16*Aw=AOUT+(rowbase+q0+wid*QBLK)*PA+ooff;
      #pragma unroll
      for(int i=0;i<8;++i){const int row=i*4+(lane>>4); const u32x4 v2=*(const u32x4*)(stg+row*128+ch*8); const u32x4 v1=*(const u32x4*)(Ow+(long)row*PO+ch*8);
        float d[8];
        #define BLO(w) __uint_as_float((w)<<16)
        #define BHI(w) __uint_as_float((w)&0xffff0000u)
        d[0]=BLO(v1[0])-lam*BLO(v2[0]);d[1]=BHI(v1[0])-lam*BHI(v2[0]);d[2]=BLO(v1[1])-lam*BLO(v2[1]);d[3]=BHI(v1[1])-lam*BHI(v2[1]);
        d[4]=BLO(v1[2])-lam*BLO(v2[2]);d[5]=BHI(v1[2])-lam*BHI(v2[2]);d[6]=BLO(v1[3])-lam*BLO(v2[3]);d[7]=BHI(v1[3])-lam*BHI(v2[3]);
        #undef BLO
        #undef BHI
        float ss=0.f;
        #pragma unroll
        for(int q=0;q<8;++q)ss+=d[q]*d[q];
        ss+=__shfl_xor(ss,1);ss+=__shfl_xor(ss,2);ss+=__shfl_xor(ss,4);ss+=__shfl_xor(ss,8);
        const float sc=0.8f/sqrtf(ss*(1.f/128.f)+1e-6f);
        u32x4 w; w[0]=cvtpk_s(d[0]*sc*g0.x,d[1]*sc*g0.y);w[1]=cvtpk_s(d[2]*sc*g0.z,d[3]*sc*g0.w);w[2]=cvtpk_s(d[4]*sc*g1.x,d[5]*sc*g1.y);w[3]=cvtpk_s(d[6]*sc*g1.z,d[7]*sc*g1.w);
        __builtin_nontemporal_store(w,(u32x4*)(Aw+(long)row*PA+ch*8));}
    } }
  }
  asm volatile("s_waitcnt lgkmcnt(0)\n\ts_barrier":::"memory");
  #undef DMA_K
  #undef DMA_V
  #undef CMASK
  #undef START
  #undef RESC
  #undef ROT
}
constexpr int ATTN_LDS_BYTES=LDS_BYTES;
#undef SBAR
#undef WAIT_BAR
}
#define GAS __attribute__((address_space(1)))
#define LAS __attribute__((address_space(3)))
typedef unsigned short bf16;
typedef unsigned v4u __attribute__((ext_vector_type(4)));
typedef float f32x4 __attribute__((ext_vector_type(4)));
typedef short bf16x8 __attribute__((ext_vector_type(8)));
typedef GAS unsigned gu32;
typedef GAS unsigned long long gu64;
#define RLX_AGENT __ATOMIC_RELAXED, __HIP_MEMORY_SCOPE_AGENT
#define LDS_WAIT() asm volatile("s_waitcnt lgkmcnt(0)" ::: "memory")
#define VM_WAIT() asm volatile("s_waitcnt vmcnt(0)" ::: "memory")
__device__ __forceinline__ unsigned long long rt() { return __builtin_amdgcn_s_memrealtime(); }
__device__ __forceinline__ unsigned f2bf(float f) { unsigned u = __builtin_bit_cast(unsigned, f); return (u + 0x7fffu + ((u >> 16) & 1u)) >> 16; }
__device__ __forceinline__ unsigned pk2(float lo, float hi) { return f2bf(lo) | (f2bf(hi) << 16); }

#define XB_TMO      128
#define XB_XCNT(j)  (256  + 64 * (j))
#define XB_XSUB(j)  (1280 + 64 * (j))
#define XB_XGEN(j)  (2304 + 64 * (j))
#define XB_TOP      3328
#define XB_TOPGEN   3392
#define XCD_BAR_WORDS 3456
#define XB_SPIN_CAP (1u << 18)

__device__ __forceinline__ unsigned xb_ld(unsigned* p)              { return __hip_atomic_load(p, __ATOMIC_RELAXED, __HIP_MEMORY_SCOPE_AGENT); }
__device__ __forceinline__ unsigned xb_add(unsigned* p, unsigned v) { return __hip_atomic_fetch_add(p, v, __ATOMIC_RELAXED, __HIP_MEMORY_SCOPE_AGENT); }
__device__ __forceinline__ unsigned xb_xcc_id() { return (unsigned)__builtin_amdgcn_s_getreg((3 << 11) | 20) & 0xFu; }
#define XB_SPIN(cond, bar) do { unsigned _sp = 0; while (cond) { __builtin_amdgcn_s_sleep(1); \
    if ((++_sp & 255u) == 0u) { if (xb_ld(&(bar)[XB_TMO])) break; if (_sp > XB_SPIN_CAP) { atomicAdd(&(bar)[XB_TMO], 1u); break; } } } } while (0)

struct XcdBarrier {
    unsigned* bar; unsigned x; int wave; unsigned G;
    volatile LAS unsigned* st;
};

__device__ __forceinline__ XcdBarrier xcd_barrier_post(unsigned* bar, volatile LAS unsigned* st, int wave, unsigned G) {
    XcdBarrier b; b.bar = bar; b.x = xb_xcc_id(); b.st = st; b.wave = wave; b.G = G;
    if (wave == 0 && mk_lane() == 0) (void)xb_add(&bar[XB_XCNT(b.x)], 1u);
    return b;
}
__device__ __forceinline__ void xcd_barrier_complete(unsigned* bar, unsigned x, unsigned& nloc, unsigned& nx, const unsigned G) {
    unsigned sum, cnt, mine, sp = 0u;
    for (;;) {
        sum = 0u; cnt = 0u; mine = 0u;
#pragma unroll
        for (unsigned j = 0; j < 16; ++j) { const unsigned c = xb_ld(&bar[XB_XCNT(j)]); sum += c; cnt += (c > 0u) ? 1u : 0u; mine = (j == x) ? c : mine; }
        if (sum == G) break;
        __builtin_amdgcn_s_sleep(1);
        if ((++sp & 255u) == 0u) { if (xb_ld(&bar[XB_TMO])) break; if (sp > XB_SPIN_CAP) { atomicAdd(&bar[XB_TMO], 1u); break; } }
    }
    nloc = mine > 0u ? mine : 1u; nx = cnt > 0u ? cnt : 1u;
}

__device__ __forceinline__ void xcd_barrier(const XcdBarrier& b) {
    asm volatile("s_waitcnt vmcnt(0)" ::: "memory");
    __syncthreads();
    if (b.wave == 0 && mk_lane() == 0) {
        unsigned* bar = b.bar;
        __builtin_amdgcn_s_waitcnt(0);
        unsigned nloc = b.st[0], nx = b.st[1];
        if (nloc == 0u) { xcd_barrier_complete(bar, b.x, nloc, nx, b.G); b.st[0] = nloc; b.st[1] = nx; }
        const unsigned old = xb_add(&bar[XB_XSUB(b.x)], 1u);
        const unsigned gen = old / nloc;
        if (old + 1u == (gen + 1u) * nloc) {
            __builtin_amdgcn_fence(__ATOMIC_RELEASE, "agent");
            asm volatile("s_waitcnt vmcnt(0)" ::: "memory");
            const unsigned og = xb_add(&bar[XB_TOP], 1u);
            const unsigned tg = og / nx;
            if (og + 1u == (tg + 1u) * nx) xb_add(&bar[XB_TOPGEN], 1u);
            else XB_SPIN(xb_ld(&bar[XB_TOPGEN]) == tg, bar);
            __builtin_amdgcn_fence(__ATOMIC_ACQUIRE, "agent");
            xb_add(&bar[XB_XGEN(b.x)], 1u);
            asm volatile("s_waitcnt vmcnt(0)" ::: "memory");
        } else {
            XB_SPIN(xb_ld(&bar[XB_XGEN(b.x)]) == gen, bar);
            __builtin_amdgcn_fence(__ATOMIC_ACQUIRE, "agent");
            asm volatile("s_waitcnt vmcnt(0)" ::: "memory");
        }
    }
    __syncthreads();
}
constexpr int NWAVES = 8;
#ifndef MK_N_LAUNCHES
#define MK_N_LAUNCHES 1
#endif
constexpr int NPH = 12;
constexpr int N_LAUNCHES = MK_N_LAUNCHES;
static_assert(N_LAUNCHES == 1 || N_LAUNCHES == NPH, "MK_N_LAUNCHES is 1 or 12");

constexpr int NB = 4, SEQ = 8192, T = NB * SEQ, D = 1024;
constexpr int NE = 32, TOPK = 4, NA = T * TOPK;
constexpr int SG = 32, SL = 32, AROW_P = 640;
constexpr float RMS_EPS = 1e-6f;
constexpr float SW_LIMIT = 7.0f, SW_ALPHA = 1.702f;
constexpr float LAMBDA_INIT = 0.2f;

constexpr size_t MiB = 1u << 20;
constexpr size_t WS_CTL = 0, CTL_ZERO_BYTES = 128 * 1024;
constexpr size_t WS_ROPE = 2 * MiB;
constexpr size_t WS_WIN = 4 * MiB;
constexpr size_t WS_WOUT = 8 * MiB;
constexpr size_t WS_WGLU = 10 * MiB;
constexpr size_t WS_SMALL = 11 * MiB;
constexpr size_t SM_AL = 1024, SM_WR = 32768;
constexpr size_t WS_BTY = 12 * MiB;
constexpr size_t WS_BTX = 32 * MiB;
constexpr size_t WS_WGU = 40 * MiB;
constexpr size_t WS_WD = 168 * MiB;
constexpr size_t WS_XN = 232 * MiB;
constexpr size_t WS_Q = 296 * MiB, WS_K = 328 * MiB, WS_V = 360 * MiB;
constexpr size_t WS_AROW = 392 * MiB;
constexpr size_t WS_XLOC = 432 * MiB;
constexpr size_t WS_O = 464 * MiB;
constexpr size_t WS_MIX = 464 * MiB;
constexpr size_t WS_ACAT = 528 * MiB;
constexpr size_t WS_HB = 528 * MiB;
constexpr size_t WS_YG = 592 * MiB;
constexpr size_t WS_GLU = 624 * MiB;
constexpr size_t WS_LIST = 656 * MiB;
constexpr size_t WS_GATES = 660 * MiB;
constexpr size_t WS_ACT = 296 * MiB;
constexpr size_t WS_YBUF = 664 * MiB;
constexpr size_t WS_END = 920 * MiB;
static_assert(WS_ACT + (size_t)(NA + 8192) * 1024 * 2 <= WS_YG, "Act overlay");
constexpr int CW_TMO = 0, CW_CODE = 1;
constexpr int CW_BAR = 4096;
constexpr int CW_ECNT = 16384;

constexpr int RING_OFF = 0, RING_BYTES = 131072;
constexpr int WRT_BYTES = 1024 * 36 * 4;
constexpr int LDSCTL_OFF = 147456, MISC_OFF = LDSCTL_OFF;
constexpr int MOE_OFF = LDSCTL_OFF + 256;
constexpr int RT_OFF = LDSCTL_OFF + 640;
constexpr int ST_OFF = LDSCTL_OFF + 1024;
constexpr int EPB_OFF = 131072;
constexpr int LDS_BYTES = 157696;
static_assert(ST_OFF + 8192 <= LDS_BYTES, "LDS map");

struct Args { const void* in[29]; float* out; unsigned char* ws; int ph_lo, ph_hi, li, pad; };
struct Frame {
    LAS unsigned char* lds;
    volatile LAS unsigned* MISC;
    gu32* ctl;
    int wave;
    int vcu, G;
};
#define INF(a, k) ((const float*)(a).in[k])
#define FTID(F) ((F).wave * 64 + mk_lane())
#ifndef PROBE_DUP
#define PROBE_DUP -1
#endif
#define NREP(k) ((PROBE_DUP == (k)) ? 2 : 1)

__device__ __forceinline__ unsigned pk_fp8x4_(float a, float b, float c, float d) { int w = 0; w = __builtin_amdgcn_cvt_pk_fp8_f32(a, b, w, false); w = __builtin_amdgcn_cvt_pk_fp8_f32(c, d, w, true); return (unsigned)w; }
__device__ __forceinline__ float wave_sum(float v) {
#pragma unroll
    for (int o = 1; o < 64; o <<= 1) v += __shfl_xor(v, o);
    return v;
}
template <bool FP8> __device__ __forceinline__ void p0_tr64(const float* W, int K, int N, void* WT, LAS float* scr, int item, int lane, float scale) {
    const int nblk = N / 64, kb = item / nblk, nb = item % nblk, k0 = 64 * kb, n0 = 64 * nb;
    f32x4 v[16];
#pragma unroll
    for (int i = 0; i < 16; ++i) v[i] = __builtin_nontemporal_load((const GAS f32x4*)(W + (size_t)(k0 + i * 4 + (lane >> 4)) * N + n0 + 4 * (lane & 15)));
#pragma unroll
    for (int i = 0; i < 16; ++i) *(LAS f32x4*)(scr + (i * 4 + (lane >> 4)) * 68 + 4 * (lane & 15)) = v[i];
    LDS_WAIT(); asm volatile("" ::: "memory");
    if constexpr (FP8) {
#pragma unroll
        for (int c = 0; c < 4; ++c) { const LAS float* s = scr + (16 * c) * 68 + lane; v4u o;
            o.x = pk_fp8x4_(s[0 * 68] * scale, s[1 * 68] * scale, s[2 * 68] * scale, s[3 * 68] * scale); o.y = pk_fp8x4_(s[4 * 68] * scale, s[5 * 68] * scale, s[6 * 68] * scale, s[7 * 68] * scale);
            o.z = pk_fp8x4_(s[8 * 68] * scale, s[9 * 68] * scale, s[10 * 68] * scale, s[11 * 68] * scale); o.w = pk_fp8x4_(s[12 * 68] * scale, s[13 * 68] * scale, s[14 * 68] * scale, s[15 * 68] * scale);
            *(GAS v4u*)((unsigned char*)WT + (size_t)(n0 + lane) * K + k0 + 16 * c) = o; }
    } else {
#pragma unroll
        for (int c = 0; c < 8; ++c) { const LAS float* s = scr + (8 * c) * 68 + lane;
            v4u o; o.x = pk2(s[0 * 68], s[1 * 68]); o.y = pk2(s[2 * 68], s[3 * 68]); o.z = pk2(s[4 * 68], s[5 * 68]); o.w = pk2(s[6 * 68], s[7 * 68]);
            *(GAS v4u*)((bf16*)WT + (size_t)(n0 + lane) * K + k0 + 8 * c) = o; }
    }
    LDS_WAIT(); asm volatile("" ::: "memory");
}
__device__ __forceinline__ void cv_wg_item(Frame& F, const Args& a, const int item, const int lane) {
    const float* W; unsigned char* WT; int N, n0, k0;
    if (item < 512) { const int e = item >> 4, r = item & 15; N = 2048; W = INF(a, 24) + (size_t)e * 1024 * 2048; WT = a.ws + WS_WGU + (size_t)e * 2048 * 1024; n0 = (r >> 3) * 1024; k0 = (r & 7) * 128; }
    else { const int i2 = item - 512, e = i2 >> 3; N = 1024; W = INF(a, 26) + (size_t)e * 1024 * 1024; WT = a.ws + WS_WD + (size_t)e * 1024 * 1024; n0 = 0; k0 = (i2 & 7) * 128; }
    LAS unsigned char* tile = F.lds;
    const float* wp = W + (size_t)(k0 + 16 * F.wave) * N + n0 + 4 * lane;
    f32x4 va[4][4], vb[4][4];
#define CVW_LOAD(v, grp) do { _Pragma("unroll") for (int ch = 0; ch < 4; ++ch) _Pragma("unroll") for (int q = 0; q < 4; ++q) v[ch][q] = __builtin_nontemporal_load((const GAS f32x4*)(wp + (size_t)(4 * (grp) + q) * N + ch * 256)); } while (0)
#define CVW_PUT(v, grp) do { _Pragma("unroll") for (int ch = 0; ch < 4; ++ch) _Pragma("unroll") for (int j = 0; j < 4; ++j) \
        *(LAS unsigned*)(tile + (ch * 256 + 4 * lane + j) * 144 + 16 * F.wave + 4 * (grp)) = pk_fp8x4_(v[ch][0][j] * 32.f, v[ch][1][j] * 32.f, v[ch][2][j] * 32.f, v[ch][3][j] * 32.f); } while (0)
    CVW_LOAD(va, 0); CVW_LOAD(vb, 1); CVW_PUT(va, 0); CVW_LOAD(va, 2); CVW_PUT(vb, 1); CVW_LOAD(vb, 3); CVW_PUT(va, 2); CVW_PUT(vb, 3);
#undef CVW_LOAD
#undef CVW_PUT
    __syncthreads();
#pragma unroll
    for (int i = 0; i < 16; ++i) { const int row = F.wave * 128 + i * 8 + (lane >> 3), c = lane & 7;
        const v4u val = *(const LAS v4u*)(tile + row * 144 + 16 * c);
        __builtin_nontemporal_store(val, (GAS v4u*)(WT + (size_t)(n0 + row) * 1024 + k0 + 16 * c)); }
    __syncthreads();
}
__device__ __forceinline__ void rms_row_to_bf16(int lane, const float* xrow, const float* g, bf16* orow) {
    const GAS f32x4* xr = (const GAS f32x4*)xrow + lane; const GAS f32x4* gr = (const GAS f32x4*)g + lane;
    f32x4 v[4]; float s = 0.f;
#pragma unroll
    for (int j = 0; j < 4; ++j) { v[j] = __builtin_nontemporal_load(xr + 64 * j); s += (v[j].x * v[j].x + v[j].y * v[j].y) + (v[j].z * v[j].z + v[j].w * v[j].w); }
    const float rstd = 1.f / sqrtf(wave_sum(s) * (1.f / D) + RMS_EPS);
    GAS unsigned long long* o8 = (GAS unsigned long long*)orow + lane;
#pragma unroll
    for (int j = 0; j < 4; ++j) { const f32x4 gg = gr[64 * j];
        o8[64 * j] = (unsigned long long)pk2(v[j].x * rstd * gg.x, v[j].y * rstd * gg.y) | ((unsigned long long)pk2(v[j].z * rstd * gg.z, v[j].w * rstd * gg.w) << 32); }
}

__device__ __forceinline__ void s5_setup(Frame& F, const Args& a, int g, int sp) {
    LAS float* L = (LAS float*)F.lds;
    LAS float* APr = L, *APi = L + 2112, *BBr = L + 4224, *BBi = L + 5248, *CCr = L + 6272, *CCi = L + 7296, *KT = L + 8320;
    const int tid = FTID(F);
    const float* dsk = INF(a, 15);
    if (tid < 64) {
        const int n = tid;
        const float dt = expf(INF(a, 16)[g]);
        const float lre = INF(a, 9)[g * 64 + n], lim = INF(a, 10)[g * 64 + n];
        const float mag = expf(lre * dt); float sn, cs; sincosf(lim * dt, &sn, &cs);
        const float ar = mag * cs, ai = mag * sn;
        const float nr = ar - 1.f, ni = ai, den = lre * lre + lim * lim;
        const float cr = (nr * lre + ni * lim) / den, ci = (ni * lre - nr * lim) / den;
        float pr = 1.f, pi = 0.f;
        for (int tau = 0; tau <= 32; ++tau) { APr[tau * 64 + n] = pr; APi[tau * 64 + n] = pi; const float t0 = pr * ar - pi * ai, t1 = pr * ai + pi * ar; pr = t0; pi = t1; }
        const float* bre = INF(a, 11) + (size_t)(g * 64 + n) * 16; const float* bim = INF(a, 12) + (size_t)(g * 64 + n) * 16;
        for (int c = 0; c < 16; ++c) { const float br = bre[c], bi = bim[c]; BBr[n * 16 + c] = cr * br - ci * bi; BBi[n * 16 + c] = cr * bi + ci * br; }
    }
    for (int i = tid; i < 1024; i += 512) { CCr[i] = INF(a, 13)[g * 1024 + i]; CCi[i] = INF(a, 14)[g * 1024 + i]; }
    __syncthreads();
    {
        const int pair = tid & 255, c = pair >> 4, cp = pair & 15, tau0 = (tid >> 8) * 16;
        float zr[64], zi[64];
#pragma unroll
        for (int n = 0; n < 64; ++n) { const float cr_ = CCr[c * 64 + n], ci_ = CCi[c * 64 + n], br = BBr[n * 16 + cp], bi = BBi[n * 16 + cp]; zr[n] = cr_ * br - ci_ * bi; zi[n] = cr_ * bi + ci_ * br; }
        for (int tau = tau0; tau < tau0 + 16; ++tau) {
            const LAS f32x4* pr4 = (const LAS f32x4*)(APr + tau * 64); const LAS f32x4* pi4 = (const LAS f32x4*)(APi + tau * 64);
            float s0 = 0.f, s1 = 0.f;
#pragma unroll
            for (int q = 0; q < 16; ++q) { const f32x4 r4 = pr4[q], i4 = pi4[q];
                s0 += zr[4 * q] * r4[0] - zi[4 * q] * i4[0]; s1 += zr[4 * q + 1] * r4[1] - zi[4 * q + 1] * i4[1];
                s0 += zr[4 * q + 2] * r4[2] - zi[4 * q + 2] * i4[2]; s1 += zr[4 * q + 3] * r4[3] - zi[4 * q + 3] * i4[3]; }
            KT[tau * 256 + pair] = s0 + s1;
        }
    }
    __syncthreads();
    bf16* BtY = (bf16*)(a.ws + WS_BTY); bf16* BtX = (bf16*)(a.ws + WS_BTX);
    if (tid < 320) {
        const int kp = tid * 2;
        GAS unsigned* dst = (GAS unsigned*)(BtY + ((size_t)(g * 512 + 4 * sp * 16) * 640 + kp));
        if (kp < 128) {
            const int n = kp & 63; const bool im = kp >= 64;
#pragma unroll 4
            for (int rl = 0; rl < 64; ++rl) { const int t = 4 * sp + (rl >> 4), c = rl & 15;
                const float c0r = CCr[c * 64 + n], c0i = CCi[c * 64 + n], c1r = CCr[c * 64 + n + 1], c1i = CCi[c * 64 + n + 1];
                const float a0r = APr[(t + 1) * 64 + n], a0i = APi[(t + 1) * 64 + n], a1r = APr[(t + 1) * 64 + n + 1], a1i = APi[(t + 1) * 64 + n + 1];
                const float v0 = im ? -(c0r * a0i + c0i * a0r) : (c0r * a0r - c0i * a0i), v1 = im ? -(c1r * a1i + c1i * a1r) : (c1r * a1r - c1i * a1i);
                dst[(size_t)rl * 320] = pk2(v0, v1); }
        } else {
            const int s = (kp - 128) >> 4, cp = (kp - 128) & 15;
#pragma unroll 4
            for (int rl = 0; rl < 64; ++rl) { const int t = 4 * sp + (rl >> 4), c = rl & 15; float v0 = 0.f, v1 = 0.f;
                if (s <= t) { v0 = KT[(t - s) * 256 + c * 16 + cp]; v1 = KT[(t - s) * 256 + c * 16 + cp + 1];
                    if (s == t) { const float dd = dsk[g * 16 + c]; v0 += (c == cp) ? dd : 0.f; v1 += (c == cp + 1) ? dd : 0.f; } }
                dst[(size_t)rl * 320] = pk2(v0, v1); }
        }
    }
    { const int kp = (tid & 255) * 2, s = kp >> 4, cp = kp & 15, r0 = (tid >> 8) * 16;
      GAS unsigned* dst = (GAS unsigned*)(BtX + ((size_t)(g * 256 + 32 * sp + r0) * 512 + kp));
#pragma unroll 4
      for (int rl = 0; rl < 16; ++rl) { const int j = 32 * sp + r0 + rl; float v0 = 0.f, v1 = 0.f;
          if (j < 128) { const int n = j & 63; const float apr = APr[(31 - s) * 64 + n], api = APi[(31 - s) * 64 + n];
              const float b0r = BBr[n * 16 + cp], b0i = BBi[n * 16 + cp], b1r = BBr[n * 16 + cp + 1], b1i = BBi[n * 16 + cp + 1];
              v0 = (j < 64) ? (apr * b0r - api * b0i) : (apr * b0i + api * b0r); v1 = (j < 64) ? (apr * b1r - api * b1i) : (apr * b1i + api * b1r); }
          dst[(size_t)rl * 256] = pk2(v0, v1); } }
    if (sp == 0 && tid < 64) { float* AL = (float*)(a.ws + WS_SMALL + SM_AL); AL[(g * 64 + tid) * 2] = APr[32 * 64 + tid]; AL[(g * 64 + tid) * 2 + 1] = APi[32 * 64 + tid]; }
    __syncthreads();
}

__device__ __forceinline__ void p0_prologue(Frame& F, const Args& a) {
    for (int rp = 0; rp < NREP(30); ++rp) for (int item = blockIdx.x; item < 256; item += F.G) s5_setup(F, a, item & 31, item >> 5);
    const int gt = blockIdx.x * (NWAVES * 64) + FTID(F), NGT = F.G * NWAVES * 64;
    if (blockIdx.x == 0 && F.wave == 0) {
        const float p1 = wave_sum(INF(a, 4)[mk_lane()] * INF(a, 5)[mk_lane()]), p2 = wave_sum(INF(a, 6)[mk_lane()] * INF(a, 7)[mk_lane()]);
        if (mk_lane() == 0) *(float*)(a.ws + WS_SMALL) = expf(p1) - expf(p2) + LAMBDA_INIT;
    }
    { float* WR = (float*)(a.ws + WS_SMALL + SM_WR);
      for (int i = gt; i < 1024 * 36; i += NGT) { const int k = i / 36, e = i % 36, p = ((k & 3) + 4 * (k >> 8)) * 64 + ((k >> 2) & 63);
          WR[p * 36 + e] = e < 32 ? INF(a, 21)[k] * INF(a, 22)[k * 32 + e] : 0.f; } }
    { float* RP = (float*)(a.ws + WS_ROPE); const int* pos = (const int*)a.in[1];
      for (int i = gt; i < T * 8; i += NGT) { const int m = i >> 3, j = i & 7;
          const float invf = j == 0 ? 1.0f : j == 1 ? 1.9392274e-01f : j == 2 ? 3.7606031e-02f : j == 3 ? 7.2926646e-03f : j == 4 ? 1.4142136e-03f : j == 5 ? 2.7424819e-04f : j == 6 ? 5.3182961e-05f : 1.0313386e-05f;
          const float ang = (float)pos[m] * invf; float sn, cs; sincosf(ang, &sn, &cs); RP[m * 16 + j] = cs; RP[m * 16 + 8 + j] = sn; } }
    LAS float* scr = (LAS float*)(F.lds + RING_OFF + F.wave * 17408);
    const int gw = F.vcu * NWAVES + F.wave, NGW = F.G * NWAVES;
    constexpr int I_IN = 16 * 32, I_OUT = 16 * 16, I_GLU = 8 * 8;
    constexpr int NITEMS = I_IN + I_OUT + I_GLU;
    for (int it = gw; it < NITEMS; it += NGW) {
        int r = it;
        if (r < I_IN) { p0_tr64<false>(INF(a, 3), 1024, 2048, a.ws + WS_WIN, scr, r, mk_lane(), 1.f); continue; } r -= I_IN;
        if (r < I_OUT) { p0_tr64<false>(INF(a, 20), 1024, 1024, a.ws + WS_WOUT, scr, r, mk_lane(), 1.f); continue; } r -= I_OUT;
        p0_tr64<false>(INF(a, 17), 512, 512, a.ws + WS_WGLU, scr, r, mk_lane(), 1.f);
    }
    __syncthreads();
    { int lane = mk_lane(); asm volatile("" : "+v"(lane));
      for (int rp = 0; rp < NREP(31); ++rp) for (int item = F.vcu; item < 768; item += F.G) cv_wg_item(F, a, item, lane); }
    for (int rp = 0; rp < NREP(32); ++rp) for (int m = gw; m < T; m += NGW) rms_row_to_bf16(mk_lane(), INF(a, 0) + (size_t)m * D, INF(a, 2), (bf16*)(a.ws + WS_XN) + (size_t)m * D);
}

struct DenseOrder {
    int nM, nN, nwg, G, c, nt; const char* A; const char* B; size_t strA, strB;
    __device__ __forceinline__ void init(int M, int N, int K, int lda, int ldb, const void* A_, const void* B_, int G_, int c_) {
        nM = M / 256; nN = N / 256; nwg = nM * nN; G = G_; c = c_; nt = K / 64; A = (const char*)A_; B = (const char*)B_; strA = (size_t)256 * lda * 2; strB = (size_t)256 * ldb * 2; }
    __device__ __forceinline__ bool next(int i, pg8::Unit& u) const {
        const long L = (long)i * G + c; if (L >= nwg) return false;
        int wgid = (int)L; { const int q = nwg / 8, r = nwg % 8, xcd = wgid % 8, off = wgid / 8; wgid = (xcd < r ? xcd * (q + 1) : r * (q + 1) + (xcd - r) * q) + off; }
        const int nig = 8 * nN, gid = wgid / nig, fm = gid * 8, gsz = (nM - fm) < 8 ? (nM - fm) : 8;
        u.pm = fm + ((wgid % nig) % gsz); u.pn = (wgid % nig) / gsz; u.a = A + (size_t)u.pm * strA; u.b = B + (size_t)u.pn * strB; u.nt = nt; u.x0 = 0; u.x1 = 0; return true;
    }
};
struct XOrder {
    int G, c; const char* AROW; const char* BTX;
    __device__ __forceinline__ bool next(int i, pg8::Unit& u) const {
        const int L = i * G + c; if (L >= 128) return false;
        const int g = L >> 2, pm = L & 3;
        u.pm = pm; u.pn = 0; u.x0 = g; u.x1 = 0; u.nt = 8;
        u.a = AROW + ((size_t)(g * 1024 + pm * 256) * AROW_P + 128) * 2; u.b = BTX + ((size_t)g * 256 * 512) * 2; return true;
    }
};
struct GluOrder {
    int rank; const char* A; const char* B;
    __device__ __forceinline__ bool next(int i, pg8::Unit& u) const {
        if (i >= 4) return false;
        u.pm = rank * 2 + (i >> 1); u.pn = i & 1; u.x0 = 0; u.x1 = 0; u.nt = 8;
        u.a = A + (size_t)u.pm * 256 * 1024; u.b = B + (size_t)u.pn * 256 * 1024; return true;
    }
};
struct YOrder {
    int G, c; const char* AROW; const char* BTY;
    __device__ __forceinline__ bool next(int i, pg8::Unit& u) const {
        const int L = i * G + c; if (L >= 256) return false;
        const int g = L >> 3, pm = (L >> 1) & 3, pn = L & 1;
        u.pm = pm; u.pn = pn; u.x0 = g; u.x1 = 0; u.nt = (128 + 256 * (pn + 1)) / 64;
        u.a = AROW + ((size_t)(g * 1024 + pm * 256) * AROW_P) * 2; u.b = BTY + ((size_t)(g * 512 + pn * 256) * AROW_P) * 2; return true;
    }
};
template <int RG  , int NC  >
struct MoeOrder {
    int G, c; const LAS int* tpre; const LAS int* cntE; const char* A; const char* B; size_t strBe;
    bool gatherA; int ntk;
    __device__ __forceinline__ bool next(int i, pg8::Unit& u) const {
        const int L = i * G + c, grp = L >> 5, w = L & 31, tt = grp * RG + (w % RG), pn = w / RG;
        const int NT = __builtin_amdgcn_readfirstlane(tpre[32]);
        if (tt >= NT) return false;
        const int e = __builtin_popcount((unsigned)__ballot(tpre[(mk_lane() & 31) + 1] <= tt));
        const int cnt = __builtin_amdgcn_readfirstlane(cntE[e]), t0 = __builtin_amdgcn_readfirstlane(tpre[e]);
        u.pm = tt; u.pn = pn; u.x0 = (tt - t0) * 256; u.x1 = e | (cnt << 8); u.nt = ntk;
        u.a = gatherA ? A : A + (size_t)tt * 256 * 1024; u.b = B + (size_t)e * strBe + (size_t)pn * 256 * 1024; return true;
    }
};
struct AGather {
    static constexpr bool PER_UNIT = true;
    const int* list;
    __device__ __forceinline__ void get(const pg8::Unit& u, unsigned (&v)[2][2], const int (&R)[2], const int (&C)[2]) const {
        const int e = u.x1 & 255, cnt = u.x1 >> 8;
#pragma unroll
        for (int h = 0; h < 2; ++h)
#pragma unroll
            for (int i = 0; i < 2; ++i) { const int slot = u.x0 + h * 128 + R[i]; const int sc = slot < cnt ? slot : 0;
                const int tok = list[(size_t)e * T + sc] >> 2; v[h][i] = (unsigned)(tok * 1024 + C[i] * 2); }
    }
    __device__ __forceinline__ size_t hstep() const { return 0; }
    __device__ __forceinline__ void issue_dma(const pg8::Unit& u, const int (&R)[2], const unsigned lds_dst) const {
        const int e = u.x1 & 255, cnt = u.x1 >> 8; const int* base = list + (size_t)e * T;
#pragma unroll
        for (int h = 0; h < 2; ++h)
#pragma unroll
            for (int i = 0; i < 2; ++i) { const int slot = u.x0 + h * 128 + R[i]; const unsigned so = (unsigned)(slot < cnt ? slot : 0) * 4u;
                pg8::glds4_sv(base, so, lds_dst + (unsigned)(2 * h + i) * 256u); }
    }
    __device__ __forceinline__ void finish(const int (&raw)[4], unsigned (&v)[2][2], const int (&C)[2]) const {
#pragma unroll
        for (int h = 0; h < 2; ++h)
#pragma unroll
            for (int i = 0; i < 2; ++i) v[h][i] = (unsigned)((raw[h * 2 + i] >> 2) * 1024 + C[i] * 2);
    }
};

using pg8::f32x2; using pg8::u32x4; using pg8::u32x2; using pg8::cvt_pk_bf16; using pg8::gelu_pk;
#define EPI_ARGS const f32x4 (&acc)[2][2][4][2], const pg8::Unit& u, int wr, int wc, int fr, int fq
__device__ __forceinline__ u32x4 pack8(const f32x4 v0, const f32x4 v1) { u32x4 w; w.x = cvt_pk_bf16(v0[0], v0[1]); w.y = cvt_pk_bf16(v0[2], v0[3]); w.z = cvt_pk_bf16(v1[0], v1[1]); w.w = cvt_pk_bf16(v1[2], v1[3]); return w; }
__device__ __forceinline__ float bf_lo(unsigned w) { return __uint_as_float(w << 16); }
__device__ __forceinline__ float bf_hi(unsigned w) { return __uint_as_float(w & 0xffff0000u); }

struct EpiInProj {
    static constexpr int BMODE = 1; static constexpr bool PREFETCH = false; static constexpr int NSTORE = 0, NPRE = 0;
    bf16 *Q, *K, *V, *AROW; const float* rope; float c2;
    __device__ __forceinline__ void operator()(EPI_ARGS) const {
        const int region = u.pn >> 1; const int colr = (u.pn & 1) * 256 + wc * 32 + 8 * fq;
        const bool dorope = (region <= 1) && ((wc & 1) == 0);
        const float sg = fq == 0 ? -1.f : 1.f; const bool rot = fq < 2;
#pragma unroll
        for (int ai = 0; ai < 2; ++ai) {
            f32x4 rp[4][4];
            if (dorope) {
#pragma unroll
                for (int m = 0; m < 4; ++m) { const f32x4* rr = (const f32x4*)(rope + (size_t)(u.pm * 256 + ai * 128 + wr * 64 + m * 16 + fr) * 16);
#pragma unroll
                    for (int q = 0; q < 4; ++q) rp[m][q] = rr[q]; }
            }
#pragma unroll
            for (int m = 0; m < 4; ++m) {
                const int row = u.pm * 256 + ai * 128 + wr * 64 + m * 16 + fr;
                f32x4 cs0 = {1.f, 1.f, 1.f, 1.f}, cs1 = cs0, sn0 = {0.f, 0.f, 0.f, 0.f}, sn1 = sn0;
                if (dorope) { cs0 = rot ? rp[m][0] : cs0; cs1 = rot ? rp[m][1] : cs1; sn0 = rot ? rp[m][2] * sg : sn0; sn1 = rot ? rp[m][3] * sg : sn1; }
#pragma unroll
                for (int bj = 0; bj < 2; ++bj) {
                    f32x4 v0 = acc[ai][bj][m][0], v1 = acc[ai][bj][m][1]; const int c = colr + bj * 128;
                    if (region <= 1) {
                        if (dorope) { f32x4 p0, p1;
#pragma unroll
                            for (int q = 0; q < 4; ++q) { p0[q] = __shfl_xor(v0[q], 16); p1[q] = __shfl_xor(v1[q], 16); }
                            v0 = v0 * cs0 + p0 * sn0; v1 = v1 * cs1 + p1 * sn1; }
                        if (region == 0) { v0 = v0 * c2; v1 = v1 * c2; }
                        *(u32x4*)((region == 0 ? Q : K) + (size_t)row * 512 + c) = pack8(v0, v1);
                    } else if (region == 2) {
                        *(u32x4*)(V + (size_t)row * 512 + c) = pack8(v0, v1);
                    } else {
                        const int g = c >> 4, cc = c & 15;
                        *(u32x4*)(AROW + ((size_t)(g * 1024 + (row >> 5)) * AROW_P + 128 + (row & 31) * 16 + cc)) = pack8(v0, v1);
                    }
                }
            }
        }
    }
};
struct EpiX {
    static constexpr int BMODE = 0; static constexpr bool PREFETCH = false; static constexpr int NSTORE = 0, NPRE = 0;
    float* X;
    __device__ __forceinline__ void operator()(EPI_ARGS) const {
        float* base = X + ((size_t)(u.x1 * 32 + u.x0) * 1024 + u.pm * 256) * 128;
#pragma unroll
        for (int ai = 0; ai < 2; ++ai)
#pragma unroll
            for (int m = 0; m < 4; ++m) { const int row = ai * 128 + wr * 64 + m * 16 + fr;
#pragma unroll
                for (int n = 0; n < 2; ++n) *(f32x4*)(base + (size_t)row * 128 + wc * 32 + 16 * n + 4 * fq) = acc[ai][0][m][n]; }
    }
};
struct EpiY {
    static constexpr int BMODE = 1; static constexpr bool PREFETCH = false; static constexpr int NSTORE = 0, NPRE = 0;
    bf16* YG;
    __device__ __forceinline__ void operator()(EPI_ARGS) const {
        const int g = u.x0;
#pragma unroll
        for (int ai = 0; ai < 2; ++ai)
#pragma unroll
            for (int m = 0; m < 4; ++m) { const int jj = u.pm * 256 + ai * 128 + wr * 64 + m * 16 + fr;
#pragma unroll
                for (int bj = 0; bj < 2; ++bj) { const int n0 = u.pn * 256 + bj * 128 + wc * 32 + 8 * fq, t = n0 >> 4, cc = n0 & 15;
                    const f32x4 v0 = acc[ai][bj][m][0], v1 = acc[ai][bj][m][1];
                    const f32x2 a = gelu_pk((f32x2){v0[0], v0[1]}), b = gelu_pk((f32x2){v0[2], v0[3]}), c = gelu_pk((f32x2){v1[0], v1[1]}), d = gelu_pk((f32x2){v1[2], v1[3]});
                    u32x4 w; w.x = cvt_pk_bf16(a.x, a.y); w.y = cvt_pk_bf16(b.x, b.y); w.z = cvt_pk_bf16(c.x, c.y); w.w = cvt_pk_bf16(d.x, d.y);
                    *(u32x4*)(YG + (size_t)(jj * 32 + t) * 512 + g * 16 + cc) = w; } }
    }
};
__device__ __forceinline__ float sigmoidf_(float z) { return __builtin_amdgcn_rcpf(1.f + __builtin_amdgcn_exp2f(-1.4426950408889634f * z)); }
struct EpiGlu {
    static constexpr int BMODE = 1; static constexpr bool PREFETCH = false; static constexpr int NSTORE = 0, NPRE = 0;
    const bf16* YG; bf16* GLU; const float* bias;
    __device__ __forceinline__ void operator()(EPI_ARGS) const {
        const int c00 = u.pn * 256 + wc * 32 + 8 * fq;
        f32x4 bv[2][2];
#pragma unroll
        for (int bj = 0; bj < 2; ++bj) { bv[bj][0] = *(const f32x4*)(bias + c00 + bj * 128); bv[bj][1] = *(const f32x4*)(bias + c00 + bj * 128 + 4); }
#pragma unroll
        for (int ai = 0; ai < 2; ++ai)
#pragma unroll
            for (int m = 0; m < 4; ++m) { const int row = u.pm * 256 + ai * 128 + wr * 64 + m * 16 + fr;
#pragma unroll
                for (int bj = 0; bj < 2; ++bj) { const int c = c00 + bj * 128;
                    const f32x4 z0 = acc[ai][bj][m][0] + bv[bj][0], z1 = acc[ai][bj][m][1] + bv[bj][1];
                    const u32x4 y = *(const u32x4*)(YG + (size_t)row * 512 + c);
                    f32x4 o0, o1;
                    o0[0] = bf_lo(y.x) * sigmoidf_(z0[0]); o0[1] = bf_hi(y.x) * sigmoidf_(z0[1]); o0[2] = bf_lo(y.y) * sigmoidf_(z0[2]); o0[3] = bf_hi(y.y) * sigmoidf_(z0[3]);
                    o1[0] = bf_lo(y.z) * sigmoidf_(z1[0]); o1[1] = bf_hi(y.z) * sigmoidf_(z1[1]); o1[2] = bf_lo(y.w) * sigmoidf_(z1[2]); o1[3] = bf_hi(y.w) * sigmoidf_(z1[3]);
                    *(u32x4*)(GLU + (size_t)row * 512 + c) = pack8(o0, o1); } }
    }
};
struct EpiMix {
    static constexpr int BMODE = 1; static constexpr bool PREFETCH = false; static constexpr int NSTORE = 0, NPRE = 0;
    bf16* MIX;
    __device__ __forceinline__ void operator()(EPI_ARGS) const {
#pragma unroll
        for (int ai = 0; ai < 2; ++ai)
#pragma unroll
            for (int m = 0; m < 4; ++m) { bf16* rowp = MIX + (size_t)(u.pm * 256 + ai * 128 + wr * 64 + m * 16 + fr) * 1024 + u.pn * 256 + wc * 32 + 8 * fq;
#pragma unroll
                for (int bj = 0; bj < 2; ++bj) *(u32x4*)(rowp + bj * 128) = pack8(acc[ai][bj][m][0], acc[ai][bj][m][1]); }
    }
};
__device__ __forceinline__ float swiglu_(float g, float up) {
    const float gc = fminf(g, SW_LIMIT), uc = __builtin_amdgcn_fmed3f(up, -SW_LIMIT, SW_LIMIT);
    const float t = gc * __builtin_amdgcn_rcpf(1.f + __builtin_amdgcn_exp2f(gc * (-SW_ALPHA * 1.4426950408889634f))); return fmaf(t, uc, t); }
__device__ __forceinline__ unsigned pk_fp8x4(float a, float b, float c, float d) { int w = 0; w = __builtin_amdgcn_cvt_pk_fp8_f32(a, b, w, false); w = __builtin_amdgcn_cvt_pk_fp8_f32(c, d, w, true); return (unsigned)w; }
constexpr float W8_SCALE = 32.f, W8_INV = 1.f / 32.f;
constexpr float YB_SCALE = 8.f, YB_INV = 1.f / 8.f;
__device__ __forceinline__ f32x2 swiglu2_(const f32x2 ga, const f32x2 ua, const f32x2 bg, const f32x2 bu) {
    const f32x2 inv = {W8_INV, W8_INV};
    const f32x2 G = __builtin_elementwise_fma(ga, inv, bg), U = __builtin_elementwise_fma(ua, inv, bu);
    f32x2 gc, uc; gc.x = fminf(G.x, SW_LIMIT); gc.y = fminf(G.y, SW_LIMIT); uc.x = __builtin_amdgcn_fmed3f(U.x, -SW_LIMIT, SW_LIMIT); uc.y = __builtin_amdgcn_fmed3f(U.y, -SW_LIMIT, SW_LIMIT);
    const f32x2 xs = gc * (-SW_ALPHA * 1.4426950408889634f);
    f32x2 ex; ex.x = __builtin_amdgcn_exp2f(xs.x); ex.y = __builtin_amdgcn_exp2f(xs.y);
    const f32x2 dn = ex + 1.0f;
    f32x2 rc; rc.x = __builtin_amdgcn_rcpf(dn.x); rc.y = __builtin_amdgcn_rcpf(dn.y);
    const f32x2 t = gc * rc;
    return __builtin_elementwise_fma(t, uc, t);
}
struct EpiGU {
    static constexpr int BMODE = 2; static constexpr bool PREFETCH = true; static constexpr int NSTORE = 4, NPRE = 1;
    unsigned char* ACT; const float* bias; LAS unsigned char* xb;
    __device__ __forceinline__ void prefetch(const pg8::Unit& u, const int wid, const int wr, const int lane) const {
        const int e = u.x1 & 255;
        const unsigned bdst = (unsigned)__builtin_amdgcn_readfirstlane((int)((unsigned)(uintptr_t)xb + (unsigned)wid * 256u));
        pg8::glds4_sv(bias + e * 2048 + 2 * (u.pn * 128 + (wid & 3) * 32), (unsigned)lane * 4u, bdst);
    }
    __device__ __forceinline__ void operator()(EPI_ARGS) const {
        const int e = u.x1 & 255, j0 = u.pn * 128 + wc * 32 + 8 * fq;
        const LAS f32x4* bp = (const LAS f32x4*)(xb + (wr * 4 + wc) * 256) + 4 * fq;
        f32x2 bg[4], bu[4];
#pragma unroll
        for (int i = 0; i < 4; ++i) { const f32x4 b = bp[i]; bg[i] = (f32x2){b[0], b[2]}; bu[i] = (f32x2){b[1], b[3]}; }
        const int jst = u.pn * 128 + wc * 32 + 8 * (fq & ~1);
#pragma unroll
        for (int ai = 0; ai < 2; ++ai)
#pragma unroll
            for (int mp = 0; mp < 2; ++mp) { u32x2 w[2];
#pragma unroll
                for (int k = 0; k < 2; ++k) { const int m = mp * 2 + k;
                    const f32x4 g0 = acc[ai][0][m][0], g1 = acc[ai][0][m][1], u0 = acc[ai][1][m][0], u1 = acc[ai][1][m][1];
                    const f32x2 o0 = swiglu2_((f32x2){g0[0], g0[1]}, (f32x2){u0[0], u0[1]}, bg[0], bu[0]), o1 = swiglu2_((f32x2){g0[2], g0[3]}, (f32x2){u0[2], u0[3]}, bg[1], bu[1]);
                    const f32x2 o2 = swiglu2_((f32x2){g1[0], g1[1]}, (f32x2){u1[0], u1[1]}, bg[2], bu[2]), o3 = swiglu2_((f32x2){g1[2], g1[3]}, (f32x2){u1[2], u1[3]}, bg[3], bu[3]);
                    w[k].x = pk_fp8x4(o0.x, o0.y, o1.x, o1.y); w[k].y = pk_fp8x4(o2.x, o2.y, o3.x, o3.y); }
                const auto rx = __builtin_amdgcn_permlane16_swap(w[0].x, w[1].x, false, false), ry = __builtin_amdgcn_permlane16_swap(w[0].y, w[1].y, false, false);
                const size_t row = (size_t)u.pm * 256 + ai * 128 + wr * 64 + (mp * 2 + (fq & 1)) * 16 + fr;
                u32x4 o; o.x = rx[0]; o.y = ry[0]; o.z = rx[1]; o.w = ry[1];
                *(u32x4*)(ACT + row * 1024 + jst) = o; }
    }
};
template <int MODE> struct EpiDownT {
    static constexpr int BMODE = 3; static constexpr bool PREFETCH = true; static constexpr int NSTORE = 0, NPRE = 0;
    unsigned char* YB; const float* bias; const int* list; const float* gates; int sel; LAS unsigned char* xl; LAS unsigned char* xb;
    __device__ __forceinline__ void prefetch(const pg8::Unit& u, const int wid, const int wr, const int lane) const {
        const int e = u.x1 & 255, cnt = u.x1 >> 8;
        const unsigned dst = (unsigned)__builtin_amdgcn_readfirstlane((int)((unsigned)(uintptr_t)xl + (unsigned)wid * 1024u));
#pragma unroll
        for (int k = 0; k < 2; ++k) { const int slot = u.x0 + k * 128 + wr * 64 + lane; const unsigned so = (unsigned)(slot < cnt ? slot : 0) * 4u;
            pg8::glds4_sv(list + (size_t)e * T, so, dst + (unsigned)k * 256u); pg8::glds4_sv(gates + (size_t)e * T, so, dst + 512u + (unsigned)k * 256u); }
        const unsigned bdst = (unsigned)__builtin_amdgcn_readfirstlane((int)((unsigned)(uintptr_t)xb + (unsigned)wid * 256u));
        pg8::glds4_sv(bias + e * 1024 + u.pn * 256 + (wid & 3) * 64, (unsigned)lane * 4u, bdst);
    }
    __device__ __forceinline__ void operator()(EPI_ARGS) const {
        const int e = u.x1 & 255, cnt = u.x1 >> 8, c0 = u.pn * 256 + wc * 64 + 16 * fq;
        f32x4 bv[2][2];
        { const LAS f32x4* bl = (const LAS f32x4*)(xb + (wr * 4 + wc) * 256) + 4 * fq; bv[0][0] = bl[0]; bv[0][1] = bl[1]; bv[1][0] = bl[2]; bv[1][1] = bl[3]; }
        int aidv[8]; float gtv[8];
        { const LAS int* xi = (const LAS int*)(xl + (wr * 4 + wc) * 1024) + fr; const LAS float* xg = (const LAS float*)xi + 128;
#pragma unroll
          for (int q = 0; q < 8; ++q) { aidv[q] = xi[(q >> 2) * 64 + (q & 3) * 16]; gtv[q] = xg[(q >> 2) * 64 + (q & 3) * 16] * YB_SCALE; } }
#pragma unroll
        for (int ai = 0; ai < 2; ++ai)
#pragma unroll
            for (int m = 0; m < 4; ++m) { const int slot = u.x0 + ai * 128 + wr * 64 + m * 16 + fr; const int aid = aidv[ai * 4 + m]; const float gt = gtv[ai * 4 + m];
                if (slot < cnt) {
                    const f32x4 z0 = (acc[ai][0][m][0] * W8_INV + bv[0][0]) * gt, z1 = (acc[ai][0][m][1] * W8_INV + bv[0][1]) * gt;
                    const f32x4 z2 = (acc[ai][1][m][0] * W8_INV + bv[1][0]) * gt, z3 = (acc[ai][1][m][1] * W8_INV + bv[1][1]) * gt;
                    u32x4 w8; w8.x = pk_fp8x4(z0[0], z0[1], z0[2], z0[3]); w8.y = pk_fp8x4(z1[0], z1[1], z1[2], z1[3]); w8.z = pk_fp8x4(z2[0], z2[1], z2[2], z2[3]); w8.w = pk_fp8x4(z3[0], z3[1], z3[2], z3[3]);
                    if constexpr (MODE == 1) { asm volatile("" :: "v"(w8)); } else { *(u32x4*)(YB + (size_t)aid * 1024 + c0) = w8; } } }
    }
};
typedef EpiDownT<0> EpiDown;

struct EpiNull {
    static constexpr int BMODE = 1; static constexpr bool PREFETCH = false; static constexpr int NSTORE = 0, NPRE = 0;
    __device__ __forceinline__ void operator()(EPI_ARGS) const {
#pragma unroll
        for (int ai = 0; ai < 2; ++ai)
#pragma unroll
            for (int bj = 0; bj < 2; ++bj)
#pragma unroll
                for (int m = 0; m < 4; ++m)
#pragma unroll
                    for (int n = 0; n < 2; ++n) asm volatile("" :: "v"(acc[ai][bj][m][n]));
    }
};
__device__ __forceinline__ void s5_scan(const Args& a, const int task, const int lane) {
    const int gw = task;
    {
        const int g = gw >> 2, b = gw & 3, n = lane;
        const float* AL = (const float*)(a.ws + WS_SMALL + SM_AL); const float ar = AL[(g * 64 + n) * 2], ai = AL[(g * 64 + n) * 2 + 1];
        const float* X0 = (const float*)(a.ws + WS_XLOC) + ((size_t)(0 * 32 + g) * 1024 + b * 256) * 128;
        const float* X1 = (const float*)(a.ws + WS_XLOC) + ((size_t)(1 * 32 + g) * 1024 + b * 256) * 128;
        bf16* AR = (bf16*)(a.ws + WS_AROW) + (size_t)(g * 1024 + b * 256) * AROW_P;
        float xr = 0.f, xi = 0.f;
        for (int j0 = 0; j0 < 256; j0 += 16) {
            float lr[16], li[16];
#pragma unroll
            for (int q = 0; q < 16; ++q) { const size_t o = (size_t)(j0 + q) * 128 + n; lr[q] = X0[o]; li[q] = X0[o + 64]; }
#pragma unroll
            for (int q = 0; q < 16; ++q) { bf16* row = AR + (size_t)(j0 + q) * AROW_P; row[n] = (bf16)f2bf(xr); row[64 + n] = (bf16)f2bf(xi);
                const float nr = ar * xr - ai * xi + lr[q], ni = ar * xi + ai * xr + li[q]; xr = nr; xi = ni; }
        }
    }
}
__device__ __forceinline__ void p3_post_scan(Frame& F, const Args& a) {
    int lane = mk_lane(); asm volatile("" : "+v"(lane));
    const int gw = F.vcu * NWAVES + F.wave, NGW = F.G * NWAVES;
    const float lam = *(const float*)(a.ws + WS_SMALL);
    const bf16* O = (const bf16*)(a.ws + WS_O); bf16* AC = (bf16*)(a.ws + WS_ACAT); const float* ng = INF(a, 8);
    const int h = lane >> 4, d0 = (lane & 15) * 8;
    const f32x4 g0 = *(const f32x4*)(ng + d0), g1 = *(const f32x4*)(ng + d0 + 4);
    for (int m = gw; m < T; m += NGW) {
        const bf16* orow = O + (size_t)m * 1024;
        const v4u p1 = *(const GAS v4u*)(orow + (h * 2 + 0) * 128 + d0), p2 = *(const GAS v4u*)(orow + (h * 2 + 1) * 128 + d0);
        float o[8];
        o[0] = bf_lo(p1.x) - lam * bf_lo(p2.x); o[1] = bf_hi(p1.x) - lam * bf_hi(p2.x); o[2] = bf_lo(p1.y) - lam * bf_lo(p2.y); o[3] = bf_hi(p1.y) - lam * bf_hi(p2.y);
        o[4] = bf_lo(p1.z) - lam * bf_lo(p2.z); o[5] = bf_hi(p1.z) - lam * bf_hi(p2.z); o[6] = bf_lo(p1.w) - lam * bf_lo(p2.w); o[7] = bf_hi(p1.w) - lam * bf_hi(p2.w);
        float s = 0.f;
#pragma unroll
        for (int q = 0; q < 8; ++q) s += o[q] * o[q];
        s += __shfl_xor(s, 1); s += __shfl_xor(s, 2); s += __shfl_xor(s, 4); s += __shfl_xor(s, 8);
        const float sc = (1.f - LAMBDA_INIT) / sqrtf(s * (1.f / 128.f) + RMS_EPS);
        v4u w; w.x = pk2(o[0] * sc * g0[0], o[1] * sc * g0[1]); w.y = pk2(o[2] * sc * g0[2], o[3] * sc * g0[3]); w.z = pk2(o[4] * sc * g1[0], o[5] * sc * g1[1]); w.w = pk2(o[6] * sc * g1[2], o[7] * sc * g1[3]);
        *(GAS v4u*)(AC + (size_t)m * 1024 + h * 128 + d0) = w;
    }
}
__device__ __forceinline__ void pn_glunorm(Frame& F, const Args& a) {
    int lane = mk_lane(); asm volatile("" : "+v"(lane));
    const int gw = F.vcu * NWAVES + F.wave, NGW = F.G * NWAVES;
    const bf16* GL = (const bf16*)(a.ws + WS_GLU); bf16* AC = (bf16*)(a.ws + WS_ACAT); const float* ng = INF(a, 19);
    const f32x4 g0 = *(const f32x4*)(ng + lane * 8), g1 = *(const f32x4*)(ng + lane * 8 + 4);
    for (int m = gw; m < T; m += NGW) {
        const v4u p = *(const GAS v4u*)(GL + (size_t)m * 512 + lane * 8);
        float o[8] = {bf_lo(p.x), bf_hi(p.x), bf_lo(p.y), bf_hi(p.y), bf_lo(p.z), bf_hi(p.z), bf_lo(p.w), bf_hi(p.w)};
        float s = 0.f;
#pragma unroll
        for (int q = 0; q < 8; ++q) s += o[q] * o[q];
        const float sc = 1.f / sqrtf(wave_sum(s) * (1.f / 512.f) + RMS_EPS);
        v4u w; w.x = pk2(o[0] * sc * g0[0], o[1] * sc * g0[1]); w.y = pk2(o[2] * sc * g0[2], o[3] * sc * g0[3]); w.z = pk2(o[4] * sc * g1[0], o[5] * sc * g1[1]); w.w = pk2(o[6] * sc * g1[2], o[7] * sc * g1[3]);
        *(GAS v4u*)(AC + (size_t)m * 1024 + 512 + lane * 8) = w;
    }
}
constexpr int NS5 = 64, CW_BAR2 = 8192;
__device__ __forceinline__ void glunorm_sub(Frame& F, const Args& a, const int rank) {
    int lane = mk_lane(); asm volatile("" : "+v"(lane));
    const bf16* GL = (const bf16*)(a.ws + WS_GLU); bf16* AC = (bf16*)(a.ws + WS_ACAT); const float* ng = INF(a, 19);
    const f32x4 g0 = *(const f32x4*)(ng + lane * 8), g1 = *(const f32x4*)(ng + lane * 8 + 4);
    const int r0 = rank * 512 + F.wave * 64;
#pragma unroll 1
    for (int m0 = r0; m0 < r0 + 64; m0 += 8) {
        v4u p[8];
#pragma unroll
        for (int q = 0; q < 8; ++q) p[q] = *(const GAS v4u*)(GL + (size_t)(m0 + q) * 512 + lane * 8);
#pragma unroll
        for (int q = 0; q < 8; ++q) {
            float o[8] = {bf_lo(p[q].x), bf_hi(p[q].x), bf_lo(p[q].y), bf_hi(p[q].y), bf_lo(p[q].z), bf_hi(p[q].z), bf_lo(p[q].w), bf_hi(p[q].w)};
            float s = 0.f;
#pragma unroll
            for (int k = 0; k < 8; ++k) s += o[k] * o[k];
            const float sc = 1.f / sqrtf(wave_sum(s) * (1.f / 512.f) + RMS_EPS);
            v4u w; w.x = pk2(o[0] * sc * g0[0], o[1] * sc * g0[1]); w.y = pk2(o[2] * sc * g0[2], o[3] * sc * g0[3]); w.z = pk2(o[4] * sc * g1[0], o[5] * sc * g1[1]); w.w = pk2(o[6] * sc * g1[2], o[7] * sc * g1[3]);
            *(GAS v4u*)(AC + (size_t)(m0 + q) * 1024 + 512 + lane * 8) = w;
        }
    }
}
__device__ const unsigned char ATT_DEAL[32][8] = {
  {48, 255, 255, 255, 255, 255, 255, 255},
  {27, 36, 35, 255, 255, 255, 255, 255},
  {59, 4, 3, 255, 255, 255, 255, 255},
  {62, 37, 34, 255, 255, 255, 255, 255},
  {16, 255, 255, 255, 255, 255, 255, 255},
  {30, 5, 2, 255, 255, 255, 255, 255},
  {61, 38, 33, 255, 255, 255, 255, 255},
  {29, 6, 1, 255, 255, 255, 255, 255},
  {47, 255, 255, 255, 255, 255, 255, 255},
  {60, 40, 32, 255, 255, 255, 255, 255},
  {28, 8, 0, 255, 255, 255, 255, 255},
  {31, 39, 255, 255, 255, 255, 255, 255},
  {15, 255, 255, 255, 255, 255, 255, 255},
  {63, 7, 255, 255, 255, 255, 255, 255},
  {58, 41, 255, 255, 255, 255, 255, 255},
  {26, 9, 255, 255, 255, 255, 255, 255},
  {46, 255, 255, 255, 255, 255, 255, 255},
  {57, 42, 255, 255, 255, 255, 255, 255},
  {25, 10, 255, 255, 255, 255, 255, 255},
  {56, 43, 255, 255, 255, 255, 255, 255},
  {14, 255, 255, 255, 255, 255, 255, 255},
  {24, 11, 255, 255, 255, 255, 255, 255},
  {55, 44, 255, 255, 255, 255, 255, 255},
  {23, 12, 255, 255, 255, 255, 255, 255},
  {45, 255, 255, 255, 255, 255, 255, 255},
  {54, 49, 255, 255, 255, 255, 255, 255},
  {22, 17, 255, 255, 255, 255, 255, 255},
  {53, 50, 255, 255, 255, 255, 255, 255},
  {13, 255, 255, 255, 255, 255, 255, 255},
  {21, 18, 255, 255, 255, 255, 255, 255},
  {52, 51, 255, 255, 255, 255, 255, 255},
  {20, 19, 255, 255, 255, 255, 255, 255}
};
__device__ __forceinline__ void pr_router(Frame& F, const Args& a) {
    LAS float* WP = (LAS float*)F.lds;
    { const GAS f32x4* src = (const GAS f32x4*)(a.ws + WS_SMALL + SM_WR); for (int i = FTID(F); i < 1024 * 36 / 4; i += NWAVES * 64) ((LAS f32x4*)WP)[i] = src[i]; }
    LAS int* cntL = (LAS int*)(F.lds + RT_OFF); LAS int* baseL = cntL + 32;
    LAS int* stA = (LAS int*)(F.lds + ST_OFF); LAS int* stE = stA + 512; LAS float* stG = (LAS float*)(stE + 512);
    if (FTID(F) < 32) cntL[FTID(F)] = 0;
    __syncthreads();
    int lane = mk_lane(); asm volatile("" : "+v"(lane));
    const int gw = F.vcu * NWAVES + F.wave;
    const float* X = INF(a, 0); const bf16* MIX = (const bf16*)(a.ws + WS_MIX); unsigned char* XN8 = (unsigned char*)(a.ws + WS_XN); const float* gf = INF(a, 21);
    const int e_me = lane >> 1; const float brt = INF(a, 23)[e_me];
    for (int rp = 0; rp < NREP(8); ++rp) { if (rp) { __syncthreads(); if (FTID(F) < 32) cntL[FTID(F)] = 0; __syncthreads(); }
    f32x4 xnx[4]; unsigned long long mnx[4];
    { const GAS f32x4* xr = (const GAS f32x4*)(X + (size_t)gw * 1024) + lane; const GAS unsigned long long* mr = (const GAS unsigned long long*)(MIX + (size_t)gw * 1024) + lane;
#pragma unroll
      for (int j = 0; j < 4; ++j) { xnx[j] = __builtin_nontemporal_load(xr + 64 * j); mnx[j] = __builtin_nontemporal_load(mr + 64 * j); } }
#pragma unroll 1
    for (int it = 0; it < 16; ++it) {
        const int m = gw + it * (256 * NWAVES);
        f32x4 xcur[4]; unsigned long long mcur[4];
#pragma unroll
        for (int j = 0; j < 4; ++j) { xcur[j] = xnx[j]; mcur[j] = mnx[j]; }
        { const int mn = gw + (it < 15 ? it + 1 : it) * (256 * NWAVES);
          const GAS f32x4* xr = (const GAS f32x4*)(X + (size_t)mn * 1024) + lane; const GAS unsigned long long* mr = (const GAS unsigned long long*)(MIX + (size_t)mn * 1024) + lane;
#pragma unroll
          for (int j = 0; j < 4; ++j) { xnx[j] = __builtin_nontemporal_load(xr + 64 * j); mnx[j] = __builtin_nontemporal_load(mr + 64 * j); } }
        f32x4 hv[4]; float ss = 0.f;
#pragma unroll
        for (int j = 0; j < 4; ++j) { const f32x4 xv = xcur[j]; const unsigned long long w = mcur[j]; const unsigned lo = (unsigned)w, hi = (unsigned)(w >> 32);
            hv[j] = (f32x4){xv.x + bf_lo(lo), xv.y + bf_hi(lo), xv.z + bf_lo(hi), xv.w + bf_hi(hi)};
            ss += (hv[j].x * hv[j].x + hv[j].y * hv[j].y) + (hv[j].z * hv[j].z + hv[j].w * hv[j].w); }
        const float rstd = 1.f / sqrtf(wave_sum(ss) * (1.f / D) + RMS_EPS);
        f32x2 p2[16];
#pragma unroll
        for (int e = 0; e < 16; ++e) p2[e] = (f32x2){0.f, 0.f};
#pragma unroll
        for (int j = 0; j < 4; ++j)
#pragma unroll
            for (int i = 0; i < 4; ++i) { const float hk = hv[j][i]; const f32x2 hk2 = {hk, hk}; const LAS float* wrow = WP + ((i + 4 * j) * 64 + lane) * 36;
#pragma unroll
                for (int e4 = 0; e4 < 8; ++e4) { const f32x4 w = *(const LAS f32x4*)(wrow + 4 * e4);
                    p2[2 * e4] = __builtin_elementwise_fma(hk2, (f32x2){w[0], w[1]}, p2[2 * e4]); p2[2 * e4 + 1] = __builtin_elementwise_fma(hk2, (f32x2){w[2], w[3]}, p2[2 * e4 + 1]); } }
        float p[32];
#pragma unroll
        for (int e = 0; e < 16; ++e) { p[2 * e] = p2[e].x; p[2 * e + 1] = p2[e].y; }
        float q16[16], q8[8], q4[4], q2[2];
        { const bool up = (lane & 32) != 0;
#pragma unroll
          for (int i = 0; i < 16; ++i) { const float keep = up ? p[16 + i] : p[i], send = up ? p[i] : p[16 + i]; q16[i] = keep + __shfl_xor(send, 32); } }
        { const bool up = (lane & 16) != 0;
#pragma unroll
          for (int i = 0; i < 8; ++i) { const float keep = up ? q16[8 + i] : q16[i], send = up ? q16[i] : q16[8 + i]; q8[i] = keep + __shfl_xor(send, 16); } }
        { const bool up = (lane & 8) != 0;
#pragma unroll
          for (int i = 0; i < 4; ++i) { const float keep = up ? q8[4 + i] : q8[i], send = up ? q8[i] : q8[4 + i]; q4[i] = keep + __shfl_xor(send, 8); } }
        { const bool up = (lane & 4) != 0;
#pragma unroll
          for (int i = 0; i < 2; ++i) { const float keep = up ? q4[2 + i] : q4[i], send = up ? q4[i] : q4[2 + i]; q2[i] = keep + __shfl_xor(send, 4); } }
        float q1; { const bool up = (lane & 2) != 0; const float keep = up ? q2[1] : q2[0], send = up ? q2[0] : q2[1]; q1 = keep + __shfl_xor(send, 2); }
        const float raw = q1 + __shfl_xor(q1, 1);
        const float v = raw * rstd + brt;
        int rank = 0;
#pragma unroll
        for (int j = 0; j < 32; ++j) { const float vj = __int_as_float(__builtin_amdgcn_readlane(__float_as_int(v), 2 * j)); rank += (vj > v || (vj == v && j < e_me)) ? 1 : 0; }
        float vk[4]; int ek[4];
#pragma unroll
        for (int k = 0; k < 4; ++k) { const unsigned long long mk = __ballot(rank == k); const int lk = (int)__builtin_ctzll(mk); ek[k] = lk >> 1; vk[k] = __int_as_float(__builtin_amdgcn_readlane(__float_as_int(v), lk)); }
        float ex[4]; float den = 0.f;
#pragma unroll
        for (int k = 0; k < 4; ++k) { ex[k] = __expf(vk[k] - vk[0]); den += ex[k]; }
        const float rden = 1.f / den;
        if (lane < 4) {
            const int e = lane == 0 ? ek[0] : lane == 1 ? ek[1] : lane == 2 ? ek[2] : ek[3];
            const float gt = (lane == 0 ? ex[0] : lane == 1 ? ex[1] : lane == 2 ? ex[2] : ex[3]) * rden;
            const int sl = __hip_atomic_fetch_add(cntL + e, 1, __ATOMIC_RELAXED, __HIP_MEMORY_SCOPE_WORKGROUP);
            const int pos = F.wave * 64 + it * 4 + lane;
            stA[pos] = m * 4 + lane; stE[pos] = e | (sl << 8); stG[pos] = gt;
        }
        { const GAS f32x4* gr = (const GAS f32x4*)gf + lane; GAS unsigned* o4 = (GAS unsigned*)(XN8 + (size_t)m * 1024) + lane;
          GAS unsigned long long* h8 = (GAS unsigned long long*)((bf16*)(a.ws + WS_HB) + (size_t)m * 1024) + lane;
#pragma unroll
          for (int j = 0; j < 4; ++j) { const f32x4 gg = gr[64 * j];
              o4[64 * j] = pk_fp8x4(hv[j].x * rstd * gg.x, hv[j].y * rstd * gg.y, hv[j].z * rstd * gg.z, hv[j].w * rstd * gg.w);
              __builtin_nontemporal_store((unsigned long long)pk2(hv[j].x, hv[j].y) | ((unsigned long long)pk2(hv[j].z, hv[j].w) << 32), h8 + 64 * j); } }
    }
    }
    __syncthreads();
    if (FTID(F) < 32) baseL[FTID(F)] = (int)__hip_atomic_fetch_add(F.ctl + CW_ECNT + 16 * FTID(F), (unsigned)cntL[FTID(F)], __ATOMIC_RELAXED, __HIP_MEMORY_SCOPE_AGENT);
    __syncthreads();
    { const int pos = FTID(F); const int aid = stA[pos], ee = stE[pos], e = ee & 255, sl = ee >> 8;
      int* list = (int*)(a.ws + WS_LIST); float* gates = (float*)(a.ws + WS_GATES);
      list[(size_t)e * T + baseL[e] + sl] = aid; gates[(size_t)e * T + baseL[e] + sl] = stG[pos]; }
}
__device__ __forceinline__ void moe_tables(Frame& F) {
    LAS int* tpre = (LAS int*)(F.lds + MOE_OFF); LAS int* cntE = tpre + 40;
    __syncthreads();
    if (FTID(F) < 32) cntE[FTID(F)] = (int)__hip_atomic_load(F.ctl + CW_ECNT + 16 * FTID(F), RLX_AGENT);
    __syncthreads();
    if (FTID(F) == 0) { int acc = 0; for (int e = 0; e < 32; ++e) { tpre[e] = acc; acc += (cntE[e] + 255) >> 8; } tpre[32] = acc; }
    __syncthreads();
}
__device__ __forceinline__ void pf_final(Frame& F, const Args& a) {
    int lane = mk_lane(); asm volatile("" : "+v"(lane));
    const int gw = F.vcu * NWAVES + F.wave, NGW = F.G * NWAVES;
    const unsigned char* YB = (const unsigned char*)(a.ws + WS_YBUF); const float* gfin = INF(a, 28);
    for (int m = gw; m < T; m += NGW) {
        GAS f32x4* hr = (GAS f32x4*)(a.out + (size_t)m * 1024) + lane;
        const GAS unsigned long long* mr = (const GAS unsigned long long*)((const bf16*)(a.ws + WS_HB) + (size_t)m * 1024) + lane;
        f32x4 v[4];
#pragma unroll
        for (int j = 0; j < 4; ++j) { const unsigned long long w = __builtin_nontemporal_load(mr + 64 * j); const unsigned lo = (unsigned)w, hi = (unsigned)(w >> 32);
            v[j].x = bf_lo(lo); v[j].y = bf_hi(lo); v[j].z = bf_lo(hi); v[j].w = bf_hi(hi); }
#pragma unroll
        for (int k = 0; k < 4; ++k) { const GAS unsigned* yr = (const GAS unsigned*)(YB + ((size_t)m * 4 + k) * 1024) + lane;
#pragma unroll
            for (int j = 0; j < 4; ++j) { const unsigned w = __builtin_nontemporal_load(yr + 64 * j); const f32x2 lo = __builtin_amdgcn_cvt_pk_f32_fp8((int)w, false), hi = __builtin_amdgcn_cvt_pk_f32_fp8((int)w, true);
                v[j].x += lo.x * YB_INV; v[j].y += lo.y * YB_INV; v[j].z += hi.x * YB_INV; v[j].w += hi.y * YB_INV; } }
        float s = 0.f;
#pragma unroll
        for (int j = 0; j < 4; ++j) s += (v[j].x * v[j].x + v[j].y * v[j].y) + (v[j].z * v[j].z + v[j].w * v[j].w);
        const float rstd = 1.f / sqrtf(wave_sum(s) * (1.f / D) + RMS_EPS);
        const GAS f32x4* gr = (const GAS f32x4*)gfin + lane;
#pragma unroll
        for (int j = 0; j < 4; ++j) { const f32x4 gg = gr[64 * j]; __builtin_nontemporal_store(v[j] * rstd * gg, hr + 64 * j); }
    }
}

__global__ void __launch_bounds__(NWAVES * 64, 2) mk_fwd(Args args) {
    extern __shared__ __attribute__((aligned(16))) unsigned char lds[];
    Frame F;
    F.lds = (LAS unsigned char*)lds;
    F.MISC = (volatile LAS unsigned*)(F.lds + MISC_OFF);
    F.wave = __builtin_amdgcn_readfirstlane((int)(threadIdx.x >> 6));
    F.G = gridDim.x; { const int bx = blockIdx.x; F.vcu = (F.G % 8 == 0) ? (bx % 8) * (F.G / 8) + bx / 8 : bx; }
    unsigned char* ws = args.ws;
    F.ctl = (gu32*)(ws + WS_CTL);
    for (int u = FTID(F); u < (LDS_BYTES - LDSCTL_OFF) / 4; u += NWAVES * 64) ((LAS unsigned*)(F.lds + LDSCTL_OFF))[u] = 0u;
    __syncthreads();
    XcdBarrier bar; bar.bar = (unsigned*)(F.ctl + CW_BAR); bar.x = 0; bar.st = nullptr; bar.wave = F.wave; bar.G = gridDim.x;
    if (N_LAUNCHES == 1) bar = xcd_barrier_post((unsigned*)(F.ctl + CW_BAR), F.MISC + 8, F.wave, gridDim.x);
#define GRID_BAR() do { if (N_LAUNCHES == 1) xcd_barrier(bar); } while (0)
    const int lo = args.ph_lo, hi = args.ph_hi;
#define IN(k) (lo <= (k) && (k) < hi)
#ifndef PROBE_DUP
#define PROBE_DUP -1
#endif
#define REP(k, ...) do { __VA_ARGS__; if constexpr (PROBE_DUP == (k)) { __VA_ARGS__; } } while (0)
#define BOTH(k) (IN(k) && IN((k) + 1))
    LAS unsigned char* ring = F.lds + RING_OFF;

    if (IN(0)) { REP(0, p0_prologue(F, args)); if (BOTH(0)) GRID_BAR(); }
    if (IN(1)) {
        DenseOrder S; S.init(T, 2048, 1024, 1024, 1024, ws + WS_XN, ws + WS_WIN, F.G, (int)blockIdx.x);
        EpiInProj E{(bf16*)(ws + WS_Q), (bf16*)(ws + WS_K), (bf16*)(ws + WS_V), (bf16*)(ws + WS_AROW), (const float*)(ws + WS_ROPE), attn_body::C2};
        pg8::ALinear AO{2048};
        REP(1, pg8::gemm_phase<EpiInProj, DenseOrder, pg8::ALinear, true>(ring, 2048, S, AO, E, F.wave));
        if (BOTH(1)) GRID_BAR();
        if constexpr (PROBE_DUP == 40) { GRID_BAR(); GRID_BAR(); GRID_BAR(); GRID_BAR(); }
    }
    if (IN(2)) {
        if (F.G == 256) {
            if ((F.vcu & 3) == 0) {
                const int rank = F.vcu >> 2;
                const XcdBarrier sbar = xcd_barrier_post((unsigned*)(F.ctl + CW_BAR2), F.MISC + 12, F.wave, NS5);
                { XOrder S{NS5, rank, (const char*)(ws + WS_AROW), (const char*)(ws + WS_BTX)}; EpiX E{(float*)(ws + WS_XLOC)}; pg8::ALinear AO{AROW_P * 2};
                  REP(50, pg8::gemm_phase<EpiX, XOrder, pg8::ALinear, true>(ring, 1024, S, AO, E, F.wave)); }
                xcd_barrier(sbar);
                REP(51, if (F.wave < 2) s5_scan(args, rank * 2 + F.wave, mk_lane()));
                xcd_barrier(sbar);
                { YOrder S{NS5, rank, (const char*)(ws + WS_AROW), (const char*)(ws + WS_BTY)}; EpiY E{(bf16*)(ws + WS_YG)}; pg8::ALinear AO{AROW_P * 2};
                  REP(52, pg8::gemm_phase<EpiY, YOrder, pg8::ALinear, true>(ring, AROW_P * 2, S, AO, E, F.wave)); }
                xcd_barrier(sbar);
                { GluOrder S{rank, (const char*)(ws + WS_YG), (const char*)(ws + WS_WGLU)};
                  EpiGlu E{(const bf16*)(ws + WS_YG), (bf16*)(ws + WS_GLU), INF(args, 18)}; pg8::ALinear AO{1024};
                  REP(53, pg8::gemm_phase<EpiGlu, GluOrder, pg8::ALinear, true>(ring, 1024, S, AO, E, F.wave)); }
                asm volatile("s_waitcnt vmcnt(0)" ::: "memory"); __syncthreads();
                REP(54, glunorm_sub(F, args, rank));
                __syncthreads();
            }
            const int xcd = F.vcu >> 5, wl = F.vcu & 31;
            const float lam = *(const float*)(ws + WS_SMALL);
            for (int rp = 0; rp < NREP(2); ++rp)
            for (int i = 0; i < 8; ++i) {
                const int e = __builtin_amdgcn_readfirstlane((int)ATT_DEAL[wl][i]); if (e == 255) break;
                const int bh = xcd * 2 + (e >> 5), qb = e & 31, b = bh >> 2, h = bh & 3;
                for (int map = 0; map < 2; ++map) { const int hm = h * 2 + map;
                    attn_body::attn_unit<8>(b, hm * 64, hm * 64, h * 128, h * 128, qb,
                        (const attn_body::bf16*)(ws + WS_Q), (const attn_body::bf16*)(ws + WS_K), (const attn_body::bf16*)(ws + WS_V), (attn_body::bf16*)(ws + WS_O), (char*)lds + RING_OFF, F.wave,
                        map, (attn_body::bf16*)(ws + WS_ACAT), lam, INF(args, 8)); }
            }
        }
        if (IN(7)) GRID_BAR();
    }
    if (IN(7)) {
        DenseOrder S; S.init(T, 1024, 1024, 1024, 1024, ws + WS_ACAT, ws + WS_WOUT, F.G, (int)blockIdx.x);
        EpiMix E{(bf16*)(ws + WS_MIX)}; pg8::ALinear AO{2048};
        REP(7, pg8::gemm_phase<EpiMix, DenseOrder, pg8::ALinear, true>(ring, 2048, S, AO, E, F.wave));
        if (BOTH(7)) GRID_BAR();
    }
    if (IN(8)) { if (F.G == 256) pr_router(F, args); if (BOTH(8)) GRID_BAR(); }
    if (IN(9)) {
        moe_tables(F);
        const LAS int* tpre = (const LAS int*)(F.lds + MOE_OFF);
        MoeOrder<4, 8> S{F.G, F.vcu, tpre, tpre + 40, (const char*)(ws + WS_XN), (const char*)(ws + WS_WGU), (size_t)2048 * 1024, true, 8};
        EpiGU E{(unsigned char*)(ws + WS_ACT), INF(args, 25), F.lds + EPB_OFF}; AGather AO{(const int*)(ws + WS_LIST)};
        if constexpr (PROBE_DUP == 61) { MoeOrder<4, 8> S2 = S; S2.ntk = 24; pg8::gemm_phase<EpiGU, MoeOrder<4, 8>, AGather, true, true>(ring, 1024, S2, AO, E, F.wave, F.lds + ST_OFF); }
        REP(9, pg8::gemm_phase<EpiGU, MoeOrder<4, 8>, AGather, true, true>(ring, 1024, S, AO, E, F.wave, F.lds + ST_OFF));
        if (BOTH(9)) GRID_BAR();
    }
    if (IN(10)) {
        moe_tables(F);
        const LAS int* tpre = (const LAS int*)(F.lds + MOE_OFF);
        MoeOrder<8, 4> S{F.G, F.vcu, tpre, tpre + 40, (const char*)(ws + WS_ACT), (const char*)(ws + WS_WD), (size_t)1024 * 1024, false, 8};
        EpiDown E{(unsigned char*)(ws + WS_YBUF), INF(args, 27), (const int*)(ws + WS_LIST), (const float*)(ws + WS_GATES), 1, F.lds + ST_OFF, F.lds + EPB_OFF}; pg8::ALinear AO{1024};
        if constexpr (PROBE_DUP == 64) { EpiDownT<1> E1{(unsigned char*)(ws + WS_YBUF), INF(args, 27), (const int*)(ws + WS_LIST), (const float*)(ws + WS_GATES), 1, F.lds + ST_OFF, F.lds + EPB_OFF}; pg8::gemm_phase<EpiDownT<1>, MoeOrder<8, 4>, pg8::ALinear, true, true>(ring, 1024, S, AO, E1, F.wave); }
        if constexpr (PROBE_DUP == 62) { EpiNull E0; pg8::gemm_phase<EpiNull, MoeOrder<8, 4>, pg8::ALinear, true, true>(ring, 1024, S, AO, E0, F.wave); }
        if constexpr (PROBE_DUP == 60) { MoeOrder<8, 4> S2 = S; S2.ntk = 24; pg8::gemm_phase<EpiDown, MoeOrder<8, 4>, pg8::ALinear, true, true>(ring, 1024, S2, AO, E, F.wave); }
        REP(10, pg8::gemm_phase<EpiDown, MoeOrder<8, 4>, pg8::ALinear, true, true>(ring, 1024, S, AO, E, F.wave));
        if (BOTH(10)) GRID_BAR();
    }
    if (IN(11)) { REP(11, pf_final(F, args)); }
#undef IN
#undef BOTH
}

extern "C" void kernel_launch(void* const* d_in, const int* in_sizes, int n_in, void* d_out, int out_size, void* d_ws, size_t ws_size, hipStream_t stream) {
    static int grid = 0;
    if (grid == 0) {
        if (n_in != 29 || in_sizes[0] != T * D || out_size != T * D || ws_size < WS_END) { fprintf(stderr, "kernel_launch: unexpected shapes / workspace (n_in %d, ws %zu)\n", n_in, ws_size); grid = -1; return; }
        int dev = 0, cus = 0, per_cu = 0;
        if (hipGetDevice(&dev) != hipSuccess || hipDeviceGetAttribute(&cus, hipDeviceAttributeMultiprocessorCount, dev) != hipSuccess) { grid = -1; return; }
        if (hipFuncSetAttribute((const void*)mk_fwd, hipFuncAttributeMaxDynamicSharedMemorySize, LDS_BYTES) != hipSuccess) { fprintf(stderr, "kernel_launch: hipFuncSetAttribute failed\n"); grid = -1; return; }
        if (hipOccupancyMaxActiveBlocksPerMultiprocessor(&per_cu, (const void*)mk_fwd, NWAVES * 64, LDS_BYTES) != hipSuccess || per_cu < 1) { fprintf(stderr, "kernel_launch: occupancy query says %d\n", per_cu); }
        (void)hipGetLastError();
        if (cus < 256) { fprintf(stderr, "kernel_launch: needs 256 CUs, device has %d\n", cus); grid = -1; return; }
        grid = 256;
    }
    if (grid < 0) return;
    if (hipMemsetAsync((char*)d_ws + WS_CTL, 0, CTL_ZERO_BYTES, stream) != hipSuccess) return;
    Args a{};
    for (int i = 0; i < 29; ++i) a.in[i] = d_in[i];
    a.out = (float*)d_out; a.ws = (unsigned char*)d_ws; a.pad = 0;
    for (int li = 0; li < N_LAUNCHES; ++li) {
        a.ph_lo = (N_LAUNCHES == NPH) ? li : 0; a.ph_hi = (N_LAUNCHES == NPH) ? li + 1 : NPH; a.li = li;
        hipLaunchKernelGGL(mk_fwd, dim3(grid), dim3(NWAVES * 64), LDS_BYTES, stream, a);
    }
}
```

```cpp
#include <hip/hip_runtime.h>
#include <hip/hip_bf16.h>
#include <cstdio>
#include <cstdint>
#include <cmath>
__device__ __forceinline__ int mk_lane() { int l; asm volatile("v_mbcnt_lo_u32_b32 %0, -1, 0\n\tv_mbcnt_hi_u32_b32 %0, -1, %0" : "=v"(l)); return l; }
namespace pg8 {
#define PG8_LAS __attribute__((address_space(3)))
typedef unsigned short bf16_t;
typedef short bf16x8 __attribute__((ext_vector_type(8)));
typedef float f32x4 __attribute__((ext_vector_type(4)));
typedef float f32x2 __attribute__((ext_vector_type(2)));
typedef unsigned u32x4 __attribute__((ext_vector_type(4)));
typedef unsigned u32x2 __attribute__((ext_vector_type(2)));
constexpr int BM = 256, BK = 64, HALF = 128, HTB = HALF * BK * 2  , STAGE_BYTES = 8 * HTB, NXCD = 8, WGM = 8;

__host__ __device__ __forceinline__ int lds_byte(int r, int c) { const int st = (r >> 4) * 2 + (c >> 5), rr = r & 15, cc = c & 31, ob = rr * 64 + cc * 2; return st * 1024 + (ob ^ (((ob >> 9) & 1) << 5)); }
__host__ __device__ __forceinline__ void stage_rc(int b, int& R, int& C) { const int st = b / 1024, sb = b % 1024, swz = sb ^ (((sb >> 9) & 1) << 5); R = (st >> 1) * 16 + swz / 64; C = (st & 1) * 32 + (swz % 64) / 2; }
__host__ __device__ __forceinline__ int perm32(int rho) { const int n = rho >> 4, i = rho & 15; return 8 * (i >> 2) + 4 * n + (i & 3); }

struct Unit { int pm, pn; const char* a; const char* b; int nt; int x0, x1; };

struct ALinear {
    static constexpr bool PER_UNIT = false;
    int lda;
    __device__ __forceinline__ void get(const Unit&, unsigned (&v)[2][2], const int (&R)[2], const int (&C)[2]) const {
#pragma unroll
        for (int h = 0; h < 2; ++h)
#pragma unroll
            for (int i = 0; i < 2; ++i) v[h][i] = (unsigned)(R[i] * lda + C[i] * 2);
    }
    __device__ __forceinline__ size_t hstep() const { return (size_t)HALF * lda; }
    __device__ __forceinline__ void issue_dma(const Unit&, const int (&)[2], unsigned) const {}
    __device__ __forceinline__ void finish(const int (&)[4], unsigned (&)[2][2], const int (&)[2]) const {}
};

__device__ __forceinline__ unsigned cvt_pk_bf16(float lo, float hi) { unsigned r; asm volatile("v_cvt_pk_bf16_f32 %0, %1, %2" : "=v"(r) : "v"(lo), "v"(hi)); return r; }
__device__ __forceinline__ f32x2 gelu_pk(f32x2 v) {
    const f32x2 av = __builtin_elementwise_abs(v), d = av * 0.2316418882f + 1.0f;
    f32x2 t; t.x = __builtin_amdgcn_rcpf(d.x); t.y = __builtin_amdgcn_rcpf(d.y);
    f32x2 q = t * 0.5307027145f + (-0.7265760135f); q = q * t + 0.7107068705f; q = q * t + (-0.142248368f); q = q * t + 0.127414796f; q = q * t;
    const f32x2 s = (v * v) * (-0.72134752044f);
    f32x2 e; e.x = __builtin_amdgcn_exp2f(s.x); e.y = __builtin_amdgcn_exp2f(s.y);
    const f32x2 m = v * (q * e), r = v - m;
    f32x2 o; o.x = v.x < 0.f ? m.x : r.x; o.y = v.y < 0.f ? m.y : r.y; return o;
}

typedef int v4i_t __attribute__((ext_vector_type(4)));
typedef int v8i_t __attribute__((ext_vector_type(8)));
template <int OFF> __device__ __forceinline__ void glds_sv(const char* sbase, unsigned voff, unsigned lds_w0) { unsigned keep;
    asm volatile("s_mov_b32 %0, m0\n\ts_add_u32 m0, %3, %4\n\ts_nop 0\n\tglobal_load_lds_dwordx4 %1, %2\n\ts_mov_b32 m0, %0" : "=&s"(keep) : "v"(voff), "s"(sbase), "s"(lds_w0), "i"(OFF) : "memory", "scc"); }
__device__ __forceinline__ void glds4_sv(const void* sbase, unsigned voff, unsigned lds_dst) { unsigned keep;
    asm volatile("s_mov_b32 %0, m0\n\ts_mov_b32 m0, %3\n\ts_nop 0\n\tglobal_load_lds_dword %1, %2\n\ts_mov_b32 m0, %0" : "=&s"(keep) : "v"(voff), "s"(sbase), "s"(lds_dst) : "memory"); }
template <int N> __device__ __forceinline__ void wait_vm_sel(int sel) { asm volatile("v_cmp_ne_u32_e32 vcc, 0, %0\n\ts_cbranch_vccz .Lw8_%=\n\ts_waitcnt vmcnt(%1)\n\ts_branch .Lwe_%=\n.Lw8_%=:\n\ts_waitcnt vmcnt(8)\n.Lwe_%=:" :: "v"(sel), "n"(N) : "memory", "vcc"); }
template <bool FP8> struct FragT;
template <> struct FragT<false> { struct A4 { bf16x8 v[4][2]; }; struct B2 { bf16x8 v[2][2]; }; };
template <> struct FragT<true> { struct A4 { v8i_t v[4]; }; struct B2 { v8i_t v[2]; }; };
template <class Epi, class Sched, class AOff, bool ALIGN_EPI = true, bool FP8 = false>
__device__ __forceinline__ void gemm_phase(PG8_LAS unsigned char* lds, const int ldb  , const Sched& S, const AOff& AO, const Epi& E, const int wave_  , PG8_LAS unsigned char* xlds = nullptr  ) {
    int tid_ = wave_ * 64 + mk_lane(); asm volatile("" : "+v"(tid_));
    const int tid = tid_, wid = __builtin_amdgcn_readfirstlane(tid >> 6), lane = tid & 63, wr = wid >> 2, wc = wid & 3, fr = lane & 15, fq = lane >> 4;
    unsigned voffB[2]; int RR[2], CC[2];
#pragma unroll
    for (int i = 0; i < 2; ++i) { int R, C; stage_rc(tid * 16 + i * 8192, R, C); RR[i] = R; CC[i] = C; const int Rp = (R & ~31) + perm32(R & 31); const int P32 = perm32(R & 31); const int Rb = Epi::BMODE == 0 ? R : Epi::BMODE == 1 ? Rp : Epi::BMODE == 2 ? 2 * Rp : 64 * (R >> 5) + 16 * (P32 >> 3) + (P32 & 7);
        voffB[i] = (unsigned)(Rb * ldb + C * 2); }
    const size_t kstep = (size_t)(BK * 2);
    const size_t hstepB = Epi::BMODE == 2 ? (size_t)ldb : Epi::BMODE == 3 ? (size_t)8 * ldb : (size_t)HALF * ldb;
    const size_t hstepA = AO.hstep();
    constexpr int AH1 = AOff::PER_UNIT ? 1 : 0;
    const unsigned ldsw0 = (unsigned)__builtin_amdgcn_readfirstlane((int)((unsigned)(uintptr_t)lds + (unsigned)wid * 1024u));
    const int aoff = lds_byte(wr * 64 + fr, fq * 8), boff = lds_byte(wc * 32 + fr, fq * 8);
#define PG8_SA(b, h) (((b) * 2 + (h)) * HTB)
#define PG8_SB(b, h) ((4 + (b) * 2 + (h)) * HTB)
#define PG8_STAGE(bufoff, gbase, voff) do { glds_sv<(bufoff)>((const char*)(gbase), (voff)[0], ldsw0); glds_sv<(bufoff) + 8192>((const char*)(gbase), (voff)[1], ldsw0); } while (0)
#define PG8_LD8(p) __builtin_shufflevector(*(const PG8_LAS v4i_t*)(p), *(const PG8_LAS v4i_t*)((p) + 1024), 0, 1, 2, 3, 4, 5, 6, 7)
#define PG8_LDA(dst, b, h) do { if constexpr (FP8) { _Pragma("unroll") for (int m = 0; m < 4; ++m) dst.v[m] = PG8_LD8(lds + PG8_SA(b, h) + aoff + m * 2048); } \
        else { _Pragma("unroll") for (int m = 0; m < 4; ++m) _Pragma("unroll") for (int k = 0; k < 2; ++k) dst.v[m][k] = *(const PG8_LAS bf16x8*)(lds + PG8_SA(b, h) + aoff + m * 2048 + k * 1024); } } while (0)
#define PG8_LDB(dst, b, h) do { if constexpr (FP8) { _Pragma("unroll") for (int n = 0; n < 2; ++n) dst.v[n] = PG8_LD8(lds + PG8_SB(b, h) + boff + n * 2048); } \
        else { _Pragma("unroll") for (int n = 0; n < 2; ++n) _Pragma("unroll") for (int k = 0; k < 2; ++k) dst.v[n][k] = *(const PG8_LAS bf16x8*)(lds + PG8_SB(b, h) + boff + n * 2048 + k * 1024); } } while (0)
#define PG8_MMA(ai, bj, At, Bt) do { __builtin_amdgcn_s_setprio(1); \
        if constexpr (FP8) { _Pragma("unroll") for (int m = 0; m < 4; ++m) _Pragma("unroll") for (int n = 0; n < 2; ++n) \
            acc[ai][bj][m][n] = __builtin_amdgcn_mfma_scale_f32_16x16x128_f8f6f4(Bt.v[n], At.v[m], acc[ai][bj][m][n], 0, 0, 0, 0, 0, 0); } \
        else { _Pragma("unroll") for (int m = 0; m < 4; ++m) _Pragma("unroll") for (int n = 0; n < 2; ++n) _Pragma("unroll") for (int k = 0; k < 2; ++k) \
            acc[ai][bj][m][n] = __builtin_amdgcn_mfma_f32_16x16x32_bf16(Bt.v[n][k], At.v[m][k], acc[ai][bj][m][n], 0, 0, 0); } \
        __builtin_amdgcn_s_setprio(0); } while (0)
#define PG8_WAIT_V(n) asm volatile("s_waitcnt vmcnt(" #n ")" ::: "memory")
#define PG8_WAIT_L(n) asm volatile("s_waitcnt lgkmcnt(" #n ")" ::: "memory")
#define PG8_BAR __builtin_amdgcn_s_barrier()
#define PG8_SCHED __builtin_amdgcn_sched_barrier(0)
    Unit cur, nxt; int ui = 0;
    if (!S.next(0, cur)) return;
    unsigned vAc[2][2];
    AO.get(cur, vAc, RR, CC);
    PG8_LAS unsigned* const xw = (PG8_LAS unsigned*)xlds + wid * 256 + lane;
    const unsigned xdst = (unsigned)__builtin_amdgcn_readfirstlane((int)((unsigned)(uintptr_t)xlds + (unsigned)wid * 1024u));
    f32x4 acc[2][2][4][2];
#pragma unroll
    for (int a = 0; a < 2; ++a)
#pragma unroll
        for (int b = 0; b < 2; ++b)
#pragma unroll
            for (int m = 0; m < 4; ++m)
#pragma unroll
                for (int n = 0; n < 2; ++n) acc[a][b][m][n] = (f32x4){0.f, 0.f, 0.f, 0.f};
    typedef typename FragT<FP8>::A4 FragA; typedef typename FragT<FP8>::B2 FragB;
    FragA At; FragB B0, B1;
    const char* cA = cur.a; const char* cB = cur.b; int nt = cur.nt; asm volatile("" : "+s"(nt));
    PG8_STAGE(PG8_SB(0, 0), cB, voffB); PG8_STAGE(PG8_SB(0, 1), cB + hstepB, voffB); PG8_STAGE(PG8_SA(0, 0), cA, vAc[0]); PG8_STAGE(PG8_SA(0, 1), cA + hstepA, vAc[AH1]);
    if (wr == 1) PG8_BAR;
    PG8_WAIT_V(2); PG8_BAR;
    PG8_STAGE(PG8_SB(1, 0), cB + kstep, voffB); PG8_STAGE(PG8_SA(1, 0), cA + kstep, vAc[0]); PG8_STAGE(PG8_SB(1, 1), cB + hstepB + kstep, voffB);
    PG8_WAIT_V(6); PG8_BAR;
    for (;;) {
        const bool has_next = S.next(ui + 1, nxt);
        if constexpr (AOff::PER_UNIT) { if (has_next) AO.issue_dma(nxt, RR, xdst); }
        if constexpr (Epi::PREFETCH) E.prefetch(cur, wid, wr, lane);
        const char* nA = has_next ? nxt.a : cA; const char* nB = has_next ? nxt.b : cB;
        for (int t = 0; t < nt; t += 2) {
            const bool last = (t == nt - 2);
            const int rlx = ((t == 0) && (ui > 0)) ? 1 : 0;
            const char* a1 = cA + (size_t)(t + 1) * kstep;
            const char* a2 = last ? nA : cA + (size_t)(t + 2) * kstep; const char* b2 = last ? nB : cB + (size_t)(t + 2) * kstep;
            const char* a3 = a2 + kstep; const char* b3 = b2 + kstep;

            PG8_LDB(B0, 0, 0); PG8_LDB(B1, 0, 1); PG8_SCHED; PG8_LDA(At, 0, 0); PG8_STAGE(PG8_SA(1, 1), a1 + hstepA, vAc[AH1]);
            if constexpr (AOff::PER_UNIT) { if (last && has_next) { int raw[4]; raw[0] = (int)xw[0]; raw[1] = (int)xw[64]; raw[2] = (int)xw[128]; raw[3] = (int)xw[192]; AO.finish(raw, vAc, CC); } }
            if constexpr (Epi::NSTORE + Epi::NPRE > 0) wait_vm_sel<8 + Epi::NSTORE + Epi::NPRE>(rlx); else PG8_WAIT_V(8);
            PG8_WAIT_L(0); PG8_BAR; PG8_MMA(0, 0, At, B0); PG8_MMA(0, 1, At, B1); PG8_BAR; PG8_SCHED;
            PG8_LDA(At, 0, 1); PG8_STAGE(PG8_SB(0, 0), b2, voffB); PG8_STAGE(PG8_SB(0, 1), b2 + hstepB, voffB); PG8_STAGE(PG8_SA(0, 0), a2, vAc[0]);
            if constexpr (Epi::NSTORE + Epi::NPRE > 0) wait_vm_sel<8 + Epi::NSTORE + Epi::NPRE>(rlx); else PG8_WAIT_V(8);
            PG8_WAIT_L(0); PG8_BAR; PG8_MMA(1, 0, At, B0); PG8_MMA(1, 1, At, B1); PG8_BAR; PG8_SCHED;
            PG8_LDB(B0, 1, 0); PG8_LDB(B1, 1, 1); PG8_SCHED; PG8_LDA(At, 1, 0); PG8_STAGE(PG8_SA(0, 1), a2 + hstepA, vAc[AH1]);
            PG8_WAIT_V(8); PG8_WAIT_L(0); PG8_BAR; PG8_MMA(0, 0, At, B0); PG8_MMA(0, 1, At, B1); PG8_BAR; PG8_SCHED;
            PG8_LDA(At, 1, 1); PG8_STAGE(PG8_SB(1, 0), b3, voffB); PG8_STAGE(PG8_SB(1, 1), b3 + hstepB, voffB); PG8_STAGE(PG8_SA(1, 0), a3, vAc[0]);
            PG8_WAIT_V(8); PG8_WAIT_L(0); PG8_BAR; PG8_MMA(1, 0, At, B0); PG8_MMA(1, 1, At, B1); PG8_BAR; PG8_SCHED;
        }
        if constexpr (ALIGN_EPI) { if (wr == 0) PG8_BAR; }
        { const int el = mk_lane(); const int efr = el & 15, efq = el >> 4;
          E(acc, cur, wr, wc, efr, efq); }
        if (!has_next) break;
#pragma unroll
        for (int a = 0; a < 2; ++a)
#pragma unroll
            for (int b = 0; b < 2; ++b)
#pragma unroll
                for (int m = 0; m < 4; ++m)
#pragma unroll
                    for (int n = 0; n < 2; ++n) acc[a][b][m][n] = (f32x4){0.f, 0.f, 0.f, 0.f};
        cur = nxt; cA = nA; cB = nB; nt = cur.nt; asm volatile("" : "+s"(nt)); ++ui;

        if constexpr (ALIGN_EPI) { if (wr == 1) PG8_BAR; }
    }
    PG8_WAIT_V(0);
    if constexpr (!ALIGN_EPI) { if (wr == 0) PG8_BAR; }
    PG8_BAR;
#undef PG8_SA
#undef PG8_SB
#undef PG8_STAGE
#undef PG8_LDA
#undef PG8_LDB
#undef PG8_MMA
#undef PG8_LD8
#undef PG8_WAIT_V
#undef PG8_WAIT_L
#undef PG8_BAR
#undef PG8_SCHED
}
}
namespace attn_body {
using bf16=__hip_bfloat16;
using bf16x8=__attribute__((ext_vector_type(8)))short;
using s16x4=__attribute__((ext_vector_type(4)))short;
using f32x16=__attribute__((ext_vector_type(16)))float;
using u32x4=__attribute__((ext_vector_type(4)))unsigned;
constexpr int SEQ=8192,D=64;
constexpr int PQ=512,PK=512,PV=512,PO=512,PA=1024;
constexpr int NW=8,QBLK=32,QB=QBLK*NW,KVBLK=64,NQB=SEQ/QB;
constexpr int ATTN_UNIT_ROWS=QB;
__device__ __forceinline__ int crow(int r,int hi){return (r&3)+8*(r>>2)+4*hi;}
#define SBAR() __builtin_amdgcn_sched_barrier(0)
__device__ __forceinline__ void cmask(f32x16&p0,f32x16&p1,int jb,int qrel,int hi){
  const float NEG=-INFINITY; int kb=64*jb+4*hi;
  #pragma unroll
  for(int r=0;r<16;++r){int kv=kb+(r&3)+8*(r>>2); if(kv>qrel)p0[r]=NEG; if(kv+32>qrel)p1[r]=NEG;}
}

constexpr int NSLOT=3, SLOTB=8192;
constexpr int LDS_K=0, LDS_V=NSLOT*SLOTB, LDS_WS=3*NSLOT*SLOTB, LDS_OST=LDS_WS+NW*64*4, LDS_BYTES=LDS_OST+NW*8192;
constexpr float C2=0.125f*1.4426950408889634f;
__device__ __forceinline__ void glds16(const void*sbase,unsigned voff,unsigned lds_dst){unsigned keep;
  asm volatile("s_mov_b32 %0, m0\n\ts_mov_b32 m0, %3\n\ts_nop 0\n\tglobal_load_lds_dwordx4 %1, %2\n\ts_mov_b32 m0, %0":"=&s"(keep):"v"(voff),"s"(sbase),"s"(lds_dst):"memory");}
__device__ __forceinline__ float max3f(float a,float b,float c){float r;asm("v_max3_f32 %0, %1, %2, %3":"=v"(r):"v"(a),"v"(b),"v"(c));return r;}
__device__ __forceinline__ float max2f(float a,float b){float r;asm("v_max_f32_e32 %0, %1, %2":"=v"(r):"v"(a),"v"(b));return r;}
__device__ __forceinline__ float fadd_s(float a,float b){float r;asm("v_add_f32_e32 %0, %1, %2":"=v"(r):"v"(a),"v"(b));return r;}
__device__ __forceinline__ float fsub_s(float a,float b){float r;asm("v_sub_f32_e32 %0, %1, %2":"=v"(r):"v"(a),"v"(b));return r;}
typedef float f32x2_t __attribute__((ext_vector_type(2))); typedef __bf16 bf16x2_t __attribute__((ext_vector_type(2)));
__device__ __forceinline__ unsigned cvtpk_s(float lo,float hi){f32x2_t v={lo,hi};bf16x2_t b=__builtin_convertvector(v,bf16x2_t);return __builtin_bit_cast(unsigned,b);}
#define WAIT_BAR(N) asm volatile("s_waitcnt vmcnt(" #N ") lgkmcnt(0)\n\ts_barrier":::"memory")

__device__ __forceinline__ void qkt(f32x16&p0,f32x16&p1,const char*Kslot,const bf16x8*qr,const f32x16&negm,int r32,int hi){
  const char*kb=Kslot+hi*1024+r32*16;
  #pragma unroll
  for(int d0=0;d0<4;++d0){
    const bf16x8 b0=*reinterpret_cast<const bf16x8*>(kb+d0*2048);
    const bf16x8 b1=*reinterpret_cast<const bf16x8*>(kb+d0*2048+512);
    if(d0==0){p0=__builtin_amdgcn_mfma_f32_32x32x16_bf16(b0,qr[0],negm,0,0,0);p1=__builtin_amdgcn_mfma_f32_32x32x16_bf16(b1,qr[0],negm,0,0,0);}
    else{p0=__builtin_amdgcn_mfma_f32_32x32x16_bf16(b0,qr[d0],p0,0,0,0);p1=__builtin_amdgcn_mfma_f32_32x32x16_bf16(b1,qr[d0],p1,0,0,0);}}
}
typedef __attribute__((address_space(3))) const char* lds_cptr;
typedef short v4i16_t __attribute__((ext_vector_type(4)));
__device__ __forceinline__ void kload8(bf16x8*kf,lds_cptr kp){
  kf[0]=*(const __attribute__((address_space(3))) bf16x8*)(kp);      kf[1]=*(const __attribute__((address_space(3))) bf16x8*)(kp+512);
  kf[2]=*(const __attribute__((address_space(3))) bf16x8*)(kp+2048); kf[3]=*(const __attribute__((address_space(3))) bf16x8*)(kp+2560);
  kf[4]=*(const __attribute__((address_space(3))) bf16x8*)(kp+4096); kf[5]=*(const __attribute__((address_space(3))) bf16x8*)(kp+4608);
  kf[6]=*(const __attribute__((address_space(3))) bf16x8*)(kp+6144); kf[7]=*(const __attribute__((address_space(3))) bf16x8*)(kp+6656);
}
__device__ __forceinline__ void kload2(bf16x8*kf,lds_cptr kp,int j){ kf[2*j]=*(const __attribute__((address_space(3))) bf16x8*)(kp+j*2048); kf[2*j+1]=*(const __attribute__((address_space(3))) bf16x8*)(kp+j*2048+512); }
__device__ __forceinline__ s16x4 vtr(lds_cptr p){ return __builtin_bit_cast(s16x4,__builtin_amdgcn_ds_read_tr16_b64_v4i16((__attribute__((address_space(3))) v4i16_t*)p)); }
__device__ __forceinline__ float rowmax(const f32x16&p0,const f32x16&p1){
  float a=max3f(p0[0],p0[1],p1[0]),b=max3f(p0[2],p0[3],p1[1]);a=max3f(a,p1[2],p1[3]);
  #pragma unroll
  for(int r=4;r<16;r+=4){a=max3f(a,p0[r],p0[r+1]);b=max3f(b,p0[r+2],p0[r+3]);a=max3f(a,p1[r],p1[r+1]);b=max3f(b,p1[r+2],p1[r+3]);}
  const float m=max2f(a,b);
  auto rr=__builtin_amdgcn_permlane32_swap(__float_as_uint(m),__float_as_uint(m),false,false);
  return max2f(__uint_as_float(rr[0]),__uint_as_float(rr[1]));
}
__device__ __forceinline__ void pv(f32x16*o,int vb,bf16x8 pa0,bf16x8 pa1,bf16x8 pa2,bf16x8 pa3){
  #pragma unroll
  for(int d0=0;d0<4;++d0){s16x4 lo[4],hi[4];
    #pragma unroll
    for(int ks=0;ks<4;++ks){
      asm volatile("ds_read_b64_tr_b16 %0,%1 offset:%c2":"=&v"(lo[ks]):"v"(vb),"i"(d0*4096+ks*1024):"memory");
      asm volatile("ds_read_b64_tr_b16 %0,%1 offset:%c2":"=&v"(hi[ks]):"v"(vb),"i"(d0*4096+ks*1024+512):"memory");}
    asm volatile("s_waitcnt lgkmcnt(0)":::"memory");SBAR();
    #define PK(k) (bf16x8){lo[k][0],lo[k][1],lo[k][2],lo[k][3],hi[k][0],hi[k][1],hi[k][2],hi[k][3]}
    o[d0]=__builtin_amdgcn_mfma_f32_32x32x16_bf16(pa0,PK(0),o[d0],0,0,0);
    o[d0]=__builtin_amdgcn_mfma_f32_32x32x16_bf16(pa1,PK(1),o[d0],0,0,0);
    o[d0]=__builtin_amdgcn_mfma_f32_32x32x16_bf16(pa2,PK(2),o[d0],0,0,0);
    o[d0]=__builtin_amdgcn_mfma_f32_32x32x16_bf16(pa3,PK(3),o[d0],0,0,0);
    #undef PK
  }
}

#ifndef ATTN_STORE16
#define ATTN_STORE16(p,v) (*(u32x4*)(p)=(v))
#endif
template<int THRL> __device__ __forceinline__ void attn_unit(int b,int qoff,int koff,int voff,int ooff,int qb,const bf16*Q,const bf16*__restrict__ K,const bf16*__restrict__ V,bf16*O,char*shm,const int wave_,const int map,bf16*AOUT,const float lam,const float*ng){
  const int lane=mk_lane(),r32=lane&31,hi=lane>>5; const int wid=__builtin_amdgcn_readfirstlane(wave_);
  const long rowbase=(long)b*SEQ; const int q0=qb*QB;
  const bf16*Qw=Q+(rowbase+q0+wid*QBLK)*PQ+qoff;
  const bf16*Kh=K+rowbase*PK+koff,*Vh=V+rowbase*PV+voff;
  const unsigned lds0=(unsigned)(uintptr_t)shm;
  float*wsf=(float*)(shm+LDS_WS)+wid*64;
  const unsigned kofs=(unsigned)(lane*PK+wid*8)*2u;
  const unsigned voffs=(unsigned)((16*(wid&3)+(lane>>2))*PV+(wid>>2)*32+(lane&3)*8)*2u;
  const unsigned kdst=lds0+LDS_K+wid*1024, vdst=lds0+LDS_V+wid*1024;
  #define DMA_K(t,slot) glds16(Kh+(long)(t)*KVBLK*PK,kofs,(unsigned)__builtin_amdgcn_readfirstlane(kdst+(slot)))
  #define DMA_V(t,slot) do{ glds16(Vh+(long)(t)*KVBLK*PV,voffs,(unsigned)__builtin_amdgcn_readfirstlane(vdst+2*(slot))); glds16(Vh+(long)(t)*KVBLK*PV+64,voffs,(unsigned)__builtin_amdgcn_readfirstlane(vdst+2*(slot)+8192)); }while(0)
  const int vb0=(int)(lds0+LDS_V)+((lane>>4)&1)*32+(lane&3)*8+(4*hi+((lane&15)>>2))*64;
  const char*Kbase=shm+LDS_K; bf16x8 kf[8];
  const lds_cptr shm3=(lds_cptr)shm; const lds_cptr kp0=shm3+LDS_K+hi*1024+r32*16; const lds_cptr vp0=shm3+LDS_V+((lane>>4)&1)*32+(lane&3)*8+(4*hi+((lane&15)>>2))*64;
  const int NT=(q0+QB)/KVBLK;
  DMA_K(0,0);DMA_V(0,0);DMA_K(1,SLOTB);
  bf16x8 qr[4];
  #pragma unroll
  for(int d0=0;d0<4;++d0)qr[d0]=*reinterpret_cast<const bf16x8*>(&Qw[(long)r32*PQ+d0*16+hi*8]);
  typedef __attribute__((address_space(3))) char* lds_wptr;
  const lds_cptr qp0=shm3+LDS_OST+wid*8192+hi*512+r32*16;
  { lds_wptr qw=(lds_wptr)shm+LDS_OST+wid*8192+hi*512+r32*16;
    _Pragma("unroll") for(int d0=0;d0<4;++d0)*(__attribute__((address_space(3))) bf16x8*)(qw+d0*1024)=qr[d0]; }
  float mhat=0.f,l_reg=0.f;f32x16 o[4];o[0]=f32x16{};o[1]=f32x16{};o[2]=f32x16{};o[3]=f32x16{};const f32x16 zero16=f32x16{};
  const int qrel=wid*QBLK+r32;
  #define CMASK(P0,P1,t) do{int jb_=(t)-(NT-4); if(jb_>=0)cmask(P0,P1,jb_,qrel,hi);}while(0)
  bool resc=false;
  #define START(P0,P1) do{ const float rm=rowmax(P0,P1); resc=false; mhat=rm; \
    _Pragma("unroll") for(int r=0;r<16;++r)P0[r]=__builtin_amdgcn_exp2f(P0[r]-mhat); }while(0)
  #define RESC() do{ if(resc){ asm volatile("s_waitcnt lgkmcnt(0)":::"memory"); \
      _Pragma("unroll") for(int d_=0;d_<4;++d_) _Pragma("unroll") for(int r=0;r<16;++r)o[d_][r]*=wsf[crow(r,hi)]; } }while(0)
  f32x16 pA0,pA1,pB0,pB1;
  int sl_prev=0,sl_cur=0,sl_next=SLOTB;
  #define ROT() do{sl_prev=sl_cur;sl_cur=sl_next;sl_next=(sl_next==(NSLOT-1)*SLOTB)?0:sl_next+SLOTB;}while(0)
  DMA_K(2,2*SLOTB);
  WAIT_BAR(4);
  qkt(pA0,pA1,Kbase,qr,zero16,r32,hi);asm volatile("s_nop 15\n\ts_nop 7":"+v"(pA0),"+v"(pA1));CMASK(pA0,pA1,0);
  START(pA0,pA1);
  _Pragma("unroll") for(int r=0;r<16;++r)pA1[r]=__builtin_amdgcn_exp2f(pA1[r]-mhat);
  WAIT_BAR(0);
  DMA_K(3,0);DMA_V(1,SLOTB);
  ROT();
  kload8(kf,kp0+sl_cur);
  WAIT_BAR(3);
  s16x4 vlo[3],vhi[3]; u32x4 pw0,pw1,pw2,pw3;
  #define PKW(P,B) cvtpk_s(P[B],P[B+1])
  #define PAF(k) __builtin_bit_cast(bf16x8,pw##k)
  #define VFS(s) (bf16x8){vlo[s][0],vlo[s][1],vlo[s][2],vlo[s][3],vhi[s][0],vhi[s][1],vhi[s][2],vhi[s][3]}
  #define PIN(x) asm volatile("":"+v"(x))
  #define MX3(a,b,c) __builtin_fmaxf(__builtin_fmaxf((a),(b)),(c))
  #define GAPA(MF,A0,A1,A2,A3,W0,W1,PW) do{ MF; sacc+=A0; sacc+=A1; sacc+=A2; sacc+=A3; PIN(sacc); W0; W1; PIN(PW); SBAR(); }while(0)
  #define EX(v) __builtin_amdgcn_exp2f(v)
  #define GAPB(MF,X,B) do{ MF; X[B]=EX(X[B]-mhat); X[B+1]=EX(X[B+1]-mhat); PIN(X); SBAR(); }while(0)
  #define VRDG(g) do{ vlo[(g)%3]=vtr(vp_+(((g)&3)*4096+((g)>>2)*1024)); vhi[(g)%3]=vtr(vp_+(((g)&3)*4096+((g)>>2)*1024+512)); SBAR(); }while(0)
  #define QRD(d0) (*(const __attribute__((address_space(3))) bf16x8*)(qp0+(d0)*1024))
  #define KRD(G,j) do{ if(G){ kload2(kf,kp0+sl_next,j); SBAR(); } }while(0)
  #define PVG(g,PF,X,B) GAPB(o[(g)&3]=__builtin_amdgcn_mfma_f32_32x32x16_bf16(PF,VFS((g)%3),o[(g)&3],0,0,0), X,B)
  #define STEP(C0,C1,P0,P1,t,GK,GV,GL) do{ SBAR(); \
    const lds_cptr vp_=vp0+2*sl_prev; \
    bf16x8 qa=QRD(0), qb=QRD(1); SBAR(); float sacc=(P0[0]+P0[1]); \
    GAPA(C0=__builtin_amdgcn_mfma_f32_32x32x16_bf16(kf[0],qa,zero16,0,0,0), P0[2],P0[3],P0[4],P0[5],     pw0[0]=PKW(P0,0), pw0[1]=PKW(P0,2), pw0); \
    GAPA(C1=__builtin_amdgcn_mfma_f32_32x32x16_bf16(kf[1],qa,zero16,0,0,0), P0[6],P0[7],P0[8],P0[9],     pw0[2]=PKW(P0,4), pw0[3]=PKW(P0,6), pw0); \
    qa=QRD(2); SBAR(); \
    GAPA(C0=__builtin_amdgcn_mfma_f32_32x32x16_bf16(kf[2],qb,C0,0,0,0),   P0[10],P0[11],P0[12],P0[13], pw1[0]=PKW(P0,8), pw1[1]=PKW(P0,10), pw1); \
    GAPA(C1=__builtin_amdgcn_mfma_f32_32x32x16_bf16(kf[3],qb,C1,0,0,0),   P0[14],P0[15],P1[0],P1[1],   pw1[2]=PKW(P0,12),pw1[3]=PKW(P0,14), pw1); \
    qb=QRD(3); SBAR(); \
    GAPA(C0=__builtin_amdgcn_mfma_f32_32x32x16_bf16(kf[4],qa,C0,0,0,0),   P1[2],P1[3],P1[4],P1[5],     pw2[0]=PKW(P1,0), pw2[1]=PKW(P1,2), pw2); \
    GAPA(C1=__builtin_amdgcn_mfma_f32_32x32x16_bf16(kf[5],qa,C1,0,0,0),   P1[6],P1[7],P1[8],P1[9],     pw2[2]=PKW(P1,4), pw2[3]=PKW(P1,6), pw2); \
    GAPA(C0=__builtin_amdgcn_mfma_f32_32x32x16_bf16(kf[6],qb,C0,0,0,0),   P1[10],P1[11],P1[12],P1[13], pw3[0]=PKW(P1,8), pw3[1]=PKW(P1,10), pw3); \
    GAPA(C1=__builtin_amdgcn_mfma_f32_32x32x16_bf16(kf[7],qb,C1,0,0,0),   P1[14],P1[15],0.f,0.f,       pw3[2]=PKW(P1,12),pw3[3]=PKW(P1,14), pw3); \
    l_reg+=sacc; \
    if(GK){DMA_K((t)+3,sl_cur);} if(GV){DMA_V((t)+1,sl_next);} \
    VRDG(0); VRDG(1); \
    CMASK(C0,C1,t); \
    { float a=MX3(C0[0],C0[1],C1[0]),b=MX3(C0[2],C0[3],C1[1]); a=MX3(a,C1[2],C1[3]); \
      _Pragma("unroll") for(int r=4;r<16;r+=4){a=MX3(a,C0[r],C0[r+1]);b=MX3(b,C0[r+2],C0[r+3]);a=MX3(a,C1[r],C1[r+1]);b=MX3(b,C1[r+2],C1[r+3]);} \
      float rm=__builtin_fmaxf(a,b); { auto rr=__builtin_amdgcn_permlane32_swap(__float_as_uint(rm),__float_as_uint(rm),false,false); rm=__builtin_fmaxf(__uint_as_float(rr[0]),__uint_as_float(rr[1])); } \
      rm-=mhat; resc=false; \
      if(__builtin_expect(__any(rm>(float)THRL),0)){ const float dl=__builtin_fmaxf(rm,0.f); mhat+=dl; \
        const float f=__builtin_amdgcn_exp2f(-dl); l_reg*=f; if(hi==0)wsf[r32]=f; resc=true; } } \
    SBAR(); \
    PVG(0,PAF(0),C0,0);  VRDG(2); \
    PVG(1,PAF(0),C0,2);  VRDG(3); \
    PVG(2,PAF(0),C0,4);  VRDG(4); \
    PVG(3,PAF(0),C0,6);  VRDG(5); \
    PVG(4,PAF(1),C0,8);  VRDG(6); \
    PVG(5,PAF(1),C0,10); VRDG(7); \
    PVG(6,PAF(1),C0,12); VRDG(8); \
    PVG(7,PAF(1),C0,14); VRDG(9); \
    PVG(8,PAF(2),C1,0);  VRDG(10); \
    PVG(9,PAF(2),C1,2);  VRDG(11); \
    PVG(10,PAF(2),C1,4); VRDG(12); \
    PVG(11,PAF(2),C1,6); VRDG(13); \
    PVG(12,PAF(3),C1,8); VRDG(14); KRD(GL,0); \
    PVG(13,PAF(3),C1,10); VRDG(15); KRD(GL,1); \
    PVG(14,PAF(3),C1,12); KRD(GL,2); \
    PVG(15,PAF(3),C1,14); KRD(GL,3); \
    }while(0)
  int t=1;
  #undef CMASK
  #define CMASK(P0,P1,t) do{}while(0)
  for(;t+5<NT;t+=2){
    STEP(pB0,pB1,pA0,pA1,t,true,true,true);     WAIT_BAR(3); RESC(); ROT();
    STEP(pA0,pA1,pB0,pB1,t+1,true,true,true);   WAIT_BAR(3); RESC(); ROT();
  }
  #undef CMASK
  #define CMASK(P0,P1,t) do{int jb_=(t)-(NT-4); if(jb_>=0)cmask(P0,P1,jb_,qrel,hi);}while(0)
  #define ENDW(tt) do{ if((tt)+3<NT){WAIT_BAR(3);} else if((tt)+2<NT){WAIT_BAR(2);} else {WAIT_BAR(0);} }while(0)
  for(;t+1<NT;t+=2){
    STEP(pB0,pB1,pA0,pA1,t,(t+3<NT),(t+1<NT),(t+1<NT));       ENDW(t);   RESC(); ROT();
    STEP(pA0,pA1,pB0,pB1,t+1,(t+4<NT),(t+2<NT),(t+2<NT));     ENDW(t+1); RESC(); ROT();
  }
  STEP(pB0,pB1,pA0,pA1,NT-1,false,false,false); RESC();
  { float sacc=pB0[0]+pB0[1]; _Pragma("unroll") for(int r=2;r<16;++r)sacc+=pB0[r]; _Pragma("unroll") for(int r=0;r<16;++r)sacc+=pB1[r]; l_reg+=sacc;
    pw0=(u32x4){PKW(pB0,0),PKW(pB0,2),PKW(pB0,4),PKW(pB0,6)};pw1=(u32x4){PKW(pB0,8),PKW(pB0,10),PKW(pB0,12),PKW(pB0,14)};pw2=(u32x4){PKW(pB1,0),PKW(pB1,2),PKW(pB1,4),PKW(pB1,6)};pw3=(u32x4){PKW(pB1,8),PKW(pB1,10),PKW(pB1,12),PKW(pB1,14)};
    SBAR(); pv(o,vb0+2*sl_cur,PAF(0),PAF(1),PAF(2),PAF(3)); }
  #undef PKW
  #undef PAF
  #undef VFS
  #undef VRDG
  #undef QRD
  #undef PVG
  #undef PIN
  #undef MX3
  #undef GAPA
  #undef GAPB
  #undef EX
  #undef KRD
  #undef STEP
  #undef ENDW
  { int lane_e=mk_lane(); asm volatile("":"+v"(lane_e)); const int lane=lane_e,r32=lane&31,hi=lane>>5;
  {auto rr=__builtin_amdgcn_permlane32_swap(__float_as_uint(l_reg),__float_as_uint(l_reg),false,false);l_reg=__uint_as_float(rr[0])+__uint_as_float(rr[1]);}
  if(hi==0)wsf[32+r32]=l_reg;asm volatile("s_waitcnt lgkmcnt(0)":::"memory");
  float rli[16];
  #pragma unroll
  for(int r=0;r<16;++r)rli[r]=__builtin_amdgcn_rcpf(wsf[32+crow(r,hi)]);
  bf16*Ow=O+(rowbase+q0+wid*QBLK)*PO+ooff;
  { bf16*stg=(bf16*)(shm+LDS_OST)+wid*4096;
    #pragma unroll
    for(int r=0;r<16;++r){const int orow=crow(r,hi);
      #pragma unroll
      for(int d0=0;d0<4;++d0)stg[orow*128+d0*32+r32]=__float2bfloat16(o[d0][r]*rli[r]);}
    asm volatile("s_waitcnt lgkmcnt(0)":::"memory");
    if(map==0){
      #pragma unroll
      for(int i=0;i<8;++i){const int row=i*4+(lane>>4),ch=lane&15; const u32x4 v=*(const u32x4*)(stg+row*128+ch*8); ATTN_STORE16(Ow+(long)row*PO+ch*8,v);}
    }else{
      const int ch=lane&15; const float4 g0=*reinterpret_cast<const float4*>(ng+ch*8),g1=*reinterpret_cast<const float4*>(ng+ch*8+4);
      bf16*Aw=AOUT+(rowbase+q0+wid*QBLK)*PA+ooff;
      #pragma unroll
      for(int i=0;i<8;++i){const int row=i*4+(lane>>4); const u32x4 v2=*(const u32x4*)(stg+row*128+ch*8); const u32x4 v1=*(const u32x4*)(Ow+(long)row*PO+ch*8);
        float d[8];
        #define BLO(w) __uint_as_float((w)<<16)
        #define BHI(w) __uint_as_float((w)&0xffff0000u)
        d[0]=BLO(v1[0])-lam*BLO(v2[0]);d[1]=BHI(v1[0])-lam*BHI(v2[0]);d[2]=BLO(v1[1])-lam*BLO(v2[1]);d[3]=BHI(v1[1])-lam*BHI(v2[1]);
        d[4]=BLO(v1[2])-lam*BLO(v2[2]);d[5]=BHI(v1[2])-lam*BHI(v2[2]);d[6]=BLO(v1[3])-lam*BLO(v2[3]);d[7]=BHI(v1[3])-lam*BHI(v2[3]);
        #undef BLO
        #undef BHI
        float ss=0.f;
        #pragma unroll
        for(int q=0;q<8;++q)ss+=d[q]*d[q];
        ss+=__shfl_xor(ss,1);ss+=__shfl_xor(ss,2);ss+=__shfl_xor(ss,4);ss+=__shfl_xor(ss,8);
        const float sc=0.8f/sqrtf(ss*(1.f/128.f)+1e-6f);
        u32x4 w; w[0]=cvtpk_s(d[0]*sc*g0.x,d[1]*sc*g0.y);w[1]=cvtpk_s(d[2]*sc*g0.z,d[3]*sc*g0.w);w[2]=cvtpk_s(d[4]*sc*g1.x,d[5]*sc*g1.y);w[3]=cvtpk_s(d[6]*sc*g1.z,d[7]*sc*g1.w);
        __builtin_nontemporal_store(w,(u32x4*)(Aw+(long)row*PA+ch*8));}
    } }
  }
  asm volatile("s_waitcnt lgkmcnt(0)\n\ts_barrier":::"memory");
  #undef DMA_K
  #undef DMA_V
  #undef CMASK
  #undef START
  #undef RESC
  #undef ROT
}
constexpr int ATTN_LDS_BYTES=LDS_BYTES;
#undef SBAR
#undef WAIT_BAR
}
#define GAS __attribute__((address_space(1)))
#define LAS __attribute__((address_space(3)))
typedef unsigned short bf16;
typedef unsigned v4u __attribute__((ext_vector_type(4)));
typedef float f32x4 __attribute__((ext_vector_type(4)));
typedef short bf16x8 __attribute__((ext_vector_type(8)));
typedef GAS unsigned gu32;
typedef GAS unsigned long long gu64;
#define RLX_AGENT __ATOMIC_RELAXED, __HIP_MEMORY_SCOPE_AGENT
#define LDS_WAIT() asm volatile("s_waitcnt lgkmcnt(0)" ::: "memory")
#define VM_WAIT() asm volatile("s_waitcnt vmcnt(0)" ::: "memory")
__device__ __forceinline__ unsigned long long rt() { return __builtin_amdgcn_s_memrealtime(); }
__device__ __forceinline__ unsigned f2bf(float f) { unsigned u = __builtin_bit_cast(unsigned, f); return (u + 0x7fffu + ((u >> 16) & 1u)) >> 16; }
__device__ __forceinline__ unsigned pk2(float lo, float hi) { return f2bf(lo) | (f2bf(hi) << 16); }

#define XB_TMO      128
#define XB_XCNT(j)  (256  + 64 * (j))
#define XB_XSUB(j)  (1280 + 64 * (j))
#define XB_XGEN(j)  (2304 + 64 * (j))
#define XB_TOP      3328
#define XB_TOPGEN   3392
#define XCD_BAR_WORDS 3456
#define XB_SPIN_CAP (1u << 18)

__device__ __forceinline__ unsigned xb_ld(unsigned* p)              { return __hip_atomic_load(p, __ATOMIC_RELAXED, __HIP_MEMORY_SCOPE_AGENT); }
__device__ __forceinline__ unsigned xb_add(unsigned* p, unsigned v) { return __hip_atomic_fetch_add(p, v, __ATOMIC_RELAXED, __HIP_MEMORY_SCOPE_AGENT); }
__device__ __forceinline__ unsigned xb_xcc_id() { return (unsigned)__builtin_amdgcn_s_getreg((3 << 11) | 20) & 0xFu; }
#define XB_SPIN(cond, bar) do { unsigned _sp = 0; while (cond) { __builtin_amdgcn_s_sleep(1); \
    if ((++_sp & 255u) == 0u) { if (xb_ld(&(bar)[XB_TMO])) break; if (_sp > XB_SPIN_CAP) { atomicAdd(&(bar)[XB_TMO], 1u); break; } } } } while (0)

struct XcdBarrier {
    unsigned* bar; unsigned x; int wave; unsigned G;
    volatile LAS unsigned* st;
};

__device__ __forceinline__ XcdBarrier xcd_barrier_post(unsigned* bar, volatile LAS unsigned* st, int wave, unsigned G) {
    XcdBarrier b; b.bar = bar; b.x = xb_xcc_id(); b.st = st; b.wave = wave; b.G = G;
    if (wave == 0 && mk_lane() == 0) (void)xb_add(&bar[XB_XCNT(b.x)], 1u);
    return b;
}
__device__ __forceinline__ void xcd_barrier_complete(unsigned* bar, unsigned x, unsigned& nloc, unsigned& nx, const unsigned G) {
    unsigned sum, cnt, mine, sp = 0u;
    for (;;) {
        sum = 0u; cnt = 0u; mine = 0u;
#pragma unroll
        for (unsigned j = 0; j < 16; ++j) { const unsigned c = xb_ld(&bar[XB_XCNT(j)]); sum += c; cnt += (c > 0u) ? 1u : 0u; mine = (j == x) ? c : mine; }
        if (sum == G) break;
        __builtin_amdgcn_s_sleep(1);
        if ((++sp & 255u) == 0u) { if (xb_ld(&bar[XB_TMO])) break; if (sp > XB_SPIN_CAP) { atomicAdd(&bar[XB_TMO], 1u); break; } }
    }
    nloc = mine > 0u ? mine : 1u; nx = cnt > 0u ? cnt : 1u;
}

__device__ __forceinline__ void xcd_barrier(const XcdBarrier& b) {
    asm volatile("s_waitcnt vmcnt(0)" ::: "memory");
    __syncthreads();
    if (b.wave == 0 && mk_lane() == 0) {
        unsigned* bar = b.bar;
        __builtin_amdgcn_s_waitcnt(0);
        unsigned nloc = b.st[0], nx = b.st[1];
        if (nloc == 0u) { xcd_barrier_complete(bar, b.x, nloc, nx, b.G); b.st[0] = nloc; b.st[1] = nx; }
        const unsigned old = xb_add(&bar[XB_XSUB(b.x)], 1u);
        const unsigned gen = old / nloc;
        if (old + 1u == (gen + 1u) * nloc) {
            __builtin_amdgcn_fence(__ATOMIC_RELEASE, "agent");
            asm volatile("s_waitcnt vmcnt(0)" ::: "memory");
            const unsigned og = xb_add(&bar[XB_TOP], 1u);
            const unsigned tg = og / nx;
            if (og + 1u == (tg + 1u) * nx) xb_add(&bar[XB_TOPGEN], 1u);
            else XB_SPIN(xb_ld(&bar[XB_TOPGEN]) == tg, bar);
            __builtin_amdgcn_fence(__ATOMIC_ACQUIRE, "agent");
            xb_add(&bar[XB_XGEN(b.x)], 1u);
            asm volatile("s_waitcnt vmcnt(0)" ::: "memory");
        } else {
            XB_SPIN(xb_ld(&bar[XB_XGEN(b.x)]) == gen, bar);
            __builtin_amdgcn_fence(__ATOMIC_ACQUIRE, "agent");
            asm volatile("s_waitcnt vmcnt(0)" ::: "memory");
        }
    }
    __syncthreads();
}
constexpr int NWAVES = 8;
#ifndef MK_N_LAUNCHES
#define MK_N_LAUNCHES 1
#endif
constexpr int NPH = 12;
constexpr int N_LAUNCHES = MK_N_LAUNCHES;
static_assert(N_LAUNCHES == 1 || N_LAUNCHES == NPH, "MK_N_LAUNCHES is 1 or 12");

constexpr int NB = 4, SEQ = 8192, T = NB * SEQ, D = 1024;
constexpr int NE = 32, TOPK = 4, NA = T * TOPK;
constexpr int SG = 32, SL = 32, AROW_P = 640;
constexpr float RMS_EPS = 1e-6f;
constexpr float SW_LIMIT = 7.0f, SW_ALPHA = 1.702f;
constexpr float LAMBDA_INIT = 0.2f;

constexpr size_t MiB = 1u << 20;
constexpr size_t WS_CTL = 0, CTL_ZERO_BYTES = 128 * 1024;
constexpr size_t WS_ROPE = 2 * MiB;
constexpr size_t WS_WIN = 4 * MiB;
constexpr size_t WS_WOUT = 8 * MiB;
constexpr size_t WS_WGLU = 10 * MiB;
constexpr size_t WS_SMALL = 11 * MiB;
constexpr size_t SM_AL = 1024, SM_WR = 32768;
constexpr size_t WS_BTY = 12 * MiB;
constexpr size_t WS_BTX = 32 * MiB;
constexpr size_t WS_WGU = 40 * MiB;
constexpr size_t WS_WD = 168 * MiB;
constexpr size_t WS_XN = 232 * MiB;
constexpr size_t WS_Q = 296 * MiB, WS_K = 328 * MiB, WS_V = 360 * MiB;
constexpr size_t WS_AROW = 392 * MiB;
constexpr size_t WS_XLOC = 432 * MiB;
constexpr size_t WS_O = 464 * MiB;
constexpr size_t WS_MIX = 464 * MiB;
constexpr size_t WS_ACAT = 528 * MiB;
constexpr size_t WS_HB = 528 * MiB;
constexpr size_t WS_YG = 592 * MiB;
constexpr size_t WS_GLU = 624 * MiB;
constexpr size_t WS_LIST = 656 * MiB;
constexpr size_t WS_GATES = 660 * MiB;
constexpr size_t WS_ACT = 296 * MiB;
constexpr size_t WS_YBUF = 664 * MiB;
constexpr size_t WS_END = 920 * MiB;
static_assert(WS_ACT + (size_t)(NA + 8192) * 1024 * 2 <= WS_YG, "Act overlay");
constexpr int CW_TMO = 0, CW_CODE = 1;
constexpr int CW_BAR = 4096;
constexpr int CW_ECNT = 16384;

constexpr int RING_OFF = 0, RING_BYTES = 131072;
constexpr int WRT_BYTES = 1024 * 36 * 4;
constexpr int LDSCTL_OFF = 147456, MISC_OFF = LDSCTL_OFF;
constexpr int MOE_OFF = LDSCTL_OFF + 256;
constexpr int RT_OFF = LDSCTL_OFF + 640;
constexpr int ST_OFF = LDSCTL_OFF + 1024;
constexpr int EPB_OFF = 131072;
constexpr int LDS_BYTES = 157696;
static_assert(ST_OFF + 8192 <= LDS_BYTES, "LDS map");

struct Args { const void* in[29]; float* out; unsigned char* ws; int ph_lo, ph_hi, li, pad; };
struct Frame {
    LAS unsigned char* lds;
    volatile LAS unsigned* MISC;
    gu32* ctl;
    int wave;
    int vcu, G;
};
#define INF(a, k) ((const float*)(a).in[k])
#define FTID(F) ((F).wave * 64 + mk_lane())
#ifndef PROBE_DUP
#define PROBE_DUP -1
#endif
#define NREP(k) ((PROBE_DUP == (k)) ? 2 : 1)

__device__ __forceinline__ unsigned pk_fp8x4_(float a, float b, float c, float d) { int w = 0; w = __builtin_amdgcn_cvt_pk_fp8_f32(a, b, w, false); w = __builtin_amdgcn_cvt_pk_fp8_f32(c, d, w, true); return (unsigned)w; }
__device__ __forceinline__ float wave_sum(float v) {
#pragma unroll
    for (int o = 1; o < 64; o <<= 1) v += __shfl_xor(v, o);
    return v;
}
template <bool FP8> __device__ __forceinline__ void p0_tr64(const float* W, int K, int N, void* WT, LAS float* scr, int item, int lane, float scale) {
    const int nblk = N / 64, kb = item / nblk, nb = item % nblk, k0 = 64 * kb, n0 = 64 * nb;
    f32x4 v[16];
#pragma unroll
    for (int i = 0; i < 16; ++i) v[i] = __builtin_nontemporal_load((const GAS f32x4*)(W + (size_t)(k0 + i * 4 + (lane >> 4)) * N + n0 + 4 * (lane & 15)));
#pragma unroll
    for (int i = 0; i < 16; ++i) *(LAS f32x4*)(scr + (i * 4 + (lane >> 4)) * 68 + 4 * (lane & 15)) = v[i];
    LDS_WAIT(); asm volatile("" ::: "memory");
    if constexpr (FP8) {
#pragma unroll
        for (int c = 0; c < 4; ++c) { const LAS float* s = scr + (16 * c) * 68 + lane; v4u o;
            o.x = pk_fp8x4_(s[0 * 68] * scale, s[1 * 68] * scale, s[2 * 68] * scale, s[3 * 68] * scale); o.y = pk_fp8x4_(s[4 * 68] * scale, s[5 * 68] * scale, s[6 * 68] * scale, s[7 * 68] * scale);
            o.z = pk_fp8x4_(s[8 * 68] * scale, s[9 * 68] * scale, s[10 * 68] * scale, s[11 * 68] * scale); o.w = pk_fp8x4_(s[12 * 68] * scale, s[13 * 68] * scale, s[14 * 68] * scale, s[15 * 68] * scale);
            *(GAS v4u*)((unsigned char*)WT + (size_t)(n0 + lane) * K + k0 + 16 * c) = o; }
    } else {
#pragma unroll
        for (int c = 0; c < 8; ++c) { const LAS float* s = scr + (8 * c) * 68 + lane;
            v4u o; o.x = pk2(s[0 * 68], s[1 * 68]); o.y = pk2(s[2 * 68], s[3 * 68]); o.z = pk2(s[4 * 68], s[5 * 68]); o.w = pk2(s[6 * 68], s[7 * 68]);
            *(GAS v4u*)((bf16*)WT + (size_t)(n0 + lane) * K + k0 + 8 * c) = o; }
    }
    LDS_WAIT(); asm volatile("" ::: "memory");
}
__device__ __forceinline__ void cv_wg_item(Frame& F, const Args& a, const int item, const int lane) {
    const float* W; unsigned char* WT; int N, n0, k0;
    if (item < 512) { const int e = item >> 4, r = item & 15; N = 2048; W = INF(a, 24) + (size_t)e * 1024 * 2048; WT = a.ws + WS_WGU + (size_t)e * 2048 * 1024; n0 = (r >> 3) * 1024; k0 = (r & 7) * 128; }
    else { const int i2 = item - 512, e = i2 >> 3; N = 1024; W = INF(a, 26) + (size_t)e * 1024 * 1024; WT = a.ws + WS_WD + (size_t)e * 1024 * 1024; n0 = 0; k0 = (i2 & 7) * 128; }
    LAS unsigned char* tile = F.lds;
    const float* wp = W + (size_t)(k0 + 16 * F.wave) * N + n0 + 4 * lane;
    f32x4 va[4][4], vb[4][4];
#define CVW_LOAD(v, grp) do { _Pragma("unroll") for (int ch = 0; ch < 4; ++ch) _Pragma("unroll") for (int q = 0; q < 4; ++q) v[ch][q] = __builtin_nontemporal_load((const GAS f32x4*)(wp + (size_t)(4 * (grp) + q) * N + ch * 256)); } while (0)
#define CVW_PUT(v, grp) do { _Pragma("unroll") for (int ch = 0; ch < 4; ++ch) _Pragma("unroll") for (int j = 0; j < 4; ++j) \
        *(LAS unsigned*)(tile + (ch * 256 + 4 * lane + j) * 144 + 16 * F.wave + 4 * (grp)) = pk_fp8x4_(v[ch][0][j] * 32.f, v[ch][1][j] * 32.f, v[ch][2][j] * 32.f, v[ch][3][j] * 32.f); } while (0)
    CVW_LOAD(va, 0); CVW_LOAD(vb, 1); CVW_PUT(va, 0); CVW_LOAD(va, 2); CVW_PUT(vb, 1); CVW_LOAD(vb, 3); CVW_PUT(va, 2); CVW_PUT(vb, 3);
#undef CVW_LOAD
#undef CVW_PUT
    __syncthreads();
#pragma unroll
    for (int i = 0; i < 16; ++i) { const int row = F.wave * 128 + i * 8 + (lane >> 3), c = lane & 7;
        const v4u val = *(const LAS v4u*)(tile + row * 144 + 16 * c);
        __builtin_nontemporal_store(val, (GAS v4u*)(WT + (size_t)(n0 + row) * 1024 + k0 + 16 * c)); }
    __syncthreads();
}
__device__ __forceinline__ void rms_row_to_bf16(int lane, const float* xrow, const float* g, bf16* orow) {
    const GAS f32x4* xr = (const GAS f32x4*)xrow + lane; const GAS f32x4* gr = (const GAS f32x4*)g + lane;
    f32x4 v[4]; float s = 0.f;
#pragma unroll
    for (int j = 0; j < 4; ++j) { v[j] = __builtin_nontemporal_load(xr + 64 * j); s += (v[j].x * v[j].x + v[j].y * v[j].y) + (v[j].z * v[j].z + v[j].w * v[j].w); }
    const float rstd = 1.f / sqrtf(wave_sum(s) * (1.f / D) + RMS_EPS);
    GAS unsigned long long* o8 = (GAS unsigned long long*)orow + lane;
#pragma unroll
    for (int j = 0; j < 4; ++j) { const f32x4 gg = gr[64 * j];
        o8[64 * j] = (unsigned long long)pk2(v[j].x * rstd * gg.x, v[j].y * rstd * gg.y) | ((unsigned long long)pk2(v[j].z * rstd * gg.z, v[j].w * rstd * gg.w) << 32); }
}

__device__ __forceinline__ void s5_setup(Frame& F, const Args& a, int g, int sp) {
    LAS float* L = (LAS float*)F.lds;
    LAS float* APr = L, *APi = L + 2112, *BBr = L + 4224, *BBi = L + 5248, *CCr = L + 6272, *CCi = L + 7296, *KT = L + 8320;
    const int tid = FTID(F);
    const float* dsk = INF(a, 15);
    if (tid < 64) {
        const int n = tid;
        const float dt = expf(INF(a, 16)[g]);
        const float lre = INF(a, 9)[g * 64 + n], lim = INF(a, 10)[g * 64 + n];
        const float mag = expf(lre * dt); float sn, cs; sincosf(lim * dt, &sn, &cs);
        const float ar = mag * cs, ai = mag * sn;
        const float nr = ar - 1.f, ni = ai, den = lre * lre + lim * lim;
        const float cr = (nr * lre + ni * lim) / den, ci = (ni * lre - nr * lim) / den;
        float pr = 1.f, pi = 0.f;
        for (int tau = 0; tau <= 32; ++tau) { APr[tau * 64 + n] = pr; APi[tau * 64 + n] = pi; const float t0 = pr * ar - pi * ai, t1 = pr * ai + pi * ar; pr = t0; pi = t1; }
        const float* bre = INF(a, 11) + (size_t)(g * 64 + n) * 16; const float* bim = INF(a, 12) + (size_t)(g * 64 + n) * 16;
        for (int c = 0; c < 16; ++c) { const float br = bre[c], bi = bim[c]; BBr[n * 16 + c] = cr * br - ci * bi; BBi[n * 16 + c] = cr * bi + ci * br; }
    }
    for (int i = tid; i < 1024; i += 512) { CCr[i] = INF(a, 13)[g * 1024 + i]; CCi[i] = INF(a, 14)[g * 1024 + i]; }
    __syncthreads();
    {
        const int pair = tid & 255, c = pair >> 4, cp = pair & 15, tau0 = (tid >> 8) * 16;
        float zr[64], zi[64];
#pragma unroll
        for (int n = 0; n < 64; ++n) { const float cr_ = CCr[c * 64 + n], ci_ = CCi[c * 64 + n], br = BBr[n * 16 + cp], bi = BBi[n * 16 + cp]; zr[n] = cr_ * br - ci_ * bi; zi[n] = cr_ * bi + ci_ * br; }
        for (int tau = tau0; tau < tau0 + 16; ++tau) {
            const LAS f32x4* pr4 = (const LAS f32x4*)(APr + tau * 64); const LAS f32x4* pi4 = (const LAS f32x4*)(APi + tau * 64);
            float s0 = 0.f, s1 = 0.f;
#pragma unroll
            for (int q = 0; q < 16; ++q) { const f32x4 r4 = pr4[q], i4 = pi4[q];
                s0 += zr[4 * q] * r4[0] - zi[4 * q] * i4[0]; s1 += zr[4 * q + 1] * r4[1] - zi[4 * q + 1] * i4[1];
                s0 += zr[4 * q + 2] * r4[2] - zi[4 * q + 2] * i4[2]; s1 += zr[4 * q + 3] * r4[3] - zi[4 * q + 3] * i4[3]; }
            KT[tau * 256 + pair] = s0 + s1;
        }
    }
    __syncthreads();
    bf16* BtY = (bf16*)(a.ws + WS_BTY); bf16* BtX = (bf16*)(a.ws + WS_BTX);
    if (tid < 480) {
        const int cg = tid % 80, rb = tid / 80;
        GAS v4u* dst = (GAS v4u*)(BtY + ((size_t)(g * 512 + 4 * sp * 16) * 640 + 8 * cg));
        if (cg < 16) {
            const int n0 = (8 * cg) & 63; const bool im = cg >= 8;
            for (int rl = rb; rl < 64; rl += 6) { const int t = 4 * sp + (rl >> 4), c = rl & 15;
                const LAS f32x4* cr4 = (const LAS f32x4*)(CCr + c * 64 + n0); const LAS f32x4* ci4 = (const LAS f32x4*)(CCi + c * 64 + n0);
                const LAS f32x4* ar4 = (const LAS f32x4*)(APr + (t + 1) * 64 + n0); const LAS f32x4* ai4 = (const LAS f32x4*)(APi + (t + 1) * 64 + n0);
                v4u w;
#pragma unroll
                for (int h = 0; h < 2; ++h) { const f32x4 cr = cr4[h], ci = ci4[h], ar = ar4[h], ai = ai4[h];
                    const f32x4 v = im ? -(cr * ai + ci * ar) : (cr * ar - ci * ai);
                    if (h == 0) { w.x = pk2(v[0], v[1]); w.y = pk2(v[2], v[3]); } else { w.z = pk2(v[0], v[1]); w.w = pk2(v[2], v[3]); } }
                dst[(size_t)rl * 80] = w; }
        } else {
            const int col0 = 8 * cg - 128, s_ = col0 >> 4, cp0 = col0 & 15;
            for (int rl = rb; rl < 64; rl += 6) { const int t = 4 * sp + (rl >> 4), c = rl & 15;
                f32x4 v0 = {0.f, 0.f, 0.f, 0.f}, v1 = v0;
                if (s_ <= t) { const LAS f32x4* k4 = (const LAS f32x4*)(KT + (t - s_) * 256 + c * 16 + cp0); v0 = k4[0]; v1 = k4[1];
                    if (s_ == t && (c >> 3) == (cp0 >> 3)) { const float dd = dsk[g * 16 + c]; const int q = c & 7;
                        v0[0] += q == 0 ? dd : 0.f; v0[1] += q == 1 ? dd : 0.f; v0[2] += q == 2 ? dd : 0.f; v0[3] += q == 3 ? dd : 0.f;
                        v1[0] += q == 4 ? dd : 0.f; v1[1] += q == 5 ? dd : 0.f; v1[2] += q == 6 ? dd : 0.f; v1[3] += q == 7 ? dd : 0.f; } }
                v4u w; w.x = pk2(v0[0], v0[1]); w.y = pk2(v0[2], v0[3]); w.z = pk2(v1[0], v1[1]); w.w = pk2(v1[2], v1[3]);
                dst[(size_t)rl * 80] = w; }
        }
    }
    { const int cg = tid & 63, s_ = cg >> 1, cp0 = (cg & 1) * 8, rb = tid >> 6;
      GAS v4u* dst = (GAS v4u*)(BtX + ((size_t)(g * 256 + 32 * sp) * 512 + 8 * cg));
#pragma unroll
      for (int i = 0; i < 4; ++i) { const int r = rb + 8 * i, j = 32 * sp + r; f32x4 v0 = {0.f, 0.f, 0.f, 0.f}, v1 = v0;
          if (j < 128) { const int n = j & 63; const float apr = APr[(31 - s_) * 64 + n], api = APi[(31 - s_) * 64 + n];
              const LAS f32x4* br4 = (const LAS f32x4*)(BBr + n * 16 + cp0); const LAS f32x4* bi4 = (const LAS f32x4*)(BBi + n * 16 + cp0);
              const f32x4 br0 = br4[0], br1 = br4[1], bi0 = bi4[0], bi1 = bi4[1];
              if (j < 64) { v0 = br0 * apr - bi0 * api; v1 = br1 * apr - bi1 * api; } else { v0 = bi0 * apr + br0 * api; v1 = bi1 * apr + br1 * api; } }
          v4u w; w.x = pk2(v0[0], v0[1]); w.y = pk2(v0[2], v0[3]); w.z = pk2(v1[0], v1[1]); w.w = pk2(v1[2], v1[3]);
          dst[(size_t)r * 64] = w; } }
    if (sp == 0 && tid < 64) { float* AL = (float*)(a.ws + WS_SMALL + SM_AL); AL[(g * 64 + tid) * 2] = APr[32 * 64 + tid]; AL[(g * 64 + tid) * 2 + 1] = APi[32 * 64 + tid]; }
    __syncthreads();
}

__device__ __forceinline__ void p0_prologue(Frame& F, const Args& a) {
    for (int rp = 0; rp < NREP(30); ++rp) for (int item = blockIdx.x; item < 256; item += F.G) s5_setup(F, a, item & 31, item >> 5);
    const int gt = blockIdx.x * (NWAVES * 64) + FTID(F), NGT = F.G * NWAVES * 64;
    if (blockIdx.x == 0 && F.wave == 0) {
        const float p1 = wave_sum(INF(a, 4)[mk_lane()] * INF(a, 5)[mk_lane()]), p2 = wave_sum(INF(a, 6)[mk_lane()] * INF(a, 7)[mk_lane()]);
        if (mk_lane() == 0) *(float*)(a.ws + WS_SMALL) = expf(p1) - expf(p2) + LAMBDA_INIT;
    }
    { float* WR = (float*)(a.ws + WS_SMALL + SM_WR);
      for (int i = gt; i < 1024 * 36; i += NGT) { const int k = i / 36, e = i % 36, p = ((k & 3) + 4 * (k >> 8)) * 64 + ((k >> 2) & 63);
          WR[p * 36 + e] = e < 32 ? INF(a, 21)[k] * INF(a, 22)[k * 32 + e] : 0.f; } }
    { float* RP = (float*)(a.ws + WS_ROPE); const int* pos = (const int*)a.in[1];
      for (int i = gt; i < T * 8; i += NGT) { const int m = i >> 3, j = i & 7;
          const float invf = j == 0 ? 1.0f : j == 1 ? 1.9392274e-01f : j == 2 ? 3.7606031e-02f : j == 3 ? 7.2926646e-03f : j == 4 ? 1.4142136e-03f : j == 5 ? 2.7424819e-04f : j == 6 ? 5.3182961e-05f : 1.0313386e-05f;
          const float ang = (float)pos[m] * invf; float sn, cs; sincosf(ang, &sn, &cs); RP[m * 16 + j] = cs; RP[m * 16 + 8 + j] = sn; } }
    LAS float* scr = (LAS float*)(F.lds + RING_OFF + F.wave * 17408);
    const int gw = F.vcu * NWAVES + F.wave, NGW = F.G * NWAVES;
    constexpr int I_IN = 16 * 32, I_OUT = 16 * 16, I_GLU = 8 * 8;
    constexpr int NITEMS = I_IN + I_OUT + I_GLU;
    for (int it = gw; it < NITEMS; it += NGW) {
        int r = it;
        if (r < I_IN) { p0_tr64<false>(INF(a, 3), 1024, 2048, a.ws + WS_WIN, scr, r, mk_lane(), 1.f); continue; } r -= I_IN;
        if (r < I_OUT) { p0_tr64<false>(INF(a, 20), 1024, 1024, a.ws + WS_WOUT, scr, r, mk_lane(), 1.f); continue; } r -= I_OUT;
        p0_tr64<false>(INF(a, 17), 512, 512, a.ws + WS_WGLU, scr, r, mk_lane(), 1.f);
    }
    __syncthreads();
    { int lane = mk_lane(); asm volatile("" : "+v"(lane));
      for (int rp = 0; rp < NREP(31); ++rp) for (int item = F.vcu; item < 768; item += F.G) cv_wg_item(F, a, item, lane); }
    for (int rp = 0; rp < NREP(32); ++rp) for (int m = gw; m < T; m += NGW) rms_row_to_bf16(mk_lane(), INF(a, 0) + (size_t)m * D, INF(a, 2), (bf16*)(a.ws + WS_XN) + (size_t)m * D);
}

struct DenseOrder {
    int nM, nN, nwg, G, c, nt; const char* A; const char* B; size_t strA, strB;
    __device__ __forceinline__ void init(int M, int N, int K, int lda, int ldb, const void* A_, const void* B_, int G_, int c_) {
        nM = M / 256; nN = N / 256; nwg = nM * nN; G = G_; c = c_; nt = K / 64; A = (const char*)A_; B = (const char*)B_; strA = (size_t)256 * lda * 2; strB = (size_t)256 * ldb * 2; }
    __device__ __forceinline__ bool next(int i, pg8::Unit& u) const {
        const long L = (long)i * G + c; if (L >= nwg) return false;
        int wgid = (int)L; { const int q = nwg / 8, r = nwg % 8, xcd = wgid % 8, off = wgid / 8; wgid = (xcd < r ? xcd * (q + 1) : r * (q + 1) + (xcd - r) * q) + off; }
        const int nig = 8 * nN, gid = wgid / nig, fm = gid * 8, gsz = (nM - fm) < 8 ? (nM - fm) : 8;
        u.pm = fm + ((wgid % nig) % gsz); u.pn = (wgid % nig) / gsz; u.a = A + (size_t)u.pm * strA; u.b = B + (size_t)u.pn * strB; u.nt = nt; u.x0 = 0; u.x1 = 0; return true;
    }
};
struct XOrder {
    int G, c; const char* AROW; const char* BTX;
    __device__ __forceinline__ bool next(int i, pg8::Unit& u) const {
        const int L = i * G + c; if (L >= 128) return false;
        const int g = L >> 2, pm = L & 3;
        u.pm = pm; u.pn = 0; u.x0 = g; u.x1 = 0; u.nt = 8;
        u.a = AROW + ((size_t)(g * 1024 + pm * 256) * AROW_P + 128) * 2; u.b = BTX + ((size_t)g * 256 * 512) * 2; return true;
    }
};
struct GluOrder {
    int rank; const char* A; const char* B;
    __device__ __forceinline__ bool next(int i, pg8::Unit& u) const {
        if (i >= 4) return false;
        u.pm = rank * 2 + (i >> 1); u.pn = i & 1; u.x0 = 0; u.x1 = 0; u.nt = 8;
        u.a = A + (size_t)u.pm * 256 * 1024; u.b = B + (size_t)u.pn * 256 * 1024; return true;
    }
};
struct YOrder {
    int G, c; const char* AROW; const char* BTY;
    __device__ __forceinline__ bool next(int i, pg8::Unit& u) const {
        const int L = i * G + c; if (L >= 256) return false;
        const int g = L >> 3, pm = (L >> 1) & 3, pn = L & 1;
        u.pm = pm; u.pn = pn; u.x0 = g; u.x1 = 0; u.nt = (128 + 256 * (pn + 1)) / 64;
        u.a = AROW + ((size_t)(g * 1024 + pm * 256) * AROW_P) * 2; u.b = BTY + ((size_t)(g * 512 + pn * 256) * AROW_P) * 2; return true;
    }
};
template <int RG  , int NC  >
struct MoeOrder {
    int G, c; const LAS int* tpre; const LAS int* cntE; const char* A; const char* B; size_t strBe;
    bool gatherA; int ntk;
    __device__ __forceinline__ bool next(int i, pg8::Unit& u) const {
        const int L = i * G + c, grp = L >> 5, w = L & 31, tt = grp * RG + (w % RG), pn = w / RG;
        const int NT = __builtin_amdgcn_readfirstlane(tpre[32]);
        if (tt >= NT) return false;
        const int e = __builtin_popcount((unsigned)__ballot(tpre[(mk_lane() & 31) + 1] <= tt));
        const int cnt = __builtin_amdgcn_readfirstlane(cntE[e]), t0 = __builtin_amdgcn_readfirstlane(tpre[e]);
        u.pm = tt; u.pn = pn; u.x0 = (tt - t0) * 256; u.x1 = e | (cnt << 8); u.nt = ntk;
        u.a = gatherA ? A : A + (size_t)tt * 256 * 1024; u.b = B + (size_t)e * strBe + (size_t)pn * 256 * 1024; return true;
    }
};
struct AGather {
    static constexpr bool PER_UNIT = true;
    const int* list;
    __device__ __forceinline__ void get(const pg8::Unit& u, unsigned (&v)[2][2], const int (&R)[2], const int (&C)[2]) const {
        const int e = u.x1 & 255, cnt = u.x1 >> 8;
#pragma unroll
        for (int h = 0; h < 2; ++h)
#pragma unroll
            for (int i = 0; i < 2; ++i) { const int slot = u.x0 + h * 128 + R[i]; const int sc = slot < cnt ? slot : 0;
                const int tok = list[(size_t)e * T + sc] >> 2; v[h][i] = (unsigned)(tok * 1024 + C[i] * 2); }
    }
    __device__ __forceinline__ size_t hstep() const { return 0; }
    __device__ __forceinline__ void issue_dma(const pg8::Unit& u, const int (&R)[2], const unsigned lds_dst) const {
        const int e = u.x1 & 255, cnt = u.x1 >> 8; const int* base = list + (size_t)e * T;
#pragma unroll
        for (int h = 0; h < 2; ++h)
#pragma unroll
            for (int i = 0; i < 2; ++i) { const int slot = u.x0 + h * 128 + R[i]; const unsigned so = (unsigned)(slot < cnt ? slot : 0) * 4u;
                pg8::glds4_sv(base, so, lds_dst + (unsigned)(2 * h + i) * 256u); }
    }
    __device__ __forceinline__ void finish(const int (&raw)[4], unsigned (&v)[2][2], const int (&C)[2]) const {
#pragma unroll
        for (int h = 0; h < 2; ++h)
#pragma unroll
            for (int i = 0; i < 2; ++i) v[h][i] = (unsigned)((raw[h * 2 + i] >> 2) * 1024 + C[i] * 2);
    }
};

using pg8::f32x2; using pg8::u32x4; using pg8::u32x2; using pg8::cvt_pk_bf16; using pg8::gelu_pk;
#define EPI_ARGS const f32x4 (&acc)[2][2][4][2], const pg8::Unit& u, int wr, int wc, int fr, int fq
__device__ __forceinline__ u32x4 pack8(const f32x4 v0, const f32x4 v1) { u32x4 w; w.x = cvt_pk_bf16(v0[0], v0[1]); w.y = cvt_pk_bf16(v0[2], v0[3]); w.z = cvt_pk_bf16(v1[0], v1[1]); w.w = cvt_pk_bf16(v1[2], v1[3]); return w; }
__device__ __forceinline__ float bf_lo(unsigned w) { return __uint_as_float(w << 16); }
__device__ __forceinline__ float bf_hi(unsigned w) { return __uint_as_float(w & 0xffff0000u); }

struct EpiInProj {
    static constexpr int BMODE = 1; static constexpr bool PREFETCH = false; static constexpr int NSTORE = 0, NPRE = 0;
    bf16 *Q, *K, *V, *AROW; const float* rope; float c2;
    __device__ __forceinline__ void operator()(EPI_ARGS) const {
        const int region = u.pn >> 1; const int colr = (u.pn & 1) * 256 + wc * 32 + 8 * fq;
        const bool dorope = (region <= 1) && ((wc & 1) == 0);
        const float sg = fq == 0 ? -1.f : 1.f; const bool rot = fq < 2;
#pragma unroll
        for (int ai = 0; ai < 2; ++ai) {
            f32x4 rp[4][4];
            if (dorope) {
#pragma unroll
                for (int m = 0; m < 4; ++m) { const f32x4* rr = (const f32x4*)(rope + (size_t)(u.pm * 256 + ai * 128 + wr * 64 + m * 16 + fr) * 16);
#pragma unroll
                    for (int q = 0; q < 4; ++q) rp[m][q] = rr[q]; }
            }
#pragma unroll
            for (int m = 0; m < 4; ++m) {
                const int row = u.pm * 256 + ai * 128 + wr * 64 + m * 16 + fr;
                f32x4 cs0 = {1.f, 1.f, 1.f, 1.f}, cs1 = cs0, sn0 = {0.f, 0.f, 0.f, 0.f}, sn1 = sn0;
                if (dorope) { cs0 = rot ? rp[m][0] : cs0; cs1 = rot ? rp[m][1] : cs1; sn0 = rot ? rp[m][2] * sg : sn0; sn1 = rot ? rp[m][3] * sg : sn1; }
#pragma unroll
                for (int bj = 0; bj < 2; ++bj) {
                    f32x4 v0 = acc[ai][bj][m][0], v1 = acc[ai][bj][m][1]; const int c = colr + bj * 128;
                    if (region <= 1) {
                        if (dorope) { f32x4 p0, p1;
#pragma unroll
                            for (int q = 0; q < 4; ++q) { p0[q] = __shfl_xor(v0[q], 16); p1[q] = __shfl_xor(v1[q], 16); }
                            v0 = v0 * cs0 + p0 * sn0; v1 = v1 * cs1 + p1 * sn1; }
                        if (region == 0) { v0 = v0 * c2; v1 = v1 * c2; }
                        *(u32x4*)((region == 0 ? Q : K) + (size_t)row * 512 + c) = pack8(v0, v1);
                    } else if (region == 2) {
                        *(u32x4*)(V + (size_t)row * 512 + c) = pack8(v0, v1);
                    } else {
                        const int g = c >> 4, cc = c & 15;
                        *(u32x4*)(AROW + ((size_t)(g * 1024 + (row >> 5)) * AROW_P + 128 + (row & 31) * 16 + cc)) = pack8(v0, v1);
                    }
                }
            }
        }
    }
};
struct EpiX {
    static constexpr int BMODE = 0; static constexpr bool PREFETCH = false; static constexpr int NSTORE = 0, NPRE = 0;
    float* X;
    __device__ __forceinline__ void operator()(EPI_ARGS) const {
        float* base = X + ((size_t)(u.x1 * 32 + u.x0) * 1024 + u.pm * 256) * 128;
#pragma unroll
        for (int ai = 0; ai < 2; ++ai)
#pragma unroll
            for (int m = 0; m < 4; ++m) { const int row = ai * 128 + wr * 64 + m * 16 + fr;
#pragma unroll
                for (int n = 0; n < 2; ++n) *(f32x4*)(base + (size_t)row * 128 + wc * 32 + 16 * n + 4 * fq) = acc[ai][0][m][n]; }
    }
};
struct EpiY {
    static constexpr int BMODE = 1; static constexpr bool PREFETCH = false; static constexpr int NSTORE = 0, NPRE = 0;
    bf16* YG;
    __device__ __forceinline__ void operator()(EPI_ARGS) const {
        const int g = u.x0;
#pragma unroll
        for (int ai = 0; ai < 2; ++ai)
#pragma unroll
            for (int m = 0; m < 4; ++m) { const int jj = u.pm * 256 + ai * 128 + wr * 64 + m * 16 + fr;
#pragma unroll
                for (int bj = 0; bj < 2; ++bj) { const int n0 = u.pn * 256 + bj * 128 + wc * 32 + 8 * fq, t = n0 >> 4, cc = n0 & 15;
                    const f32x4 v0 = acc[ai][bj][m][0], v1 = acc[ai][bj][m][1];
                    const f32x2 a = gelu_pk((f32x2){v0[0], v0[1]}), b = gelu_pk((f32x2){v0[2], v0[3]}), c = gelu_pk((f32x2){v1[0], v1[1]}), d = gelu_pk((f32x2){v1[2], v1[3]});
                    u32x4 w; w.x = cvt_pk_bf16(a.x, a.y); w.y = cvt_pk_bf16(b.x, b.y); w.z = cvt_pk_bf16(c.x, c.y); w.w = cvt_pk_bf16(d.x, d.y);
                    *(u32x4*)(YG + (size_t)(jj * 32 + t) * 512 + g * 16 + cc) = w; } }
    }
};
__device__ __forceinline__ float sigmoidf_(float z) { return __builtin_amdgcn_rcpf(1.f + __builtin_amdgcn_exp2f(-1.4426950408889634f * z)); }
struct EpiGlu {
    static constexpr int BMODE = 1; static constexpr bool PREFETCH = false; static constexpr int NSTORE = 0, NPRE = 0;
    const bf16* YG; bf16* GLU; const float* bias;
    __device__ __forceinline__ void operator()(EPI_ARGS) const {
        const int c00 = u.pn * 256 + wc * 32 + 8 * fq;
        f32x4 bv[2][2];
#pragma unroll
        for (int bj = 0; bj < 2; ++bj) { bv[bj][0] = *(const f32x4*)(bias + c00 + bj * 128); bv[bj][1] = *(const f32x4*)(bias + c00 + bj * 128 + 4); }
#pragma unroll
        for (int ai = 0; ai < 2; ++ai)
#pragma unroll
            for (int m = 0; m < 4; ++m) { const int row = u.pm * 256 + ai * 128 + wr * 64 + m * 16 + fr;
#pragma unroll
                for (int bj = 0; bj < 2; ++bj) { const int c = c00 + bj * 128;
                    const f32x4 z0 = acc[ai][bj][m][0] + bv[bj][0], z1 = acc[ai][bj][m][1] + bv[bj][1];
                    const u32x4 y = *(const u32x4*)(YG + (size_t)row * 512 + c);
                    f32x4 o0, o1;
                    o0[0] = bf_lo(y.x) * sigmoidf_(z0[0]); o0[1] = bf_hi(y.x) * sigmoidf_(z0[1]); o0[2] = bf_lo(y.y) * sigmoidf_(z0[2]); o0[3] = bf_hi(y.y) * sigmoidf_(z0[3]);
                    o1[0] = bf_lo(y.z) * sigmoidf_(z1[0]); o1[1] = bf_hi(y.z) * sigmoidf_(z1[1]); o1[2] = bf_lo(y.w) * sigmoidf_(z1[2]); o1[3] = bf_hi(y.w) * sigmoidf_(z1[3]);
                    *(u32x4*)(GLU + (size_t)row * 512 + c) = pack8(o0, o1); } }
    }
};
struct EpiMix {
    static constexpr int BMODE = 1; static constexpr bool PREFETCH = false; static constexpr int NSTORE = 0, NPRE = 0;
    bf16* MIX;
    __device__ __forceinline__ void operator()(EPI_ARGS) const {
#pragma unroll
        for (int ai = 0; ai < 2; ++ai)
#pragma unroll
            for (int m = 0; m < 4; ++m) { bf16* rowp = MIX + (size_t)(u.pm * 256 + ai * 128 + wr * 64 + m * 16 + fr) * 1024 + u.pn * 256 + wc * 32 + 8 * fq;
#pragma unroll
                for (int bj = 0; bj < 2; ++bj) *(u32x4*)(rowp + bj * 128) = pack8(acc[ai][bj][m][0], acc[ai][bj][m][1]); }
    }
};
__device__ __forceinline__ float swiglu_(float g, float up) {
    const float gc = fminf(g, SW_LIMIT), uc = __builtin_amdgcn_fmed3f(up, -SW_LIMIT, SW_LIMIT);
    const float t = gc * __builtin_amdgcn_rcpf(1.f + __builtin_amdgcn_exp2f(gc * (-SW_ALPHA * 1.4426950408889634f))); return fmaf(t, uc, t); }
__device__ __forceinline__ unsigned pk_fp8x4(float a, float b, float c, float d) { int w = 0; w = __builtin_amdgcn_cvt_pk_fp8_f32(a, b, w, false); w = __builtin_amdgcn_cvt_pk_fp8_f32(c, d, w, true); return (unsigned)w; }
constexpr float W8_SCALE = 32.f, W8_INV = 1.f / 32.f;
constexpr float YB_SCALE = 8.f, YB_INV = 1.f / 8.f;
__device__ __forceinline__ f32x2 swiglu2_(const f32x2 ga, const f32x2 ua, const f32x2 bg, const f32x2 bu) {
    const f32x2 inv = {W8_INV, W8_INV};
    const f32x2 G = __builtin_elementwise_fma(ga, inv, bg), U = __builtin_elementwise_fma(ua, inv, bu);
    f32x2 gc, uc; gc.x = fminf(G.x, SW_LIMIT); gc.y = fminf(G.y, SW_LIMIT); uc.x = __builtin_amdgcn_fmed3f(U.x, -SW_LIMIT, SW_LIMIT); uc.y = __builtin_amdgcn_fmed3f(U.y, -SW_LIMIT, SW_LIMIT);
    const f32x2 xs = gc * (-SW_ALPHA * 1.4426950408889634f);
    f32x2 ex; ex.x = __builtin_amdgcn_exp2f(xs.x); ex.y = __builtin_amdgcn_exp2f(xs.y);
    const f32x2 dn = ex + 1.0f;
    f32x2 rc; rc.x = __builtin_amdgcn_rcpf(dn.x); rc.y = __builtin_amdgcn_rcpf(dn.y);
    const f32x2 t = gc * rc;
    return __builtin_elementwise_fma(t, uc, t);
}
struct EpiGU {
    static constexpr int BMODE = 2; static constexpr bool PREFETCH = true; static constexpr int NSTORE = 4, NPRE = 1;
    unsigned char* ACT; const float* bias; LAS unsigned char* xb;
    __device__ __forceinline__ void prefetch(const pg8::Unit& u, const int wid, const int wr, const int lane) const {
        const int e = u.x1 & 255;
        const unsigned bdst = (unsigned)__builtin_amdgcn_readfirstlane((int)((unsigned)(uintptr_t)xb + (unsigned)wid * 256u));
        pg8::glds4_sv(bias + e * 2048 + 2 * (u.pn * 128 + (wid & 3) * 32), (unsigned)lane * 4u, bdst);
    }
    __device__ __forceinline__ void operator()(EPI_ARGS) const {
        const int e = u.x1 & 255, j0 = u.pn * 128 + wc * 32 + 8 * fq;
        const LAS f32x4* bp = (const LAS f32x4*)(xb + (wr * 4 + wc) * 256) + 4 * fq;
        f32x2 bg[4], bu[4];
#pragma unroll
        for (int i = 0; i < 4; ++i) { const f32x4 b = bp[i]; bg[i] = (f32x2){b[0], b[2]}; bu[i] = (f32x2){b[1], b[3]}; }
        const int jst = u.pn * 128 + wc * 32 + 8 * (fq & ~1);
#pragma unroll
        for (int ai = 0; ai < 2; ++ai)
#pragma unroll
            for (int mp = 0; mp < 2; ++mp) { u32x2 w[2];
#pragma unroll
                for (int k = 0; k < 2; ++k) { const int m = mp * 2 + k;
                    const f32x4 g0 = acc[ai][0][m][0], g1 = acc[ai][0][m][1], u0 = acc[ai][1][m][0], u1 = acc[ai][1][m][1];
                    const f32x2 o0 = swiglu2_((f32x2){g0[0], g0[1]}, (f32x2){u0[0], u0[1]}, bg[0], bu[0]), o1 = swiglu2_((f32x2){g0[2], g0[3]}, (f32x2){u0[2], u0[3]}, bg[1], bu[1]);
                    const f32x2 o2 = swiglu2_((f32x2){g1[0], g1[1]}, (f32x2){u1[0], u1[1]}, bg[2], bu[2]), o3 = swiglu2_((f32x2){g1[2], g1[3]}, (f32x2){u1[2], u1[3]}, bg[3], bu[3]);
                    w[k].x = pk_fp8x4(o0.x, o0.y, o1.x, o1.y); w[k].y = pk_fp8x4(o2.x, o2.y, o3.x, o3.y); }
                const auto rx = __builtin_amdgcn_permlane16_swap(w[0].x, w[1].x, false, false), ry = __builtin_amdgcn_permlane16_swap(w[0].y, w[1].y, false, false);
                const size_t row = (size_t)u.pm * 256 + ai * 128 + wr * 64 + (mp * 2 + (fq & 1)) * 16 + fr;
                u32x4 o; o.x = rx[0]; o.y = ry[0]; o.z = rx[1]; o.w = ry[1];
                *(u32x4*)(ACT + row * 1024 + jst) = o; }
    }
};
template <int MODE> struct EpiDownT {
    static constexpr int BMODE = 3; static constexpr bool PREFETCH = true; static constexpr int NSTORE = 0, NPRE = 0;
    unsigned char* YB; const float* bias; const int* list; const float* gates; int sel; LAS unsigned char* xl; LAS unsigned char* xb;
    __device__ __forceinline__ void prefetch(const pg8::Unit& u, const int wid, const int wr, const int lane) const {
        const int e = u.x1 & 255, cnt = u.x1 >> 8;
        const unsigned dst = (unsigned)__builtin_amdgcn_readfirstlane((int)((unsigned)(uintptr_t)xl + (unsigned)wid * 1024u));
#pragma unroll
        for (int k = 0; k < 2; ++k) { const int slot = u.x0 + k * 128 + wr * 64 + lane; const unsigned so = (unsigned)(slot < cnt ? slot : 0) * 4u;
            pg8::glds4_sv(list + (size_t)e * T, so, dst + (unsigned)k * 256u); pg8::glds4_sv(gates + (size_t)e * T, so, dst + 512u + (unsigned)k * 256u); }
        const unsigned bdst = (unsigned)__builtin_amdgcn_readfirstlane((int)((unsigned)(uintptr_t)xb + (unsigned)wid * 256u));
        pg8::glds4_sv(bias + e * 1024 + u.pn * 256 + (wid & 3) * 64, (unsigned)lane * 4u, bdst);
    }
    __device__ __forceinline__ void operator()(EPI_ARGS) const {
        const int e = u.x1 & 255, cnt = u.x1 >> 8, c0 = u.pn * 256 + wc * 64 + 16 * fq;
        f32x4 bv[2][2];
        { const LAS f32x4* bl = (const LAS f32x4*)(xb + (wr * 4 + wc) * 256) + 4 * fq; bv[0][0] = bl[0]; bv[0][1] = bl[1]; bv[1][0] = bl[2]; bv[1][1] = bl[3]; }
        int aidv[8]; float gtv[8];
        { const LAS int* xi = (const LAS int*)(xl + (wr * 4 + wc) * 1024) + fr; const LAS float* xg = (const LAS float*)xi + 128;
#pragma unroll
          for (int q = 0; q < 8; ++q) { aidv[q] = xi[(q >> 2) * 64 + (q & 3) * 16]; gtv[q] = xg[(q >> 2) * 64 + (q & 3) * 16] * YB_SCALE; } }
#pragma unroll
        for (int ai = 0; ai < 2; ++ai)
#pragma unroll
            for (int m = 0; m < 4; ++m) { const int slot = u.x0 + ai * 128 + wr * 64 + m * 16 + fr; const int aid = aidv[ai * 4 + m]; const float gt = gtv[ai * 4 + m];
                if (slot < cnt) {
                    const f32x4 z0 = (acc[ai][0][m][0] * W8_INV + bv[0][0]) * gt, z1 = (acc[ai][0][m][1] * W8_INV + bv[0][1]) * gt;
                    const f32x4 z2 = (acc[ai][1][m][0] * W8_INV + bv[1][0]) * gt, z3 = (acc[ai][1][m][1] * W8_INV + bv[1][1]) * gt;
                    u32x4 w8; w8.x = pk_fp8x4(z0[0], z0[1], z0[2], z0[3]); w8.y = pk_fp8x4(z1[0], z1[1], z1[2], z1[3]); w8.z = pk_fp8x4(z2[0], z2[1], z2[2], z2[3]); w8.w = pk_fp8x4(z3[0], z3[1], z3[2], z3[3]);
                    if constexpr (MODE == 1) { asm volatile("" :: "v"(w8)); } else { *(u32x4*)(YB + (size_t)aid * 1024 + c0) = w8; } } }
    }
};
typedef EpiDownT<0> EpiDown;

struct EpiNull {
    static constexpr int BMODE = 1; static constexpr bool PREFETCH = false; static constexpr int NSTORE = 0, NPRE = 0;
    __device__ __forceinline__ void operator()(EPI_ARGS) const {
#pragma unroll
        for (int ai = 0; ai < 2; ++ai)
#pragma unroll
            for (int bj = 0; bj < 2; ++bj)
#pragma unroll
                for (int m = 0; m < 4; ++m)
#pragma unroll
                    for (int n = 0; n < 2; ++n) asm volatile("" :: "v"(acc[ai][bj][m][n]));
    }
};
__device__ __forceinline__ void s5_scan(const Args& a, const int task, const int lane) {
    const int gw = task;
    {
        const int g = gw >> 2, b = gw & 3, n = lane;
        const float* AL = (const float*)(a.ws + WS_SMALL + SM_AL); const float ar = AL[(g * 64 + n) * 2], ai = AL[(g * 64 + n) * 2 + 1];
        const float* X0 = (const float*)(a.ws + WS_XLOC) + ((size_t)(0 * 32 + g) * 1024 + b * 256) * 128;
        const float* X1 = (const float*)(a.ws + WS_XLOC) + ((size_t)(1 * 32 + g) * 1024 + b * 256) * 128;
        bf16* AR = (bf16*)(a.ws + WS_AROW) + (size_t)(g * 1024 + b * 256) * AROW_P;
        float xr = 0.f, xi = 0.f;
        for (int j0 = 0; j0 < 256; j0 += 16) {
            float lr[16], li[16];
#pragma unroll
            for (int q = 0; q < 16; ++q) { const size_t o = (size_t)(j0 + q) * 128 + n; lr[q] = X0[o]; li[q] = X0[o + 64]; }
#pragma unroll
            for (int q = 0; q < 16; ++q) { bf16* row = AR + (size_t)(j0 + q) * AROW_P; row[n] = (bf16)f2bf(xr); row[64 + n] = (bf16)f2bf(xi);
                const float nr = ar * xr - ai * xi + lr[q], ni = ar * xi + ai * xr + li[q]; xr = nr; xi = ni; }
        }
    }
}
__device__ __forceinline__ void p3_post_scan(Frame& F, const Args& a) {
    int lane = mk_lane(); asm volatile("" : "+v"(lane));
    const int gw = F.vcu * NWAVES + F.wave, NGW = F.G * NWAVES;
    const float lam = *(const float*)(a.ws + WS_SMALL);
    const bf16* O = (const bf16*)(a.ws + WS_O); bf16* AC = (bf16*)(a.ws + WS_ACAT); const float* ng = INF(a, 8);
    const int h = lane >> 4, d0 = (lane & 15) * 8;
    const f32x4 g0 = *(const f32x4*)(ng + d0), g1 = *(const f32x4*)(ng + d0 + 4);
    for (int m = gw; m < T; m += NGW) {
        const bf16* orow = O + (size_t)m * 1024;
        const v4u p1 = *(const GAS v4u*)(orow + (h * 2 + 0) * 128 + d0), p2 = *(const GAS v4u*)(orow + (h * 2 + 1) * 128 + d0);
        float o[8];
        o[0] = bf_lo(p1.x) - lam * bf_lo(p2.x); o[1] = bf_hi(p1.x) - lam * bf_hi(p2.x); o[2] = bf_lo(p1.y) - lam * bf_lo(p2.y); o[3] = bf_hi(p1.y) - lam * bf_hi(p2.y);
        o[4] = bf_lo(p1.z) - lam * bf_lo(p2.z); o[5] = bf_hi(p1.z) - lam * bf_hi(p2.z); o[6] = bf_lo(p1.w) - lam * bf_lo(p2.w); o[7] = bf_hi(p1.w) - lam * bf_hi(p2.w);
        float s = 0.f;
#pragma unroll
        for (int q = 0; q < 8; ++q) s += o[q] * o[q];
        s += __shfl_xor(s, 1); s += __shfl_xor(s, 2); s += __shfl_xor(s, 4); s += __shfl_xor(s, 8);
        const float sc = (1.f - LAMBDA_INIT) / sqrtf(s * (1.f / 128.f) + RMS_EPS);
        v4u w; w.x = pk2(o[0] * sc * g0[0], o[1] * sc * g0[1]); w.y = pk2(o[2] * sc * g0[2], o[3] * sc * g0[3]); w.z = pk2(o[4] * sc * g1[0], o[5] * sc * g1[1]); w.w = pk2(o[6] * sc * g1[2], o[7] * sc * g1[3]);
        *(GAS v4u*)(AC + (size_t)m * 1024 + h * 128 + d0) = w;
    }
}
__device__ __forceinline__ void pn_glunorm(Frame& F, const Args& a) {
    int lane = mk_lane(); asm volatile("" : "+v"(lane));
    const int gw = F.vcu * NWAVES + F.wave, NGW = F.G * NWAVES;
    const bf16* GL = (const bf16*)(a.ws + WS_GLU); bf16* AC = (bf16*)(a.ws + WS_ACAT); const float* ng = INF(a, 19);
    const f32x4 g0 = *(const f32x4*)(ng + lane * 8), g1 = *(const f32x4*)(ng + lane * 8 + 4);
    for (int m = gw; m < T; m += NGW) {
        const v4u p = *(const GAS v4u*)(GL + (size_t)m * 512 + lane * 8);
        float o[8] = {bf_lo(p.x), bf_hi(p.x), bf_lo(p.y), bf_hi(p.y), bf_lo(p.z), bf_hi(p.z), bf_lo(p.w), bf_hi(p.w)};
        float s = 0.f;
#pragma unroll
        for (int q = 0; q < 8; ++q) s += o[q] * o[q];
        const float sc = 1.f / sqrtf(wave_sum(s) * (1.f / 512.f) + RMS_EPS);
        v4u w; w.x = pk2(o[0] * sc * g0[0], o[1] * sc * g0[1]); w.y = pk2(o[2] * sc * g0[2], o[3] * sc * g0[3]); w.z = pk2(o[4] * sc * g1[0], o[5] * sc * g1[1]); w.w = pk2(o[6] * sc * g1[2], o[7] * sc * g1[3]);
        *(GAS v4u*)(AC + (size_t)m * 1024 + 512 + lane * 8) = w;
    }
}
constexpr int NS5 = 64, CW_BAR2 = 8192;
__device__ __forceinline__ void glunorm_sub(Frame& F, const Args& a, const int rank) {
    int lane = mk_lane(); asm volatile("" : "+v"(lane));
    const bf16* GL = (const bf16*)(a.ws + WS_GLU); bf16* AC = (bf16*)(a.ws + WS_ACAT); const float* ng = INF(a, 19);
    const f32x4 g0 = *(const f32x4*)(ng + lane * 8), g1 = *(const f32x4*)(ng + lane * 8 + 4);
    const int r0 = rank * 512 + F.wave * 64;
#pragma unroll 1
    for (int m0 = r0; m0 < r0 + 64; m0 += 8) {
        v4u p[8];
#pragma unroll
        for (int q = 0; q < 8; ++q) p[q] = *(const GAS v4u*)(GL + (size_t)(m0 + q) * 512 + lane * 8);
#pragma unroll
        for (int q = 0; q < 8; ++q) {
            float o[8] = {bf_lo(p[q].x), bf_hi(p[q].x), bf_lo(p[q].y), bf_hi(p[q].y), bf_lo(p[q].z), bf_hi(p[q].z), bf_lo(p[q].w), bf_hi(p[q].w)};
            float s = 0.f;
#pragma unroll
            for (int k = 0; k < 8; ++k) s += o[k] * o[k];
            const float sc = 1.f / sqrtf(wave_sum(s) * (1.f / 512.f) + RMS_EPS);
            v4u w; w.x = pk2(o[0] * sc * g0[0], o[1] * sc * g0[1]); w.y = pk2(o[2] * sc * g0[2], o[3] * sc * g0[3]); w.z = pk2(o[4] * sc * g1[0], o[5] * sc * g1[1]); w.w = pk2(o[6] * sc * g1[2], o[7] * sc * g1[3]);
            *(GAS v4u*)(AC + (size_t)(m0 + q) * 1024 + 512 + lane * 8) = w;
        }
    }
}
__device__ const unsigned char ATT_DEAL[32][8] = {
  {48, 255, 255, 255, 255, 255, 255, 255},
  {27, 36, 35, 255, 255, 255, 255, 255},
  {59, 4, 3, 255, 255, 255, 255, 255},
  {62, 37, 34, 255, 255, 255, 255, 255},
  {16, 255, 255, 255, 255, 255, 255, 255},
  {30, 5, 2, 255, 255, 255, 255, 255},
  {61, 38, 33, 255, 255, 255, 255, 255},
  {29, 6, 1, 255, 255, 255, 255, 255},
  {47, 255, 255, 255, 255, 255, 255, 255},
  {60, 40, 32, 255, 255, 255, 255, 255},
  {28, 8, 0, 255, 255, 255, 255, 255},
  {31, 39, 255, 255, 255, 255, 255, 255},
  {15, 255, 255, 255, 255, 255, 255, 255},
  {63, 7, 255, 255, 255, 255, 255, 255},
  {58, 41, 255, 255, 255, 255, 255, 255},
  {26, 9, 255, 255, 255, 255, 255, 255},
  {46, 255, 255, 255, 255, 255, 255, 255},
  {57, 42, 255, 255, 255, 255, 255, 255},
  {25, 10, 255, 255, 255, 255, 255, 255},
  {56, 43, 255, 255, 255, 255, 255, 255},
  {14, 255, 255, 255, 255, 255, 255, 255},
  {24, 11, 255, 255, 255, 255, 255, 255},
  {55, 44, 255, 255, 255, 255, 255, 255},
  {23, 12, 255, 255, 255, 255, 255, 255},
  {45, 255, 255, 255, 255, 255, 255, 255},
  {54, 49, 255, 255, 255, 255, 255, 255},
  {22, 17, 255, 255, 255, 255, 255, 255},
  {53, 50, 255, 255, 255, 255, 255, 255},
  {13, 255, 255, 255, 255, 255, 255, 255},
  {21, 18, 255, 255, 255, 255, 255, 255},
  {52, 51, 255, 255, 255, 255, 255, 255},
  {20, 19, 255, 255, 255, 255, 255, 255}
};
__device__ __forceinline__ void pr_router(Frame& F, const Args& a) {
    LAS float* WP = (LAS float*)F.lds;
    { const GAS f32x4* src = (const GAS f32x4*)(a.ws + WS_SMALL + SM_WR); for (int i = FTID(F); i < 1024 * 36 / 4; i += NWAVES * 64) ((LAS f32x4*)WP)[i] = src[i]; }
    LAS int* cntL = (LAS int*)(F.lds + RT_OFF); LAS int* baseL = cntL + 32;
    LAS int* stA = (LAS int*)(F.lds + ST_OFF); LAS int* stE = stA + 512; LAS float* stG = (LAS float*)(stE + 512);
    if (FTID(F) < 32) cntL[FTID(F)] = 0;
    __syncthreads();
    int lane = mk_lane(); asm volatile("" : "+v"(lane));
    const int gw = F.vcu * NWAVES + F.wave;
    const float* X = INF(a, 0); const bf16* MIX = (const bf16*)(a.ws + WS_MIX); unsigned char* XN8 = (unsigned char*)(a.ws + WS_XN); const float* gf = INF(a, 21);
    const int e_me = lane >> 1; const float brt = INF(a, 23)[e_me];
    for (int rp = 0; rp < NREP(8); ++rp) { if (rp) { __syncthreads(); if (FTID(F) < 32) cntL[FTID(F)] = 0; __syncthreads(); }
    f32x4 xnx[4]; unsigned long long mnx[4];
    { const GAS f32x4* xr = (const GAS f32x4*)(X + (size_t)gw * 1024) + lane; const GAS unsigned long long* mr = (const GAS unsigned long long*)(MIX + (size_t)gw * 1024) + lane;
#pragma unroll
      for (int j = 0; j < 4; ++j) { xnx[j] = __builtin_nontemporal_load(xr + 64 * j); mnx[j] = __builtin_nontemporal_load(mr + 64 * j); } }
#pragma unroll 1
    for (int it = 0; it < 16; ++it) {
        const int m = gw + it * (256 * NWAVES);
        f32x4 xcur[4]; unsigned long long mcur[4];
#pragma unroll
        for (int j = 0; j < 4; ++j) { xcur[j] = xnx[j]; mcur[j] = mnx[j]; }
        { const int mn = gw + (it < 15 ? it + 1 : it) * (256 * NWAVES);
          const GAS f32x4* xr = (const GAS f32x4*)(X + (size_t)mn * 1024) + lane; const GAS unsigned long long* mr = (const GAS unsigned long long*)(MIX + (size_t)mn * 1024) + lane;
#pragma unroll
          for (int j = 0; j < 4; ++j) { xnx[j] = __builtin_nontemporal_load(xr + 64 * j); mnx[j] = __builtin_nontemporal_load(mr + 64 * j); } }
        f32x4 hv[4]; float ss = 0.f;
#pragma unroll
        for (int j = 0; j < 4; ++j) { const f32x4 xv = xcur[j]; const unsigned long long w = mcur[j]; const unsigned lo = (unsigned)w, hi = (unsigned)(w >> 32);
            hv[j] = (f32x4){xv.x + bf_lo(lo), xv.y + bf_hi(lo), xv.z + bf_lo(hi), xv.w + bf_hi(hi)};
            ss += (hv[j].x * hv[j].x + hv[j].y * hv[j].y) + (hv[j].z * hv[j].z + hv[j].w * hv[j].w); }
        const float rstd = 1.f / sqrtf(wave_sum(ss) * (1.f / D) + RMS_EPS);
        f32x2 p2[16];
#pragma unroll
        for (int e = 0; e < 16; ++e) p2[e] = (f32x2){0.f, 0.f};
#pragma unroll
        for (int j = 0; j < 4; ++j)
#pragma unroll
            for (int i = 0; i < 4; ++i) { const float hk = hv[j][i]; const f32x2 hk2 = {hk, hk}; const LAS float* wrow = WP + ((i + 4 * j) * 64 + lane) * 36;
#pragma unroll
                for (int e4 = 0; e4 < 8; ++e4) { const f32x4 w = *(const LAS f32x4*)(wrow + 4 * e4);
                    p2[2 * e4] = __builtin_elementwise_fma(hk2, (f32x2){w[0], w[1]}, p2[2 * e4]); p2[2 * e4 + 1] = __builtin_elementwise_fma(hk2, (f32x2){w[2], w[3]}, p2[2 * e4 + 1]); } }
        float p[32];
#pragma unroll
        for (int e = 0; e < 16; ++e) { p[2 * e] = p2[e].x; p[2 * e + 1] = p2[e].y; }
        float q16[16], q8[8], q4[4], q2[2];
        { const bool up = (lane & 32) != 0;
#pragma unroll
          for (int i = 0; i < 16; ++i) { const float keep = up ? p[16 + i] : p[i], send = up ? p[i] : p[16 + i]; q16[i] = keep + __shfl_xor(send, 32); } }
        { const bool up = (lane & 16) != 0;
#pragma unroll
          for (int i = 0; i < 8; ++i) { const float keep = up ? q16[8 + i] : q16[i], send = up ? q16[i] : q16[8 + i]; q8[i] = keep + __shfl_xor(send, 16); } }
        { const bool up = (lane & 8) != 0;
#pragma unroll
          for (int i = 0; i < 4; ++i) { const float keep = up ? q8[4 + i] : q8[i], send = up ? q8[i] : q8[4 + i]; q4[i] = keep + __shfl_xor(send, 8); } }
        { const bool up = (lane & 4) != 0;
#pragma unroll
          for (int i = 0; i < 2; ++i) { const float keep = up ? q4[2 + i] : q4[i], send = up ? q4[i] : q4[2 + i]; q2[i] = keep + __shfl_xor(send, 4); } }
        float q1; { const bool up = (lane & 2) != 0; const float keep = up ? q2[1] : q2[0], send = up ? q2[0] : q2[1]; q1 = keep + __shfl_xor(send, 2); }
        const float raw = q1 + __shfl_xor(q1, 1);
        const float v = raw * rstd + brt;
        int rank = 0;
#pragma unroll
        for (int j = 0; j < 32; ++j) { const float vj = __int_as_float(__builtin_amdgcn_readlane(__float_as_int(v), 2 * j)); rank += (vj > v || (vj == v && j < e_me)) ? 1 : 0; }
        float vk[4]; int ek[4];
#pragma unroll
        for (int k = 0; k < 4; ++k) { const unsigned long long mk = __ballot(rank == k); const int lk = (int)__builtin_ctzll(mk); ek[k] = lk >> 1; vk[k] = __int_as_float(__builtin_amdgcn_readlane(__float_as_int(v), lk)); }
        float ex[4]; float den = 0.f;
#pragma unroll
        for (int k = 0; k < 4; ++k) { ex[k] = __expf(vk[k] - vk[0]); den += ex[k]; }
        const float rden = 1.f / den;
        if (lane < 4) {
            const int e = lane == 0 ? ek[0] : lane == 1 ? ek[1] : lane == 2 ? ek[2] : ek[3];
            const float gt = (lane == 0 ? ex[0] : lane == 1 ? ex[1] : lane == 2 ? ex[2] : ex[3]) * rden;
            const int sl = __hip_atomic_fetch_add(cntL + e, 1, __ATOMIC_RELAXED, __HIP_MEMORY_SCOPE_WORKGROUP);
            const int pos = F.wave * 64 + it * 4 + lane;
            stA[pos] = m * 4 + lane; stE[pos] = e | (sl << 8); stG[pos] = gt;
        }
        { const GAS f32x4* gr = (const GAS f32x4*)gf + lane; GAS unsigned* o4 = (GAS unsigned*)(XN8 + (size_t)m * 1024) + lane;
          GAS unsigned long long* h8 = (GAS unsigned long long*)((bf16*)(a.ws + WS_HB) + (size_t)m * 1024) + lane;
#pragma unroll
          for (int j = 0; j < 4; ++j) { const f32x4 gg = gr[64 * j];
              o4[64 * j] = pk_fp8x4(hv[j].x * rstd * gg.x, hv[j].y * rstd * gg.y, hv[j].z * rstd * gg.z, hv[j].w * rstd * gg.w);
              __builtin_nontemporal_store((unsigned long long)pk2(hv[j].x, hv[j].y) | ((unsigned long long)pk2(hv[j].z, hv[j].w) << 32), h8 + 64 * j); } }
    }
    }
    __syncthreads();
    if (FTID(F) < 32) baseL[FTID(F)] = (int)__hip_atomic_fetch_add(F.ctl + CW_ECNT + 16 * FTID(F), (unsigned)cntL[FTID(F)], __ATOMIC_RELAXED, __HIP_MEMORY_SCOPE_AGENT);
    __syncthreads();
    { const int pos = FTID(F); const int aid = stA[pos], ee = stE[pos], e = ee & 255, sl = ee >> 8;
      int* list = (int*)(a.ws + WS_LIST); float* gates = (float*)(a.ws + WS_GATES);
      list[(size_t)e * T + baseL[e] + sl] = aid; gates[(size_t)e * T + baseL[e] + sl] = stG[pos]; }
}
__device__ __forceinline__ void moe_tables(Frame& F) {
    LAS int* tpre = (LAS int*)(F.lds + MOE_OFF); LAS int* cntE = tpre + 40;
    __syncthreads();
    if (FTID(F) < 32) cntE[FTID(F)] = (int)__hip_atomic_load(F.ctl + CW_ECNT + 16 * FTID(F), RLX_AGENT);
    __syncthreads();
    if (FTID(F) == 0) { int acc = 0; for (int e = 0; e < 32; ++e) { tpre[e] = acc; acc += (cntE[e] + 255) >> 8; } tpre[32] = acc; }
    __syncthreads();
}
__device__ __forceinline__ void pf_final(Frame& F, const Args& a) {
    int lane = mk_lane(); asm volatile("" : "+v"(lane));
    const int gw = F.vcu * NWAVES + F.wave, NGW = F.G * NWAVES;
    const unsigned char* YB = (const unsigned char*)(a.ws + WS_YBUF); const float* gfin = INF(a, 28);
    for (int m = gw; m < T; m += NGW) {
        GAS f32x4* hr = (GAS f32x4*)(a.out + (size_t)m * 1024) + lane;
        const GAS unsigned long long* mr = (const GAS unsigned long long*)((const bf16*)(a.ws + WS_HB) + (size_t)m * 1024) + lane;
        f32x4 v[4];
#pragma unroll
        for (int j = 0; j < 4; ++j) { const unsigned long long w = __builtin_nontemporal_load(mr + 64 * j); const unsigned lo = (unsigned)w, hi = (unsigned)(w >> 32);
            v[j].x = bf_lo(lo); v[j].y = bf_hi(lo); v[j].z = bf_lo(hi); v[j].w = bf_hi(hi); }
#pragma unroll
        for (int k = 0; k < 4; ++k) { const GAS unsigned* yr = (const GAS unsigned*)(YB + ((size_t)m * 4 + k) * 1024) + lane;
#pragma unroll
            for (int j = 0; j < 4; ++j) { const unsigned w = __builtin_nontemporal_load(yr + 64 * j); const f32x2 lo = __builtin_amdgcn_cvt_pk_f32_fp8((int)w, false), hi = __builtin_amdgcn_cvt_pk_f32_fp8((int)w, true);
                v[j].x += lo.x * YB_INV; v[j].y += lo.y * YB_INV; v[j].z += hi.x * YB_INV; v[j].w += hi.y * YB_INV; } }
        float s = 0.f;
#pragma unroll
        for (int j = 0; j < 4; ++j) s += (v[j].x * v[j].x + v[j].y * v[j].y) + (v[j].z * v[j].z + v[j].w * v[j].w);
        const float rstd = 1.f / sqrtf(wave_sum(s) * (1.f / D) + RMS_EPS);
        const GAS f32x4* gr = (const GAS f32x4*)gfin + lane;
#pragma unroll
        for (int j = 0; j < 4; ++j) { const f32x4 gg = gr[64 * j]; __builtin_nontemporal_store(v[j] * rstd * gg, hr + 64 * j); }
    }
}

__global__ void __launch_bounds__(NWAVES * 64, 2) mk_fwd(Args args) {
    extern __shared__ __attribute__((aligned(16))) unsigned char lds[];
    Frame F;
    F.lds = (LAS unsigned char*)lds;
    F.MISC = (volatile LAS unsigned*)(F.lds + MISC_OFF);
    F.wave = __builtin_amdgcn_readfirstlane((int)(threadIdx.x >> 6));
    F.G = gridDim.x; { const int bx = blockIdx.x; F.vcu = (F.G % 8 == 0) ? (bx % 8) * (F.G / 8) + bx / 8 : bx; }
    unsigned char* ws = args.ws;
    F.ctl = (gu32*)(ws + WS_CTL);
    for (int u = FTID(F); u < (LDS_BYTES - LDSCTL_OFF) / 4; u += NWAVES * 64) ((LAS unsigned*)(F.lds + LDSCTL_OFF))[u] = 0u;
    __syncthreads();
    XcdBarrier bar; bar.bar = (unsigned*)(F.ctl + CW_BAR); bar.x = 0; bar.st = nullptr; bar.wave = F.wave; bar.G = gridDim.x;
    if (N_LAUNCHES == 1) bar = xcd_barrier_post((unsigned*)(F.ctl + CW_BAR), F.MISC + 8, F.wave, gridDim.x);
#define GRID_BAR() do { if (N_LAUNCHES == 1) xcd_barrier(bar); } while (0)
    const int lo = args.ph_lo, hi = args.ph_hi;
#define IN(k) (lo <= (k) && (k) < hi)
#ifndef PROBE_DUP
#define PROBE_DUP -1
#endif
#define REP(k, ...) do { __VA_ARGS__; if constexpr (PROBE_DUP == (k)) { __VA_ARGS__; } } while (0)
#define BOTH(k) (IN(k) && IN((k) + 1))
    LAS unsigned char* ring = F.lds + RING_OFF;

    if (IN(0)) { REP(0, p0_prologue(F, args)); if (BOTH(0)) GRID_BAR(); }
    if (IN(1)) {
        DenseOrder S; S.init(T, 2048, 1024, 1024, 1024, ws + WS_XN, ws + WS_WIN, F.G, (int)blockIdx.x);
        EpiInProj E{(bf16*)(ws + WS_Q), (bf16*)(ws + WS_K), (bf16*)(ws + WS_V), (bf16*)(ws + WS_AROW), (const float*)(ws + WS_ROPE), attn_body::C2};
        pg8::ALinear AO{2048};
        REP(1, pg8::gemm_phase<EpiInProj, DenseOrder, pg8::ALinear, true>(ring, 2048, S, AO, E, F.wave));
        if (BOTH(1)) GRID_BAR();
        if constexpr (PROBE_DUP == 40) { GRID_BAR(); GRID_BAR(); GRID_BAR(); GRID_BAR(); }
    }
    if (IN(2)) {
        if (F.G == 256) {
            if ((F.vcu & 3) == 0) {
                const int rank = F.vcu >> 2;
                const XcdBarrier sbar = xcd_barrier_post((unsigned*)(F.ctl + CW_BAR2), F.MISC + 12, F.wave, NS5);
                { XOrder S{NS5, rank, (const char*)(ws + WS_AROW), (const char*)(ws + WS_BTX)}; EpiX E{(float*)(ws + WS_XLOC)}; pg8::ALinear AO{AROW_P * 2};
                  REP(50, pg8::gemm_phase<EpiX, XOrder, pg8::ALinear, true>(ring, 1024, S, AO, E, F.wave)); }
                xcd_barrier(sbar);
                REP(51, if (F.wave < 2) s5_scan(args, rank * 2 + F.wave, mk_lane()));
                xcd_barrier(sbar);
                { YOrder S{NS5, rank, (const char*)(ws + WS_AROW), (const char*)(ws + WS_BTY)}; EpiY E{(bf16*)(ws + WS_YG)}; pg8::ALinear AO{AROW_P * 2};
                  REP(52, pg8::gemm_phase<EpiY, YOrder, pg8::ALinear, true>(ring, AROW_P * 2, S, AO, E, F.wave)); }
                xcd_barrier(sbar);
                { GluOrder S{rank, (const char*)(ws + WS_YG), (const char*)(ws + WS_WGLU)};
                  EpiGlu E{(const bf16*)(ws + WS_YG), (bf16*)(ws + WS_GLU), INF(args, 18)}; pg8::ALinear AO{1024};
                  REP(53, pg8::gemm_phase<EpiGlu, GluOrder, pg8::ALinear, true>(ring, 1024, S, AO, E, F.wave)); }
                asm volatile("s_waitcnt vmcnt(0)" ::: "memory"); __syncthreads();
                REP(54, glunorm_sub(F, args, rank));
                __syncthreads();
            }
            const int xcd = F.vcu >> 5, wl = F.vcu & 31;
            const float lam = *(const float*)(ws + WS_SMALL);
            for (int rp = 0; rp < NREP(2); ++rp)
            for (int i = 0; i < 8; ++i) {
                const int e = __builtin_amdgcn_readfirstlane((int)ATT_DEAL[wl][i]); if (e == 255) break;
                const int bh = xcd * 2 + (e >> 5), qb = e & 31, b = bh >> 2, h = bh & 3;
                for (int map = 0; map < 2; ++map) { const int hm = h * 2 + map;
                    attn_body::attn_unit<8>(b, hm * 64, hm * 64, h * 128, h * 128, qb,
                        (const attn_body::bf16*)(ws + WS_Q), (const attn_body::bf16*)(ws + WS_K), (const attn_body::bf16*)(ws + WS_V), (attn_body::bf16*)(ws + WS_O), (char*)lds + RING_OFF, F.wave,
                        map, (attn_body::bf16*)(ws + WS_ACAT), lam, INF(args, 8)); }
            }
        }
        if (IN(7)) GRID_BAR();
    }
    if (IN(7)) {
        DenseOrder S; S.init(T, 1024, 1024, 1024, 1024, ws + WS_ACAT, ws + WS_WOUT, F.G, (int)blockIdx.x);
        EpiMix E{(bf16*)(ws + WS_MIX)}; pg8::ALinear AO{2048};
        REP(7, pg8::gemm_phase<EpiMix, DenseOrder, pg8::ALinear, true>(ring, 2048, S, AO, E, F.wave));
        if (BOTH(7)) GRID_BAR();
    }
    if (IN(8)) { if (F.G == 256) pr_router(F, args); if (BOTH(8)) GRID_BAR(); }
    if (IN(9)) {
        moe_tables(F);
        const LAS int* tpre = (const LAS int*)(F.lds + MOE_OFF);
        MoeOrder<4, 8> S{F.G, F.vcu, tpre, tpre + 40, (const char*)(ws + WS_XN), (const char*)(ws + WS_WGU), (size_t)2048 * 1024, true, 8};
        EpiGU E{(unsigned char*)(ws + WS_ACT), INF(args, 25), F.lds + EPB_OFF}; AGather AO{(const int*)(ws + WS_LIST)};
        if constexpr (PROBE_DUP == 61) { MoeOrder<4, 8> S2 = S; S2.ntk = 24; pg8::gemm_phase<EpiGU, MoeOrder<4, 8>, AGather, true, true>(ring, 1024, S2, AO, E, F.wave, F.lds + ST_OFF); }
        REP(9, pg8::gemm_phase<EpiGU, MoeOrder<4, 8>, AGather, true, true>(ring, 1024, S, AO, E, F.wave, F.lds + ST_OFF));
        if (BOTH(9)) GRID_BAR();
    }
    if (IN(10)) {
        moe_tables(F);
        const LAS int* tpre = (const LAS int*)(F.lds + MOE_OFF);
        MoeOrder<8, 4> S{F.G, F.vcu, tpre, tpre + 40, (const char*)(ws + WS_ACT), (const char*)(ws + WS_WD), (size_t)1024 * 1024, false, 8};
        EpiDown E{(unsigned char*)(ws + WS_YBUF), INF(args, 27), (const int*)(ws + WS_LIST), (const float*)(ws + WS_GATES), 1, F.lds + ST_OFF, F.lds + EPB_OFF}; pg8::ALinear AO{1024};
        if constexpr (PROBE_DUP == 64) { EpiDownT<1> E1{(unsigned char*)(ws + WS_YBUF), INF(args, 27), (const int*)(ws + WS_LIST), (const float*)(ws + WS_GATES), 1, F.lds + ST_OFF, F.lds + EPB_OFF}; pg8::gemm_phase<EpiDownT<1>, MoeOrder<8, 4>, pg8::ALinear, true, true>(ring, 1024, S, AO, E1, F.wave); }
        if constexpr (PROBE_DUP == 62) { EpiNull E0; pg8::gemm_phase<EpiNull, MoeOrder<8, 4>, pg8::ALinear, true, true>(ring, 1024, S, AO, E0, F.wave); }
        if constexpr (PROBE_DUP == 60) { MoeOrder<8, 4> S2 = S; S2.ntk = 24; pg8::gemm_phase<EpiDown, MoeOrder<8, 4>, pg8::ALinear, true, true>(ring, 1024, S2, AO, E, F.wave); }
        REP(10, pg8::gemm_phase<EpiDown, MoeOrder<8, 4>, pg8::ALinear, true, true>(ring, 1024, S, AO, E, F.wave));
        if (BOTH(10)) GRID_BAR();
    }
    if (IN(11)) { REP(11, pf_final(F, args)); }
#undef IN
#undef BOTH
}

extern "C" void kernel_launch(void* const* d_in, const int* in_sizes, int n_in, void* d_out, int out_size, void* d_ws, size_t ws_size, hipStream_t stream) {
    static int grid = 0;
    if (grid == 0) {
        if (n_in != 29 || in_sizes[0] != T * D || out_size != T * D || ws_size < WS_END) { fprintf(stderr, "kernel_launch: unexpected shapes / workspace (n_in %d, ws %zu)\n", n_in, ws_size); grid = -1; return; }
        int dev = 0, cus = 0, per_cu = 0;
        if (hipGetDevice(&dev) != hipSuccess || hipDeviceGetAttribute(&cus, hipDeviceAttributeMultiprocessorCount, dev) != hipSuccess) { grid = -1; return; }
        if (hipFuncSetAttribute((const void*)mk_fwd, hipFuncAttributeMaxDynamicSharedMemorySize, LDS_BYTES) != hipSuccess) { fprintf(stderr, "kernel_launch: hipFuncSetAttribute failed\n"); grid = -1; return; }
        if (hipOccupancyMaxActiveBlocksPerMultiprocessor(&per_cu, (const void*)mk_fwd, NWAVES * 64, LDS_BYTES) != hipSuccess || per_cu < 1) { fprintf(stderr, "kernel_launch: occupancy query says %d\n", per_cu); }
        (void)hipGetLastError();
        if (cus < 256) { fprintf(stderr, "kernel_launch: needs 256 CUs, device has %d\n", cus); grid = -1; return; }
        grid = 256;
    }
    if (grid < 0) return;
    if (hipMemsetAsync((char*)d_ws + WS_CTL, 0, CTL_ZERO_BYTES, stream) != hipSuccess) return;
    Args a{};
    for (int i = 0; i < 29; ++i) a.in[i] = d_in[i];
    a.out = (float*)d_out; a.ws = (unsigned char*)d_ws; a.pad = 0;
    for (int li = 0; li < N_LAUNCHES; ++li) {
        a.ph_lo = (N_LAUNCHES == NPH) ? li : 0; a.ph_hi = (N_LAUNCHES == NPH) ? li + 1 : NPH; a.li = li;
        hipLaunchKernelGGL(mk_fwd, dim3(grid), dim3(NWAVES * 64), LDS_BYTES, stream, a);
    }
}
```

```cpp
#include <hip/hip_runtime.h>
#include <hip/hip_bf16.h>
#include <cstdio>
#include <cstdint>
#include <cmath>
__device__ __forceinline__ int mk_lane() { int l; asm volatile("v_mbcnt_lo_u32_b32 %0, -1, 0\n\tv_mbcnt_hi_u32_b32 %0, -1, %0" : "=v"(l)); return l; }
namespace pg8 {
#define PG8_LAS __attribute__((address_space(3)))
typedef unsigned short bf16_t;
typedef short bf16x8 __attribute__((ext_vector_type(8)));
typedef float f32x4 __attribute__((ext_vector_type(4)));
typedef float f32x2 __attribute__((ext_vector_type(2)));
typedef unsigned u32x4 __attribute__((ext_vector_type(4)));
typedef unsigned u32x2 __attribute__((ext_vector_type(2)));
constexpr int BM = 256, BK = 64, HALF = 128, HTB = HALF * BK * 2  , STAGE_BYTES = 8 * HTB, NXCD = 8, WGM = 8;

__host__ __device__ __forceinline__ int lds_byte(int r, int c) { const int st = (r >> 4) * 2 + (c >> 5), rr = r & 15, cc = c & 31, ob = rr * 64 + cc * 2; return st * 1024 + (ob ^ (((ob >> 9) & 1) << 5)); }
__host__ __device__ __forceinline__ void stage_rc(int b, int& R, int& C) { const int st = b / 1024, sb = b % 1024, swz = sb ^ (((sb >> 9) & 1) << 5); R = (st >> 1) * 16 + swz / 64; C = (st & 1) * 32 + (swz % 64) / 2; }
__host__ __device__ __forceinline__ int perm32(int rho) { const int n = rho >> 4, i = rho & 15; return 8 * (i >> 2) + 4 * n + (i & 3); }

struct Unit { int pm, pn; const char* a; const char* b; int nt; int x0, x1; };

struct ALinear {
    static constexpr bool PER_UNIT = false;
    int lda;
    __device__ __forceinline__ void get(const Unit&, unsigned (&v)[2][2], const int (&R)[2], const int (&C)[2]) const {
#pragma unroll
        for (int h = 0; h < 2; ++h)
#pragma unroll
            for (int i = 0; i < 2; ++i) v[h][i] = (unsigned)(R[i] * lda + C[i] * 2);
    }
    __device__ __forceinline__ size_t hstep() const { return (size_t)HALF * lda; }
    __device__ __forceinline__ void issue_dma(const Unit&, const int (&)[2], unsigned) const {}
    __device__ __forceinline__ void finish(const int (&)[4], unsigned (&)[2][2], const int (&)[2]) const {}
};

__device__ __forceinline__ unsigned cvt_pk_bf16(float lo, float hi) { unsigned r; asm volatile("v_cvt_pk_bf16_f32 %0, %1, %2" : "=v"(r) : "v"(lo), "v"(hi)); return r; }
__device__ __forceinline__ f32x2 gelu_pk(f32x2 v) {
    const f32x2 av = __builtin_elementwise_abs(v), d = av * 0.2316418882f + 1.0f;
    f32x2 t; t.x = __builtin_amdgcn_rcpf(d.x); t.y = __builtin_amdgcn_rcpf(d.y);
    f32x2 q = t * 0.5307027145f + (-0.7265760135f); q = q * t + 0.7107068705f; q = q * t + (-0.142248368f); q = q * t + 0.127414796f; q = q * t;
    const f32x2 s = (v * v) * (-0.72134752044f);
    f32x2 e; e.x = __builtin_amdgcn_exp2f(s.x); e.y = __builtin_amdgcn_exp2f(s.y);
    const f32x2 m = v * (q * e), r = v - m;
    f32x2 o; o.x = v.x < 0.f ? m.x : r.x; o.y = v.y < 0.f ? m.y : r.y; return o;
}

typedef int v4i_t __attribute__((ext_vector_type(4)));
typedef int v8i_t __attribute__((ext_vector_type(8)));
template <int OFF> __device__ __forceinline__ void glds_sv(const char* sbase, unsigned voff, unsigned lds_w0) { unsigned keep;
    asm volatile("s_mov_b32 %0, m0\n\ts_add_u32 m0, %3, %4\n\ts_nop 0\n\tglobal_load_lds_dwordx4 %1, %2\n\ts_mov_b32 m0, %0" : "=&s"(keep) : "v"(voff), "s"(sbase), "s"(lds_w0), "i"(OFF) : "memory", "scc"); }
__device__ __forceinline__ void glds4_sv(const void* sbase, unsigned voff, unsigned lds_dst) { unsigned keep;
    asm volatile("s_mov_b32 %0, m0\n\ts_mov_b32 m0, %3\n\ts_nop 0\n\tglobal_load_lds_dword %1, %2\n\ts_mov_b32 m0, %0" : "=&s"(keep) : "v"(voff), "s"(sbase), "s"(lds_dst) : "memory"); }
template <int N> __device__ __forceinline__ void wait_vm_sel(int sel) { asm volatile("v_cmp_ne_u32_e32 vcc, 0, %0\n\ts_cbranch_vccz .Lw8_%=\n\ts_waitcnt vmcnt(%1)\n\ts_branch .Lwe_%=\n.Lw8_%=:\n\ts_waitcnt vmcnt(8)\n.Lwe_%=:" :: "v"(sel), "n"(N) : "memory", "vcc"); }
template <bool FP8> struct FragT;
template <> struct FragT<false> { struct A4 { bf16x8 v[4][2]; }; struct B2 { bf16x8 v[2][2]; }; };
template <> struct FragT<true> { struct A4 { v8i_t v[4]; }; struct B2 { v8i_t v[2]; }; };
template <class Epi, class Sched, class AOff, bool ALIGN_EPI = true, bool FP8 = false>
__device__ __forceinline__ void gemm_phase(PG8_LAS unsigned char* lds, const int ldb  , const Sched& S, const AOff& AO, const Epi& E, const int wave_  , PG8_LAS unsigned char* xlds = nullptr  ) {
    int tid_ = wave_ * 64 + mk_lane(); asm volatile("" : "+v"(tid_));
    const int tid = tid_, wid = __builtin_amdgcn_readfirstlane(tid >> 6), lane = tid & 63, wr = wid >> 2, wc = wid & 3, fr = lane & 15, fq = lane >> 4;
    unsigned voffB[2]; int RR[2], CC[2];
#pragma unroll
    for (int i = 0; i < 2; ++i) { int R, C; stage_rc(tid * 16 + i * 8192, R, C); RR[i] = R; CC[i] = C; const int Rp = (R & ~31) + perm32(R & 31); const int P32 = perm32(R & 31); const int Rb = Epi::BMODE == 0 ? R : Epi::BMODE == 1 ? Rp : Epi::BMODE == 2 ? 2 * Rp : 64 * (R >> 5) + 16 * (P32 >> 3) + (P32 & 7);
        voffB[i] = (unsigned)(Rb * ldb + C * 2); }
    const size_t kstep = (size_t)(BK * 2);
    const size_t hstepB = Epi::BMODE == 2 ? (size_t)ldb : Epi::BMODE == 3 ? (size_t)8 * ldb : (size_t)HALF * ldb;
    const size_t hstepA = AO.hstep();
    constexpr int AH1 = AOff::PER_UNIT ? 1 : 0;
    const unsigned ldsw0 = (unsigned)__builtin_amdgcn_readfirstlane((int)((unsigned)(uintptr_t)lds + (unsigned)wid * 1024u));
    const int aoff = lds_byte(wr * 64 + fr, fq * 8), boff = lds_byte(wc * 32 + fr, fq * 8);
#define PG8_SA(b, h) (((b) * 2 + (h)) * HTB)
#define PG8_SB(b, h) ((4 + (b) * 2 + (h)) * HTB)
#define PG8_STAGE(bufoff, gbase, voff) do { glds_sv<(bufoff)>((const char*)(gbase), (voff)[0], ldsw0); glds_sv<(bufoff) + 8192>((const char*)(gbase), (voff)[1], ldsw0); } while (0)
#define PG8_LD8(p) __builtin_shufflevector(*(const PG8_LAS v4i_t*)(p), *(const PG8_LAS v4i_t*)((p) + 1024), 0, 1, 2, 3, 4, 5, 6, 7)
#define PG8_LDA(dst, b, h) do { if constexpr (FP8) { _Pragma("unroll") for (int m = 0; m < 4; ++m) dst.v[m] = PG8_LD8(lds + PG8_SA(b, h) + aoff + m * 2048); } \
        else { _Pragma("unroll") for (int m = 0; m < 4; ++m) _Pragma("unroll") for (int k = 0; k < 2; ++k) dst.v[m][k] = *(const PG8_LAS bf16x8*)(lds + PG8_SA(b, h) + aoff + m * 2048 + k * 1024); } } while (0)
#define PG8_LDB(dst, b, h) do { if constexpr (FP8) { _Pragma("unroll") for (int n = 0; n < 2; ++n) dst.v[n] = PG8_LD8(lds + PG8_SB(b, h) + boff + n * 2048); } \
        else { _Pragma("unroll") for (int n = 0; n < 2; ++n) _Pragma("unroll") for (int k = 0; k < 2; ++k) dst.v[n][k] = *(const PG8_LAS bf16x8*)(lds + PG8_SB(b, h) + boff + n * 2048 + k * 1024); } } while (0)
#define PG8_MMA(ai, bj, At, Bt) do { __builtin_amdgcn_s_setprio(1); \
        if constexpr (FP8) { _Pragma("unroll") for (int m = 0; m < 4; ++m) _Pragma("unroll") for (int n = 0; n < 2; ++n) \
            acc[ai][bj][m][n] = __builtin_amdgcn_mfma_scale_f32_16x16x128_f8f6f4(Bt.v[n], At.v[m], acc[ai][bj][m][n], 0, 0, 0, 0, 0, 0); } \
        else { _Pragma("unroll") for (int m = 0; m < 4; ++m) _Pragma("unroll") for (int n = 0; n < 2; ++n) _Pragma("unroll") for (int k = 0; k < 2; ++k) \
            acc[ai][bj][m][n] = __builtin_amdgcn_mfma_f32_16x16x32_bf16(Bt.v[n][k], At.v[m][k], acc[ai][bj][m][n], 0, 0, 0); } \
        __builtin_amdgcn_s_setprio(0); } while (0)
#define PG8_WAIT_V(n) asm volatile("s_waitcnt vmcnt(" #n ")" ::: "memory")
#define PG8_WAIT_L(n) asm volatile("s_waitcnt lgkmcnt(" #n ")" ::: "memory")
#define PG8_BAR __builtin_amdgcn_s_barrier()
#define PG8_SCHED __builtin_amdgcn_sched_barrier(0)
    Unit cur, nxt; int ui = 0;
    if (!S.next(0, cur)) return;
    unsigned vAc[2][2];
    AO.get(cur, vAc, RR, CC);
    PG8_LAS unsigned* const xw = (PG8_LAS unsigned*)xlds + wid * 256 + lane;
    const unsigned xdst = (unsigned)__builtin_amdgcn_readfirstlane((int)((unsigned)(uintptr_t)xlds + (unsigned)wid * 1024u));
    f32x4 acc[2][2][4][2];
#pragma unroll
    for (int a = 0; a < 2; ++a)
#pragma unroll
        for (int b = 0; b < 2; ++b)
#pragma unroll
            for (int m = 0; m < 4; ++m)
#pragma unroll
                for (int n = 0; n < 2; ++n) acc[a][b][m][n] = (f32x4){0.f, 0.f, 0.f, 0.f};
    typedef typename FragT<FP8>::A4 FragA; typedef typename FragT<FP8>::B2 FragB;
    FragA At; FragB B0, B1;
    const char* cA = cur.a; const char* cB = cur.b; int nt = cur.nt; asm volatile("" : "+s"(nt));
    PG8_STAGE(PG8_SB(0, 0), cB, voffB); PG8_STAGE(PG8_SB(0, 1), cB + hstepB, voffB); PG8_STAGE(PG8_SA(0, 0), cA, vAc[0]); PG8_STAGE(PG8_SA(0, 1), cA + hstepA, vAc[AH1]);
    if (wr == 1) PG8_BAR;
    PG8_WAIT_V(2); PG8_BAR;
    PG8_STAGE(PG8_SB(1, 0), cB + kstep, voffB); PG8_STAGE(PG8_SA(1, 0), cA + kstep, vAc[0]); PG8_STAGE(PG8_SB(1, 1), cB + hstepB + kstep, voffB);
    PG8_WAIT_V(6); PG8_BAR;
    for (;;) {
        const bool has_next = S.next(ui + 1, nxt);
        if constexpr (AOff::PER_UNIT) { if (has_next) AO.issue_dma(nxt, RR, xdst); }
        if constexpr (Epi::PREFETCH) E.prefetch(cur, wid, wr, lane);
        const char* nA = has_next ? nxt.a : cA; const char* nB = has_next ? nxt.b : cB;
        for (int t = 0; t < nt; t += 2) {
            const bool last = (t == nt - 2);
            const int rlx = ((t == 0) && (ui > 0)) ? 1 : 0;
            const char* a1 = cA + (size_t)(t + 1) * kstep;
            const char* a2 = last ? nA : cA + (size_t)(t + 2) * kstep; const char* b2 = last ? nB : cB + (size_t)(t + 2) * kstep;
            const char* a3 = a2 + kstep; const char* b3 = b2 + kstep;

            PG8_LDB(B0, 0, 0); PG8_LDB(B1, 0, 1); PG8_SCHED; PG8_LDA(At, 0, 0); PG8_STAGE(PG8_SA(1, 1), a1 + hstepA, vAc[AH1]);
            if constexpr (AOff::PER_UNIT) { if (last && has_next) { int raw[4]; raw[0] = (int)xw[0]; raw[1] = (int)xw[64]; raw[2] = (int)xw[128]; raw[3] = (int)xw[192]; AO.finish(raw, vAc, CC); } }
            if constexpr (Epi::NSTORE + Epi::NPRE > 0) wait_vm_sel<8 + Epi::NSTORE + Epi::NPRE>(rlx); else PG8_WAIT_V(8);
            PG8_WAIT_L(0); PG8_BAR; PG8_MMA(0, 0, At, B0); PG8_MMA(0, 1, At, B1); PG8_BAR; PG8_SCHED;
            PG8_LDA(At, 0, 1); PG8_STAGE(PG8_SB(0, 0), b2, voffB); PG8_STAGE(PG8_SB(0, 1), b2 + hstepB, voffB); PG8_STAGE(PG8_SA(0, 0), a2, vAc[0]);
            if constexpr (Epi::NSTORE + Epi::NPRE > 0) wait_vm_sel<8 + Epi::NSTORE + Epi::NPRE>(rlx); else PG8_WAIT_V(8);
            PG8_WAIT_L(0); PG8_BAR; PG8_MMA(1, 0, At, B0); PG8_MMA(1, 1, At, B1); PG8_BAR; PG8_SCHED;
            PG8_LDB(B0, 1, 0); PG8_LDB(B1, 1, 1); PG8_SCHED; PG8_LDA(At, 1, 0); PG8_STAGE(PG8_SA(0, 1), a2 + hstepA, vAc[AH1]);
            PG8_WAIT_V(8); PG8_WAIT_L(0); PG8_BAR; PG8_MMA(0, 0, At, B0); PG8_MMA(0, 1, At, B1); PG8_BAR; PG8_SCHED;
            PG8_LDA(At, 1, 1); PG8_STAGE(PG8_SB(1, 0), b3, voffB); PG8_STAGE(PG8_SB(1, 1), b3 + hstepB, voffB); PG8_STAGE(PG8_SA(1, 0), a3, vAc[0]);
            PG8_WAIT_V(8); PG8_WAIT_L(0); PG8_BAR; PG8_MMA(1, 0, At, B0); PG8_MMA(1, 1, At, B1); PG8_BAR; PG8_SCHED;
        }
        if constexpr (ALIGN_EPI) { if (wr == 0) PG8_BAR; }
        { const int el = mk_lane(); const int efr = el & 15, efq = el >> 4;
          E(acc, cur, wr, wc, efr, efq); }
        if (!has_next) break;
#pragma unroll
        for (int a = 0; a < 2; ++a)
#pragma unroll
            for (int b = 0; b < 2; ++b)
#pragma unroll
                for (int m = 0; m < 4; ++m)
#pragma unroll
                    for (int n = 0; n < 2; ++n) acc[a][b][m][n] = (f32x4){0.f, 0.f, 0.f, 0.f};
        cur = nxt; cA = nA; cB = nB; nt = cur.nt; asm volatile("" : "+s"(nt)); ++ui;

        if constexpr (ALIGN_EPI) { if (wr == 1) PG8_BAR; }
    }
    PG8_WAIT_V(0);
    if constexpr (!ALIGN_EPI) { if (wr == 0) PG8_BAR; }
    PG8_BAR;
#undef PG8_SA
#undef PG8_SB
#undef PG8_STAGE
#undef PG8_LDA
#undef PG8_LDB
#undef PG8_MMA
#undef PG8_LD8
#undef PG8_WAIT_V
#undef PG8_WAIT_L
#undef PG8_BAR
#undef PG8_SCHED
}
}
namespace attn_body {
using bf16=__hip_bfloat16;
using bf16x8=__attribute__((ext_vector_type(8)))short;
using s16x4=__attribute__((ext_vector_type(4)))short;
using f32x16=__attribute__((ext_vector_type(16)))float;
using u32x4=__attribute__((ext_vector_type(4)))unsigned;
constexpr int SEQ=8192,D=64;
constexpr int PQ=512,PK=512,PV=512,PO=512,PA=1024;
constexpr int NW=8,QBLK=32,QB=QBLK*NW,KVBLK=64,NQB=SEQ/QB;
constexpr int ATTN_UNIT_ROWS=QB;
__device__ __forceinline__ int crow(int r,int hi){return (r&3)+8*(r>>2)+4*hi;}
#define SBAR() __builtin_amdgcn_sched_barrier(0)
__device__ __forceinline__ void cmask(f32x16&p0,f32x16&p1,int jb,int qrel,int hi){
  const float NEG=-INFINITY; int kb=64*jb+4*hi;
  #pragma unroll
  for(int r=0;r<16;++r){int kv=kb+(r&3)+8*(r>>2); if(kv>qrel)p0[r]=NEG; if(kv+32>qrel)p1[r]=NEG;}
}

constexpr int NSLOT=3, SLOTB=8192;
constexpr int LDS_K=0, LDS_V=NSLOT*SLOTB, LDS_WS=3*NSLOT*SLOTB, LDS_OST=LDS_WS+NW*64*4, LDS_BYTES=LDS_OST+NW*8192;
constexpr float C2=0.125f*1.4426950408889634f;
__device__ __forceinline__ void glds16(const void*sbase,unsigned voff,unsigned lds_dst){unsigned keep;
  asm volatile("s_mov_b32 %0, m0\n\ts_mov_b32 m0, %3\n\ts_nop 0\n\tglobal_load_lds_dwordx4 %1, %2\n\ts_mov_b32 m0, %0":"=&s"(keep):"v"(voff),"s"(sbase),"s"(lds_dst):"memory");}
__device__ __forceinline__ float max3f(float a,float b,float c){float r;asm("v_max3_f32 %0, %1, %2, %3":"=v"(r):"v"(a),"v"(b),"v"(c));return r;}
__device__ __forceinline__ float max2f(float a,float b){float r;asm("v_max_f32_e32 %0, %1, %2":"=v"(r):"v"(a),"v"(b));return r;}
__device__ __forceinline__ float fadd_s(float a,float b){float r;asm("v_add_f32_e32 %0, %1, %2":"=v"(r):"v"(a),"v"(b));return r;}
__device__ __forceinline__ float fsub_s(float a,float b){float r;asm("v_sub_f32_e32 %0, %1, %2":"=v"(r):"v"(a),"v"(b));return r;}
typedef float f32x2_t __attribute__((ext_vector_type(2))); typedef __bf16 bf16x2_t __attribute__((ext_vector_type(2)));
__device__ __forceinline__ unsigned cvtpk_s(float lo,float hi){f32x2_t v={lo,hi};bf16x2_t b=__builtin_convertvector(v,bf16x2_t);return __builtin_bit_cast(unsigned,b);}
#define WAIT_BAR(N) asm volatile("s_waitcnt vmcnt(" #N ") lgkmcnt(0)\n\ts_barrier":::"memory")

__device__ __forceinline__ void qkt(f32x16&p0,f32x16&p1,const char*Kslot,const bf16x8*qr,const f32x16&negm,int r32,int hi){
  const char*kb=Kslot+hi*1024+r32*16;
  #pragma unroll
  for(int d0=0;d0<4;++d0){
    const bf16x8 b0=*reinterpret_cast<const bf16x8*>(kb+d0*2048);
    const bf16x8 b1=*reinterpret_cast<const bf16x8*>(kb+d0*2048+512);
    if(d0==0){p0=__builtin_amdgcn_mfma_f32_32x32x16_bf16(b0,qr[0],negm,0,0,0);p1=__builtin_amdgcn_mfma_f32_32x32x16_bf16(b1,qr[0],negm,0,0,0);}
    else{p0=__builtin_amdgcn_mfma_f32_32x32x16_bf16(b0,qr[d0],p0,0,0,0);p1=__builtin_amdgcn_mfma_f32_32x32x16_bf16(b1,qr[d0],p1,0,0,0);}}
}
typedef __attribute__((address_space(3))) const char* lds_cptr;
typedef short v4i16_t __attribute__((ext_vector_type(4)));
__device__ __forceinline__ void kload8(bf16x8*kf,lds_cptr kp){
  kf[0]=*(const __attribute__((address_space(3))) bf16x8*)(kp);      kf[1]=*(const __attribute__((address_space(3))) bf16x8*)(kp+512);
  kf[2]=*(const __attribute__((address_space(3))) bf16x8*)(kp+2048); kf[3]=*(const __attribute__((address_space(3))) bf16x8*)(kp+2560);
  kf[4]=*(const __attribute__((address_space(3))) bf16x8*)(kp+4096); kf[5]=*(const __attribute__((address_space(3))) bf16x8*)(kp+4608);
  kf[6]=*(const __attribute__((address_space(3))) bf16x8*)(kp+6144); kf[7]=*(const __attribute__((address_space(3))) bf16x8*)(kp+6656);
}
__device__ __forceinline__ void kload2(bf16x8*kf,lds_cptr kp,int j){ kf[2*j]=*(const __attribute__((address_space(3))) bf16x8*)(kp+j*2048); kf[2*j+1]=*(const __attribute__((address_space(3))) bf16x8*)(kp+j*2048+512); }
__device__ __forceinline__ s16x4 vtr(lds_cptr p){ return __builtin_bit_cast(s16x4,__builtin_amdgcn_ds_read_tr16_b64_v4i16((__attribute__((address_space(3))) v4i16_t*)p)); }
__device__ __forceinline__ float rowmax(const f32x16&p0,const f32x16&p1){
  float a=max3f(p0[0],p0[1],p1[0]),b=max3f(p0[2],p0[3],p1[1]);a=max3f(a,p1[2],p1[3]);
  #pragma unroll
  for(int r=4;r<16;r+=4){a=max3f(a,p0[r],p0[r+1]);b=max3f(b,p0[r+2],p0[r+3]);a=max3f(a,p1[r],p1[r+1]);b=max3f(b,p1[r+2],p1[r+3]);}
  const float m=max2f(a,b);
  auto rr=__builtin_amdgcn_permlane32_swap(__float_as_uint(m),__float_as_uint(m),false,false);
  return max2f(__uint_as_float(rr[0]),__uint_as_float(rr[1]));
}
__device__ __forceinline__ void pv(f32x16*o,int vb,bf16x8 pa0,bf16x8 pa1,bf16x8 pa2,bf16x8 pa3){
  #pragma unroll
  for(int d0=0;d0<4;++d0){s16x4 lo[4],hi[4];
    #pragma unroll
    for(int ks=0;ks<4;++ks){
      asm volatile("ds_read_b64_tr_b16 %0,%1 offset:%c2":"=&v"(lo[ks]):"v"(vb),"i"(d0*4096+ks*1024):"memory");
      asm volatile("ds_read_b64_tr_b16 %0,%1 offset:%c2":"=&v"(hi[ks]):"v"(vb),"i"(d0*4096+ks*1024+512):"memory");}
    asm volatile("s_waitcnt lgkmcnt(0)":::"memory");SBAR();
    #define PK(k) (bf16x8){lo[k][0],lo[k][1],lo[k][2],lo[k][3],hi[k][0],hi[k][1],hi[k][2],hi[k][3]}
    o[d0]=__builtin_amdgcn_mfma_f32_32x32x16_bf16(pa0,PK(0),o[d0],0,0,0);
    o[d0]=__builtin_amdgcn_mfma_f32_32x32x16_bf16(pa1,PK(1),o[d0],0,0,0);
    o[d0]=__builtin_amdgcn_mfma_f32_32x32x16_bf16(pa2,PK(2),o[d0],0,0,0);
    o[d0]=__builtin_amdgcn_mfma_f32_32x32x16_bf16(pa3,PK(3),o[d0],0,0,0);
    #undef PK
  }
}

#ifndef ATTN_STORE16
#define ATTN_STORE16(p,v) (*(u32x4*)(p)=(v))
#endif
template<int THRL> __device__ __forceinline__ void attn_unit(int b,int qoff,int koff,int voff,int ooff,int qb,const bf16*Q,const bf16*__restrict__ K,const bf16*__restrict__ V,bf16*O,char*shm,const int wave_,const int map,bf16*AOUT,const float lam,const float*ng){
  const int lane=mk_lane(),r32=lane&31,hi=lane>>5; const int wid=__builtin_amdgcn_readfirstlane(wave_);
  const long rowbase=(long)b*SEQ; const int q0=qb*QB;
  const bf16*Qw=Q+(rowbase+q0+wid*QBLK)*PQ+qoff;
  const bf16*Kh=K+rowbase*PK+koff,*Vh=V+rowbase*PV+voff;
  const unsigned lds0=(unsigned)(uintptr_t)shm;
  float*wsf=(float*)(shm+LDS_WS)+wid*64;
  const unsigned kofs=(unsigned)(lane*PK+wid*8)*2u;
  const unsigned voffs=(unsigned)((16*(wid&3)+(lane>>2))*PV+(wid>>2)*32+(lane&3)*8)*2u;
  const unsigned kdst=lds0+LDS_K+wid*1024, vdst=lds0+LDS_V+wid*1024;
  #define DMA_K(t,slot) glds16(Kh+(long)(t)*KVBLK*PK,kofs,(unsigned)__builtin_amdgcn_readfirstlane(kdst+(slot)))
  #define DMA_V(t,slot) do{ glds16(Vh+(long)(t)*KVBLK*PV,voffs,(unsigned)__builtin_amdgcn_readfirstlane(vdst+2*(slot))); glds16(Vh+(long)(t)*KVBLK*PV+64,voffs,(unsigned)__builtin_amdgcn_readfirstlane(vdst+2*(slot)+8192)); }while(0)
  const int vb0=(int)(lds0+LDS_V)+((lane>>4)&1)*32+(lane&3)*8+(4*hi+((lane&15)>>2))*64;
  const char*Kbase=shm+LDS_K; bf16x8 kf[8];
  const lds_cptr shm3=(lds_cptr)shm; const lds_cptr kp0=shm3+LDS_K+hi*1024+r32*16; const lds_cptr vp0=shm3+LDS_V+((lane>>4)&1)*32+(lane&3)*8+(4*hi+((lane&15)>>2))*64;
  const int NT=(q0+QB)/KVBLK;
  DMA_K(0,0);DMA_V(0,0);DMA_K(1,SLOTB);
  bf16x8 qr[4];
  #pragma unroll
  for(int d0=0;d0<4;++d0)qr[d0]=*reinterpret_cast<const bf16x8*>(&Qw[(long)r32*PQ+d0*16+hi*8]);
  typedef __attribute__((address_space(3))) char* lds_wptr;
  const lds_cptr qp0=shm3+LDS_OST+wid*8192+hi*512+r32*16;
  { lds_wptr qw=(lds_wptr)shm+LDS_OST+wid*8192+hi*512+r32*16;
    _Pragma("unroll") for(int d0=0;d0<4;++d0)*(__attribute__((address_space(3))) bf16x8*)(qw+d0*1024)=qr[d0]; }
  float mhat=0.f,l_reg=0.f;f32x16 o[4];o[0]=f32x16{};o[1]=f32x16{};o[2]=f32x16{};o[3]=f32x16{};const f32x16 zero16=f32x16{};
  const int qrel=wid*QBLK+r32;
  #define CMASK(P0,P1,t) do{int jb_=(t)-(NT-4); if(jb_>=0)cmask(P0,P1,jb_,qrel,hi);}while(0)
  bool resc=false;
  #define START(P0,P1) do{ const float rm=rowmax(P0,P1); resc=false; mhat=rm; \
    _Pragma("unroll") for(int r=0;r<16;++r)P0[r]=__builtin_amdgcn_exp2f(P0[r]-mhat); }while(0)
  #define RESC() do{ if(resc){ asm volatile("s_waitcnt lgkmcnt(0)":::"memory"); \
      _Pragma("unroll") for(int d_=0;d_<4;++d_) _Pragma("unroll") for(int r=0;r<16;++r)o[d_][r]*=wsf[crow(r,hi)]; } }while(0)
  f32x16 pA0,pA1,pB0,pB1;
  int sl_prev=0,sl_cur=0,sl_next=SLOTB;
  #define ROT() do{sl_prev=sl_cur;sl_cur=sl_next;sl_next=(sl_next==(NSLOT-1)*SLOTB)?0:sl_next+SLOTB;}while(0)
  DMA_K(2,2*SLOTB);
  WAIT_BAR(4);
  qkt(pA0,pA1,Kbase,qr,zero16,r32,hi);asm volatile("s_nop 15\n\ts_nop 7":"+v"(pA0),"+v"(pA1));CMASK(pA0,pA1,0);
  START(pA0,pA1);
  _Pragma("unroll") for(int r=0;r<16;++r)pA1[r]=__builtin_amdgcn_exp2f(pA1[r]-mhat);
  WAIT_BAR(0);
  DMA_K(3,0);DMA_V(1,SLOTB);
  ROT();
  kload8(kf,kp0+sl_cur);
  WAIT_BAR(3);
  s16x4 vlo[3],vhi[3]; u32x4 pw0,pw1,pw2,pw3;
  #define PKW(P,B) cvtpk_s(P[B],P[B+1])
  #define PAF(k) __builtin_bit_cast(bf16x8,pw##k)
  #define VFS(s) (bf16x8){vlo[s][0],vlo[s][1],vlo[s][2],vlo[s][3],vhi[s][0],vhi[s][1],vhi[s][2],vhi[s][3]}
  #define PIN(x) asm volatile("":"+v"(x))
  #define MX3(a,b,c) __builtin_fmaxf(__builtin_fmaxf((a),(b)),(c))
  #define GAPA(MF,A0,A1,A2,A3,W0,W1,PW) do{ MF; sacc+=A0; sacc+=A1; sacc+=A2; sacc+=A3; PIN(sacc); W0; W1; PIN(PW); SBAR(); }while(0)
  #define EX(v) __builtin_amdgcn_exp2f(v)
  #define GAPB(MF,X,B) do{ MF; X[B]=EX(X[B]-mhat); X[B+1]=EX(X[B+1]-mhat); PIN(X); SBAR(); }while(0)
  #define VRDG(g) do{ vlo[(g)%3]=vtr(vp_+(((g)&3)*4096+((g)>>2)*1024)); vhi[(g)%3]=vtr(vp_+(((g)&3)*4096+((g)>>2)*1024+512)); SBAR(); }while(0)
  #define QRD(d0) (*(const __attribute__((address_space(3))) bf16x8*)(qp0+(d0)*1024))
  #define KRD(G,j) do{ if(G){ kload2(kf,kp0+sl_next,j); SBAR(); } }while(0)
  #define PVG(g,PF,X,B) GAPB(o[(g)&3]=__builtin_amdgcn_mfma_f32_32x32x16_bf16(PF,VFS((g)%3),o[(g)&3],0,0,0), X,B)
  #define STEP(C0,C1,P0,P1,t,GK,GV,GL) do{ SBAR(); \
    const lds_cptr vp_=vp0+2*sl_prev; \
    bf16x8 qa=QRD(0), qb=QRD(1); SBAR(); float sacc=(P0[0]+P0[1]); \
    GAPA(C0=__builtin_amdgcn_mfma_f32_32x32x16_bf16(kf[0],qa,zero16,0,0,0), P0[2],P0[3],P0[4],P0[5],     pw0[0]=PKW(P0,0), pw0[1]=PKW(P0,2), pw0); \
    GAPA(C1=__builtin_amdgcn_mfma_f32_32x32x16_bf16(kf[1],qa,zero16,0,0,0), P0[6],P0[7],P0[8],P0[9],     pw0[2]=PKW(P0,4), pw0[3]=PKW(P0,6), pw0); \
    qa=QRD(2); SBAR(); \
    GAPA(C0=__builtin_amdgcn_mfma_f32_32x32x16_bf16(kf[2],qb,C0,0,0,0),   P0[10],P0[11],P0[12],P0[13], pw1[0]=PKW(P0,8), pw1[1]=PKW(P0,10), pw1); \
    GAPA(C1=__builtin_amdgcn_mfma_f32_32x32x16_bf16(kf[3],qb,C1,0,0,0),   P0[14],P0[15],P1[0],P1[1],   pw1[2]=PKW(P0,12),pw1[3]=PKW(P0,14), pw1); \
    qb=QRD(3); SBAR(); \
    GAPA(C0=__builtin_amdgcn_mfma_f32_32x32x16_bf16(kf[4],qa,C0,0,0,0),   P1[2],P1[3],P1[4],P1[5],     pw2[0]=PKW(P1,0), pw2[1]=PKW(P1,2), pw2); \
    GAPA(C1=__builtin_amdgcn_mfma_f32_32x32x16_bf16(kf[5],qa,C1,0,0,0),   P1[6],P1[7],P1[8],P1[9],     pw2[2]=PKW(P1,4), pw2[3]=PKW(P1,6), pw2); \
    GAPA(C0=__builtin_amdgcn_mfma_f32_32x32x16_bf16(kf[6],qb,C0,0,0,0),   P1[10],P1[11],P1[12],P1[13], pw3[0]=PKW(P1,8), pw3[1]=PKW(P1,10), pw3); \
    GAPA(C1=__builtin_amdgcn_mfma_f32_32x32x16_bf16(kf[7],qb,C1,0,0,0),   P1[14],P1[15],0.f,0.f,       pw3[2]=PKW(P1,12),pw3[3]=PKW(P1,14), pw3); \
    l_reg+=sacc; \
    if(GK){DMA_K((t)+3,sl_cur);} if(GV){DMA_V((t)+1,sl_next);} \
    VRDG(0); VRDG(1); \
    CMASK(C0,C1,t); \
    { float a=MX3(C0[0],C0[1],C1[0]),b=MX3(C0[2],C0[3],C1[1]); a=MX3(a,C1[2],C1[3]); \
      _Pragma("unroll") for(int r=4;r<16;r+=4){a=MX3(a,C0[r],C0[r+1]);b=MX3(b,C0[r+2],C0[r+3]);a=MX3(a,C1[r],C1[r+1]);b=MX3(b,C1[r+2],C1[r+3]);} \
      float rm=__builtin_fmaxf(a,b); { auto rr=__builtin_amdgcn_permlane32_swap(__float_as_uint(rm),__float_as_uint(rm),false,false); rm=__builtin_fmaxf(__uint_as_float(rr[0]),__uint_as_float(rr[1])); } \
      rm-=mhat; resc=false; \
      if(__builtin_expect(__any(rm>(float)THRL),0)){ const float dl=__builtin_fmaxf(rm,0.f); mhat+=dl; \
        const float f=__builtin_amdgcn_exp2f(-dl); l_reg*=f; if(hi==0)wsf[r32]=f; resc=true; } } \
    SBAR(); \
    PVG(0,PAF(0),C0,0);  VRDG(2); \
    PVG(1,PAF(0),C0,2);  VRDG(3); \
    PVG(2,PAF(0),C0,4);  VRDG(4); \
    PVG(3,PAF(0),C0,6);  VRDG(5); \
    PVG(4,PAF(1),C0,8);  VRDG(6); \
    PVG(5,PAF(1),C0,10); VRDG(7); \
    PVG(6,PAF(1),C0,12); VRDG(8); \
    PVG(7,PAF(1),C0,14); VRDG(9); \
    PVG(8,PAF(2),C1,0);  VRDG(10); \
    PVG(9,PAF(2),C1,2);  VRDG(11); \
    PVG(10,PAF(2),C1,4); VRDG(12); \
    PVG(11,PAF(2),C1,6); VRDG(13); \
    PVG(12,PAF(3),C1,8); VRDG(14); KRD(GL,0); \
    PVG(13,PAF(3),C1,10); VRDG(15); KRD(GL,1); \
    PVG(14,PAF(3),C1,12); KRD(GL,2); \
    PVG(15,PAF(3),C1,14); KRD(GL,3); \
    }while(0)
  int t=1;
  #undef CMASK
  #define CMASK(P0,P1,t) do{}while(0)
  for(;t+5<NT;t+=2){
    STEP(pB0,pB1,pA0,pA1,t,true,true,true);     WAIT_BAR(3); RESC(); ROT();
    STEP(pA0,pA1,pB0,pB1,t+1,true,true,true);   WAIT_BAR(3); RESC(); ROT();
  }
  #undef CMASK
  #define CMASK(P0,P1,t) do{int jb_=(t)-(NT-4); if(jb_>=0)cmask(P0,P1,jb_,qrel,hi);}while(0)
  #define ENDW(tt) do{ if((tt)+3<NT){WAIT_BAR(3);} else if((tt)+2<NT){WAIT_BAR(2);} else {WAIT_BAR(0);} }while(0)
  for(;t+1<NT;t+=2){
    STEP(pB0,pB1,pA0,pA1,t,(t+3<NT),(t+1<NT),(t+1<NT));       ENDW(t);   RESC(); ROT();
    STEP(pA0,pA1,pB0,pB1,t+1,(t+4<NT),(t+2<NT),(t+2<NT));     ENDW(t+1); RESC(); ROT();
  }
  STEP(pB0,pB1,pA0,pA1,NT-1,false,false,false); RESC();
  { float sacc=pB0[0]+pB0[1]; _Pragma("unroll") for(int r=2;r<16;++r)sacc+=pB0[r]; _Pragma("unroll") for(int r=0;r<16;++r)sacc+=pB1[r]; l_reg+=sacc;
    pw0=(u32x4){PKW(pB0,0),PKW(pB0,2),PKW(pB0,4),PKW(pB0,6)};pw1=(u32x4){PKW(pB0,8),PKW(pB0,10),PKW(pB0,12),PKW(pB0,14)};pw2=(u32x4){PKW(pB1,0),PKW(pB1,2),PKW(pB1,4),PKW(pB1,6)};pw3=(u32x4){PKW(pB1,8),PKW(pB1,10),PKW(pB1,12),PKW(pB1,14)};
    SBAR(); pv(o,vb0+2*sl_cur,PAF(0),PAF(1),PAF(2),PAF(3)); }
  #undef PKW
  #undef PAF
  #undef VFS
  #undef VRDG
  #undef QRD
  #undef PVG
  #undef PIN
  #undef MX3
  #undef GAPA
  #undef GAPB
  #undef EX
  #undef KRD
  #undef STEP
  #undef ENDW
  { int lane_e=mk_lane(); asm volatile("":"+v"(lane_e)); const int lane=lane_e,r32=lane&31,hi=lane>>5;
  {auto rr=__builtin_amdgcn_permlane32_swap(__float_as_uint(l_reg),__float_as_uint(l_reg),false,false);l_reg=__uint_as_float(rr[0])+__uint_as_float(rr[1]);}
  if(hi==0)wsf[32+r32]=l_reg;asm volatile("s_waitcnt lgkmcnt(0)":::"memory");
  float rli[16];
  #pragma unroll
  for(int r=0;r<16;++r)rli[r]=__builtin_amdgcn_rcpf(wsf[32+crow(r,hi)]);
  bf16*Ow=O+(rowbase+q0+wid*QBLK)*PO+ooff;
  { bf16*stg=(bf16*)(shm+LDS_OST)+wid*4096;
    #pragma unroll
    for(int r=0;r<16;++r){const int orow=crow(r,hi);
      #pragma unroll
      for(int d0=0;d0<4;++d0)stg[orow*128+d0*32+r32]=__float2bfloat16(o[d0][r]*rli[r]);}
    asm volatile("s_waitcnt lgkmcnt(0)":::"memory");
    if(map==0){
      #pragma unroll
      for(int i=0;i<8;++i){const int row=i*4+(lane>>4),ch=lane&15; const u32x4 v=*(const u32x4*)(stg+row*128+ch*8); ATTN_STORE16(Ow+(long)row*PO+ch*8,v);}
    }else{
      const int ch=lane&15; const float4 g0=*reinterpret_cast<const float4*>(ng+ch*8),g1=*reinterpret_cast<const float4*>(ng+ch*8+4);
      bf16*Aw=AOUT+(rowbase+q0+wid*QBLK)*PA+ooff;
      #pragma unroll
      for(int i=0;i<8;++i){const int row=i*4+(lane>>4); const u32x4 v2=*(const u32x4*)(stg+row*128+ch*8); const u32x4 v1=*(const u32x4*)(Ow+(long)row*PO+ch*8);
        float d[8];
        #define BLO(w) __uint_as_float((w)<<16)
        #define BHI(w) __uint_as_float((w)&0xffff0000u)
        d[0]=BLO(v1[0])-lam*BLO(v2[0]);d[1]=BHI(v1[0])-lam*BHI(v2[0]);d[2]=BLO(v1[1])-lam*BLO(v2[1]);d[3]=BHI(v1[1])-lam*BHI(v2[1]);
        d[4]=BLO(v1[2])-lam*BLO(v2[2]);d[5]=BHI(v1[2])-lam*BHI(v2[2]);d[6]=BLO(v1[3])-lam*BLO(v2[3]);d[7]=BHI(v1[3])-lam*BHI(v2[3]);
        #undef BLO
        #undef BHI
        float ss=0.f;
        #pragma unroll
        for(int q=0;q<8;++q)ss+=d[q]*d[q];
        ss+=__shfl_xor(ss,1);ss+=__shfl_xor(ss,2);ss+=__shfl_xor(ss,4);ss+=__shfl_xor(ss,8);
        const float sc=0.8f/sqrtf(ss*(1.f/128.f)+1e-6f);
        u32x4 w; w[0]=cvtpk_s(d[0]*sc*g0.x,d[1]*sc*g0.y);w[1]=cvtpk_s(d[2]*sc*g0.z,d[3]*sc*g0.w);w[2]=cvtpk_s(d[4]*sc*g1.x,d[5]*sc*g1.y);w[3]=cvtpk_s(d[6]*sc*g1.z,d[7]*sc*g1.w);
        __builtin_nontemporal_store(w,(u32x4*)(Aw+(long)row*PA+ch*8));}
    } }
  }
  asm volatile("s_waitcnt lgkmcnt(0)\n\ts_barrier":::"memory");
  #undef DMA_K
  #undef DMA_V
  #undef CMASK
  #undef START
  #undef RESC
  #undef ROT
}
constexpr int ATTN_LDS_BYTES=LDS_BYTES;
#undef SBAR
#undef WAIT_BAR
}
#define GAS __attribute__((address_space(1)))
#define LAS __attribute__((address_space(3)))
typedef unsigned short bf16;
typedef unsigned v4u __attribute__((ext_vector_type(4)));
typedef float f32x4 __attribute__((ext_vector_type(4)));
typedef short bf16x8 __attribute__((ext_vector_type(8)));
typedef GAS unsigned gu32;
typedef GAS unsigned long long gu64;
#define RLX_AGENT __ATOMIC_RELAXED, __HIP_MEMORY_SCOPE_AGENT
#define LDS_WAIT() asm volatile("s_waitcnt lgkmcnt(0)" ::: "memory")
#define VM_WAIT() asm volatile("s_waitcnt vmcnt(0)" ::: "memory")
__device__ __forceinline__ unsigned long long rt() { return __builtin_amdgcn_s_memrealtime(); }
__device__ __forceinline__ unsigned f2bf(float f) { unsigned u = __builtin_bit_cast(unsigned, f); return (u + 0x7fffu + ((u >> 16) & 1u)) >> 16; }
__device__ __forceinline__ unsigned pk2(float lo, float hi) { return f2bf(lo) | (f2bf(hi) << 16); }

#define XB_TMO      128
#define XB_XCNT(j)  (256  + 64 * (j))
#define XB_XSUB(j)  (1280 + 64 * (j))
#define XB_XGEN(j)  (2304 + 64 * (j))
#define XB_TOP      3328
#define XB_TOPGEN   3392
#define XCD_BAR_WORDS 3456
#define XB_SPIN_CAP (1u << 18)

__device__ __forceinline__ unsigned xb_ld(unsigned* p)              { return __hip_atomic_load(p, __ATOMIC_RELAXED, __HIP_MEMORY_SCOPE_AGENT); }
__device__ __forceinline__ unsigned xb_add(unsigned* p, unsigned v) { return __hip_atomic_fetch_add(p, v, __ATOMIC_RELAXED, __HIP_MEMORY_SCOPE_AGENT); }
__device__ __forceinline__ unsigned xb_xcc_id() { return (unsigned)__builtin_amdgcn_s_getreg((3 << 11) | 20) & 0xFu; }
#define XB_SPIN(cond, bar) do { unsigned _sp = 0; while (cond) { __builtin_amdgcn_s_sleep(1); \
    if ((++_sp & 255u) == 0u) { if (xb_ld(&(bar)[XB_TMO])) break; if (_sp > XB_SPIN_CAP) { atomicAdd(&(bar)[XB_TMO], 1u); break; } } } } while (0)

struct XcdBarrier {
    unsigned* bar; unsigned x; int wave; unsigned G;
    volatile LAS unsigned* st;
};

__device__ __forceinline__ XcdBarrier xcd_barrier_post(unsigned* bar, volatile LAS unsigned* st, int wave, unsigned G) {
    XcdBarrier b; b.bar = bar; b.x = xb_xcc_id(); b.st = st; b.wave = wave; b.G = G;
    if (wave == 0 && mk_lane() == 0) (void)xb_add(&bar[XB_XCNT(b.x)], 1u);
    return b;
}
__device__ __forceinline__ void xcd_barrier_complete(unsigned* bar, unsigned x, unsigned& nloc, unsigned& nx, const unsigned G) {
    unsigned sum, cnt, mine, sp = 0u;
    for (;;) {
        sum = 0u; cnt = 0u; mine = 0u;
#pragma unroll
        for (unsigned j = 0; j < 16; ++j) { const unsigned c = xb_ld(&bar[XB_XCNT(j)]); sum += c; cnt += (c > 0u) ? 1u : 0u; mine = (j == x) ? c : mine; }
        if (sum == G) break;
        __builtin_amdgcn_s_sleep(1);
        if ((++sp & 255u) == 0u) { if (xb_ld(&bar[XB_TMO])) break; if (sp > XB_SPIN_CAP) { atomicAdd(&bar[XB_TMO], 1u); break; } }
    }
    nloc = mine > 0u ? mine : 1u; nx = cnt > 0u ? cnt : 1u;
}

__device__ __forceinline__ void xcd_barrier(const XcdBarrier& b) {
    asm volatile("s_waitcnt vmcnt(0)" ::: "memory");
    __syncthreads();
    if (b.wave == 0 && mk_lane() == 0) {
        unsigned* bar = b.bar;
        __builtin_amdgcn_s_waitcnt(0);
        unsigned nloc = b.st[0], nx = b.st[1];
        if (nloc == 0u) { xcd_barrier_complete(bar, b.x, nloc, nx, b.G); b.st[0] = nloc; b.st[1] = nx; }
        const unsigned old = xb_add(&bar[XB_XSUB(b.x)], 1u);
        const unsigned gen = old / nloc;
        if (old + 1u == (gen + 1u) * nloc) {
            __builtin_amdgcn_fence(__ATOMIC_RELEASE, "agent");
            asm volatile("s_waitcnt vmcnt(0)" ::: "memory");
            const unsigned og = xb_add(&bar[XB_TOP], 1u);
            const unsigned tg = og / nx;
            if (og + 1u == (tg + 1u) * nx) xb_add(&bar[XB_TOPGEN], 1u);
            else XB_SPIN(xb_ld(&bar[XB_TOPGEN]) == tg, bar);
            __builtin_amdgcn_fence(__ATOMIC_ACQUIRE, "agent");
            xb_add(&bar[XB_XGEN(b.x)], 1u);
            asm volatile("s_waitcnt vmcnt(0)" ::: "memory");
        } else {
            XB_SPIN(xb_ld(&bar[XB_XGEN(b.x)]) == gen, bar);
            __builtin_amdgcn_fence(__ATOMIC_ACQUIRE, "agent");
            asm volatile("s_waitcnt vmcnt(0)" ::: "memory");
        }
    }
    __syncthreads();
}
constexpr int NWAVES = 8;
#ifndef MK_N_LAUNCHES
#define MK_N_LAUNCHES 1
#endif
constexpr int NPH = 12;
constexpr int N_LAUNCHES = MK_N_LAUNCHES;
static_assert(N_LAUNCHES == 1 || N_LAUNCHES == NPH, "MK_N_LAUNCHES is 1 or 12");

constexpr int NB = 4, SEQ = 8192, T = NB * SEQ, D = 1024;
constexpr int NE = 32, TOPK = 4, NA = T * TOPK;
constexpr int SG = 32, SL = 32, AROW_P = 640;
constexpr float RMS_EPS = 1e-6f;
constexpr float SW_LIMIT = 7.0f, SW_ALPHA = 1.702f;
constexpr float LAMBDA_INIT = 0.2f;

constexpr size_t MiB = 1u << 20;
constexpr size_t WS_CTL = 0, CTL_ZERO_BYTES = 128 * 1024;
constexpr size_t WS_ROPE = 2 * MiB;
constexpr size_t WS_WIN = 4 * MiB;
constexpr size_t WS_WOUT = 8 * MiB;
constexpr size_t WS_WGLU = 10 * MiB;
constexpr size_t WS_SMALL = 11 * MiB;
constexpr size_t SM_AL = 1024, SM_WR = 32768;
constexpr size_t WS_BTY = 12 * MiB;
constexpr size_t WS_BTX = 32 * MiB;
constexpr size_t WS_WGU = 40 * MiB;
constexpr size_t WS_WD = 168 * MiB;
constexpr size_t WS_XN = 232 * MiB;
constexpr size_t WS_Q = 296 * MiB, WS_K = 328 * MiB, WS_V = 360 * MiB;
constexpr size_t WS_AROW = 392 * MiB;
constexpr size_t WS_XLOC = 432 * MiB;
constexpr size_t WS_O = 464 * MiB;
constexpr size_t WS_MIX = 464 * MiB;
constexpr size_t WS_ACAT = 528 * MiB;
constexpr size_t WS_HB = 528 * MiB;
constexpr size_t WS_YG = 592 * MiB;
constexpr size_t WS_GLU = 624 * MiB;
constexpr size_t WS_LIST = 656 * MiB;
constexpr size_t WS_GATES = 660 * MiB;
constexpr size_t WS_ACT = 296 * MiB;
constexpr size_t WS_YBUF = 664 * MiB;
constexpr size_t WS_END = 920 * MiB;
static_assert(WS_ACT + (size_t)(NA + 8192) * 1024 * 2 <= WS_YG, "Act overlay");
constexpr int CW_TMO = 0, CW_CODE = 1;
constexpr int CW_BAR = 4096;
constexpr int CW_ECNT = 16384;

constexpr int RING_OFF = 0, RING_BYTES = 131072;
constexpr int WRT_BYTES = 1024 * 36 * 4;
constexpr int LDSCTL_OFF = 147456, MISC_OFF = LDSCTL_OFF;
constexpr int MOE_OFF = LDSCTL_OFF + 256;
constexpr int RT_OFF = LDSCTL_OFF + 640;
constexpr int ST_OFF = LDSCTL_OFF + 1024;
constexpr int EPB_OFF = 131072;
constexpr int LDS_BYTES = 157696;
static_assert(ST_OFF + 8192 <= LDS_BYTES, "LDS map");

struct Args { const void* in[29]; float* out; unsigned char* ws; int ph_lo, ph_hi, li, pad; };
struct Frame {
    LAS unsigned char* lds;
    volatile LAS unsigned* MISC;
    gu32* ctl;
    int wave;
    int vcu, G;
};
#define INF(a, k) ((const float*)(a).in[k])
#define FTID(F) ((F).wave * 64 + mk_lane())
#ifndef PROBE_DUP
#define PROBE_DUP -1
#endif
#define NREP(k) ((PROBE_DUP == (k)) ? 2 : 1)

__device__ __forceinline__ unsigned pk_fp8x4_(float a, float b, float c, float d) { int w = 0; w = __builtin_amdgcn_cvt_pk_fp8_f32(a, b, w, false); w = __builtin_amdgcn_cvt_pk_fp8_f32(c, d, w, true); return (unsigned)w; }
__device__ __forceinline__ float wave_sum(float v) {
#pragma unroll
    for (int o = 1; o < 64; o <<= 1) v += __shfl_xor(v, o);
    return v;
}
template <bool FP8> __device__ __forceinline__ void p0_tr64(const float* W, int K, int N, void* WT, LAS float* scr, int item, int lane, float scale) {
    const int nblk = N / 64, kb = item / nblk, nb = item % nblk, k0 = 64 * kb, n0 = 64 * nb;
    f32x4 v[16];
#pragma unroll
    for (int i = 0; i < 16; ++i) v[i] = __builtin_nontemporal_load((const GAS f32x4*)(W + (size_t)(k0 + i * 4 + (lane >> 4)) * N + n0 + 4 * (lane & 15)));
#pragma unroll
    for (int i = 0; i < 16; ++i) *(LAS f32x4*)(scr + (i * 4 + (lane >> 4)) * 68 + 4 * (lane & 15)) = v[i];
    LDS_WAIT(); asm volatile("" ::: "memory");
    if constexpr (FP8) {
#pragma unroll
        for (int c = 0; c < 4; ++c) { const LAS float* s = scr + (16 * c) * 68 + lane; v4u o;
            o.x = pk_fp8x4_(s[0 * 68] * scale, s[1 * 68] * scale, s[2 * 68] * scale, s[3 * 68] * scale); o.y = pk_fp8x4_(s[4 * 68] * scale, s[5 * 68] * scale, s[6 * 68] * scale, s[7 * 68] * scale);
            o.z = pk_fp8x4_(s[8 * 68] * scale, s[9 * 68] * scale, s[10 * 68] * scale, s[11 * 68] * scale); o.w = pk_fp8x4_(s[12 * 68] * scale, s[13 * 68] * scale, s[14 * 68] * scale, s[15 * 68] * scale);
            *(GAS v4u*)((unsigned char*)WT + (size_t)(n0 + lane) * K + k0 + 16 * c) = o; }
    } else {
#pragma unroll
        for (int c = 0; c < 8; ++c) { const LAS float* s = scr + (8 * c) * 68 + lane;
            v4u o; o.x = pk2(s[0 * 68], s[1 * 68]); o.y = pk2(s[2 * 68], s[3 * 68]); o.z = pk2(s[4 * 68], s[5 * 68]); o.w = pk2(s[6 * 68], s[7 * 68]);
            *(GAS v4u*)((bf16*)WT + (size_t)(n0 + lane) * K + k0 + 8 * c) = o; }
    }
    LDS_WAIT(); asm volatile("" ::: "memory");
}
__device__ __forceinline__ void cv_wg_item(Frame& F, const Args& a, const int item, const int lane) {
    const float* W; unsigned char* WT; int N, n0, k0;
    if (item < 512) { const int e = item >> 4, r = item & 15; N = 2048; W = INF(a, 24) + (size_t)e * 1024 * 2048; WT = a.ws + WS_WGU + (size_t)e * 2048 * 1024; n0 = (r >> 3) * 1024; k0 = (r & 7) * 128; }
    else { const int i2 = item - 512, e = i2 >> 3; N = 1024; W = INF(a, 26) + (size_t)e * 1024 * 1024; WT = a.ws + WS_WD + (size_t)e * 1024 * 1024; n0 = 0; k0 = (i2 & 7) * 128; }
    LAS unsigned char* tile = F.lds;
    const float* wp = W + (size_t)(k0 + 16 * F.wave) * N + n0 + 4 * lane;
    f32x4 va[4][4], vb[4][4];
#define CVW_LOAD(v, grp) do { _Pragma("unroll") for (int ch = 0; ch < 4; ++ch) _Pragma("unroll") for (int q = 0; q < 4; ++q) v[ch][q] = __builtin_nontemporal_load((const GAS f32x4*)(wp + (size_t)(4 * (grp) + q) * N + ch * 256)); } while (0)
#define CVW_PUT(v, grp) do { _Pragma("unroll") for (int ch = 0; ch < 4; ++ch) _Pragma("unroll") for (int j = 0; j < 4; ++j) \
        *(LAS unsigned*)(tile + (ch * 256 + 4 * lane + j) * 144 + 16 * F.wave + 4 * (grp)) = pk_fp8x4_(v[ch][0][j] * 32.f, v[ch][1][j] * 32.f, v[ch][2][j] * 32.f, v[ch][3][j] * 32.f); } while (0)
    CVW_LOAD(va, 0); CVW_LOAD(vb, 1); CVW_PUT(va, 0); CVW_LOAD(va, 2); CVW_PUT(vb, 1); CVW_LOAD(vb, 3); CVW_PUT(va, 2); CVW_PUT(vb, 3);
#undef CVW_LOAD
#undef CVW_PUT
    __syncthreads();
#pragma unroll
    for (int i = 0; i < 16; ++i) { const int row = F.wave * 128 + i * 8 + (lane >> 3), c = lane & 7;
        const v4u val = *(const LAS v4u*)(tile + row * 144 + 16 * c);
        __builtin_nontemporal_store(val, (GAS v4u*)(WT + (size_t)(n0 + row) * 1024 + k0 + 16 * c)); }
    __syncthreads();
}
__device__ __forceinline__ void rms_row_to_bf16(int lane, const float* xrow, const float* g, bf16* orow) {
    const GAS f32x4* xr = (const GAS f32x4*)xrow + lane; const GAS f32x4* gr = (const GAS f32x4*)g + lane;
    f32x4 v[4]; float s = 0.f;
#pragma unroll
    for (int j = 0; j < 4; ++j) { v[j] = __builtin_nontemporal_load(xr + 64 * j); s += (v[j].x * v[j].x + v[j].y * v[j].y) + (v[j].z * v[j].z + v[j].w * v[j].w); }
    const float rstd = 1.f / sqrtf(wave_sum(s) * (1.f / D) + RMS_EPS);
    GAS unsigned long long* o8 = (GAS unsigned long long*)orow + lane;
#pragma unroll
    for (int j = 0; j < 4; ++j) { const f32x4 gg = gr[64 * j];
        o8[64 * j] = (unsigned long long)pk2(v[j].x * rstd * gg.x, v[j].y * rstd * gg.y) | ((unsigned long long)pk2(v[j].z * rstd * gg.z, v[j].w * rstd * gg.w) << 32); }
}

__device__ __forceinline__ void s5_setup(Frame& F, const Args& a, int g, int sp) {
    LAS float* L = (LAS float*)F.lds;
    LAS float* APr = L, *APi = L + 2112, *BBr = L + 4224, *BBi = L + 5248, *CCr = L + 6272, *CCi = L + 7296, *KT = L + 8320;
    const int tid = FTID(F);
    const float* dsk = INF(a, 15);
    if (tid < 64) {
        const int n = tid;
        const float dt = expf(INF(a, 16)[g]);
        const float lre = INF(a, 9)[g * 64 + n], lim = INF(a, 10)[g * 64 + n];
        const float mag = expf(lre * dt); float sn, cs; sincosf(lim * dt, &sn, &cs);
        const float ar = mag * cs, ai = mag * sn;
        const float nr = ar - 1.f, ni = ai, den = lre * lre + lim * lim;
        const float cr = (nr * lre + ni * lim) / den, ci = (ni * lre - nr * lim) / den;
        float pr = 1.f, pi = 0.f;
        for (int tau = 0; tau <= 32; ++tau) { APr[tau * 64 + n] = pr; APi[tau * 64 + n] = pi; const float t0 = pr * ar - pi * ai, t1 = pr * ai + pi * ar; pr = t0; pi = t1; }
        const float* bre = INF(a, 11) + (size_t)(g * 64 + n) * 16; const float* bim = INF(a, 12) + (size_t)(g * 64 + n) * 16;
        for (int c = 0; c < 16; ++c) { const float br = bre[c], bi = bim[c]; BBr[n * 16 + c] = cr * br - ci * bi; BBi[n * 16 + c] = cr * bi + ci * br; }
    }
    for (int i = tid; i < 1024; i += 512) { CCr[i] = INF(a, 13)[g * 1024 + i]; CCi[i] = INF(a, 14)[g * 1024 + i]; }
    __syncthreads();
    {
        const int pair = tid & 255, c = pair >> 4, cp = pair & 15, tau0 = (tid >> 8) * 16;
        float zr[64], zi[64];
#pragma unroll
        for (int n = 0; n < 64; ++n) { const float cr_ = CCr[c * 64 + n], ci_ = CCi[c * 64 + n], br = BBr[n * 16 + cp], bi = BBi[n * 16 + cp]; zr[n] = cr_ * br - ci_ * bi; zi[n] = cr_ * bi + ci_ * br; }
        for (int tau = tau0; tau < tau0 + 16; ++tau) {
            const LAS f32x4* pr4 = (const LAS f32x4*)(APr + tau * 64); const LAS f32x4* pi4 = (const LAS f32x4*)(APi + tau * 64);
            float s0 = 0.f, s1 = 0.f;
#pragma unroll
            for (int q = 0; q < 16; ++q) { const f32x4 r4 = pr4[q], i4 = pi4[q];
                s0 += zr[4 * q] * r4[0] - zi[4 * q] * i4[0]; s1 += zr[4 * q + 1] * r4[1] - zi[4 * q + 1] * i4[1];
                s0 += zr[4 * q + 2] * r4[2] - zi[4 * q + 2] * i4[2]; s1 += zr[4 * q + 3] * r4[3] - zi[4 * q + 3] * i4[3]; }
            KT[tau * 256 + pair] = s0 + s1;
        }
    }
    __syncthreads();
    bf16* BtY = (bf16*)(a.ws + WS_BTY); bf16* BtX = (bf16*)(a.ws + WS_BTX);
    if (tid < 480) {
        const int cg = tid % 80, rb = tid / 80;
        GAS v4u* dst = (GAS v4u*)(BtY + ((size_t)(g * 512 + 4 * sp * 16) * 640 + 8 * cg));
        if (cg < 16) {
            const int n0 = (8 * cg) & 63; const bool im = cg >= 8;
            for (int rl = rb; rl < 64; rl += 6) { const int t = 4 * sp + (rl >> 4), c = rl & 15;
                const LAS f32x4* cr4 = (const LAS f32x4*)(CCr + c * 64 + n0); const LAS f32x4* ci4 = (const LAS f32x4*)(CCi + c * 64 + n0);
                const LAS f32x4* ar4 = (const LAS f32x4*)(APr + (t + 1) * 64 + n0); const LAS f32x4* ai4 = (const LAS f32x4*)(APi + (t + 1) * 64 + n0);
                v4u w;
#pragma unroll
                for (int h = 0; h < 2; ++h) { const f32x4 cr = cr4[h], ci = ci4[h], ar = ar4[h], ai = ai4[h];
                    const f32x4 v = im ? -(cr * ai + ci * ar) : (cr * ar - ci * ai);
                    if (h == 0) { w.x = pk2(v[0], v[1]); w.y = pk2(v[2], v[3]); } else { w.z = pk2(v[0], v[1]); w.w = pk2(v[2], v[3]); } }
                dst[(size_t)rl * 80] = w; }
        } else {
            const int col0 = 8 * cg - 128, s_ = col0 >> 4, cp0 = col0 & 15;
            for (int rl = rb; rl < 64; rl += 6) { const int t = 4 * sp + (rl >> 4), c = rl & 15;
                f32x4 v0 = {0.f, 0.f, 0.f, 0.f}, v1 = v0;
                if (s_ <= t) { const LAS f32x4* k4 = (const LAS f32x4*)(KT + (t - s_) * 256 + c * 16 + cp0); v0 = k4[0]; v1 = k4[1];
                    if (s_ == t && (c >> 3) == (cp0 >> 3)) { const float dd = dsk[g * 16 + c]; const int q = c & 7;
                        v0[0] += q == 0 ? dd : 0.f; v0[1] += q == 1 ? dd : 0.f; v0[2] += q == 2 ? dd : 0.f; v0[3] += q == 3 ? dd : 0.f;
                        v1[0] += q == 4 ? dd : 0.f; v1[1] += q == 5 ? dd : 0.f; v1[2] += q == 6 ? dd : 0.f; v1[3] += q == 7 ? dd : 0.f; } }
                v4u w; w.x = pk2(v0[0], v0[1]); w.y = pk2(v0[2], v0[3]); w.z = pk2(v1[0], v1[1]); w.w = pk2(v1[2], v1[3]);
                dst[(size_t)rl * 80] = w; }
        }
    }
    { const int cg = tid & 63, s_ = cg >> 1, cp0 = (cg & 1) * 8, rb = tid >> 6;
      GAS v4u* dst = (GAS v4u*)(BtX + ((size_t)(g * 256 + 32 * sp) * 512 + 8 * cg));
#pragma unroll
      for (int i = 0; i < 4; ++i) { const int r = rb + 8 * i, j = 32 * sp + r; f32x4 v0 = {0.f, 0.f, 0.f, 0.f}, v1 = v0;
          if (j < 128) { const int n = j & 63; const float apr = APr[(31 - s_) * 64 + n], api = APi[(31 - s_) * 64 + n];
              const LAS f32x4* br4 = (const LAS f32x4*)(BBr + n * 16 + cp0); const LAS f32x4* bi4 = (const LAS f32x4*)(BBi + n * 16 + cp0);
              const f32x4 br0 = br4[0], br1 = br4[1], bi0 = bi4[0], bi1 = bi4[1];
              if (j < 64) { v0 = br0 * apr - bi0 * api; v1 = br1 * apr - bi1 * api; } else { v0 = bi0 * apr + br0 * api; v1 = bi1 * apr + br1 * api; } }
          v4u w; w.x = pk2(v0[0], v0[1]); w.y = pk2(v0[2], v0[3]); w.z = pk2(v1[0], v1[1]); w.w = pk2(v1[2], v1[3]);
          dst[(size_t)r * 64] = w; } }
    if (sp == 0 && tid < 64) { float* AL = (float*)(a.ws + WS_SMALL + SM_AL); AL[(g * 64 + tid) * 2] = APr[32 * 64 + tid]; AL[(g * 64 + tid) * 2 + 1] = APi[32 * 64 + tid]; }
    __syncthreads();
}

__device__ __forceinline__ void p0_prologue(Frame& F, const Args& a) {
    for (int rp = 0; rp < NREP(30); ++rp) for (int item = blockIdx.x; item < 256; item += F.G) s5_setup(F, a, item & 31, item >> 5);
    const int gt = blockIdx.x * (NWAVES * 64) + FTID(F), NGT = F.G * NWAVES * 64;
    if (blockIdx.x == 0 && F.wave == 0) {
        const float p1 = wave_sum(INF(a, 4)[mk_lane()] * INF(a, 5)[mk_lane()]), p2 = wave_sum(INF(a, 6)[mk_lane()] * INF(a, 7)[mk_lane()]);
        if (mk_lane() == 0) *(float*)(a.ws + WS_SMALL) = expf(p1) - expf(p2) + LAMBDA_INIT;
    }
    { float* WR = (float*)(a.ws + WS_SMALL + SM_WR);
      for (int i = gt; i < 1024 * 36; i += NGT) { const int k = i / 36, e = i % 36, p = ((k & 3) + 4 * (k >> 8)) * 64 + ((k >> 2) & 63);
          WR[p * 36 + e] = e < 32 ? INF(a, 21)[k] * INF(a, 22)[k * 32 + e] : 0.f; } }
    { float* RP = (float*)(a.ws + WS_ROPE); const int* pos = (const int*)a.in[1];
      for (int i = gt; i < T * 8; i += NGT) { const int m = i >> 3, j = i & 7;
          const float invf = j == 0 ? 1.0f : j == 1 ? 1.9392274e-01f : j == 2 ? 3.7606031e-02f : j == 3 ? 7.2926646e-03f : j == 4 ? 1.4142136e-03f : j == 5 ? 2.7424819e-04f : j == 6 ? 5.3182961e-05f : 1.0313386e-05f;
          const float ang = (float)pos[m] * invf; float sn, cs; sincosf(ang, &sn, &cs); RP[m * 16 + j] = cs; RP[m * 16 + 8 + j] = sn; } }
    LAS float* scr = (LAS float*)(F.lds + RING_OFF + F.wave * 17408);
    const int gw = F.vcu * NWAVES + F.wave, NGW = F.G * NWAVES;
    constexpr int I_IN = 16 * 32, I_OUT = 16 * 16, I_GLU = 8 * 8;
    constexpr int NITEMS = I_IN + I_OUT + I_GLU;
    for (int it = gw; it < NITEMS; it += NGW) {
        int r = it;
        if (r < I_IN) { p0_tr64<false>(INF(a, 3), 1024, 2048, a.ws + WS_WIN, scr, r, mk_lane(), 1.f); continue; } r -= I_IN;
        if (r < I_OUT) { p0_tr64<false>(INF(a, 20), 1024, 1024, a.ws + WS_WOUT, scr, r, mk_lane(), 1.f); continue; } r -= I_OUT;
        p0_tr64<false>(INF(a, 17), 512, 512, a.ws + WS_WGLU, scr, r, mk_lane(), 1.f);
    }
    __syncthreads();
    { int lane = mk_lane(); asm volatile("" : "+v"(lane));
      for (int rp = 0; rp < NREP(31); ++rp) for (int item = F.vcu; item < 768; item += F.G) cv_wg_item(F, a, item, lane); }
    for (int rp = 0; rp < NREP(32); ++rp) for (int m = gw; m < T; m += NGW) rms_row_to_bf16(mk_lane(), INF(a, 0) + (size_t)m * D, INF(a, 2), (bf16*)(a.ws + WS_XN) + (size_t)m * D);
}

struct DenseOrder {
    int nM, nN, nwg, G, c, nt; const char* A; const char* B; size_t strA, strB;
    __device__ __forceinline__ void init(int M, int N, int K, int lda, int ldb, const void* A_, const void* B_, int G_, int c_) {
        nM = M / 256; nN = N / 256; nwg = nM * nN; G = G_; c = c_; nt = K / 64; A = (const char*)A_; B = (const char*)B_; strA = (size_t)256 * lda * 2; strB = (size_t)256 * ldb * 2; }
    __device__ __forceinline__ bool next(int i, pg8::Unit& u) const {
        const long L = (long)i * G + c; if (L >= nwg) return false;
        int wgid = (int)L; { const int q = nwg / 8, r = nwg % 8, xcd = wgid % 8, off = wgid / 8; wgid = (xcd < r ? xcd * (q + 1) : r * (q + 1) + (xcd - r) * q) + off; }
        const int nig = 8 * nN, gid = wgid / nig, fm = gid * 8, gsz = (nM - fm) < 8 ? (nM - fm) : 8;
        u.pm = fm + ((wgid % nig) % gsz); u.pn = (wgid % nig) / gsz; u.a = A + (size_t)u.pm * strA; u.b = B + (size_t)u.pn * strB; u.nt = nt; u.x0 = 0; u.x1 = 0; return true;
    }
};
struct XOrder {
    int G, c; const char* AROW; const char* BTX;
    __device__ __forceinline__ bool next(int i, pg8::Unit& u) const {
        const int L = i * G + c; if (L >= 128) return false;
        const int g = L >> 2, pm = L & 3;
        u.pm = pm; u.pn = 0; u.x0 = g; u.x1 = 0; u.nt = 8;
        u.a = AROW + ((size_t)(g * 1024 + pm * 256) * AROW_P + 128) * 2; u.b = BTX + ((size_t)g * 256 * 512) * 2; return true;
    }
};
struct GluOrder {
    int rank; const char* A; const char* B;
    __device__ __forceinline__ bool next(int i, pg8::Unit& u) const {
        if (i >= 4) return false;
        u.pm = rank * 2 + (i >> 1); u.pn = i & 1; u.x0 = 0; u.x1 = 0; u.nt = 8;
        u.a = A + (size_t)u.pm * 256 * 1024; u.b = B + (size_t)u.pn * 256 * 1024; return true;
    }
};
struct YOrder {
    int G, c; const char* AROW; const char* BTY;
    __device__ __forceinline__ bool next(int i, pg8::Unit& u) const {
        const int L = i * G + c; if (L >= 256) return false;
        const int g = L >> 3, pm = (L >> 1) & 3, pn = L & 1;
        u.pm = pm; u.pn = pn; u.x0 = g; u.x1 = 0; u.nt = (128 + 256 * (pn + 1)) / 64;
        u.a = AROW + ((size_t)(g * 1024 + pm * 256) * AROW_P) * 2; u.b = BTY + ((size_t)(g * 512 + pn * 256) * AROW_P) * 2; return true;
    }
};
template <int RG  , int NC  >
struct MoeOrder {
    int G, c; const LAS int* tpre; const LAS int* cntE; const char* A; const char* B; size_t strBe;
    bool gatherA; int ntk;
    __device__ __forceinline__ bool next(int i, pg8::Unit& u) const {
        const int L = i * G + c, grp = L >> 5, w = L & 31, tt = grp * RG + (w % RG), pn = w / RG;
        const int NT = __builtin_amdgcn_readfirstlane(tpre[32]);
        if (tt >= NT) return false;
        const int e = __builtin_popcount((unsigned)__ballot(tpre[(mk_lane() & 31) + 1] <= tt));
        const int cnt = __builtin_amdgcn_readfirstlane(cntE[e]), t0 = __builtin_amdgcn_readfirstlane(tpre[e]);
        u.pm = tt; u.pn = pn; u.x0 = (tt - t0) * 256; u.x1 = e | (cnt << 8); u.nt = ntk;
        u.a = gatherA ? A : A + (size_t)tt * 256 * 1024; u.b = B + (size_t)e * strBe + (size_t)pn * 256 * 1024; return true;
    }
};
struct AGather {
    static constexpr bool PER_UNIT = true;
    const int* list;
    __device__ __forceinline__ void get(const pg8::Unit& u, unsigned (&v)[2][2], const int (&R)[2], const int (&C)[2]) const {
        const int e = u.x1 & 255, cnt = u.x1 >> 8;
#pragma unroll
        for (int h = 0; h < 2; ++h)
#pragma unroll
            for (int i = 0; i < 2; ++i) { const int slot = u.x0 + h * 128 + R[i]; const int sc = slot < cnt ? slot : 0;
                const int tok = list[(size_t)e * T + sc] >> 2; v[h][i] = (unsigned)(tok * 1024 + C[i] * 2); }
    }
    __device__ __forceinline__ size_t hstep() const { return 0; }
    __device__ __forceinline__ void issue_dma(const pg8::Unit& u, const int (&R)[2], const unsigned lds_dst) const {
        const int e = u.x1 & 255, cnt = u.x1 >> 8; const int* base = list + (size_t)e * T;
#pragma unroll
        for (int h = 0; h < 2; ++h)
#pragma unroll
            for (int i = 0; i < 2; ++i) { const int slot = u.x0 + h * 128 + R[i]; const unsigned so = (unsigned)(slot < cnt ? slot : 0) * 4u;
                pg8::glds4_sv(base, so, lds_dst + (unsigned)(2 * h + i) * 256u); }
    }
    __device__ __forceinline__ void finish(const int (&raw)[4], unsigned (&v)[2][2], const int (&C)[2]) const {
#pragma unroll
        for (int h = 0; h < 2; ++h)
#pragma unroll
            for (int i = 0; i < 2; ++i) v[h][i] = (unsigned)((raw[h * 2 + i] >> 2) * 1024 + C[i] * 2);
    }
};

using pg8::f32x2; using pg8::u32x4; using pg8::u32x2; using pg8::cvt_pk_bf16; using pg8::gelu_pk;
#define EPI_ARGS const f32x4 (&acc)[2][2][4][2], const pg8::Unit& u, int wr, int wc, int fr, int fq
__device__ __forceinline__ u32x4 pack8(const f32x4 v0, const f32x4 v1) { u32x4 w; w.x = cvt_pk_bf16(v0[0], v0[1]); w.y = cvt_pk_bf16(v0[2], v0[3]); w.z = cvt_pk_bf16(v1[0], v1[1]); w.w = cvt_pk_bf16(v1[2], v1[3]); return w; }
__device__ __forceinline__ float bf_lo(unsigned w) { return __uint_as_float(w << 16); }
__device__ __forceinline__ float bf_hi(unsigned w) { return __uint_as_float(w & 0xffff0000u); }

struct EpiInProj {
    static constexpr int BMODE = 1; static constexpr bool PREFETCH = false; static constexpr int NSTORE = 0, NPRE = 0;
    bf16 *Q, *K, *V, *AROW; const float* rope; float c2;
    __device__ __forceinline__ void operator()(EPI_ARGS) const {
        const int region = u.pn >> 1; const int colr = (u.pn & 1) * 256 + wc * 32 + 8 * fq;
        const bool dorope = (region <= 1) && ((wc & 1) == 0);
        const float sg = fq == 0 ? -1.f : 1.f; const bool rot = fq < 2;
#pragma unroll
        for (int ai = 0; ai < 2; ++ai) {
            f32x4 rp[4][4];
            if (dorope) {
#pragma unroll
                for (int m = 0; m < 4; ++m) { const f32x4* rr = (const f32x4*)(rope + (size_t)(u.pm * 256 + ai * 128 + wr * 64 + m * 16 + fr) * 16);
#pragma unroll
                    for (int q = 0; q < 4; ++q) rp[m][q] = rr[q]; }
            }
#pragma unroll
            for (int m = 0; m < 4; ++m) {
                const int row = u.pm * 256 + ai * 128 + wr * 64 + m * 16 + fr;
                f32x4 cs0 = {1.f, 1.f, 1.f, 1.f}, cs1 = cs0, sn0 = {0.f, 0.f, 0.f, 0.f}, sn1 = sn0;
                if (dorope) { cs0 = rot ? rp[m][0] : cs0; cs1 = rot ? rp[m][1] : cs1; sn0 = rot ? rp[m][2] * sg : sn0; sn1 = rot ? rp[m][3] * sg : sn1; }
#pragma unroll
                for (int bj = 0; bj < 2; ++bj) {
                    f32x4 v0 = acc[ai][bj][m][0], v1 = acc[ai][bj][m][1]; const int c = colr + bj * 128;
                    if (region <= 1) {
                        if (dorope) { f32x4 p0, p1;
#pragma unroll
                            for (int q = 0; q < 4; ++q) { p0[q] = __shfl_xor(v0[q], 16); p1[q] = __shfl_xor(v1[q], 16); }
                            v0 = v0 * cs0 + p0 * sn0; v1 = v1 * cs1 + p1 * sn1; }
                        if (region == 0) { v0 = v0 * c2; v1 = v1 * c2; }
                        *(u32x4*)((region == 0 ? Q : K) + (size_t)row * 512 + c) = pack8(v0, v1);
                    } else if (region == 2) {
                        *(u32x4*)(V + (size_t)row * 512 + c) = pack8(v0, v1);
                    } else {
                        const int g = c >> 4, cc = c & 15;
                        *(u32x4*)(AROW + ((size_t)(g * 1024 + (row >> 5)) * AROW_P + 128 + (row & 31) * 16 + cc)) = pack8(v0, v1);
                    }
                }
            }
        }
    }
};
struct EpiX {
    static constexpr int BMODE = 0; static constexpr bool PREFETCH = false; static constexpr int NSTORE = 0, NPRE = 0;
    float* X;
    __device__ __forceinline__ void operator()(EPI_ARGS) const {
        float* base = X + ((size_t)(u.x1 * 32 + u.x0) * 1024 + u.pm * 256) * 128;
#pragma unroll
        for (int ai = 0; ai < 2; ++ai)
#pragma unroll
            for (int m = 0; m < 4; ++m) { const int row = ai * 128 + wr * 64 + m * 16 + fr;
#pragma unroll
                for (int n = 0; n < 2; ++n) *(f32x4*)(base + (size_t)row * 128 + wc * 32 + 16 * n + 4 * fq) = acc[ai][0][m][n]; }
    }
};
struct EpiY {
    static constexpr int BMODE = 1; static constexpr bool PREFETCH = false; static constexpr int NSTORE = 0, NPRE = 0;
    bf16* YG;
    __device__ __forceinline__ void operator()(EPI_ARGS) const {
        const int g = u.x0;
#pragma unroll
        for (int ai = 0; ai < 2; ++ai)
#pragma unroll
            for (int m = 0; m < 4; ++m) { const int jj = u.pm * 256 + ai * 128 + wr * 64 + m * 16 + fr;
#pragma unroll
                for (int bj = 0; bj < 2; ++bj) { const int n0 = u.pn * 256 + bj * 128 + wc * 32 + 8 * fq, t = n0 >> 4, cc = n0 & 15;
                    const f32x4 v0 = acc[ai][bj][m][0], v1 = acc[ai][bj][m][1];
                    const f32x2 a = gelu_pk((f32x2){v0[0], v0[1]}), b = gelu_pk((f32x2){v0[2], v0[3]}), c = gelu_pk((f32x2){v1[0], v1[1]}), d = gelu_pk((f32x2){v1[2], v1[3]});
                    u32x4 w; w.x = cvt_pk_bf16(a.x, a.y); w.y = cvt_pk_bf16(b.x, b.y); w.z = cvt_pk_bf16(c.x, c.y); w.w = cvt_pk_bf16(d.x, d.y);
                    *(u32x4*)(YG + (size_t)(jj * 32 + t) * 512 + g * 16 + cc) = w; } }
    }
};
__device__ __forceinline__ float sigmoidf_(float z) { return __builtin_amdgcn_rcpf(1.f + __builtin_amdgcn_exp2f(-1.4426950408889634f * z)); }
struct EpiGlu {
    static constexpr int BMODE = 1; static constexpr bool PREFETCH = false; static constexpr int NSTORE = 0, NPRE = 0;
    const bf16* YG; bf16* GLU; const float* bias;
    __device__ __forceinline__ void operator()(EPI_ARGS) const {
        const int c00 = u.pn * 256 + wc * 32 + 8 * fq;
        f32x4 bv[2][2];
#pragma unroll
        for (int bj = 0; bj < 2; ++bj) { bv[bj][0] = *(const f32x4*)(bias + c00 + bj * 128); bv[bj][1] = *(const f32x4*)(bias + c00 + bj * 128 + 4); }
#pragma unroll
        for (int ai = 0; ai < 2; ++ai)
#pragma unroll
            for (int m = 0; m < 4; ++m) { const int row = u.pm * 256 + ai * 128 + wr * 64 + m * 16 + fr;
#pragma unroll
                for (int bj = 0; bj < 2; ++bj) { const int c = c00 + bj * 128;
                    const f32x4 z0 = acc[ai][bj][m][0] + bv[bj][0], z1 = acc[ai][bj][m][1] + bv[bj][1];
                    const u32x4 y = *(const u32x4*)(YG + (size_t)row * 512 + c);
                    f32x4 o0, o1;
                    o0[0] = bf_lo(y.x) * sigmoidf_(z0[0]); o0[1] = bf_hi(y.x) * sigmoidf_(z0[1]); o0[2] = bf_lo(y.y) * sigmoidf_(z0[2]); o0[3] = bf_hi(y.y) * sigmoidf_(z0[3]);
                    o1[0] = bf_lo(y.z) * sigmoidf_(z1[0]); o1[1] = bf_hi(y.z) * sigmoidf_(z1[1]); o1[2] = bf_lo(y.w) * sigmoidf_(z1[2]); o1[3] = bf_hi(y.w) * sigmoidf_(z1[3]);
                    *(u32x4*)(GLU + (size_t)row * 512 + c) = pack8(o0, o1); } }
    }
};
struct EpiMix {
    static constexpr int BMODE = 1; static constexpr bool PREFETCH = false; static constexpr int NSTORE = 0, NPRE = 0;
    bf16* MIX;
    __device__ __forceinline__ void operator()(EPI_ARGS) const {
#pragma unroll
        for (int ai = 0; ai < 2; ++ai)
#pragma unroll
            for (int m = 0; m < 4; ++m) { bf16* rowp = MIX + (size_t)(u.pm * 256 + ai * 128 + wr * 64 + m * 16 + fr) * 1024 + u.pn * 256 + wc * 32 + 8 * fq;
#pragma unroll
                for (int bj = 0; bj < 2; ++bj) *(u32x4*)(rowp + bj * 128) = pack8(acc[ai][bj][m][0], acc[ai][bj][m][1]); }
    }
};
__device__ __forceinline__ float swiglu_(float g, float up) {
    const float gc = fminf(g, SW_LIMIT), uc = __builtin_amdgcn_fmed3f(up, -SW_LIMIT, SW_LIMIT);
    const float t = gc * __builtin_amdgcn_rcpf(1.f + __builtin_amdgcn_exp2f(gc * (-SW_ALPHA * 1.4426950408889634f))); return fmaf(t, uc, t); }
__device__ __forceinline__ unsigned pk_fp8x4(float a, float b, float c, float d) { int w = 0; w = __builtin_amdgcn_cvt_pk_fp8_f32(a, b, w, false); w = __builtin_amdgcn_cvt_pk_fp8_f32(c, d, w, true); return (unsigned)w; }
constexpr float W8_SCALE = 32.f, W8_INV = 1.f / 32.f;
constexpr float YB_SCALE = 8.f, YB_INV = 1.f / 8.f;
__device__ __forceinline__ f32x2 swiglu2_(const f32x2 ga, const f32x2 ua, const f32x2 bg, const f32x2 bu) {
    const f32x2 inv = {W8_INV, W8_INV};
    const f32x2 G = __builtin_elementwise_fma(ga, inv, bg), U = __builtin_elementwise_fma(ua, inv, bu);
    f32x2 gc, uc; gc.x = fminf(G.x, SW_LIMIT); gc.y = fminf(G.y, SW_LIMIT); uc.x = __builtin_amdgcn_fmed3f(U.x, -SW_LIMIT, SW_LIMIT); uc.y = __builtin_amdgcn_fmed3f(U.y, -SW_LIMIT, SW_LIMIT);
    const f32x2 xs = gc * (-SW_ALPHA * 1.4426950408889634f);
    f32x2 ex; ex.x = __builtin_amdgcn_exp2f(xs.x); ex.y = __builtin_amdgcn_exp2f(xs.y);
    const f32x2 dn = ex + 1.0f;
    f32x2 rc; rc.x = __builtin_amdgcn_rcpf(dn.x); rc.y = __builtin_amdgcn_rcpf(dn.y);
    const f32x2 t = gc * rc;
    return __builtin_elementwise_fma(t, uc, t);
}
struct EpiGU {
    static constexpr int BMODE = 2; static constexpr bool PREFETCH = true; static constexpr int NSTORE = 0, NPRE = 0;
    unsigned char* ACT; const float* bias; LAS unsigned char* xb;
    __device__ __forceinline__ void prefetch(const pg8::Unit& u, const int wid, const int wr, const int lane) const {
        const int e = u.x1 & 255;
        const unsigned bdst = (unsigned)__builtin_amdgcn_readfirstlane((int)((unsigned)(uintptr_t)xb + (unsigned)wid * 256u));
        pg8::glds4_sv(bias + e * 2048 + 2 * (u.pn * 128 + (wid & 3) * 32), (unsigned)lane * 4u, bdst);
    }
    __device__ __forceinline__ void operator()(EPI_ARGS) const {
        const int e = u.x1 & 255, j0 = u.pn * 128 + wc * 32 + 8 * fq;
        const LAS f32x4* bp = (const LAS f32x4*)(xb + (wr * 4 + wc) * 256) + 4 * fq;
        f32x2 bg[4], bu[4];
#pragma unroll
        for (int i = 0; i < 4; ++i) { const f32x4 b = bp[i]; bg[i] = (f32x2){b[0], b[2]}; bu[i] = (f32x2){b[1], b[3]}; }
        const int jst = u.pn * 128 + wc * 32 + 8 * (fq & ~1);
#pragma unroll
        for (int ai = 0; ai < 2; ++ai)
#pragma unroll
            for (int mp = 0; mp < 2; ++mp) { u32x2 w[2];
#pragma unroll
                for (int k = 0; k < 2; ++k) { const int m = mp * 2 + k;
                    const f32x4 g0 = acc[ai][0][m][0], g1 = acc[ai][0][m][1], u0 = acc[ai][1][m][0], u1 = acc[ai][1][m][1];
                    const f32x2 o0 = swiglu2_((f32x2){g0[0], g0[1]}, (f32x2){u0[0], u0[1]}, bg[0], bu[0]), o1 = swiglu2_((f32x2){g0[2], g0[3]}, (f32x2){u0[2], u0[3]}, bg[1], bu[1]);
                    const f32x2 o2 = swiglu2_((f32x2){g1[0], g1[1]}, (f32x2){u1[0], u1[1]}, bg[2], bu[2]), o3 = swiglu2_((f32x2){g1[2], g1[3]}, (f32x2){u1[2], u1[3]}, bg[3], bu[3]);
                    w[k].x = pk_fp8x4(o0.x, o0.y, o1.x, o1.y); w[k].y = pk_fp8x4(o2.x, o2.y, o3.x, o3.y); }
                const auto rx = __builtin_amdgcn_permlane16_swap(w[0].x, w[1].x, false, false), ry = __builtin_amdgcn_permlane16_swap(w[0].y, w[1].y, false, false);
                const size_t row = (size_t)u.pm * 256 + ai * 128 + wr * 64 + (mp * 2 + (fq & 1)) * 16 + fr;
                u32x4 o; o.x = rx[0]; o.y = ry[0]; o.z = rx[1]; o.w = ry[1];
                *(u32x4*)(ACT + row * 1024 + jst) = o; }
    }
};
template <int MODE> struct EpiDownT {
    static constexpr int BMODE = 3; static constexpr bool PREFETCH = true; static constexpr int NSTORE = 0, NPRE = 0;
    unsigned char* YB; const float* bias; const int* list; const float* gates; int sel; LAS unsigned char* xl; LAS unsigned char* xb;
    __device__ __forceinline__ void prefetch(const pg8::Unit& u, const int wid, const int wr, const int lane) const {
        const int e = u.x1 & 255, cnt = u.x1 >> 8;
        const unsigned dst = (unsigned)__builtin_amdgcn_readfirstlane((int)((unsigned)(uintptr_t)xl + (unsigned)wid * 1024u));
#pragma unroll
        for (int k = 0; k < 2; ++k) { const int slot = u.x0 + k * 128 + wr * 64 + lane; const unsigned so = (unsigned)(slot < cnt ? slot : 0) * 4u;
            pg8::glds4_sv(list + (size_t)e * T, so, dst + (unsigned)k * 256u); pg8::glds4_sv(gates + (size_t)e * T, so, dst + 512u + (unsigned)k * 256u); }
        const unsigned bdst = (unsigned)__builtin_amdgcn_readfirstlane((int)((unsigned)(uintptr_t)xb + (unsigned)wid * 256u));
        pg8::glds4_sv(bias + e * 1024 + u.pn * 256 + (wid & 3) * 64, (unsigned)lane * 4u, bdst);
    }
    __device__ __forceinline__ void operator()(EPI_ARGS) const {
        const int e = u.x1 & 255, cnt = u.x1 >> 8, c0 = u.pn * 256 + wc * 64 + 16 * fq;
        f32x4 bv[2][2];
        { const LAS f32x4* bl = (const LAS f32x4*)(xb + (wr * 4 + wc) * 256) + 4 * fq; bv[0][0] = bl[0]; bv[0][1] = bl[1]; bv[1][0] = bl[2]; bv[1][1] = bl[3]; }
        int aidv[8]; float gtv[8];
        { const LAS int* xi = (const LAS int*)(xl + (wr * 4 + wc) * 1024) + fr; const LAS float* xg = (const LAS float*)xi + 128;
#pragma unroll
          for (int q = 0; q < 8; ++q) { aidv[q] = xi[(q >> 2) * 64 + (q & 3) * 16]; gtv[q] = xg[(q >> 2) * 64 + (q & 3) * 16] * YB_SCALE; } }
#pragma unroll
        for (int ai = 0; ai < 2; ++ai)
#pragma unroll
            for (int m = 0; m < 4; ++m) { const int slot = u.x0 + ai * 128 + wr * 64 + m * 16 + fr; const int aid = aidv[ai * 4 + m]; const float gt = gtv[ai * 4 + m];
                if (slot < cnt) {
                    const f32x4 z0 = (acc[ai][0][m][0] * W8_INV + bv[0][0]) * gt, z1 = (acc[ai][0][m][1] * W8_INV + bv[0][1]) * gt;
                    const f32x4 z2 = (acc[ai][1][m][0] * W8_INV + bv[1][0]) * gt, z3 = (acc[ai][1][m][1] * W8_INV + bv[1][1]) * gt;
                    u32x4 w8; w8.x = pk_fp8x4(z0[0], z0[1], z0[2], z0[3]); w8.y = pk_fp8x4(z1[0], z1[1], z1[2], z1[3]); w8.z = pk_fp8x4(z2[0], z2[1], z2[2], z2[3]); w8.w = pk_fp8x4(z3[0], z3[1], z3[2], z3[3]);
                    if constexpr (MODE == 1) { asm volatile("" :: "v"(w8)); } else { *(u32x4*)(YB + (size_t)aid * 1024 + c0) = w8; } } }
    }
};
typedef EpiDownT<0> EpiDown;

template <int BM_> struct EpiNullT {
    static constexpr int BMODE = BM_; static constexpr bool PREFETCH = false; static constexpr int NSTORE = 0, NPRE = 0;
    __device__ __forceinline__ void operator()(EPI_ARGS) const {
#pragma unroll
        for (int ai = 0; ai < 2; ++ai)
#pragma unroll
            for (int bj = 0; bj < 2; ++bj)
#pragma unroll
                for (int m = 0; m < 4; ++m)
#pragma unroll
                    for (int n = 0; n < 2; ++n) asm volatile("" :: "v"(acc[ai][bj][m][n]));
    }
};
typedef EpiNullT<1> EpiNull;
__device__ __forceinline__ void s5_scan(const Args& a, const int task, const int lane) {
    const int gw = task;
    {
        const int g = gw >> 2, b = gw & 3, n = lane;
        const float* AL = (const float*)(a.ws + WS_SMALL + SM_AL); const float ar = AL[(g * 64 + n) * 2], ai = AL[(g * 64 + n) * 2 + 1];
        const float* X0 = (const float*)(a.ws + WS_XLOC) + ((size_t)(0 * 32 + g) * 1024 + b * 256) * 128;
        const float* X1 = (const float*)(a.ws + WS_XLOC) + ((size_t)(1 * 32 + g) * 1024 + b * 256) * 128;
        bf16* AR = (bf16*)(a.ws + WS_AROW) + (size_t)(g * 1024 + b * 256) * AROW_P;
        float xr = 0.f, xi = 0.f;
        for (int j0 = 0; j0 < 256; j0 += 16) {
            float lr[16], li[16];
#pragma unroll
            for (int q = 0; q < 16; ++q) { const size_t o = (size_t)(j0 + q) * 128 + n; lr[q] = X0[o]; li[q] = X0[o + 64]; }
#pragma unroll
            for (int q = 0; q < 16; ++q) { bf16* row = AR + (size_t)(j0 + q) * AROW_P; row[n] = (bf16)f2bf(xr); row[64 + n] = (bf16)f2bf(xi);
                const float nr = ar * xr - ai * xi + lr[q], ni = ar * xi + ai * xr + li[q]; xr = nr; xi = ni; }
        }
    }
}
__device__ __forceinline__ void p3_post_scan(Frame& F, const Args& a) {
    int lane = mk_lane(); asm volatile("" : "+v"(lane));
    const int gw = F.vcu * NWAVES + F.wave, NGW = F.G * NWAVES;
    const float lam = *(const float*)(a.ws + WS_SMALL);
    const bf16* O = (const bf16*)(a.ws + WS_O); bf16* AC = (bf16*)(a.ws + WS_ACAT); const float* ng = INF(a, 8);
    const int h = lane >> 4, d0 = (lane & 15) * 8;
    const f32x4 g0 = *(const f32x4*)(ng + d0), g1 = *(const f32x4*)(ng + d0 + 4);
    for (int m = gw; m < T; m += NGW) {
        const bf16* orow = O + (size_t)m * 1024;
        const v4u p1 = *(const GAS v4u*)(orow + (h * 2 + 0) * 128 + d0), p2 = *(const GAS v4u*)(orow + (h * 2 + 1) * 128 + d0);
        float o[8];
        o[0] = bf_lo(p1.x) - lam * bf_lo(p2.x); o[1] = bf_hi(p1.x) - lam * bf_hi(p2.x); o[2] = bf_lo(p1.y) - lam * bf_lo(p2.y); o[3] = bf_hi(p1.y) - lam * bf_hi(p2.y);
        o[4] = bf_lo(p1.z) - lam * bf_lo(p2.z); o[5] = bf_hi(p1.z) - lam * bf_hi(p2.z); o[6] = bf_lo(p1.w) - lam * bf_lo(p2.w); o[7] = bf_hi(p1.w) - lam * bf_hi(p2.w);
        float s = 0.f;
#pragma unroll
        for (int q = 0; q < 8; ++q) s += o[q] * o[q];
        s += __shfl_xor(s, 1); s += __shfl_xor(s, 2); s += __shfl_xor(s, 4); s += __shfl_xor(s, 8);
        const float sc = (1.f - LAMBDA_INIT) / sqrtf(s * (1.f / 128.f) + RMS_EPS);
        v4u w; w.x = pk2(o[0] * sc * g0[0], o[1] * sc * g0[1]); w.y = pk2(o[2] * sc * g0[2], o[3] * sc * g0[3]); w.z = pk2(o[4] * sc * g1[0], o[5] * sc * g1[1]); w.w = pk2(o[6] * sc * g1[2], o[7] * sc * g1[3]);
        *(GAS v4u*)(AC + (size_t)m * 1024 + h * 128 + d0) = w;
    }
}
__device__ __forceinline__ void pn_glunorm(Frame& F, const Args& a) {
    int lane = mk_lane(); asm volatile("" : "+v"(lane));
    const int gw = F.vcu * NWAVES + F.wave, NGW = F.G * NWAVES;
    const bf16* GL = (const bf16*)(a.ws + WS_GLU); bf16* AC = (bf16*)(a.ws + WS_ACAT); const float* ng = INF(a, 19);
    const f32x4 g0 = *(const f32x4*)(ng + lane * 8), g1 = *(const f32x4*)(ng + lane * 8 + 4);
    for (int m = gw; m < T; m += NGW) {
        const v4u p = *(const GAS v4u*)(GL + (size_t)m * 512 + lane * 8);
        float o[8] = {bf_lo(p.x), bf_hi(p.x), bf_lo(p.y), bf_hi(p.y), bf_lo(p.z), bf_hi(p.z), bf_lo(p.w), bf_hi(p.w)};
        float s = 0.f;
#pragma unroll
        for (int q = 0; q < 8; ++q) s += o[q] * o[q];
        const float sc = 1.f / sqrtf(wave_sum(s) * (1.f / 512.f) + RMS_EPS);
        v4u w; w.x = pk2(o[0] * sc * g0[0], o[1] * sc * g0[1]); w.y = pk2(o[2] * sc * g0[2], o[3] * sc * g0[3]); w.z = pk2(o[4] * sc * g1[0], o[5] * sc * g1[1]); w.w = pk2(o[6] * sc * g1[2], o[7] * sc * g1[3]);
        *(GAS v4u*)(AC + (size_t)m * 1024 + 512 + lane * 8) = w;
    }
}
constexpr int NS5 = 64, CW_BAR2 = 8192;
__device__ __forceinline__ void glunorm_sub(Frame& F, const Args& a, const int rank) {
    int lane = mk_lane(); asm volatile("" : "+v"(lane));
    const bf16* GL = (const bf16*)(a.ws + WS_GLU); bf16* AC = (bf16*)(a.ws + WS_ACAT); const float* ng = INF(a, 19);
    const f32x4 g0 = *(const f32x4*)(ng + lane * 8), g1 = *(const f32x4*)(ng + lane * 8 + 4);
    const int r0 = rank * 512 + F.wave * 64;
#pragma unroll 1
    for (int m0 = r0; m0 < r0 + 64; m0 += 8) {
        v4u p[8];
#pragma unroll
        for (int q = 0; q < 8; ++q) p[q] = *(const GAS v4u*)(GL + (size_t)(m0 + q) * 512 + lane * 8);
#pragma unroll
        for (int q = 0; q < 8; ++q) {
            float o[8] = {bf_lo(p[q].x), bf_hi(p[q].x), bf_lo(p[q].y), bf_hi(p[q].y), bf_lo(p[q].z), bf_hi(p[q].z), bf_lo(p[q].w), bf_hi(p[q].w)};
            float s = 0.f;
#pragma unroll
            for (int k = 0; k < 8; ++k) s += o[k] * o[k];
            const float sc = 1.f / sqrtf(wave_sum(s) * (1.f / 512.f) + RMS_EPS);
            v4u w; w.x = pk2(o[0] * sc * g0[0], o[1] * sc * g0[1]); w.y = pk2(o[2] * sc * g0[2], o[3] * sc * g0[3]); w.z = pk2(o[4] * sc * g1[0], o[5] * sc * g1[1]); w.w = pk2(o[6] * sc * g1[2], o[7] * sc * g1[3]);
            *(GAS v4u*)(AC + (size_t)(m0 + q) * 1024 + 512 + lane * 8) = w;
        }
    }
}
__device__ const unsigned char ATT_DEAL[32][8] = {
  {48, 255, 255, 255, 255, 255, 255, 255},
  {27, 36, 35, 255, 255, 255, 255, 255},
  {59, 4, 3, 255, 255, 255, 255, 255},
  {62, 37, 34, 255, 255, 255, 255, 255},
  {16, 255, 255, 255, 255, 255, 255, 255},
  {30, 5, 2, 255, 255, 255, 255, 255},
  {61, 38, 33, 255, 255, 255, 255, 255},
  {29, 6, 1, 255, 255, 255, 255, 255},
  {47, 255, 255, 255, 255, 255, 255, 255},
  {60, 40, 32, 255, 255, 255, 255, 255},
  {28, 8, 0, 255, 255, 255, 255, 255},
  {31, 39, 255, 255, 255, 255, 255, 255},
  {15, 255, 255, 255, 255, 255, 255, 255},
  {63, 7, 255, 255, 255, 255, 255, 255},
  {58, 41, 255, 255, 255, 255, 255, 255},
  {26, 9, 255, 255, 255, 255, 255, 255},
  {46, 255, 255, 255, 255, 255, 255, 255},
  {57, 42, 255, 255, 255, 255, 255, 255},
  {25, 10, 255, 255, 255, 255, 255, 255},
  {56, 43, 255, 255, 255, 255, 255, 255},
  {14, 255, 255, 255, 255, 255, 255, 255},
  {24, 11, 255, 255, 255, 255, 255, 255},
  {55, 44, 255, 255, 255, 255, 255, 255},
  {23, 12, 255, 255, 255, 255, 255, 255},
  {45, 255, 255, 255, 255, 255, 255, 255},
  {54, 49, 255, 255, 255, 255, 255, 255},
  {22, 17, 255, 255, 255, 255, 255, 255},
  {53, 50, 255, 255, 255, 255, 255, 255},
  {13, 255, 255, 255, 255, 255, 255, 255},
  {21, 18, 255, 255, 255, 255, 255, 255},
  {52, 51, 255, 255, 255, 255, 255, 255},
  {20, 19, 255, 255, 255, 255, 255, 255}
};
__device__ __forceinline__ void pr_router(Frame& F, const Args& a) {
    LAS float* WP = (LAS float*)F.lds;
    { const GAS f32x4* src = (const GAS f32x4*)(a.ws + WS_SMALL + SM_WR); for (int i = FTID(F); i < 1024 * 36 / 4; i += NWAVES * 64) ((LAS f32x4*)WP)[i] = src[i]; }
    LAS int* cntL = (LAS int*)(F.lds + RT_OFF); LAS int* baseL = cntL + 32;
    LAS int* stA = (LAS int*)(F.lds + ST_OFF); LAS int* stE = stA + 512; LAS float* stG = (LAS float*)(stE + 512);
    if (FTID(F) < 32) cntL[FTID(F)] = 0;
    __syncthreads();
    int lane = mk_lane(); asm volatile("" : "+v"(lane));
    const int gw = F.vcu * NWAVES + F.wave;
    const float* X = INF(a, 0); const bf16* MIX = (const bf16*)(a.ws + WS_MIX); unsigned char* XN8 = (unsigned char*)(a.ws + WS_XN); const float* gf = INF(a, 21);
    const int e_me = lane >> 1; const float brt = INF(a, 23)[e_me];
    for (int rp = 0; rp < NREP(8); ++rp) { if (rp) { __syncthreads(); if (FTID(F) < 32) cntL[FTID(F)] = 0; __syncthreads(); }
    f32x4 xnx[4]; unsigned long long mnx[4];
    { const GAS f32x4* xr = (const GAS f32x4*)(X + (size_t)gw * 1024) + lane; const GAS unsigned long long* mr = (const GAS unsigned long long*)(MIX + (size_t)gw * 1024) + lane;
#pragma unroll
      for (int j = 0; j < 4; ++j) { xnx[j] = __builtin_nontemporal_load(xr + 64 * j); mnx[j] = __builtin_nontemporal_load(mr + 64 * j); } }
#pragma unroll 1
    for (int it = 0; it < 16; ++it) {
        const int m = gw + it * (256 * NWAVES);
        f32x4 xcur[4]; unsigned long long mcur[4];
#pragma unroll
        for (int j = 0; j < 4; ++j) { xcur[j] = xnx[j]; mcur[j] = mnx[j]; }
        { const int mn = gw + (it < 15 ? it + 1 : it) * (256 * NWAVES);
          const GAS f32x4* xr = (const GAS f32x4*)(X + (size_t)mn * 1024) + lane; const GAS unsigned long long* mr = (const GAS unsigned long long*)(MIX + (size_t)mn * 1024) + lane;
#pragma unroll
          for (int j = 0; j < 4; ++j) { xnx[j] = __builtin_nontemporal_load(xr + 64 * j); mnx[j] = __builtin_nontemporal_load(mr + 64 * j); } }
        f32x4 hv[4]; float ss = 0.f;
#pragma unroll
        for (int j = 0; j < 4; ++j) { const f32x4 xv = xcur[j]; const unsigned long long w = mcur[j]; const unsigned lo = (unsigned)w, hi = (unsigned)(w >> 32);
            hv[j] = (f32x4){xv.x + bf_lo(lo), xv.y + bf_hi(lo), xv.z + bf_lo(hi), xv.w + bf_hi(hi)};
            ss += (hv[j].x * hv[j].x + hv[j].y * hv[j].y) + (hv[j].z * hv[j].z + hv[j].w * hv[j].w); }
        const float rstd = 1.f / sqrtf(wave_sum(ss) * (1.f / D) + RMS_EPS);
        f32x2 p2[16];
#pragma unroll
        for (int e = 0; e < 16; ++e) p2[e] = (f32x2){0.f, 0.f};
#pragma unroll
        for (int j = 0; j < 4; ++j)
#pragma unroll
            for (int i = 0; i < 4; ++i) { const float hk = hv[j][i]; const f32x2 hk2 = {hk, hk}; const LAS float* wrow = WP + ((i + 4 * j) * 64 + lane) * 36;
#pragma unroll
                for (int e4 = 0; e4 < 8; ++e4) { const f32x4 w = *(const LAS f32x4*)(wrow + 4 * e4);
                    p2[2 * e4] = __builtin_elementwise_fma(hk2, (f32x2){w[0], w[1]}, p2[2 * e4]); p2[2 * e4 + 1] = __builtin_elementwise_fma(hk2, (f32x2){w[2], w[3]}, p2[2 * e4 + 1]); } }
        float p[32];
#pragma unroll
        for (int e = 0; e < 16; ++e) { p[2 * e] = p2[e].x; p[2 * e + 1] = p2[e].y; }
        float q16[16], q8[8], q4[4], q2[2];
        { const bool up = (lane & 32) != 0;
#pragma unroll
          for (int i = 0; i < 16; ++i) { const float keep = up ? p[16 + i] : p[i], send = up ? p[i] : p[16 + i]; q16[i] = keep + __shfl_xor(send, 32); } }
        { const bool up = (lane & 16) != 0;
#pragma unroll
          for (int i = 0; i < 8; ++i) { const float keep = up ? q16[8 + i] : q16[i], send = up ? q16[i] : q16[8 + i]; q8[i] = keep + __shfl_xor(send, 16); } }
        { const bool up = (lane & 8) != 0;
#pragma unroll
          for (int i = 0; i < 4; ++i) { const float keep = up ? q8[4 + i] : q8[i], send = up ? q8[i] : q8[4 + i]; q4[i] = keep + __shfl_xor(send, 8); } }
        { const bool up = (lane & 4) != 0;
#pragma unroll
          for (int i = 0; i < 2; ++i) { const float keep = up ? q4[2 + i] : q4[i], send = up ? q4[i] : q4[2 + i]; q2[i] = keep + __shfl_xor(send, 4); } }
        float q1; { const bool up = (lane & 2) != 0; const float keep = up ? q2[1] : q2[0], send = up ? q2[0] : q2[1]; q1 = keep + __shfl_xor(send, 2); }
        const float raw = q1 + __shfl_xor(q1, 1);
        const float v = raw * rstd + brt;
        int rank = 0;
#pragma unroll
        for (int j = 0; j < 32; ++j) { const float vj = __int_as_float(__builtin_amdgcn_readlane(__float_as_int(v), 2 * j)); rank += (vj > v || (vj == v && j < e_me)) ? 1 : 0; }
        float vk[4]; int ek[4];
#pragma unroll
        for (int k = 0; k < 4; ++k) { const unsigned long long mk = __ballot(rank == k); const int lk = (int)__builtin_ctzll(mk); ek[k] = lk >> 1; vk[k] = __int_as_float(__builtin_amdgcn_readlane(__float_as_int(v), lk)); }
        float ex[4]; float den = 0.f;
#pragma unroll
        for (int k = 0; k < 4; ++k) { ex[k] = __expf(vk[k] - vk[0]); den += ex[k]; }
        const float rden = 1.f / den;
        if (lane < 4) {
            const int e = lane == 0 ? ek[0] : lane == 1 ? ek[1] : lane == 2 ? ek[2] : ek[3];
            const float gt = (lane == 0 ? ex[0] : lane == 1 ? ex[1] : lane == 2 ? ex[2] : ex[3]) * rden;
            const int sl = __hip_atomic_fetch_add(cntL + e, 1, __ATOMIC_RELAXED, __HIP_MEMORY_SCOPE_WORKGROUP);
            const int pos = F.wave * 64 + it * 4 + lane;
            stA[pos] = m * 4 + lane; stE[pos] = e | (sl << 8); stG[pos] = gt;
        }
        { const GAS f32x4* gr = (const GAS f32x4*)gf + lane; GAS unsigned* o4 = (GAS unsigned*)(XN8 + (size_t)m * 1024) + lane;
          GAS unsigned long long* h8 = (GAS unsigned long long*)((bf16*)(a.ws + WS_HB) + (size_t)m * 1024) + lane;
#pragma unroll
          for (int j = 0; j < 4; ++j) { const f32x4 gg = gr[64 * j];
              o4[64 * j] = pk_fp8x4(hv[j].x * rstd * gg.x, hv[j].y * rstd * gg.y, hv[j].z * rstd * gg.z, hv[j].w * rstd * gg.w);
              __builtin_nontemporal_store((unsigned long long)pk2(hv[j].x, hv[j].y) | ((unsigned long long)pk2(hv[j].z, hv[j].w) << 32), h8 + 64 * j); } }
    }
    }
    __syncthreads();
    if (FTID(F) < 32) baseL[FTID(F)] = (int)__hip_atomic_fetch_add(F.ctl + CW_ECNT + 16 * FTID(F), (unsigned)cntL[FTID(F)], __ATOMIC_RELAXED, __HIP_MEMORY_SCOPE_AGENT);
    __syncthreads();
    { const int pos = FTID(F); const int aid = stA[pos], ee = stE[pos], e = ee & 255, sl = ee >> 8;
      int* list = (int*)(a.ws + WS_LIST); float* gates = (float*)(a.ws + WS_GATES);
      list[(size_t)e * T + baseL[e] + sl] = aid; gates[(size_t)e * T + baseL[e] + sl] = stG[pos]; }
}
__device__ __forceinline__ void moe_tables(Frame& F) {
    LAS int* tpre = (LAS int*)(F.lds + MOE_OFF); LAS int* cntE = tpre + 40;
    __syncthreads();
    if (FTID(F) < 32) cntE[FTID(F)] = (int)__hip_atomic_load(F.ctl + CW_ECNT + 16 * FTID(F), RLX_AGENT);
    __syncthreads();
    if (FTID(F) == 0) { int acc = 0; for (int e = 0; e < 32; ++e) { tpre[e] = acc; acc += (cntE[e] + 255) >> 8; } tpre[32] = acc; }
    __syncthreads();
}
__device__ __forceinline__ void pf_final(Frame& F, const Args& a) {
    int lane = mk_lane(); asm volatile("" : "+v"(lane));
    const int gw = F.vcu * NWAVES + F.wave, NGW = F.G * NWAVES;
    const unsigned char* YB = (const unsigned char*)(a.ws + WS_YBUF); const float* gfin = INF(a, 28);
    for (int m = gw; m < T; m += NGW) {
        GAS f32x4* hr = (GAS f32x4*)(a.out + (size_t)m * 1024) + lane;
        const GAS unsigned long long* mr = (const GAS unsigned long long*)((const bf16*)(a.ws + WS_HB) + (size_t)m * 1024) + lane;
        f32x4 v[4];
#pragma unroll
        for (int j = 0; j < 4; ++j) { const unsigned long long w = __builtin_nontemporal_load(mr + 64 * j); const unsigned lo = (unsigned)w, hi = (unsigned)(w >> 32);
            v[j].x = bf_lo(lo); v[j].y = bf_hi(lo); v[j].z = bf_lo(hi); v[j].w = bf_hi(hi); }
#pragma unroll
        for (int k = 0; k < 4; ++k) { const GAS unsigned* yr = (const GAS unsigned*)(YB + ((size_t)m * 4 + k) * 1024) + lane;
#pragma unroll
            for (int j = 0; j < 4; ++j) { const unsigned w = __builtin_nontemporal_load(yr + 64 * j); const f32x2 lo = __builtin_amdgcn_cvt_pk_f32_fp8((int)w, false), hi = __builtin_amdgcn_cvt_pk_f32_fp8((int)w, true);
                v[j].x += lo.x * YB_INV; v[j].y += lo.y * YB_INV; v[j].z += hi.x * YB_INV; v[j].w += hi.y * YB_INV; } }
        float s = 0.f;
#pragma unroll
        for (int j = 0; j < 4; ++j) s += (v[j].x * v[j].x + v[j].y * v[j].y) + (v[j].z * v[j].z + v[j].w * v[j].w);
        const float rstd = 1.f / sqrtf(wave_sum(s) * (1.f / D) + RMS_EPS);
        const GAS f32x4* gr = (const GAS f32x4*)gfin + lane;
#pragma unroll
        for (int j = 0; j < 4; ++j) { const f32x4 gg = gr[64 * j]; __builtin_nontemporal_store(v[j] * rstd * gg, hr + 64 * j); }
    }
}

__global__ void __launch_bounds__(NWAVES * 64, 2) mk_fwd(Args args) {
    extern __shared__ __attribute__((aligned(16))) unsigned char lds[];
    Frame F;
    F.lds = (LAS unsigned char*)lds;
    F.MISC = (volatile LAS unsigned*)(F.lds + MISC_OFF);
    F.wave = __builtin_amdgcn_readfirstlane((int)(threadIdx.x >> 6));
    F.G = gridDim.x; { const int bx = blockIdx.x; F.vcu = (F.G % 8 == 0) ? (bx % 8) * (F.G / 8) + bx / 8 : bx; }
    unsigned char* ws = args.ws;
    F.ctl = (gu32*)(ws + WS_CTL);
    for (int u = FTID(F); u < (LDS_BYTES - LDSCTL_OFF) / 4; u += NWAVES * 64) ((LAS unsigned*)(F.lds + LDSCTL_OFF))[u] = 0u;
    __syncthreads();
    XcdBarrier bar; bar.bar = (unsigned*)(F.ctl + CW_BAR); bar.x = 0; bar.st = nullptr; bar.wave = F.wave; bar.G = gridDim.x;
    if (N_LAUNCHES == 1) bar = xcd_barrier_post((unsigned*)(F.ctl + CW_BAR), F.MISC + 8, F.wave, gridDim.x);
#define GRID_BAR() do { if (N_LAUNCHES == 1) xcd_barrier(bar); } while (0)
    const int lo = args.ph_lo, hi = args.ph_hi;
#define IN(k) (lo <= (k) && (k) < hi)
#ifndef PROBE_DUP
#define PROBE_DUP -1
#endif
#define REP(k, ...) do { __VA_ARGS__; if constexpr (PROBE_DUP == (k)) { __VA_ARGS__; } } while (0)
#define BOTH(k) (IN(k) && IN((k) + 1))
    LAS unsigned char* ring = F.lds + RING_OFF;

    if (IN(0)) { REP(0, p0_prologue(F, args)); if (BOTH(0)) GRID_BAR(); }
    if (IN(1)) {
        DenseOrder S; S.init(T, 2048, 1024, 1024, 1024, ws + WS_XN, ws + WS_WIN, F.G, (int)blockIdx.x);
        EpiInProj E{(bf16*)(ws + WS_Q), (bf16*)(ws + WS_K), (bf16*)(ws + WS_V), (bf16*)(ws + WS_AROW), (const float*)(ws + WS_ROPE), attn_body::C2};
        pg8::ALinear AO{2048};
        REP(1, pg8::gemm_phase<EpiInProj, DenseOrder, pg8::ALinear, true>(ring, 2048, S, AO, E, F.wave));
        if (BOTH(1)) GRID_BAR();
        if constexpr (PROBE_DUP == 40) { GRID_BAR(); GRID_BAR(); GRID_BAR(); GRID_BAR(); }
    }
    if (IN(2)) {
        if (F.G == 256) {
            if ((F.vcu & 3) == 0) {
                const int rank = F.vcu >> 2;
                const XcdBarrier sbar = xcd_barrier_post((unsigned*)(F.ctl + CW_BAR2), F.MISC + 12, F.wave, NS5);
                { XOrder S{NS5, rank, (const char*)(ws + WS_AROW), (const char*)(ws + WS_BTX)}; EpiX E{(float*)(ws + WS_XLOC)}; pg8::ALinear AO{AROW_P * 2};
                  REP(50, pg8::gemm_phase<EpiX, XOrder, pg8::ALinear, true>(ring, 1024, S, AO, E, F.wave)); }
                xcd_barrier(sbar);
                REP(51, if (F.wave < 2) s5_scan(args, rank * 2 + F.wave, mk_lane()));
                xcd_barrier(sbar);
                { YOrder S{NS5, rank, (const char*)(ws + WS_AROW), (const char*)(ws + WS_BTY)}; EpiY E{(bf16*)(ws + WS_YG)}; pg8::ALinear AO{AROW_P * 2};
                  REP(52, pg8::gemm_phase<EpiY, YOrder, pg8::ALinear, true>(ring, AROW_P * 2, S, AO, E, F.wave)); }
                xcd_barrier(sbar);
                { GluOrder S{rank, (const char*)(ws + WS_YG), (const char*)(ws + WS_WGLU)};
                  EpiGlu E{(const bf16*)(ws + WS_YG), (bf16*)(ws + WS_GLU), INF(args, 18)}; pg8::ALinear AO{1024};
                  REP(53, pg8::gemm_phase<EpiGlu, GluOrder, pg8::ALinear, true>(ring, 1024, S, AO, E, F.wave)); }
                asm volatile("s_waitcnt vmcnt(0)" ::: "memory"); __syncthreads();
                REP(54, glunorm_sub(F, args, rank));
                __syncthreads();
            }
            const int xcd = F.vcu >> 5, wl = F.vcu & 31;
            const float lam = *(const float*)(ws + WS_SMALL);
            for (int rp = 0; rp < NREP(2); ++rp)
            for (int i = 0; i < 8; ++i) {
                const int e = __builtin_amdgcn_readfirstlane((int)ATT_DEAL[wl][i]); if (e == 255) break;
                const int bh = xcd * 2 + (e >> 5), qb = e & 31, b = bh >> 2, h = bh & 3;
                for (int map = 0; map < 2; ++map) { const int hm = h * 2 + map;
                    attn_body::attn_unit<8>(b, hm * 64, hm * 64, h * 128, h * 128, qb,
                        (const attn_body::bf16*)(ws + WS_Q), (const attn_body::bf16*)(ws + WS_K), (const attn_body::bf16*)(ws + WS_V), (attn_body::bf16*)(ws + WS_O), (char*)lds + RING_OFF, F.wave,
                        map, (attn_body::bf16*)(ws + WS_ACAT), lam, INF(args, 8)); }
            }
        }
        if (IN(7)) GRID_BAR();
    }
    if (IN(7)) {
        DenseOrder S; S.init(T, 1024, 1024, 1024, 1024, ws + WS_ACAT, ws + WS_WOUT, F.G, (int)blockIdx.x);
        EpiMix E{(bf16*)(ws + WS_MIX)}; pg8::ALinear AO{2048};
        REP(7, pg8::gemm_phase<EpiMix, DenseOrder, pg8::ALinear, true>(ring, 2048, S, AO, E, F.wave));
        if (BOTH(7)) GRID_BAR();
    }
    if (IN(8)) { if (F.G == 256) pr_router(F, args); if (BOTH(8)) GRID_BAR(); }
    if (IN(9)) {
        moe_tables(F);
        const LAS int* tpre = (const LAS int*)(F.lds + MOE_OFF);
        MoeOrder<4, 8> S{F.G, F.vcu, tpre, tpre + 40, (const char*)(ws + WS_XN), (const char*)(ws + WS_WGU), (size_t)2048 * 1024, true, 8};
        EpiGU E{(unsigned char*)(ws + WS_ACT), INF(args, 25), F.lds + EPB_OFF}; AGather AO{(const int*)(ws + WS_LIST)};
        if constexpr (PROBE_DUP == 66) { EpiNullT<2> E0; pg8::gemm_phase<EpiNullT<2>, MoeOrder<4, 8>, AGather, true, true>(ring, 1024, S, AO, E0, F.wave, F.lds + ST_OFF); }
        if constexpr (PROBE_DUP == 61) { MoeOrder<4, 8> S2 = S; S2.ntk = 24; pg8::gemm_phase<EpiGU, MoeOrder<4, 8>, AGather, true, true>(ring, 1024, S2, AO, E, F.wave, F.lds + ST_OFF); }
        REP(9, pg8::gemm_phase<EpiGU, MoeOrder<4, 8>, AGather, true, true>(ring, 1024, S, AO, E, F.wave, F.lds + ST_OFF));
        if (BOTH(9)) GRID_BAR();
    }
    if (IN(10)) {
        moe_tables(F);
        const LAS int* tpre = (const LAS int*)(F.lds + MOE_OFF);
        MoeOrder<8, 4> S{F.G, F.vcu, tpre, tpre + 40, (const char*)(ws + WS_ACT), (const char*)(ws + WS_WD), (size_t)1024 * 1024, false, 8};
        EpiDown E{(unsigned char*)(ws + WS_YBUF), INF(args, 27), (const int*)(ws + WS_LIST), (const float*)(ws + WS_GATES), 1, F.lds + ST_OFF, F.lds + EPB_OFF}; pg8::ALinear AO{1024};
        if constexpr (PROBE_DUP == 64) { EpiDownT<1> E1{(unsigned char*)(ws + WS_YBUF), INF(args, 27), (const int*)(ws + WS_LIST), (const float*)(ws + WS_GATES), 1, F.lds + ST_OFF, F.lds + EPB_OFF}; pg8::gemm_phase<EpiDownT<1>, MoeOrder<8, 4>, pg8::ALinear, true, true>(ring, 1024, S, AO, E1, F.wave); }
        if constexpr (PROBE_DUP == 62) { EpiNull E0; pg8::gemm_phase<EpiNull, MoeOrder<8, 4>, pg8::ALinear, true, true>(ring, 1024, S, AO, E0, F.wave); }
        if constexpr (PROBE_DUP == 60) { MoeOrder<8, 4> S2 = S; S2.ntk = 24; pg8::gemm_phase<EpiDown, MoeOrder<8, 4>, pg8::ALinear, true, true>(ring, 1024, S2, AO, E, F.wave); }
        REP(10, pg8::gemm_phase<EpiDown, MoeOrder<8, 4>, pg8::ALinear, true, true>(ring, 1024, S, AO, E, F.wave));
        if (BOTH(10)) GRID_BAR();
    }
    if (IN(11)) { REP(11, pf_final(F, args)); }
#undef IN
#undef BOTH
}

extern "C" void kernel_launch(void* const* d_in, const int* in_sizes, int n_in, void* d_out, int out_size, void* d_ws, size_t ws_size, hipStream_t stream) {
    static int grid = 0;
    if (grid == 0) {
        if (n_in != 29 || in_sizes[0] != T * D || out_size != T * D || ws_size < WS_END) { fprintf(stderr, "kernel_launch: unexpected shapes / workspace (n_in %d, ws %zu)\n", n_in, ws_size); grid = -1; return; }
        int dev = 0, cus = 0, per_cu = 0;
        if (hipGetDevice(&dev) != hipSuccess || hipDeviceGetAttribute(&cus, hipDeviceAttributeMultiprocessorCount, dev) != hipSuccess) { grid = -1; return; }
        if (hipFuncSetAttribute((const void*)mk_fwd, hipFuncAttributeMaxDynamicSharedMemorySize, LDS_BYTES) != hipSuccess) { fprintf(stderr, "kernel_launch: hipFuncSetAttribute failed\n"); grid = -1; return; }
        if (hipOccupancyMaxActiveBlocksPerMultiprocessor(&per_cu, (const void*)mk_fwd, NWAVES * 64, LDS_BYTES) != hipSuccess || per_cu < 1) { fprintf(stderr, "kernel_launch: occupancy query says %d\n", per_cu); }
        (void)hipGetLastError();
        if (cus < 256) { fprintf(stderr, "kernel_launch: needs 256 CUs, device has %d\n", cus); grid = -1; return; }
        grid = 256;
    }
    if (grid < 0) return;
    if (hipMemsetAsync((char*)d_ws + WS_CTL, 0, CTL_ZERO_BYTES, stream) != hipSuccess) return;
    Args a{};
    for (int i = 0; i < 29; ++i) a.in[i] = d_in[i];
    a.out = (float*)d_out; a.ws = (unsigned char*)d_ws; a.pad = 0;
    for (int li = 0; li < N_LAUNCHES; ++li) {
        a.ph_lo = (N_LAUNCHES == NPH) ? li : 0; a.ph_hi = (N_LAUNCHES == NPH) ? li + 1 : NPH; a.li = li;
        hipLaunchKernelGGL(mk_fwd, dim3(grid), dim3(NWAVES * 64), LDS_BYTES, stream, a);
    }
}
```

```cpp
#include <hip/hip_runtime.h>
#include <hip/hip_bf16.h>
#include <cstdio>
#include <cstdint>
#include <cmath>
__device__ __forceinline__ int mk_lane() { int l; asm volatile("v_mbcnt_lo_u32_b32 %0, -1, 0\n\tv_mbcnt_hi_u32_b32 %0, -1, %0" : "=v"(l)); return l; }
namespace pg8 {
#define PG8_LAS __attribute__((address_space(3)))
typedef unsigned short bf16_t;
typedef short bf16x8 __attribute__((ext_vector_type(8)));
typedef float f32x4 __attribute__((ext_vector_type(4)));
typedef float f32x2 __attribute__((ext_vector_type(2)));
typedef unsigned u32x4 __attribute__((ext_vector_type(4)));
typedef unsigned u32x2 __attribute__((ext_vector_type(2)));
constexpr int BM = 256, BK = 64, HALF = 128, HTB = HALF * BK * 2  , STAGE_BYTES = 8 * HTB, NXCD = 8, WGM = 8;

__host__ __device__ __forceinline__ int lds_byte(int r, int c) { const int st = (r >> 4) * 2 + (c >> 5), rr = r & 15, cc = c & 31, ob = rr * 64 + cc * 2; return st * 1024 + (ob ^ (((ob >> 9) & 1) << 5)); }
__host__ __device__ __forceinline__ void stage_rc(int b, int& R, int& C) { const int st = b / 1024, sb = b % 1024, swz = sb ^ (((sb >> 9) & 1) << 5); R = (st >> 1) * 16 + swz / 64; C = (st & 1) * 32 + (swz % 64) / 2; }
__host__ __device__ __forceinline__ int perm32(int rho) { const int n = rho >> 4, i = rho & 15; return 8 * (i >> 2) + 4 * n + (i & 3); }

struct Unit { int pm, pn; const char* a; const char* b; int nt; int x0, x1; };

struct ALinear {
    static constexpr bool PER_UNIT = false;
    int lda;
    __device__ __forceinline__ void get(const Unit&, unsigned (&v)[2][2], const int (&R)[2], const int (&C)[2]) const {
#pragma unroll
        for (int h = 0; h < 2; ++h)
#pragma unroll
            for (int i = 0; i < 2; ++i) v[h][i] = (unsigned)(R[i] * lda + C[i] * 2);
    }
    __device__ __forceinline__ size_t hstep() const { return (size_t)HALF * lda; }
    __device__ __forceinline__ void issue_dma(const Unit&, const int (&)[2], unsigned) const {}
    __device__ __forceinline__ void finish(const int (&)[4], unsigned (&)[2][2], const int (&)[2]) const {}
};

__device__ __forceinline__ unsigned cvt_pk_bf16(float lo, float hi) { unsigned r; asm volatile("v_cvt_pk_bf16_f32 %0, %1, %2" : "=v"(r) : "v"(lo), "v"(hi)); return r; }
__device__ __forceinline__ f32x2 gelu_pk(f32x2 v) {
    const f32x2 av = __builtin_elementwise_abs(v), d = av * 0.2316418882f + 1.0f;
    f32x2 t; t.x = __builtin_amdgcn_rcpf(d.x); t.y = __builtin_amdgcn_rcpf(d.y);
    f32x2 q = t * 0.5307027145f + (-0.7265760135f); q = q * t + 0.7107068705f; q = q * t + (-0.142248368f); q = q * t + 0.127414796f; q = q * t;
    const f32x2 s = (v * v) * (-0.72134752044f);
    f32x2 e; e.x = __builtin_amdgcn_exp2f(s.x); e.y = __builtin_amdgcn_exp2f(s.y);
    const f32x2 m = v * (q * e), r = v - m;
    f32x2 o; o.x = v.x < 0.f ? m.x : r.x; o.y = v.y < 0.f ? m.y : r.y; return o;
}

typedef int v4i_t __attribute__((ext_vector_type(4)));
typedef int v8i_t __attribute__((ext_vector_type(8)));
template <int OFF> __device__ __forceinline__ void glds_sv(const char* sbase, unsigned voff, unsigned lds_w0) { unsigned keep;
    asm volatile("s_mov_b32 %0, m0\n\ts_add_u32 m0, %3, %4\n\ts_nop 0\n\tglobal_load_lds_dwordx4 %1, %2\n\ts_mov_b32 m0, %0" : "=&s"(keep) : "v"(voff), "s"(sbase), "s"(lds_w0), "i"(OFF) : "memory", "scc"); }
__device__ __forceinline__ void glds4_sv(const void* sbase, unsigned voff, unsigned lds_dst) { unsigned keep;
    asm volatile("s_mov_b32 %0, m0\n\ts_mov_b32 m0, %3\n\ts_nop 0\n\tglobal_load_lds_dword %1, %2\n\ts_mov_b32 m0, %0" : "=&s"(keep) : "v"(voff), "s"(sbase), "s"(lds_dst) : "memory"); }
template <int N> __device__ __forceinline__ void wait_vm_sel(int sel) { asm volatile("v_cmp_ne_u32_e32 vcc, 0, %0\n\ts_cbranch_vccz .Lw8_%=\n\ts_waitcnt vmcnt(%1)\n\ts_branch .Lwe_%=\n.Lw8_%=:\n\ts_waitcnt vmcnt(8)\n.Lwe_%=:" :: "v"(sel), "n"(N) : "memory", "vcc"); }
template <bool FP8> struct FragT;
template <> struct FragT<false> { struct A4 { bf16x8 v[4][2]; }; struct B2 { bf16x8 v[2][2]; }; };
template <> struct FragT<true> { struct A4 { v8i_t v[4]; }; struct B2 { v8i_t v[2]; }; };
template <class Epi, class Sched, class AOff, bool ALIGN_EPI = true, bool FP8 = false>
__device__ __forceinline__ void gemm_phase(PG8_LAS unsigned char* lds, const int ldb  , const Sched& S, const AOff& AO, const Epi& E, const int wave_  , PG8_LAS unsigned char* xlds = nullptr  ) {
    int tid_ = wave_ * 64 + mk_lane(); asm volatile("" : "+v"(tid_));
    const int tid = tid_, wid = __builtin_amdgcn_readfirstlane(tid >> 6), lane = tid & 63, wr = wid >> 2, wc = wid & 3, fr = lane & 15, fq = lane >> 4;
    unsigned voffB[2]; int RR[2], CC[2];
#pragma unroll
    for (int i = 0; i < 2; ++i) { int R, C; stage_rc(tid * 16 + i * 8192, R, C); RR[i] = R; CC[i] = C; const int Rp = (R & ~31) + perm32(R & 31); const int P32 = perm32(R & 31); const int Rb = Epi::BMODE == 0 ? R : Epi::BMODE == 1 ? Rp : Epi::BMODE == 2 ? 2 * Rp : 64 * (R >> 5) + 16 * (P32 >> 3) + (P32 & 7);
        voffB[i] = (unsigned)(Rb * ldb + C * 2); }
    const size_t kstep = (size_t)(BK * 2);
    const size_t hstepB = Epi::BMODE == 2 ? (size_t)ldb : Epi::BMODE == 3 ? (size_t)8 * ldb : (size_t)HALF * ldb;
    const size_t hstepA = AO.hstep();
    constexpr int AH1 = AOff::PER_UNIT ? 1 : 0;
    const unsigned ldsw0 = (unsigned)__builtin_amdgcn_readfirstlane((int)((unsigned)(uintptr_t)lds + (unsigned)wid * 1024u));
    const int aoff = lds_byte(wr * 64 + fr, fq * 8), boff = lds_byte(wc * 32 + fr, fq * 8);
#define PG8_SA(b, h) (((b) * 2 + (h)) * HTB)
#define PG8_SB(b, h) ((4 + (b) * 2 + (h)) * HTB)
#define PG8_STAGE(bufoff, gbase, voff) do { glds_sv<(bufoff)>((const char*)(gbase), (voff)[0], ldsw0); glds_sv<(bufoff) + 8192>((const char*)(gbase), (voff)[1], ldsw0); } while (0)
#define PG8_LD8(p) __builtin_shufflevector(*(const PG8_LAS v4i_t*)(p), *(const PG8_LAS v4i_t*)((p) + 1024), 0, 1, 2, 3, 4, 5, 6, 7)
#define PG8_LDA(dst, b, h) do { if constexpr (FP8) { _Pragma("unroll") for (int m = 0; m < 4; ++m) dst.v[m] = PG8_LD8(lds + PG8_SA(b, h) + aoff + m * 2048); } \
        else { _Pragma("unroll") for (int m = 0; m < 4; ++m) _Pragma("unroll") for (int k = 0; k < 2; ++k) dst.v[m][k] = *(const PG8_LAS bf16x8*)(lds + PG8_SA(b, h) + aoff + m * 2048 + k * 1024); } } while (0)
#define PG8_LDB(dst, b, h) do { if constexpr (FP8) { _Pragma("unroll") for (int n = 0; n < 2; ++n) dst.v[n] = PG8_LD8(lds + PG8_SB(b, h) + boff + n * 2048); } \
        else { _Pragma("unroll") for (int n = 0; n < 2; ++n) _Pragma("unroll") for (int k = 0; k < 2; ++k) dst.v[n][k] = *(const PG8_LAS bf16x8*)(lds + PG8_SB(b, h) + boff + n * 2048 + k * 1024); } } while (0)
#define PG8_MMA(ai, bj, At, Bt) do { __builtin_amdgcn_s_setprio(1); \
        if constexpr (FP8) { _Pragma("unroll") for (int m = 0; m < 4; ++m) _Pragma("unroll") for (int n = 0; n < 2; ++n) \
            acc[ai][bj][m][n] = __builtin_amdgcn_mfma_scale_f32_16x16x128_f8f6f4(Bt.v[n], At.v[m], acc[ai][bj][m][n], 0, 0, 0, 0, 0, 0); } \
        else { _Pragma("unroll") for (int m = 0; m < 4; ++m) _Pragma("unroll") for (int n = 0; n < 2; ++n) _Pragma("unroll") for (int k = 0; k < 2; ++k) \
            acc[ai][bj][m][n] = __builtin_amdgcn_mfma_f32_16x16x32_bf16(Bt.v[n][k], At.v[m][k], acc[ai][bj][m][n], 0, 0, 0); } \
        __builtin_amdgcn_s_setprio(0); } while (0)
#define PG8_WAIT_V(n) asm volatile("s_waitcnt vmcnt(" #n ")" ::: "memory")
#define PG8_WAIT_L(n) asm volatile("s_waitcnt lgkmcnt(" #n ")" ::: "memory")
#define PG8_BAR __builtin_amdgcn_s_barrier()
#define PG8_SCHED __builtin_amdgcn_sched_barrier(0)
    Unit cur, nxt; int ui = 0;
    if (!S.next(0, cur)) return;
    unsigned vAc[2][2];
    AO.get(cur, vAc, RR, CC);
    PG8_LAS unsigned* const xw = (PG8_LAS unsigned*)xlds + wid * 256 + lane;
    const unsigned xdst = (unsigned)__builtin_amdgcn_readfirstlane((int)((unsigned)(uintptr_t)xlds + (unsigned)wid * 1024u));
    f32x4 acc[2][2][4][2];
#pragma unroll
    for (int a = 0; a < 2; ++a)
#pragma unroll
        for (int b = 0; b < 2; ++b)
#pragma unroll
            for (int m = 0; m < 4; ++m)
#pragma unroll
                for (int n = 0; n < 2; ++n) acc[a][b][m][n] = (f32x4){0.f, 0.f, 0.f, 0.f};
    typedef typename FragT<FP8>::A4 FragA; typedef typename FragT<FP8>::B2 FragB;
    FragA At; FragB B0, B1;
    const char* cA = cur.a; const char* cB = cur.b; int nt = cur.nt; asm volatile("" : "+s"(nt));
    PG8_STAGE(PG8_SB(0, 0), cB, voffB); PG8_STAGE(PG8_SB(0, 1), cB + hstepB, voffB); PG8_STAGE(PG8_SA(0, 0), cA, vAc[0]); PG8_STAGE(PG8_SA(0, 1), cA + hstepA, vAc[AH1]);
    if (wr == 1) PG8_BAR;
    PG8_WAIT_V(2); PG8_BAR;
    PG8_STAGE(PG8_SB(1, 0), cB + kstep, voffB); PG8_STAGE(PG8_SA(1, 0), cA + kstep, vAc[0]); PG8_STAGE(PG8_SB(1, 1), cB + hstepB + kstep, voffB);
    PG8_WAIT_V(6); PG8_BAR;
    for (;;) {
        const bool has_next = S.next(ui + 1, nxt);
        if constexpr (AOff::PER_UNIT) { if (has_next) AO.issue_dma(nxt, RR, xdst); }
        if constexpr (Epi::PREFETCH) E.prefetch(cur, wid, wr, lane);
        const char* nA = has_next ? nxt.a : cA; const char* nB = has_next ? nxt.b : cB;
        for (int t = 0; t < nt; t += 2) {
            const bool last = (t == nt - 2);
            const int rlx = ((t == 0) && (ui > 0)) ? 1 : 0;
            const char* a1 = cA + (size_t)(t + 1) * kstep;
            const char* a2 = last ? nA : cA + (size_t)(t + 2) * kstep; const char* b2 = last ? nB : cB + (size_t)(t + 2) * kstep;
            const char* a3 = a2 + kstep; const char* b3 = b2 + kstep;

            PG8_LDB(B0, 0, 0); PG8_LDB(B1, 0, 1); PG8_SCHED; PG8_LDA(At, 0, 0); PG8_STAGE(PG8_SA(1, 1), a1 + hstepA, vAc[AH1]);
            if constexpr (AOff::PER_UNIT) { if (last && has_next) { int raw[4]; raw[0] = (int)xw[0]; raw[1] = (int)xw[64]; raw[2] = (int)xw[128]; raw[3] = (int)xw[192]; AO.finish(raw, vAc, CC); } }
            if constexpr (Epi::NSTORE + Epi::NPRE > 0) wait_vm_sel<8 + Epi::NSTORE + Epi::NPRE>(rlx); else PG8_WAIT_V(8);
            PG8_WAIT_L(0); PG8_BAR; PG8_MMA(0, 0, At, B0); PG8_MMA(0, 1, At, B1); PG8_BAR; PG8_SCHED;
            PG8_LDA(At, 0, 1); PG8_STAGE(PG8_SB(0, 0), b2, voffB); PG8_STAGE(PG8_SB(0, 1), b2 + hstepB, voffB); PG8_STAGE(PG8_SA(0, 0), a2, vAc[0]);
            if constexpr (Epi::NSTORE + Epi::NPRE > 0) wait_vm_sel<8 + Epi::NSTORE + Epi::NPRE>(rlx); else PG8_WAIT_V(8);
            PG8_WAIT_L(0); PG8_BAR; PG8_MMA(1, 0, At, B0); PG8_MMA(1, 1, At, B1); PG8_BAR; PG8_SCHED;
            PG8_LDB(B0, 1, 0); PG8_LDB(B1, 1, 1); PG8_SCHED; PG8_LDA(At, 1, 0); PG8_STAGE(PG8_SA(0, 1), a2 + hstepA, vAc[AH1]);
            PG8_WAIT_V(8); PG8_WAIT_L(0); PG8_BAR; PG8_MMA(0, 0, At, B0); PG8_MMA(0, 1, At, B1); PG8_BAR; PG8_SCHED;
            PG8_LDA(At, 1, 1); PG8_STAGE(PG8_SB(1, 0), b3, voffB); PG8_STAGE(PG8_SB(1, 1), b3 + hstepB, voffB); PG8_STAGE(PG8_SA(1, 0), a3, vAc[0]);
            PG8_WAIT_V(8); PG8_WAIT_L(0); PG8_BAR; PG8_MMA(1, 0, At, B0); PG8_MMA(1, 1, At, B1); PG8_BAR; PG8_SCHED;
        }
        if constexpr (ALIGN_EPI) { if (wr == 0) PG8_BAR; }
        { const int el = mk_lane(); const int efr = el & 15, efq = el >> 4;
          E(acc, cur, wr, wc, efr, efq); }
        if (!has_next) break;
#pragma unroll
        for (int a = 0; a < 2; ++a)
#pragma unroll
            for (int b = 0; b < 2; ++b)
#pragma unroll
                for (int m = 0; m < 4; ++m)
#pragma unroll
                    for (int n = 0; n < 2; ++n) acc[a][b][m][n] = (f32x4){0.f, 0.f, 0.f, 0.f};
        cur = nxt; cA = nA; cB = nB; nt = cur.nt; asm volatile("" : "+s"(nt)); ++ui;

        if constexpr (ALIGN_EPI) { if (wr == 1) PG8_BAR; }
    }
    PG8_WAIT_V(0);
    if constexpr (!ALIGN_EPI) { if (wr == 0) PG8_BAR; }
    PG8_BAR;
#undef PG8_SA
#undef PG8_SB
#undef PG8_STAGE
#undef PG8_LDA
#undef PG8_LDB
#undef PG8_MMA
#undef PG8_LD8
#undef PG8_WAIT_V
#undef PG8_WAIT_L
#undef PG8_BAR
#undef PG8_SCHED
}
}
namespace attn_body {
using bf16=__hip_bfloat16;
using bf16x8=__attribute__((ext_vector_type(8)))short;
using s16x4=__attribute__((ext_vector_type(4)))short;
using f32x16=__attribute__((ext_vector_type(16)))float;
using u32x4=__attribute__((ext_vector_type(4)))unsigned;
constexpr int SEQ=8192,D=64;
constexpr int PQ=512,PK=512,PV=512,PO=512,PA=1024;
constexpr int NW=8,QBLK=32,QB=QBLK*NW,KVBLK=64,NQB=SEQ/QB;
constexpr int ATTN_UNIT_ROWS=QB;
__device__ __forceinline__ int crow(int r,int hi){return (r&3)+8*(r>>2)+4*hi;}
#define SBAR() __builtin_amdgcn_sched_barrier(0)
__device__ __forceinline__ void cmask(f32x16&p0,f32x16&p1,int jb,int qrel,int hi){
  const float NEG=-INFINITY; int kb=64*jb+4*hi;
  #pragma unroll
  for(int r=0;r<16;++r){int kv=kb+(r&3)+8*(r>>2); if(kv>qrel)p0[r]=NEG; if(kv+32>qrel)p1[r]=NEG;}
}

constexpr int NSLOT=3, SLOTB=8192;
constexpr int LDS_K=0, LDS_V=NSLOT*SLOTB, LDS_WS=3*NSLOT*SLOTB, LDS_OST=LDS_WS+NW*64*4, LDS_BYTES=LDS_OST+NW*8192;
constexpr float C2=0.125f*1.4426950408889634f;
__device__ __forceinline__ void glds16(const void*sbase,unsigned voff,unsigned lds_dst){unsigned keep;
  asm volatile("s_mov_b32 %0, m0\n\ts_mov_b32 m0, %3\n\ts_nop 0\n\tglobal_load_lds_dwordx4 %1, %2\n\ts_mov_b32 m0, %0":"=&s"(keep):"v"(voff),"s"(sbase),"s"(lds_dst):"memory");}
__device__ __forceinline__ float max3f(float a,float b,float c){float r;asm("v_max3_f32 %0, %1, %2, %3":"=v"(r):"v"(a),"v"(b),"v"(c));return r;}
__device__ __forceinline__ float max2f(float a,float b){float r;asm("v_max_f32_e32 %0, %1, %2":"=v"(r):"v"(a),"v"(b));return r;}
__device__ __forceinline__ float fadd_s(float a,float b){float r;asm("v_add_f32_e32 %0, %1, %2":"=v"(r):"v"(a),"v"(b));return r;}
__device__ __forceinline__ float fsub_s(float a,float b){float r;asm("v_sub_f32_e32 %0, %1, %2":"=v"(r):"v"(a),"v"(b));return r;}
typedef float f32x2_t __attribute__((ext_vector_type(2))); typedef __bf16 bf16x2_t __attribute__((ext_vector_type(2)));
__device__ __forceinline__ unsigned cvtpk_s(float lo,float hi){f32x2_t v={lo,hi};bf16x2_t b=__builtin_convertvector(v,bf16x2_t);return __builtin_bit_cast(unsigned,b);}
#define WAIT_BAR(N) asm volatile("s_waitcnt vmcnt(" #N ") lgkmcnt(0)\n\ts_barrier":::"memory")

__device__ __forceinline__ void qkt(f32x16&p0,f32x16&p1,const char*Kslot,const bf16x8*qr,const f32x16&negm,int r32,int hi){
  const char*kb=Kslot+hi*1024+r32*16;
  #pragma unroll
  for(int d0=0;d0<4;++d0){
    const bf16x8 b0=*reinterpret_cast<const bf16x8*>(kb+d0*2048);
    const bf16x8 b1=*reinterpret_cast<const bf16x8*>(kb+d0*2048+512);
    if(d0==0){p0=__builtin_amdgcn_mfma_f32_32x32x16_bf16(b0,qr[0],negm,0,0,0);p1=__builtin_amdgcn_mfma_f32_32x32x16_bf16(b1,qr[0],negm,0,0,0);}
    else{p0=__builtin_amdgcn_mfma_f32_32x32x16_bf16(b0,qr[d0],p0,0,0,0);p1=__builtin_amdgcn_mfma_f32_32x32x16_bf16(b1,qr[d0],p1,0,0,0);}}
}
typedef __attribute__((address_space(3))) const char* lds_cptr;
typedef short v4i16_t __attribute__((ext_vector_type(4)));
__device__ __forceinline__ void kload8(bf16x8*kf,lds_cptr kp){
  kf[0]=*(const __attribute__((address_space(3))) bf16x8*)(kp);      kf[1]=*(const __attribute__((address_space(3))) bf16x8*)(kp+512);
  kf[2]=*(const __attribute__((address_space(3))) bf16x8*)(kp+2048); kf[3]=*(const __attribute__((address_space(3))) bf16x8*)(kp+2560);
  kf[4]=*(const __attribute__((address_space(3))) bf16x8*)(kp+4096); kf[5]=*(const __attribute__((address_space(3))) bf16x8*)(kp+4608);
  kf[6]=*(const __attribute__((address_space(3))) bf16x8*)(kp+6144); kf[7]=*(const __attribute__((address_space(3))) bf16x8*)(kp+6656);
}
__device__ __forceinline__ void kload2(bf16x8*kf,lds_cptr kp,int j){ kf[2*j]=*(const __attribute__((address_space(3))) bf16x8*)(kp+j*2048); kf[2*j+1]=*(const __attribute__((address_space(3))) bf16x8*)(kp+j*2048+512); }
__device__ __forceinline__ s16x4 vtr(lds_cptr p){ return __builtin_bit_cast(s16x4,__builtin_amdgcn_ds_read_tr16_b64_v4i16((__attribute__((address_space(3))) v4i16_t*)p)); }
__device__ __forceinline__ float rowmax(const f32x16&p0,const f32x16&p1){
  float a=max3f(p0[0],p0[1],p1[0]),b=max3f(p0[2],p0[3],p1[1]);a=max3f(a,p1[2],p1[3]);
  #pragma unroll
  for(int r=4;r<16;r+=4){a=max3f(a,p0[r],p0[r+1]);b=max3f(b,p0[r+2],p0[r+3]);a=max3f(a,p1[r],p1[r+1]);b=max3f(b,p1[r+2],p1[r+3]);}
  const float m=max2f(a,b);
  auto rr=__builtin_amdgcn_permlane32_swap(__float_as_uint(m),__float_as_uint(m),false,false);
  return max2f(__uint_as_float(rr[0]),__uint_as_float(rr[1]));
}
__device__ __forceinline__ void pv(f32x16*o,int vb,bf16x8 pa0,bf16x8 pa1,bf16x8 pa2,bf16x8 pa3){
  #pragma unroll
  for(int d0=0;d0<4;++d0){s16x4 lo[4],hi[4];
    #pragma unroll
    for(int ks=0;ks<4;++ks){
      asm volatile("ds_read_b64_tr_b16 %0,%1 offset:%c2":"=&v"(lo[ks]):"v"(vb),"i"(d0*4096+ks*1024):"memory");
      asm volatile("ds_read_b64_tr_b16 %0,%1 offset:%c2":"=&v"(hi[ks]):"v"(vb),"i"(d0*4096+ks*1024+512):"memory");}
    asm volatile("s_waitcnt lgkmcnt(0)":::"memory");SBAR();
    #define PK(k) (bf16x8){lo[k][0],lo[k][1],lo[k][2],lo[k][3],hi[k][0],hi[k][1],hi[k][2],hi[k][3]}
    o[d0]=__builtin_amdgcn_mfma_f32_32x32x16_bf16(pa0,PK(0),o[d0],0,0,0);
    o[d0]=__builtin_amdgcn_mfma_f32_32x32x16_bf16(pa1,PK(1),o[d0],0,0,0);
    o[d0]=__builtin_amdgcn_mfma_f32_32x32x16_bf16(pa2,PK(2),o[d0],0,0,0);
    o[d0]=__builtin_amdgcn_mfma_f32_32x32x16_bf16(pa3,PK(3),o[d0],0,0,0);
    #undef PK
  }
}

#ifndef ATTN_STORE16
#define ATTN_STORE16(p,v) (*(u32x4*)(p)=(v))
#endif
template<int THRL> __device__ __forceinline__ void attn_unit(int b,int qoff,int koff,int voff,int ooff,int qb,const bf16*Q,const bf16*__restrict__ K,const bf16*__restrict__ V,bf16*O,char*shm,const int wave_,const int map,bf16*AOUT,const float lam,const float*ng){
  const int lane=mk_lane(),r32=lane&31,hi=lane>>5; const int wid=__builtin_amdgcn_readfirstlane(wave_);
  const long rowbase=(long)b*SEQ; const int q0=qb*QB;
  const bf16*Qw=Q+(rowbase+q0+wid*QBLK)*PQ+qoff;
  const bf16*Kh=K+rowbase*PK+koff,*Vh=V+rowbase*PV+voff;
  const unsigned lds0=(unsigned)(uintptr_t)shm;
  float*wsf=(float*)(shm+LDS_WS)+wid*64;
  const unsigned kofs=(unsigned)(lane*PK+wid*8)*2u;
  const unsigned voffs=(unsigned)((16*(wid&3)+(lane>>2))*PV+(wid>>2)*32+(lane&3)*8)*2u;
  const unsigned kdst=lds0+LDS_K+wid*1024, vdst=lds0+LDS_V+wid*1024;
  #define DMA_K(t,slot) glds16(Kh+(long)(t)*KVBLK*PK,kofs,(unsigned)__builtin_amdgcn_readfirstlane(kdst+(slot)))
  #define DMA_V(t,slot) do{ glds16(Vh+(long)(t)*KVBLK*PV,voffs,(unsigned)__builtin_amdgcn_readfirstlane(vdst+2*(slot))); glds16(Vh+(long)(t)*KVBLK*PV+64,voffs,(unsigned)__builtin_amdgcn_readfirstlane(vdst+2*(slot)+8192)); }while(0)
  const int vb0=(int)(lds0+LDS_V)+((lane>>4)&1)*32+(lane&3)*8+(4*hi+((lane&15)>>2))*64;
  const char*Kbase=shm+LDS_K; bf16x8 kf[8];
  const lds_cptr shm3=(lds_cptr)shm; const lds_cptr kp0=shm3+LDS_K+hi*1024+r32*16; const lds_cptr vp0=shm3+LDS_V+((lane>>4)&1)*32+(lane&3)*8+(4*hi+((lane&15)>>2))*64;
  const int NT=(q0+QB)/KVBLK;
  DMA_K(0,0);DMA_V(0,0);DMA_K(1,SLOTB);
  bf16x8 qr[4];
  #pragma unroll
  for(int d0=0;d0<4;++d0)qr[d0]=*reinterpret_cast<const bf16x8*>(&Qw[(long)r32*PQ+d0*16+hi*8]);
  typedef __attribute__((address_space(3))) char* lds_wptr;
  const lds_cptr qp0=shm3+LDS_OST+wid*8192+hi*512+r32*16;
  { lds_wptr qw=(lds_wptr)shm+LDS_OST+wid*8192+hi*512+r32*16;
    _Pragma("unroll") for(int d0=0;d0<4;++d0)*(__attribute__((address_space(3))) bf16x8*)(qw+d0*1024)=qr[d0]; }
  float mhat=0.f,l_reg=0.f;f32x16 o[4];o[0]=f32x16{};o[1]=f32x16{};o[2]=f32x16{};o[3]=f32x16{};const f32x16 zero16=f32x16{};
  const int qrel=wid*QBLK+r32;
  #define CMASK(P0,P1,t) do{int jb_=(t)-(NT-4); if(jb_>=0)cmask(P0,P1,jb_,qrel,hi);}while(0)
  bool resc=false;
  #define START(P0,P1) do{ const float rm=rowmax(P0,P1); resc=false; mhat=rm; \
    _Pragma("unroll") for(int r=0;r<16;++r)P0[r]=__builtin_amdgcn_exp2f(P0[r]-mhat); }while(0)
  #define RESC() do{ if(resc){ asm volatile("s_waitcnt lgkmcnt(0)":::"memory"); \
      _Pragma("unroll") for(int d_=0;d_<4;++d_) _Pragma("unroll") for(int r=0;r<16;++r)o[d_][r]*=wsf[crow(r,hi)]; } }while(0)
  f32x16 pA0,pA1,pB0,pB1;
  int sl_prev=0,sl_cur=0,sl_next=SLOTB;
  #define ROT() do{sl_prev=sl_cur;sl_cur=sl_next;sl_next=(sl_next==(NSLOT-1)*SLOTB)?0:sl_next+SLOTB;}while(0)
  DMA_K(2,2*SLOTB);
  WAIT_BAR(4);
  qkt(pA0,pA1,Kbase,qr,zero16,r32,hi);asm volatile("s_nop 15\n\ts_nop 7":"+v"(pA0),"+v"(pA1));CMASK(pA0,pA1,0);
  START(pA0,pA1);
  _Pragma("unroll") for(int r=0;r<16;++r)pA1[r]=__builtin_amdgcn_exp2f(pA1[r]-mhat);
  WAIT_BAR(0);
  DMA_K(3,0);DMA_V(1,SLOTB);
  ROT();
  kload8(kf,kp0+sl_cur);
  WAIT_BAR(3);
  s16x4 vlo[3],vhi[3]; u32x4 pw0,pw1,pw2,pw3;
  #define PKW(P,B) cvtpk_s(P[B],P[B+1])
  #define PAF(k) __builtin_bit_cast(bf16x8,pw##k)
  #define VFS(s) (bf16x8){vlo[s][0],vlo[s][1],vlo[s][2],vlo[s][3],vhi[s][0],vhi[s][1],vhi[s][2],vhi[s][3]}
  #define PIN(x) asm volatile("":"+v"(x))
  #define MX3(a,b,c) __builtin_fmaxf(__builtin_fmaxf((a),(b)),(c))
  #define GAPA(MF,A0,A1,A2,A3,W0,W1,PW) do{ MF; sacc+=A0; sacc+=A1; sacc+=A2; sacc+=A3; PIN(sacc); W0; W1; PIN(PW); SBAR(); }while(0)
  #define EX(v) __builtin_amdgcn_exp2f(v)
  #define GAPB(MF,X,B) do{ MF; X[B]=EX(X[B]-mhat); X[B+1]=EX(X[B+1]-mhat); PIN(X); SBAR(); }while(0)
  #define VRDG(g) do{ vlo[(g)%3]=vtr(vp_+(((g)&3)*4096+((g)>>2)*1024)); vhi[(g)%3]=vtr(vp_+(((g)&3)*4096+((g)>>2)*1024+512)); SBAR(); }while(0)
  #define QRD(d0) (*(const __attribute__((address_space(3))) bf16x8*)(qp0+(d0)*1024))
  #define KRD(G,j) do{ if(G){ kload2(kf,kp0+sl_next,j); SBAR(); } }while(0)
  #define PVG(g,PF,X,B) GAPB(o[(g)&3]=__builtin_amdgcn_mfma_f32_32x32x16_bf16(PF,VFS((g)%3),o[(g)&3],0,0,0), X,B)
  #define STEP(C0,C1,P0,P1,t,GK,GV,GL) do{ SBAR(); \
    const lds_cptr vp_=vp0+2*sl_prev; \
    bf16x8 qa=QRD(0), qb=QRD(1); SBAR(); float sacc=(P0[0]+P0[1]); \
    GAPA(C0=__builtin_amdgcn_mfma_f32_32x32x16_bf16(kf[0],qa,zero16,0,0,0), P0[2],P0[3],P0[4],P0[5],     pw0[0]=PKW(P0,0), pw0[1]=PKW(P0,2), pw0); \
    GAPA(C1=__builtin_amdgcn_mfma_f32_32x32x16_bf16(kf[1],qa,zero16,0,0,0), P0[6],P0[7],P0[8],P0[9],     pw0[2]=PKW(P0,4), pw0[3]=PKW(P0,6), pw0); \
    qa=QRD(2); SBAR(); \
    GAPA(C0=__builtin_amdgcn_mfma_f32_32x32x16_bf16(kf[2],qb,C0,0,0,0),   P0[10],P0[11],P0[12],P0[13], pw1[0]=PKW(P0,8), pw1[1]=PKW(P0,10), pw1); \
    GAPA(C1=__builtin_amdgcn_mfma_f32_32x32x16_bf16(kf[3],qb,C1,0,0,0),   P0[14],P0[15],P1[0],P1[1],   pw1[2]=PKW(P0,12),pw1[3]=PKW(P0,14), pw1); \
    qb=QRD(3); SBAR(); \
    GAPA(C0=__builtin_amdgcn_mfma_f32_32x32x16_bf16(kf[4],qa,C0,0,0,0),   P1[2],P1[3],P1[4],P1[5],     pw2[0]=PKW(P1,0), pw2[1]=PKW(P1,2), pw2); \
    GAPA(C1=__builtin_amdgcn_mfma_f32_32x32x16_bf16(kf[5],qa,C1,0,0,0),   P1[6],P1[7],P1[8],P1[9],     pw2[2]=PKW(P1,4), pw2[3]=PKW(P1,6), pw2); \
    GAPA(C0=__builtin_amdgcn_mfma_f32_32x32x16_bf16(kf[6],qb,C0,0,0,0),   P1[10],P1[11],P1[12],P1[13], pw3[0]=PKW(P1,8), pw3[1]=PKW(P1,10), pw3); \
    GAPA(C1=__builtin_amdgcn_mfma_f32_32x32x16_bf16(kf[7],qb,C1,0,0,0),   P1[14],P1[15],0.f,0.f,       pw3[2]=PKW(P1,12),pw3[3]=PKW(P1,14), pw3); \
    l_reg+=sacc; \
    if(GK){DMA_K((t)+3,sl_cur);} if(GV){DMA_V((t)+1,sl_next);} \
    VRDG(0); VRDG(1); \
    CMASK(C0,C1,t); \
    { float a=MX3(C0[0],C0[1],C1[0]),b=MX3(C0[2],C0[3],C1[1]); a=MX3(a,C1[2],C1[3]); \
      _Pragma("unroll") for(int r=4;r<16;r+=4){a=MX3(a,C0[r],C0[r+1]);b=MX3(b,C0[r+2],C0[r+3]);a=MX3(a,C1[r],C1[r+1]);b=MX3(b,C1[r+2],C1[r+3]);} \
      float rm=__builtin_fmaxf(a,b); { auto rr=__builtin_amdgcn_permlane32_swap(__float_as_uint(rm),__float_as_uint(rm),false,false); rm=__builtin_fmaxf(__uint_as_float(rr[0]),__uint_as_float(rr[1])); } \
      rm-=mhat; resc=false; \
      if(__builtin_expect(__any(rm>(float)THRL),0)){ const float dl=__builtin_fmaxf(rm,0.f); mhat+=dl; \
        const float f=__builtin_amdgcn_exp2f(-dl); l_reg*=f; if(hi==0)wsf[r32]=f; resc=true; } } \
    SBAR(); \
    PVG(0,PAF(0),C0,0);  VRDG(2); \
    PVG(1,PAF(0),C0,2);  VRDG(3); \
    PVG(2,PAF(0),C0,4);  VRDG(4); \
    PVG(3,PAF(0),C0,6);  VRDG(5); \
    PVG(4,PAF(1),C0,8);  VRDG(6); \
    PVG(5,PAF(1),C0,10); VRDG(7); \
    PVG(6,PAF(1),C0,12); VRDG(8); \
    PVG(7,PAF(1),C0,14); VRDG(9); \
    PVG(8,PAF(2),C1,0);  VRDG(10); \
    PVG(9,PAF(2),C1,2);  VRDG(11); \
    PVG(10,PAF(2),C1,4); VRDG(12); \
    PVG(11,PAF(2),C1,6); VRDG(13); \
    PVG(12,PAF(3),C1,8); VRDG(14); KRD(GL,0); \
    PVG(13,PAF(3),C1,10); VRDG(15); KRD(GL,1); \
    PVG(14,PAF(3),C1,12); KRD(GL,2); \
    PVG(15,PAF(3),C1,14); KRD(GL,3); \
    }while(0)
  int t=1;
  #undef CMASK
  #define CMASK(P0,P1,t) do{}while(0)
  for(;t+5<NT;t+=2){
    STEP(pB0,pB1,pA0,pA1,t,true,true,true);     WAIT_BAR(3); RESC(); ROT();
    STEP(pA0,pA1,pB0,pB1,t+1,true,true,true);   WAIT_BAR(3); RESC(); ROT();
  }
  #undef CMASK
  #define CMASK(P0,P1,t) do{int jb_=(t)-(NT-4); if(jb_>=0)cmask(P0,P1,jb_,qrel,hi);}while(0)
  #define ENDW(tt) do{ if((tt)+3<NT){WAIT_BAR(3);} else if((tt)+2<NT){WAIT_BAR(2);} else {WAIT_BAR(0);} }while(0)
  for(;t+1<NT;t+=2){
    STEP(pB0,pB1,pA0,pA1,t,(t+3<NT),(t+1<NT),(t+1<NT));       ENDW(t);   RESC(); ROT();
    STEP(pA0,pA1,pB0,pB1,t+1,(t+4<NT),(t+2<NT),(t+2<NT));     ENDW(t+1); RESC(); ROT();
  }
  STEP(pB0,pB1,pA0,pA1,NT-1,false,false,false); RESC();
  { float sacc=pB0[0]+pB0[1]; _Pragma("unroll") for(int r=2;r<16;++r)sacc+=pB0[r]; _Pragma("unroll") for(int r=0;r<16;++r)sacc+=pB1[r]; l_reg+=sacc;
    pw0=(u32x4){PKW(pB0,0),PKW(pB0,2),PKW(pB0,4),PKW(pB0,6)};pw1=(u32x4){PKW(pB0,8),PKW(pB0,10),PKW(pB0,12),PKW(pB0,14)};pw2=(u32x4){PKW(pB1,0),PKW(pB1,2),PKW(pB1,4),PKW(pB1,6)};pw3=(u32x4){PKW(pB1,8),PKW(pB1,10),PKW(pB1,12),PKW(pB1,14)};
    SBAR(); pv(o,vb0+2*sl_cur,PAF(0),PAF(1),PAF(2),PAF(3)); }
  #undef PKW
  #undef PAF
  #undef VFS
  #undef VRDG
  #undef QRD
  #undef PVG
  #undef PIN
  #undef MX3
  #undef GAPA
  #undef GAPB
  #undef EX
  #undef KRD
  #undef STEP
  #undef ENDW
  { int lane_e=mk_lane(); asm volatile("":"+v"(lane_e)); const int lane=lane_e,r32=lane&31,hi=lane>>5;
  {auto rr=__builtin_amdgcn_permlane32_swap(__float_as_uint(l_reg),__float_as_uint(l_reg),false,false);l_reg=__uint_as_float(rr[0])+__uint_as_float(rr[1]);}
  if(hi==0)wsf[32+r32]=l_reg;asm volatile("s_waitcnt lgkmcnt(0)":::"memory");
  float rli[16];
  #pragma unroll
  for(int r=0;r<16;++r)rli[r]=__builtin_amdgcn_rcpf(wsf[32+crow(r,hi)]);
  bf16*Ow=O+(rowbase+q0+wid*QBLK)*PO+ooff;
  { bf16*stg=(bf16*)(shm+LDS_OST)+wid*4096;
    #pragma unroll
    for(int r=0;r<16;++r){const int orow=crow(r,hi);
      #pragma unroll
      for(int d0=0;d0<4;++d0)stg[orow*128+d0*32+r32]=__float2bfloat16(o[d0][r]*rli[r]);}
    asm volatile("s_waitcnt lgkmcnt(0)":::"memory");
    if(map==0){
      #pragma unroll
      for(int i=0;i<8;++i){const int row=i*4+(lane>>4),ch=lane&15; const u32x4 v=*(const u32x4*)(stg+row*128+ch*8); ATTN_STORE16(Ow+(long)row*PO+ch*8,v);}
    }else{
      const int ch=lane&15; const float4 g0=*reinterpret_cast<const float4*>(ng+ch*8),g1=*reinterpret_cast<const float4*>(ng+ch*8+4);
      bf16*Aw=AOUT+(rowbase+q0+wid*QBLK)*PA+ooff;
      #pragma unroll
      for(int i=0;i<8;++i){const int row=i*4+(lane>>4); const u32x4 v2=*(const u32x4*)(stg+row*128+ch*8); const u32x4 v1=*(const u32x4*)(Ow+(long)row*PO+ch*8);
        float d[8];
        #define BLO(w) __uint_as_float((w)<<16)
        #define BHI(w) __uint_as_float((w)&0xffff0000u)
        d[0]=BLO(v1[0])-lam*BLO(v2[0]);d[1]=BHI(v1[0])-lam*BHI(v2[0]);d[2]=BLO(v1[1])-lam*BLO(v2[1]);d[3]=BHI(v1[1])-lam*BHI(v2[1]);
        d[4]=BLO(v1[2])-lam*BLO(v2[2]);d[5]=BHI(v1[2])-lam*BHI(v2[2]);d[6]=BLO(v1[3])-lam*BLO(v2[3]);d[7]=BHI(v1[3])-lam*BHI(v2[3]);
        #undef BLO
        #undef BHI
        float ss=0.f;
        #pragma unroll
        for(int q=0;q<8;++q)ss+=d[q]*d[q];
        ss+=__shfl_xor(ss,1);ss+=__shfl_xor(ss,2);ss+=__shfl_xor(ss,4);ss+=__shfl_xor(ss,8);
        const float sc=0.8f/sqrtf(ss*(1.f/128.f)+1e-6f);
        u32x4 w; w[0]=cvtpk_s(d[0]*sc*g0.x,d[1]*sc*g0.y);w[1]=cvtpk_s(d[2]*sc*g0.z,d[3]*sc*g0.w);w[2]=cvtpk_s(d[4]*sc*g1.x,d[5]*sc*g1.y);w[3]=cvtpk_s(d[6]*sc*g1.z,d[7]*sc*g1.w);
        __builtin_nontemporal_store(w,(u32x4*)(Aw+(long)row*PA+ch*8));}
    } }
  }
  asm volatile("s_waitcnt lgkmcnt(0)\n\ts_barrier":::"memory");
  #undef DMA_K
  #undef DMA_V
  #undef CMASK
  #undef START
  #undef RESC
  #undef ROT
}
constexpr int ATTN_LDS_BYTES=LDS_BYTES;
#undef SBAR
#undef WAIT_BAR
}
#define GAS __attribute__((address_space(1)))
#define LAS __attribute__((address_space(3)))
typedef unsigned short bf16;
typedef unsigned v4u __attribute__((ext_vector_type(4)));
typedef float f32x4 __attribute__((ext_vector_type(4)));
typedef short bf16x8 __attribute__((ext_vector_type(8)));
typedef GAS unsigned gu32;
typedef GAS unsigned long long gu64;
#define RLX_AGENT __ATOMIC_RELAXED, __HIP_MEMORY_SCOPE_AGENT
#define LDS_WAIT() asm volatile("s_waitcnt lgkmcnt(0)" ::: "memory")
#define VM_WAIT() asm volatile("s_waitcnt vmcnt(0)" ::: "memory")
__device__ __forceinline__ unsigned long long rt() { return __builtin_amdgcn_s_memrealtime(); }
__device__ __forceinline__ unsigned f2bf(float f) { unsigned u = __builtin_bit_cast(unsigned, f); return (u + 0x7fffu + ((u >> 16) & 1u)) >> 16; }
__device__ __forceinline__ unsigned pk2(float lo, float hi) { return f2bf(lo) | (f2bf(hi) << 16); }

#define XB_TMO      128
#define XB_XCNT(j)  (256  + 64 * (j))
#define XB_XSUB(j)  (1280 + 64 * (j))
#define XB_XGEN(j)  (2304 + 64 * (j))
#define XB_TOP      3328
#define XB_TOPGEN   3392
#define XCD_BAR_WORDS 3456
#define XB_SPIN_CAP (1u << 18)

__device__ __forceinline__ unsigned xb_ld(unsigned* p)              { return __hip_atomic_load(p, __ATOMIC_RELAXED, __HIP_MEMORY_SCOPE_AGENT); }
__device__ __forceinline__ unsigned xb_add(unsigned* p, unsigned v) { return __hip_atomic_fetch_add(p, v, __ATOMIC_RELAXED, __HIP_MEMORY_SCOPE_AGENT); }
__device__ __forceinline__ unsigned xb_xcc_id() { return (unsigned)__builtin_amdgcn_s_getreg((3 << 11) | 20) & 0xFu; }
#define XB_SPIN(cond, bar) do { unsigned _sp = 0; while (cond) { __builtin_amdgcn_s_sleep(1); \
    if ((++_sp & 255u) == 0u) { if (xb_ld(&(bar)[XB_TMO])) break; if (_sp > XB_SPIN_CAP) { atomicAdd(&(bar)[XB_TMO], 1u); break; } } } } while (0)

struct XcdBarrier {
    unsigned* bar; unsigned x; int wave; unsigned G;
    volatile LAS unsigned* st;
};

__device__ __forceinline__ XcdBarrier xcd_barrier_post(unsigned* bar, volatile LAS unsigned* st, int wave, unsigned G) {
    XcdBarrier b; b.bar = bar; b.x = xb_xcc_id(); b.st = st; b.wave = wave; b.G = G;
    if (wave == 0 && mk_lane() == 0) (void)xb_add(&bar[XB_XCNT(b.x)], 1u);
    return b;
}
__device__ __forceinline__ void xcd_barrier_complete(unsigned* bar, unsigned x, unsigned& nloc, unsigned& nx, const unsigned G) {
    unsigned sum, cnt, mine, sp = 0u;
    for (;;) {
        sum = 0u; cnt = 0u; mine = 0u;
#pragma unroll
        for (unsigned j = 0; j < 16; ++j) { const unsigned c = xb_ld(&bar[XB_XCNT(j)]); sum += c; cnt += (c > 0u) ? 1u : 0u; mine = (j == x) ? c : mine; }
        if (sum == G) break;
        __builtin_amdgcn_s_sleep(1);
        if ((++sp & 255u) == 0u) { if (xb_ld(&bar[XB_TMO])) break; if (sp > XB_SPIN_CAP) { atomicAdd(&bar[XB_TMO], 1u); break; } }
    }
    nloc = mine > 0u ? mine : 1u; nx = cnt > 0u ? cnt : 1u;
}

__device__ __forceinline__ void xcd_barrier(const XcdBarrier& b) {
    asm volatile("s_waitcnt vmcnt(0)" ::: "memory");
    __syncthreads();
    if (b.wave == 0 && mk_lane() == 0) {
        unsigned* bar = b.bar;
        __builtin_amdgcn_s_waitcnt(0);
        unsigned nloc = b.st[0], nx = b.st[1];
        if (nloc == 0u) { xcd_barrier_complete(bar, b.x, nloc, nx, b.G); b.st[0] = nloc; b.st[1] = nx; }
        const unsigned old = xb_add(&bar[XB_XSUB(b.x)], 1u);
        const unsigned gen = old / nloc;
        if (old + 1u == (gen + 1u) * nloc) {
            __builtin_amdgcn_fence(__ATOMIC_RELEASE, "agent");
            asm volatile("s_waitcnt vmcnt(0)" ::: "memory");
            const unsigned og = xb_add(&bar[XB_TOP], 1u);
            const unsigned tg = og / nx;
            if (og + 1u == (tg + 1u) * nx) xb_add(&bar[XB_TOPGEN], 1u);
            else XB_SPIN(xb_ld(&bar[XB_TOPGEN]) == tg, bar);
            __builtin_amdgcn_fence(__ATOMIC_ACQUIRE, "agent");
            xb_add(&bar[XB_XGEN(b.x)], 1u);
            asm volatile("s_waitcnt vmcnt(0)" ::: "memory");
        } else {
            XB_SPIN(xb_ld(&bar[XB_XGEN(b.x)]) == gen, bar);
            __builtin_amdgcn_fence(__ATOMIC_ACQUIRE, "agent");
            asm volatile("s_waitcnt vmcnt(0)" ::: "memory");
        }
    }
    __syncthreads();
}
constexpr int NWAVES = 8;
#ifndef MK_N_LAUNCHES
#define MK_N_LAUNCHES 1
#endif
constexpr int NPH = 12;
constexpr int N_LAUNCHES = MK_N_LAUNCHES;
static_assert(N_LAUNCHES == 1 || N_LAUNCHES == NPH, "MK_N_LAUNCHES is 1 or 12");

constexpr int NB = 4, SEQ = 8192, T = NB * SEQ, D = 1024;
constexpr int NE = 32, TOPK = 4, NA = T * TOPK;
constexpr int SG = 32, SL = 32, AROW_P = 640;
constexpr float RMS_EPS = 1e-6f;
constexpr float SW_LIMIT = 7.0f, SW_ALPHA = 1.702f;
constexpr float LAMBDA_INIT = 0.2f;

constexpr size_t MiB = 1u << 20;
constexpr size_t WS_CTL = 0, CTL_ZERO_BYTES = 128 * 1024;
constexpr size_t WS_ROPE = 2 * MiB;
constexpr size_t WS_WIN = 4 * MiB;
constexpr size_t WS_WOUT = 8 * MiB;
constexpr size_t WS_WGLU = 10 * MiB;
constexpr size_t WS_SMALL = 11 * MiB;
constexpr size_t SM_AL = 1024, SM_WR = 32768;
constexpr size_t WS_BTY = 12 * MiB;
constexpr size_t WS_BTX = 32 * MiB;
constexpr size_t WS_WGU = 40 * MiB;
constexpr size_t WS_WD = 168 * MiB;
constexpr size_t WS_XN = 232 * MiB;
constexpr size_t WS_Q = 296 * MiB, WS_K = 328 * MiB, WS_V = 360 * MiB;
constexpr size_t WS_AROW = 392 * MiB;
constexpr size_t WS_XLOC = 432 * MiB;
constexpr size_t WS_O = 464 * MiB;
constexpr size_t WS_MIX = 464 * MiB;
constexpr size_t WS_ACAT = 528 * MiB;
constexpr size_t WS_HB = 528 * MiB;
constexpr size_t WS_YG = 592 * MiB;
constexpr size_t WS_GLU = 624 * MiB;
constexpr size_t WS_LIST = 656 * MiB;
constexpr size_t WS_GATES = 660 * MiB;
constexpr size_t WS_ACT = 296 * MiB;
constexpr size_t WS_YBUF = 664 * MiB;
constexpr size_t WS_END = 920 * MiB;
static_assert(WS_ACT + (size_t)(NA + 8192) * 1024 * 2 <= WS_YG, "Act overlay");
constexpr int CW_TMO = 0, CW_CODE = 1;
constexpr int CW_BAR = 4096;
constexpr int CW_ECNT = 16384;

constexpr int RING_OFF = 0, RING_BYTES = 131072;
constexpr int WRT_BYTES = 1024 * 36 * 4;
constexpr int LDSCTL_OFF = 147456, MISC_OFF = LDSCTL_OFF;
constexpr int MOE_OFF = LDSCTL_OFF + 256;
constexpr int RT_OFF = LDSCTL_OFF + 640;
constexpr int ST_OFF = LDSCTL_OFF + 1024;
constexpr int EPB_OFF = 131072;
constexpr int LDS_BYTES = 157696;
static_assert(ST_OFF + 8192 <= LDS_BYTES, "LDS map");

struct Args { const void* in[29]; float* out; unsigned char* ws; int ph_lo, ph_hi, li, pad; };
struct Frame {
    LAS unsigned char* lds;
    volatile LAS unsigned* MISC;
    gu32* ctl;
    int wave;
    int vcu, G;
};
#define INF(a, k) ((const float*)(a).in[k])
#define FTID(F) ((F).wave * 64 + mk_lane())
#ifndef PROBE_DUP
#define PROBE_DUP -1
#endif
#define NREP(k) ((PROBE_DUP == (k)) ? 2 : 1)

__device__ __forceinline__ unsigned pk_fp8x4_(float a, float b, float c, float d) { int w = 0; w = __builtin_amdgcn_cvt_pk_fp8_f32(a, b, w, false); w = __builtin_amdgcn_cvt_pk_fp8_f32(c, d, w, true); return (unsigned)w; }
__device__ __forceinline__ float wave_sum(float v) {
#pragma unroll
    for (int o = 1; o < 64; o <<= 1) v += __shfl_xor(v, o);
    return v;
}
template <bool FP8> __device__ __forceinline__ void p0_tr64(const float* W, int K, int N, void* WT, LAS float* scr, int item, int lane, float scale) {
    const int nblk = N / 64, kb = item / nblk, nb = item % nblk, k0 = 64 * kb, n0 = 64 * nb;
    f32x4 v[16];
#pragma unroll
    for (int i = 0; i < 16; ++i) v[i] = __builtin_nontemporal_load((const GAS f32x4*)(W + (size_t)(k0 + i * 4 + (lane >> 4)) * N + n0 + 4 * (lane & 15)));
#pragma unroll
    for (int i = 0; i < 16; ++i) *(LAS f32x4*)(scr + (i * 4 + (lane >> 4)) * 68 + 4 * (lane & 15)) = v[i];
    LDS_WAIT(); asm volatile("" ::: "memory");
    if constexpr (FP8) {
#pragma unroll
        for (int c = 0; c < 4; ++c) { const LAS float* s = scr + (16 * c) * 68 + lane; v4u o;
            o.x = pk_fp8x4_(s[0 * 68] * scale, s[1 * 68] * scale, s[2 * 68] * scale, s[3 * 68] * scale); o.y = pk_fp8x4_(s[4 * 68] * scale, s[5 * 68] * scale, s[6 * 68] * scale, s[7 * 68] * scale);
            o.z = pk_fp8x4_(s[8 * 68] * scale, s[9 * 68] * scale, s[10 * 68] * scale, s[11 * 68] * scale); o.w = pk_fp8x4_(s[12 * 68] * scale, s[13 * 68] * scale, s[14 * 68] * scale, s[15 * 68] * scale);
            *(GAS v4u*)((unsigned char*)WT + (size_t)(n0 + lane) * K + k0 + 16 * c) = o; }
    } else {
#pragma unroll
        for (int c = 0; c < 8; ++c) { const LAS float* s = scr + (8 * c) * 68 + lane;
            v4u o; o.x = pk2(s[0 * 68], s[1 * 68]); o.y = pk2(s[2 * 68], s[3 * 68]); o.z = pk2(s[4 * 68], s[5 * 68]); o.w = pk2(s[6 * 68], s[7 * 68]);
            *(GAS v4u*)((bf16*)WT + (size_t)(n0 + lane) * K + k0 + 8 * c) = o; }
    }
    LDS_WAIT(); asm volatile("" ::: "memory");
}
__device__ __forceinline__ void cv_wg_item(Frame& F, const Args& a, const int item, const int lane) {
    const float* W; unsigned char* WT; int N, n0, k0;
    if (item < 512) { const int e = item >> 4, r = item & 15; N = 2048; W = INF(a, 24) + (size_t)e * 1024 * 2048; WT = a.ws + WS_WGU + (size_t)e * 2048 * 1024; n0 = (r >> 3) * 1024; k0 = (r & 7) * 128; }
    else { const int i2 = item - 512, e = i2 >> 3; N = 1024; W = INF(a, 26) + (size_t)e * 1024 * 1024; WT = a.ws + WS_WD + (size_t)e * 1024 * 1024; n0 = 0; k0 = (i2 & 7) * 128; }
    LAS unsigned char* tile = F.lds;
    const float* wp = W + (size_t)(k0 + 16 * F.wave) * N + n0 + 4 * lane;
    f32x4 va[4][4], vb[4][4];
#define CVW_LOAD(v, grp) do { _Pragma("unroll") for (int ch = 0; ch < 4; ++ch) _Pragma("unroll") for (int q = 0; q < 4; ++q) v[ch][q] = __builtin_nontemporal_load((const GAS f32x4*)(wp + (size_t)(4 * (grp) + q) * N + ch * 256)); } while (0)
#define CVW_PUT(v, grp) do { _Pragma("unroll") for (int ch = 0; ch < 4; ++ch) _Pragma("unroll") for (int j = 0; j < 4; ++j) \
        *(LAS unsigned*)(tile + (ch * 256 + 4 * lane + j) * 144 + 16 * F.wave + 4 * (grp)) = pk_fp8x4_(v[ch][0][j] * 32.f, v[ch][1][j] * 32.f, v[ch][2][j] * 32.f, v[ch][3][j] * 32.f); } while (0)
    CVW_LOAD(va, 0); CVW_LOAD(vb, 1); CVW_PUT(va, 0); CVW_LOAD(va, 2); CVW_PUT(vb, 1); CVW_LOAD(vb, 3); CVW_PUT(va, 2); CVW_PUT(vb, 3);
#undef CVW_LOAD
#undef CVW_PUT
    __syncthreads();
#pragma unroll
    for (int i = 0; i < 16; ++i) { const int row = F.wave * 128 + i * 8 + (lane >> 3), c = lane & 7;
        const v4u val = *(const LAS v4u*)(tile + row * 144 + 16 * c);
        __builtin_nontemporal_store(val, (GAS v4u*)(WT + (size_t)(n0 + row) * 1024 + k0 + 16 * c)); }
    __syncthreads();
}
__device__ __forceinline__ void rms_row_to_bf16(int lane, const float* xrow, const float* g, bf16* orow) {
    const GAS f32x4* xr = (const GAS f32x4*)xrow + lane; const GAS f32x4* gr = (const GAS f32x4*)g + lane;
    f32x4 v[4]; float s = 0.f;
#pragma unroll
    for (int j = 0; j < 4; ++j) { v[j] = __builtin_nontemporal_load(xr + 64 * j); s += (v[j].x * v[j].x + v[j].y * v[j].y) + (v[j].z * v[j].z + v[j].w * v[j].w); }
    const float rstd = 1.f / sqrtf(wave_sum(s) * (1.f / D) + RMS_EPS);
    GAS unsigned long long* o8 = (GAS unsigned long long*)orow + lane;
#pragma unroll
    for (int j = 0; j < 4; ++j) { const f32x4 gg = gr[64 * j];
        o8[64 * j] = (unsigned long long)pk2(v[j].x * rstd * gg.x, v[j].y * rstd * gg.y) | ((unsigned long long)pk2(v[j].z * rstd * gg.z, v[j].w * rstd * gg.w) << 32); }
}

#define S5_SYNC() asm volatile("s_waitcnt lgkmcnt(0)\n\ts_barrier" ::: "memory")
template <int NT> __device__ __forceinline__ void s5_setup(Frame& F, const Args& a, int g, int sp) {
    LAS float* L = (LAS float*)F.lds;
    LAS float* APr = L, *APi = L + 2112, *BBr = L + 4224, *BBi = L + 5248, *CCr = L + 6272, *CCi = L + 7296, *KT = L + 8320;
    const int tid = FTID(F);
    if (tid < 64) {
        const int n = tid;
        const float dt = expf(INF(a, 16)[g]);
        const float lre = INF(a, 9)[g * 64 + n], lim = INF(a, 10)[g * 64 + n];
        const float mag = expf(lre * dt); float sn, cs; sincosf(lim * dt, &sn, &cs);
        const float ar = mag * cs, ai = mag * sn;
        const float nr = ar - 1.f, ni = ai, den = lre * lre + lim * lim;
        const float cr = (nr * lre + ni * lim) / den, ci = (ni * lre - nr * lim) / den;
        float pr = 1.f, pi = 0.f;
        for (int tau = 0; tau <= 32; ++tau) { APr[tau * 64 + n] = pr; APi[tau * 64 + n] = pi; const float t0 = pr * ar - pi * ai, t1 = pr * ai + pi * ar; pr = t0; pi = t1; }
        const float* bre = INF(a, 11) + (size_t)(g * 64 + n) * 16; const float* bim = INF(a, 12) + (size_t)(g * 64 + n) * 16;
        for (int c = 0; c < 16; ++c) { const float br = bre[c], bi = bim[c]; BBr[n * 16 + c] = cr * br - ci * bi; BBi[n * 16 + c] = cr * bi + ci * br; }
    }
    for (int i = tid; i < 1024; i += NT) { CCr[i] = INF(a, 13)[g * 1024 + i]; CCi[i] = INF(a, 14)[g * 1024 + i]; }
    S5_SYNC();
    {
        constexpr int NTAU = 32 * 256 / NT;
        const int pair = tid & 255, c = pair >> 4, cp = pair & 15, tau0 = (tid >> 8) * NTAU;
#pragma unroll 1
        for (int nh = 0; nh < 2; ++nh) {
            float zr[32], zi[32];
#pragma unroll
            for (int n = 0; n < 32; ++n) { const int nn = nh * 32 + n; const float cr_ = CCr[c * 64 + nn], ci_ = CCi[c * 64 + nn], br = BBr[nn * 16 + cp], bi = BBi[nn * 16 + cp]; zr[n] = cr_ * br - ci_ * bi; zi[n] = cr_ * bi + ci_ * br; }
#pragma unroll 1
            for (int tau = tau0; tau < tau0 + NTAU; ++tau) {
                const LAS f32x4* pr4 = (const LAS f32x4*)(APr + tau * 64 + nh * 32); const LAS f32x4* pi4 = (const LAS f32x4*)(APi + tau * 64 + nh * 32);
                float s0 = 0.f, s1 = 0.f;
#pragma unroll
                for (int q = 0; q < 8; ++q) { const f32x4 r4 = pr4[q], i4 = pi4[q];
                    s0 += zr[4 * q] * r4[0] - zi[4 * q] * i4[0]; s1 += zr[4 * q + 1] * r4[1] - zi[4 * q + 1] * i4[1];
                    s0 += zr[4 * q + 2] * r4[2] - zi[4 * q + 2] * i4[2]; s1 += zr[4 * q + 3] * r4[3] - zi[4 * q + 3] * i4[3]; }
                if (nh == 0) KT[tau * 256 + pair] = s0 + s1; else KT[tau * 256 + pair] += s0 + s1;
            }
        }
    }
    S5_SYNC();
    bf16* BtY = (bf16*)(a.ws + WS_BTY); bf16* BtX = (bf16*)(a.ws + WS_BTX);
    constexpr int NRB = NT / 80;
    if (tid < NRB * 80) {
        const int cg = tid % 80, rb = tid / 80;
        GAS v4u* dst = (GAS v4u*)(BtY + ((size_t)(g * 512 + 4 * sp * 16) * 640 + 8 * cg));
        if (cg < 16) {
            const int n0 = (8 * cg) & 63; const bool im = cg >= 8;
            for (int rl = rb; rl < 64; rl += NRB) { const int t = 4 * sp + (rl >> 4), c = rl & 15;
                const LAS f32x4* cr4 = (const LAS f32x4*)(CCr + c * 64 + n0); const LAS f32x4* ci4 = (const LAS f32x4*)(CCi + c * 64 + n0);
                const LAS f32x4* ar4 = (const LAS f32x4*)(APr + (t + 1) * 64 + n0); const LAS f32x4* ai4 = (const LAS f32x4*)(APi + (t + 1) * 64 + n0);
                v4u w;
#pragma unroll
                for (int h = 0; h < 2; ++h) { const f32x4 cr = cr4[h], ci = ci4[h], ar = ar4[h], ai = ai4[h];
                    const f32x4 v = im ? -(cr * ai + ci * ar) : (cr * ar - ci * ai);
                    if (h == 0) { w.x = pk2(v[0], v[1]); w.y = pk2(v[2], v[3]); } else { w.z = pk2(v[0], v[1]); w.w = pk2(v[2], v[3]); } }
                dst[(size_t)rl * 80] = w; }
        } else {
            const int col0 = 8 * cg - 128, s_ = col0 >> 4, cp0 = col0 & 15;
            for (int rl = rb; rl < 64; rl += NRB) { const int t = 4 * sp + (rl >> 4), c = rl & 15;
                f32x4 v0 = {0.f, 0.f, 0.f, 0.f}, v1 = v0;
                if (s_ <= t) { const LAS f32x4* k4 = (const LAS f32x4*)(KT + (t - s_) * 256 + c * 16 + cp0); v0 = k4[0]; v1 = k4[1];
                    if (s_ == t && (c >> 3) == (cp0 >> 3)) { const float dd = INF(a, 15)[g * 16 + c]; const int q = c & 7;
                        v0[0] += q == 0 ? dd : 0.f; v0[1] += q == 1 ? dd : 0.f; v0[2] += q == 2 ? dd : 0.f; v0[3] += q == 3 ? dd : 0.f;
                        v1[0] += q == 4 ? dd : 0.f; v1[1] += q == 5 ? dd : 0.f; v1[2] += q == 6 ? dd : 0.f; v1[3] += q == 7 ? dd : 0.f; } }
                v4u w; w.x = pk2(v0[0], v0[1]); w.y = pk2(v0[2], v0[3]); w.z = pk2(v1[0], v1[1]); w.w = pk2(v1[2], v1[3]);
                dst[(size_t)rl * 80] = w; }
        }
    }
    { const int cg = tid & 63, s_ = cg >> 1, cp0 = (cg & 1) * 8, rb = tid >> 6;
      GAS v4u* dst = (GAS v4u*)(BtX + ((size_t)(g * 256 + 32 * sp) * 512 + 8 * cg));
#pragma unroll
      for (int i = 0; i < 32 * 64 / NT; ++i) { const int r = rb + (NT / 64) * i, j = 32 * sp + r; f32x4 v0 = {0.f, 0.f, 0.f, 0.f}, v1 = v0;
          if (j < 128) { const int n = j & 63; const float apr = APr[(31 - s_) * 64 + n], api = APi[(31 - s_) * 64 + n];
              const LAS f32x4* br4 = (const LAS f32x4*)(BBr + n * 16 + cp0); const LAS f32x4* bi4 = (const LAS f32x4*)(BBi + n * 16 + cp0);
              const f32x4 br0 = br4[0], br1 = br4[1], bi0 = bi4[0], bi1 = bi4[1];
              if (j < 64) { v0 = br0 * apr - bi0 * api; v1 = br1 * apr - bi1 * api; } else { v0 = bi0 * apr + br0 * api; v1 = bi1 * apr + br1 * api; } }
          v4u w; w.x = pk2(v0[0], v0[1]); w.y = pk2(v0[2], v0[3]); w.z = pk2(v1[0], v1[1]); w.w = pk2(v1[2], v1[3]);
          dst[(size_t)r * 64] = w; } }
    if (sp == 0 && tid < 64) { float* AL = (float*)(a.ws + WS_SMALL + SM_AL); AL[(g * 64 + tid) * 2] = APr[32 * 64 + tid]; AL[(g * 64 + tid) * 2 + 1] = APi[32 * 64 + tid]; }
    S5_SYNC();
}

__device__ __forceinline__ void rms_row2_to_bf16(int lane, const float* x0, const float* x1, const float* g, bf16* o0, bf16* o1) {
    const GAS f32x4* xr0 = (const GAS f32x4*)x0 + lane; const GAS f32x4* xr1 = (const GAS f32x4*)x1 + lane; const GAS f32x4* gr = (const GAS f32x4*)g + lane;
    f32x4 v[2][4]; float s0 = 0.f, s1 = 0.f;
#pragma unroll
    for (int j = 0; j < 4; ++j) { v[0][j] = __builtin_nontemporal_load(xr0 + 64 * j); v[1][j] = __builtin_nontemporal_load(xr1 + 64 * j); }
#pragma unroll
    for (int j = 0; j < 4; ++j) { s0 += (v[0][j].x * v[0][j].x + v[0][j].y * v[0][j].y) + (v[0][j].z * v[0][j].z + v[0][j].w * v[0][j].w); s1 += (v[1][j].x * v[1][j].x + v[1][j].y * v[1][j].y) + (v[1][j].z * v[1][j].z + v[1][j].w * v[1][j].w); }
    const float r0 = 1.f / sqrtf(wave_sum(s0) * (1.f / D) + RMS_EPS), r1 = 1.f / sqrtf(wave_sum(s1) * (1.f / D) + RMS_EPS);
    GAS unsigned long long* p0 = (GAS unsigned long long*)o0 + lane; GAS unsigned long long* p1 = (GAS unsigned long long*)o1 + lane;
#pragma unroll
    for (int j = 0; j < 4; ++j) { const f32x4 gg = gr[64 * j];
        p0[64 * j] = (unsigned long long)pk2(v[0][j].x * r0 * gg.x, v[0][j].y * r0 * gg.y) | ((unsigned long long)pk2(v[0][j].z * r0 * gg.z, v[0][j].w * r0 * gg.w) << 32);
        p1[64 * j] = (unsigned long long)pk2(v[1][j].x * r1 * gg.x, v[1][j].y * r1 * gg.y) | ((unsigned long long)pk2(v[1][j].z * r1 * gg.z, v[1][j].w * r1 * gg.w) << 32); }
}
__device__ __forceinline__ void p0_prologue(Frame& F, const Args& a) {
    const bool split = (F.G == 256);
    if (split) {
        if (F.wave < 4) { s5_setup<256>(F, a, (int)blockIdx.x & 31, (int)blockIdx.x >> 5); }
        else { const int w4 = F.vcu * 4 + (F.wave - 4);
#pragma unroll 1
            for (int k = 0; k < 16; ++k) { const int m = w4 * 2 + 2048 * k;
                rms_row2_to_bf16(mk_lane(), INF(a, 0) + (size_t)m * D, INF(a, 0) + (size_t)(m + 1) * D, INF(a, 2), (bf16*)(a.ws + WS_XN) + (size_t)m * D, (bf16*)(a.ws + WS_XN) + (size_t)(m + 1) * D);
                if (k == 1 || k == 9 || k == 13) __builtin_amdgcn_s_barrier(); } }
    } else {
        for (int item = blockIdx.x; item < 256; item += F.G) s5_setup<512>(F, a, item & 31, item >> 5);
    }
    const int gt = blockIdx.x * (NWAVES * 64) + FTID(F), NGT = F.G * NWAVES * 64;
    if (blockIdx.x == 0 && F.wave == 0) {
        const float p1 = wave_sum(INF(a, 4)[mk_lane()] * INF(a, 5)[mk_lane()]), p2 = wave_sum(INF(a, 6)[mk_lane()] * INF(a, 7)[mk_lane()]);
        if (mk_lane() == 0) *(float*)(a.ws + WS_SMALL) = expf(p1) - expf(p2) + LAMBDA_INIT;
    }
    { float* WR = (float*)(a.ws + WS_SMALL + SM_WR);
      for (int i = gt; i < 1024 * 36; i += NGT) { const int k = i / 36, e = i % 36, p = ((k & 3) + 4 * (k >> 8)) * 64 + ((k >> 2) & 63);
          WR[p * 36 + e] = e < 32 ? INF(a, 21)[k] * INF(a, 22)[k * 32 + e] : 0.f; } }
    { float* RP = (float*)(a.ws + WS_ROPE); const int* pos = (const int*)a.in[1];
      for (int i = gt; i < T * 8; i += NGT) { const int m = i >> 3, j = i & 7;
          const float invf = j == 0 ? 1.0f : j == 1 ? 1.9392274e-01f : j == 2 ? 3.7606031e-02f : j == 3 ? 7.2926646e-03f : j == 4 ? 1.4142136e-03f : j == 5 ? 2.7424819e-04f : j == 6 ? 5.3182961e-05f : 1.0313386e-05f;
          const float ang = (float)pos[m] * invf; float sn, cs; sincosf(ang, &sn, &cs); RP[m * 16 + j] = cs; RP[m * 16 + 8 + j] = sn; } }
    LAS float* scr = (LAS float*)(F.lds + RING_OFF + F.wave * 17408);
    const int gw = F.vcu * NWAVES + F.wave, NGW = F.G * NWAVES;
    constexpr int I_IN = 16 * 32, I_OUT = 16 * 16, I_GLU = 8 * 8;
    constexpr int NITEMS = I_IN + I_OUT + I_GLU;
    for (int it = gw; it < NITEMS; it += NGW) {
        int r = it;
        if (r < I_IN) { p0_tr64<false>(INF(a, 3), 1024, 2048, a.ws + WS_WIN, scr, r, mk_lane(), 1.f); continue; } r -= I_IN;
        if (r < I_OUT) { p0_tr64<false>(INF(a, 20), 1024, 1024, a.ws + WS_WOUT, scr, r, mk_lane(), 1.f); continue; } r -= I_OUT;
        p0_tr64<false>(INF(a, 17), 512, 512, a.ws + WS_WGLU, scr, r, mk_lane(), 1.f);
    }
    __syncthreads();
    { int lane = mk_lane(); asm volatile("" : "+v"(lane));
      for (int rp = 0; rp < NREP(31); ++rp) for (int item = F.vcu; item < 768; item += F.G) cv_wg_item(F, a, item, lane); }
    if (!split) for (int m = gw; m < T; m += NGW) rms_row_to_bf16(mk_lane(), INF(a, 0) + (size_t)m * D, INF(a, 2), (bf16*)(a.ws + WS_XN) + (size_t)m * D);
}

struct DenseOrder {
    int nM, nN, nwg, G, c, nt; const char* A; const char* B; size_t strA, strB;
    __device__ __forceinline__ void init(int M, int N, int K, int lda, int ldb, const void* A_, const void* B_, int G_, int c_) {
        nM = M / 256; nN = N / 256; nwg = nM * nN; G = G_; c = c_; nt = K / 64; A = (const char*)A_; B = (const char*)B_; strA = (size_t)256 * lda * 2; strB = (size_t)256 * ldb * 2; }
    __device__ __forceinline__ bool next(int i, pg8::Unit& u) const {
        const long L = (long)i * G + c; if (L >= nwg) return false;
        int wgid = (int)L; { const int q = nwg / 8, r = nwg % 8, xcd = wgid % 8, off = wgid / 8; wgid = (xcd < r ? xcd * (q + 1) : r * (q + 1) + (xcd - r) * q) + off; }
        const int nig = 8 * nN, gid = wgid / nig, fm = gid * 8, gsz = (nM - fm) < 8 ? (nM - fm) : 8;
        u.pm = fm + ((wgid % nig) % gsz); u.pn = (wgid % nig) / gsz; u.a = A + (size_t)u.pm * strA; u.b = B + (size_t)u.pn * strB; u.nt = nt; u.x0 = 0; u.x1 = 0; return true;
    }
};
struct XOrder {
    int G, c; const char* AROW; const char* BTX;
    __device__ __forceinline__ bool next(int i, pg8::Unit& u) const {
        const int L = i * G + c; if (L >= 128) return false;
        const int g = L >> 2, pm = L & 3;
        u.pm = pm; u.pn = 0; u.x0 = g; u.x1 = 0; u.nt = 8;
        u.a = AROW + ((size_t)(g * 1024 + pm * 256) * AROW_P + 128) * 2; u.b = BTX + ((size_t)g * 256 * 512) * 2; return true;
    }
};
struct GluOrder {
    int rank; const char* A; const char* B;
    __device__ __forceinline__ bool next(int i, pg8::Unit& u) const {
        if (i >= 4) return false;
        u.pm = rank * 2 + (i >> 1); u.pn = i & 1; u.x0 = 0; u.x1 = 0; u.nt = 8;
        u.a = A + (size_t)u.pm * 256 * 1024; u.b = B + (size_t)u.pn * 256 * 1024; return true;
    }
};
struct YOrder {
    int G, c; const char* AROW; const char* BTY;
    __device__ __forceinline__ bool next(int i, pg8::Unit& u) const {
        const int L = i * G + c; if (L >= 256) return false;
        const int g = L >> 3, pm = (L >> 1) & 3, pn = L & 1;
        u.pm = pm; u.pn = pn; u.x0 = g; u.x1 = 0; u.nt = (128 + 256 * (pn + 1)) / 64;
        u.a = AROW + ((size_t)(g * 1024 + pm * 256) * AROW_P) * 2; u.b = BTY + ((size_t)(g * 512 + pn * 256) * AROW_P) * 2; return true;
    }
};
template <int RG  , int NC  >
struct MoeOrder {
    int G, c; const LAS int* tpre; const LAS int* cntE; const char* A; const char* B; size_t strBe;
    bool gatherA; int ntk;
    __device__ __forceinline__ bool next(int i, pg8::Unit& u) const {
        const int L = i * G + c, grp = L >> 5, w = L & 31, tt = grp * RG + (w % RG), pn = w / RG;
        const int NT = __builtin_amdgcn_readfirstlane(tpre[32]);
        if (tt >= NT) return false;
        const int e = __builtin_popcount((unsigned)__ballot(tpre[(mk_lane() & 31) + 1] <= tt));
        const int cnt = __builtin_amdgcn_readfirstlane(cntE[e]), t0 = __builtin_amdgcn_readfirstlane(tpre[e]);
        u.pm = tt; u.pn = pn; u.x0 = (tt - t0) * 256; u.x1 = e | (cnt << 8); u.nt = ntk;
        u.a = gatherA ? A : A + (size_t)tt * 256 * 1024; u.b = B + (size_t)e * strBe + (size_t)pn * 256 * 1024; return true;
    }
};
struct AGather {
    static constexpr bool PER_UNIT = true;
    const int* list;
    __device__ __forceinline__ void get(const pg8::Unit& u, unsigned (&v)[2][2], const int (&R)[2], const int (&C)[2]) const {
        const int e = u.x1 & 255, cnt = u.x1 >> 8;
#pragma unroll
        for (int h = 0; h < 2; ++h)
#pragma unroll
            for (int i = 0; i < 2; ++i) { const int slot = u.x0 + h * 128 + R[i]; const int sc = slot < cnt ? slot : 0;
                const int tok = list[(size_t)e * T + sc] >> 2; v[h][i] = (unsigned)(tok * 1024 + C[i] * 2); }
    }
    __device__ __forceinline__ size_t hstep() const { return 0; }
    __device__ __forceinline__ void issue_dma(const pg8::Unit& u, const int (&R)[2], const unsigned lds_dst) const {
        const int e = u.x1 & 255, cnt = u.x1 >> 8; const int* base = list + (size_t)e * T;
#pragma unroll
        for (int h = 0; h < 2; ++h)
#pragma unroll
            for (int i = 0; i < 2; ++i) { const int slot = u.x0 + h * 128 + R[i]; const unsigned so = (unsigned)(slot < cnt ? slot : 0) * 4u;
                pg8::glds4_sv(base, so, lds_dst + (unsigned)(2 * h + i) * 256u); }
    }
    __device__ __forceinline__ void finish(const int (&raw)[4], unsigned (&v)[2][2], const int (&C)[2]) const {
#pragma unroll
        for (int h = 0; h < 2; ++h)
#pragma unroll
            for (int i = 0; i < 2; ++i) v[h][i] = (unsigned)((raw[h * 2 + i] >> 2) * 1024 + C[i] * 2);
    }
};

using pg8::f32x2; using pg8::u32x4; using pg8::u32x2; using pg8::cvt_pk_bf16; using pg8::gelu_pk;
#define EPI_ARGS const f32x4 (&acc)[2][2][4][2], const pg8::Unit& u, int wr, int wc, int fr, int fq
__device__ __forceinline__ u32x4 pack8(const f32x4 v0, const f32x4 v1) { u32x4 w; w.x = cvt_pk_bf16(v0[0], v0[1]); w.y = cvt_pk_bf16(v0[2], v0[3]); w.z = cvt_pk_bf16(v1[0], v1[1]); w.w = cvt_pk_bf16(v1[2], v1[3]); return w; }
__device__ __forceinline__ float bf_lo(unsigned w) { return __uint_as_float(w << 16); }
__device__ __forceinline__ float bf_hi(unsigned w) { return __uint_as_float(w & 0xffff0000u); }

struct EpiInProj {
    static constexpr int BMODE = 1; static constexpr bool PREFETCH = false; static constexpr int NSTORE = 0, NPRE = 0;
    bf16 *Q, *K, *V, *AROW; const float* rope; float c2;
    __device__ __forceinline__ void operator()(EPI_ARGS) const {
        const int region = u.pn >> 1; const int colr = (u.pn & 1) * 256 + wc * 32 + 8 * fq;
        const bool dorope = (region <= 1) && ((wc & 1) == 0);
        const float sg = fq == 0 ? -1.f : 1.f; const bool rot = fq < 2;
#pragma unroll
        for (int ai = 0; ai < 2; ++ai) {
            f32x4 rp[4][4];
            if (dorope) {
#pragma unroll
                for (int m = 0; m < 4; ++m) { const f32x4* rr = (const f32x4*)(rope + (size_t)(u.pm * 256 + ai * 128 + wr * 64 + m * 16 + fr) * 16);
#pragma unroll
                    for (int q = 0; q < 4; ++q) rp[m][q] = rr[q]; }
            }
#pragma unroll
            for (int m = 0; m < 4; ++m) {
                const int row = u.pm * 256 + ai * 128 + wr * 64 + m * 16 + fr;
                f32x4 cs0 = {1.f, 1.f, 1.f, 1.f}, cs1 = cs0, sn0 = {0.f, 0.f, 0.f, 0.f}, sn1 = sn0;
                if (dorope) { cs0 = rot ? rp[m][0] : cs0; cs1 = rot ? rp[m][1] : cs1; sn0 = rot ? rp[m][2] * sg : sn0; sn1 = rot ? rp[m][3] * sg : sn1; }
#pragma unroll
                for (int bj = 0; bj < 2; ++bj) {
                    f32x4 v0 = acc[ai][bj][m][0], v1 = acc[ai][bj][m][1]; const int c = colr + bj * 128;
                    if (region <= 1) {
                        if (dorope) { f32x4 p0, p1;
#pragma unroll
                            for (int q = 0; q < 4; ++q) { p0[q] = __shfl_xor(v0[q], 16); p1[q] = __shfl_xor(v1[q], 16); }
                            v0 = v0 * cs0 + p0 * sn0; v1 = v1 * cs1 + p1 * sn1; }
                        if (region == 0) { v0 = v0 * c2; v1 = v1 * c2; }
                        *(u32x4*)((region == 0 ? Q : K) + (size_t)row * 512 + c) = pack8(v0, v1);
                    } else if (region == 2) {
                        *(u32x4*)(V + (size_t)row * 512 + c) = pack8(v0, v1);
                    } else {
                        const int g = c >> 4, cc = c & 15;
                        *(u32x4*)(AROW + ((size_t)(g * 1024 + (row >> 5)) * AROW_P + 128 + (row & 31) * 16 + cc)) = pack8(v0, v1);
                    }
                }
            }
        }
    }
};
struct EpiX {
    static constexpr int BMODE = 0; static constexpr bool PREFETCH = false; static constexpr int NSTORE = 0, NPRE = 0;
    float* X;
    __device__ __forceinline__ void operator()(EPI_ARGS) const {
        float* base = X + ((size_t)(u.x1 * 32 + u.x0) * 1024 + u.pm * 256) * 128;
#pragma unroll
        for (int ai = 0; ai < 2; ++ai)
#pragma unroll
            for (int m = 0; m < 4; ++m) { const int row = ai * 128 + wr * 64 + m * 16 + fr;
#pragma unroll
                for (int n = 0; n < 2; ++n) *(f32x4*)(base + (size_t)row * 128 + wc * 32 + 16 * n + 4 * fq) = acc[ai][0][m][n]; }
    }
};
struct EpiY {
    static constexpr int BMODE = 1; static constexpr bool PREFETCH = false; static constexpr int NSTORE = 0, NPRE = 0;
    bf16* YG;
    __device__ __forceinline__ void operator()(EPI_ARGS) const {
        const int g = u.x0;
#pragma unroll
        for (int ai = 0; ai < 2; ++ai)
#pragma unroll
            for (int m = 0; m < 4; ++m) { const int jj = u.pm * 256 + ai * 128 + wr * 64 + m * 16 + fr;
#pragma unroll
                for (int bj = 0; bj < 2; ++bj) { const int n0 = u.pn * 256 + bj * 128 + wc * 32 + 8 * fq, t = n0 >> 4, cc = n0 & 15;
                    const f32x4 v0 = acc[ai][bj][m][0], v1 = acc[ai][bj][m][1];
                    const f32x2 a = gelu_pk((f32x2){v0[0], v0[1]}), b = gelu_pk((f32x2){v0[2], v0[3]}), c = gelu_pk((f32x2){v1[0], v1[1]}), d = gelu_pk((f32x2){v1[2], v1[3]});
                    u32x4 w; w.x = cvt_pk_bf16(a.x, a.y); w.y = cvt_pk_bf16(b.x, b.y); w.z = cvt_pk_bf16(c.x, c.y); w.w = cvt_pk_bf16(d.x, d.y);
                    *(u32x4*)(YG + (size_t)(jj * 32 + t) * 512 + g * 16 + cc) = w; } }
    }
};
__device__ __forceinline__ float sigmoidf_(float z) { return __builtin_amdgcn_rcpf(1.f + __builtin_amdgcn_exp2f(-1.4426950408889634f * z)); }
struct EpiGlu {
    static constexpr int BMODE = 1; static constexpr bool PREFETCH = false; static constexpr int NSTORE = 0, NPRE = 0;
    const bf16* YG; bf16* GLU; const float* bias;
    __device__ __forceinline__ void operator()(EPI_ARGS) const {
        const int c00 = u.pn * 256 + wc * 32 + 8 * fq;
        f32x4 bv[2][2];
#pragma unroll
        for (int bj = 0; bj < 2; ++bj) { bv[bj][0] = *(const f32x4*)(bias + c00 + bj * 128); bv[bj][1] = *(const f32x4*)(bias + c00 + bj * 128 + 4); }
#pragma unroll
        for (int ai = 0; ai < 2; ++ai)
#pragma unroll
            for (int m = 0; m < 4; ++m) { const int row = u.pm * 256 + ai * 128 + wr * 64 + m * 16 + fr;
#pragma unroll
                for (int bj = 0; bj < 2; ++bj) { const int c = c00 + bj * 128;
                    const f32x4 z0 = acc[ai][bj][m][0] + bv[bj][0], z1 = acc[ai][bj][m][1] + bv[bj][1];
                    const u32x4 y = *(const u32x4*)(YG + (size_t)row * 512 + c);
                    f32x4 o0, o1;
                    o0[0] = bf_lo(y.x) * sigmoidf_(z0[0]); o0[1] = bf_hi(y.x) * sigmoidf_(z0[1]); o0[2] = bf_lo(y.y) * sigmoidf_(z0[2]); o0[3] = bf_hi(y.y) * sigmoidf_(z0[3]);
                    o1[0] = bf_lo(y.z) * sigmoidf_(z1[0]); o1[1] = bf_hi(y.z) * sigmoidf_(z1[1]); o1[2] = bf_lo(y.w) * sigmoidf_(z1[2]); o1[3] = bf_hi(y.w) * sigmoidf_(z1[3]);
                    *(u32x4*)(GLU + (size_t)row * 512 + c) = pack8(o0, o1); } }
    }
};
struct EpiMix {
    static constexpr int BMODE = 1; static constexpr bool PREFETCH = false; static constexpr int NSTORE = 0, NPRE = 0;
    bf16* MIX;
    __device__ __forceinline__ void operator()(EPI_ARGS) const {
#pragma unroll
        for (int ai = 0; ai < 2; ++ai)
#pragma unroll
            for (int m = 0; m < 4; ++m) { bf16* rowp = MIX + (size_t)(u.pm * 256 + ai * 128 + wr * 64 + m * 16 + fr) * 1024 + u.pn * 256 + wc * 32 + 8 * fq;
#pragma unroll
                for (int bj = 0; bj < 2; ++bj) *(u32x4*)(rowp + bj * 128) = pack8(acc[ai][bj][m][0], acc[ai][bj][m][1]); }
    }
};
__device__ __forceinline__ float swiglu_(float g, float up) {
    const float gc = fminf(g, SW_LIMIT), uc = __builtin_amdgcn_fmed3f(up, -SW_LIMIT, SW_LIMIT);
    const float t = gc * __builtin_amdgcn_rcpf(1.f + __builtin_amdgcn_exp2f(gc * (-SW_ALPHA * 1.4426950408889634f))); return fmaf(t, uc, t); }
__device__ __forceinline__ unsigned pk_fp8x4(float a, float b, float c, float d) { int w = 0; w = __builtin_amdgcn_cvt_pk_fp8_f32(a, b, w, false); w = __builtin_amdgcn_cvt_pk_fp8_f32(c, d, w, true); return (unsigned)w; }
constexpr float W8_SCALE = 32.f, W8_INV = 1.f / 32.f;
constexpr float YB_SCALE = 8.f, YB_INV = 1.f / 8.f;
__device__ __forceinline__ f32x2 swiglu2_(const f32x2 ga, const f32x2 ua, const f32x2 bg, const f32x2 bu) {
    const f32x2 inv = {W8_INV, W8_INV};
    const f32x2 G = __builtin_elementwise_fma(ga, inv, bg), U = __builtin_elementwise_fma(ua, inv, bu);
    f32x2 gc, uc; gc.x = fminf(G.x, SW_LIMIT); gc.y = fminf(G.y, SW_LIMIT); uc.x = __builtin_amdgcn_fmed3f(U.x, -SW_LIMIT, SW_LIMIT); uc.y = __builtin_amdgcn_fmed3f(U.y, -SW_LIMIT, SW_LIMIT);
    const f32x2 xs = gc * (-SW_ALPHA * 1.4426950408889634f);
    f32x2 ex; ex.x = __builtin_amdgcn_exp2f(xs.x); ex.y = __builtin_amdgcn_exp2f(xs.y);
    const f32x2 dn = ex + 1.0f;
    f32x2 rc; rc.x = __builtin_amdgcn_rcpf(dn.x); rc.y = __builtin_amdgcn_rcpf(dn.y);
    const f32x2 t = gc * rc;
    return __builtin_elementwise_fma(t, uc, t);
}
struct EpiGU {
    static constexpr int BMODE = 2; static constexpr bool PREFETCH = true; static constexpr int NSTORE = 0, NPRE = 0;
    unsigned char* ACT; const float* bias; LAS unsigned char* xb;
    __device__ __forceinline__ void prefetch(const pg8::Unit& u, const int wid, const int wr, const int lane) const {
        const int e = u.x1 & 255;
        const unsigned bdst = (unsigned)__builtin_amdgcn_readfirstlane((int)((unsigned)(uintptr_t)xb + (unsigned)wid * 256u));
        pg8::glds4_sv(bias + e * 2048 + 2 * (u.pn * 128 + (wid & 3) * 32), (unsigned)lane * 4u, bdst);
    }
    __device__ __forceinline__ void operator()(EPI_ARGS) const {
        const int e = u.x1 & 255, j0 = u.pn * 128 + wc * 32 + 8 * fq;
        const LAS f32x4* bp = (const LAS f32x4*)(xb + (wr * 4 + wc) * 256) + 4 * fq;
        f32x2 bg[4], bu[4];
#pragma unroll
        for (int i = 0; i < 4; ++i) { const f32x4 b = bp[i]; bg[i] = (f32x2){b[0], b[2]}; bu[i] = (f32x2){b[1], b[3]}; }
        const int jst = u.pn * 128 + wc * 32 + 8 * (fq & ~1);
#pragma unroll
        for (int ai = 0; ai < 2; ++ai)
#pragma unroll
            for (int mp = 0; mp < 2; ++mp) { u32x2 w[2];
#pragma unroll
                for (int k = 0; k < 2; ++k) { const int m = mp * 2 + k;
                    const f32x4 g0 = acc[ai][0][m][0], g1 = acc[ai][0][m][1], u0 = acc[ai][1][m][0], u1 = acc[ai][1][m][1];
                    const f32x2 o0 = swiglu2_((f32x2){g0[0], g0[1]}, (f32x2){u0[0], u0[1]}, bg[0], bu[0]), o1 = swiglu2_((f32x2){g0[2], g0[3]}, (f32x2){u0[2], u0[3]}, bg[1], bu[1]);
                    const f32x2 o2 = swiglu2_((f32x2){g1[0], g1[1]}, (f32x2){u1[0], u1[1]}, bg[2], bu[2]), o3 = swiglu2_((f32x2){g1[2], g1[3]}, (f32x2){u1[2], u1[3]}, bg[3], bu[3]);
                    w[k].x = pk_fp8x4(o0.x, o0.y, o1.x, o1.y); w[k].y = pk_fp8x4(o2.x, o2.y, o3.x, o3.y); }
                const auto rx = __builtin_amdgcn_permlane16_swap(w[0].x, w[1].x, false, false), ry = __builtin_amdgcn_permlane16_swap(w[0].y, w[1].y, false, false);
                const size_t row = (size_t)u.pm * 256 + ai * 128 + wr * 64 + (mp * 2 + (fq & 1)) * 16 + fr;
                u32x4 o; o.x = rx[0]; o.y = ry[0]; o.z = rx[1]; o.w = ry[1];
                *(u32x4*)(ACT + row * 1024 + jst) = o; }
    }
};
template <int MODE> struct EpiDownT {
    static constexpr int BMODE = 3; static constexpr bool PREFETCH = true; static constexpr int NSTORE = 0, NPRE = 0;
    unsigned char* YB; const float* bias; const int* list; const float* gates; int sel; LAS unsigned char* xl; LAS unsigned char* xb;
    __device__ __forceinline__ void prefetch(const pg8::Unit& u, const int wid, const int wr, const int lane) const {
        const int e = u.x1 & 255, cnt = u.x1 >> 8;
        const unsigned dst = (unsigned)__builtin_amdgcn_readfirstlane((int)((unsigned)(uintptr_t)xl + (unsigned)wid * 1024u));
#pragma unroll
        for (int k = 0; k < 2; ++k) { const int slot = u.x0 + k * 128 + wr * 64 + lane; const unsigned so = (unsigned)(slot < cnt ? slot : 0) * 4u;
            pg8::glds4_sv(list + (size_t)e * T, so, dst + (unsigned)k * 256u); pg8::glds4_sv(gates + (size_t)e * T, so, dst + 512u + (unsigned)k * 256u); }
        const unsigned bdst = (unsigned)__builtin_amdgcn_readfirstlane((int)((unsigned)(uintptr_t)xb + (unsigned)wid * 256u));
        pg8::glds4_sv(bias + e * 1024 + u.pn * 256 + (wid & 3) * 64, (unsigned)lane * 4u, bdst);
    }
    __device__ __forceinline__ void operator()(EPI_ARGS) const {
        const int e = u.x1 & 255, cnt = u.x1 >> 8, c0 = u.pn * 256 + wc * 64 + 16 * fq;
        f32x4 bv[2][2];
        { const LAS f32x4* bl = (const LAS f32x4*)(xb + (wr * 4 + wc) * 256) + 4 * fq; bv[0][0] = bl[0]; bv[0][1] = bl[1]; bv[1][0] = bl[2]; bv[1][1] = bl[3]; }
        int aidv[8]; float gtv[8];
        { const LAS int* xi = (const LAS int*)(xl + (wr * 4 + wc) * 1024) + fr; const LAS float* xg = (const LAS float*)xi + 128;
#pragma unroll
          for (int q = 0; q < 8; ++q) { aidv[q] = xi[(q >> 2) * 64 + (q & 3) * 16]; gtv[q] = xg[(q >> 2) * 64 + (q & 3) * 16] * YB_SCALE; } }
#pragma unroll
        for (int ai = 0; ai < 2; ++ai)
#pragma unroll
            for (int m = 0; m < 4; ++m) { const int slot = u.x0 + ai * 128 + wr * 64 + m * 16 + fr; const int aid = aidv[ai * 4 + m]; const float gt = gtv[ai * 4 + m];
                if (slot < cnt) {
                    const f32x4 z0 = (acc[ai][0][m][0] * W8_INV + bv[0][0]) * gt, z1 = (acc[ai][0][m][1] * W8_INV + bv[0][1]) * gt;
                    const f32x4 z2 = (acc[ai][1][m][0] * W8_INV + bv[1][0]) * gt, z3 = (acc[ai][1][m][1] * W8_INV + bv[1][1]) * gt;
                    u32x4 w8; w8.x = pk_fp8x4(z0[0], z0[1], z0[2], z0[3]); w8.y = pk_fp8x4(z1[0], z1[1], z1[2], z1[3]); w8.z = pk_fp8x4(z2[0], z2[1], z2[2], z2[3]); w8.w = pk_fp8x4(z3[0], z3[1], z3[2], z3[3]);
                    if constexpr (MODE == 1) { asm volatile("" :: "v"(w8)); } else { *(u32x4*)(YB + (size_t)aid * 1024 + c0) = w8; } } }
    }
};
typedef EpiDownT<0> EpiDown;

template <int BM_> struct EpiNullT {
    static constexpr int BMODE = BM_; static constexpr bool PREFETCH = false; static constexpr int NSTORE = 0, NPRE = 0;
    __device__ __forceinline__ void operator()(EPI_ARGS) const {
#pragma unroll
        for (int ai = 0; ai < 2; ++ai)
#pragma unroll
            for (int bj = 0; bj < 2; ++bj)
#pragma unroll
                for (int m = 0; m < 4; ++m)
#pragma unroll
                    for (int n = 0; n < 2; ++n) asm volatile("" :: "v"(acc[ai][bj][m][n]));
    }
};
typedef EpiNullT<1> EpiNull;
__device__ __forceinline__ void s5_scan(const Args& a, const int task, const int lane) {
    const int gw = task;
    {
        const int g = gw >> 2, b = gw & 3, n = lane;
        const float* AL = (const float*)(a.ws + WS_SMALL + SM_AL); const float ar = AL[(g * 64 + n) * 2], ai = AL[(g * 64 + n) * 2 + 1];
        const float* X0 = (const float*)(a.ws + WS_XLOC) + ((size_t)(0 * 32 + g) * 1024 + b * 256) * 128;
        const float* X1 = (const float*)(a.ws + WS_XLOC) + ((size_t)(1 * 32 + g) * 1024 + b * 256) * 128;
        bf16* AR = (bf16*)(a.ws + WS_AROW) + (size_t)(g * 1024 + b * 256) * AROW_P;
        float xr = 0.f, xi = 0.f;
        for (int j0 = 0; j0 < 256; j0 += 16) {
            float lr[16], li[16];
#pragma unroll
            for (int q = 0; q < 16; ++q) { const size_t o = (size_t)(j0 + q) * 128 + n; lr[q] = X0[o]; li[q] = X0[o + 64]; }
#pragma unroll
            for (int q = 0; q < 16; ++q) { bf16* row = AR + (size_t)(j0 + q) * AROW_P; row[n] = (bf16)f2bf(xr); row[64 + n] = (bf16)f2bf(xi);
                const float nr = ar * xr - ai * xi + lr[q], ni = ar * xi + ai * xr + li[q]; xr = nr; xi = ni; }
        }
    }
}
__device__ __forceinline__ void p3_post_scan(Frame& F, const Args& a) {
    int lane = mk_lane(); asm volatile("" : "+v"(lane));
    const int gw = F.vcu * NWAVES + F.wave, NGW = F.G * NWAVES;
    const float lam = *(const float*)(a.ws + WS_SMALL);
    const bf16* O = (const bf16*)(a.ws + WS_O); bf16* AC = (bf16*)(a.ws + WS_ACAT); const float* ng = INF(a, 8);
    const int h = lane >> 4, d0 = (lane & 15) * 8;
    const f32x4 g0 = *(const f32x4*)(ng + d0), g1 = *(const f32x4*)(ng + d0 + 4);
    for (int m = gw; m < T; m += NGW) {
        const bf16* orow = O + (size_t)m * 1024;
        const v4u p1 = *(const GAS v4u*)(orow + (h * 2 + 0) * 128 + d0), p2 = *(const GAS v4u*)(orow + (h * 2 + 1) * 128 + d0);
        float o[8];
        o[0] = bf_lo(p1.x) - lam * bf_lo(p2.x); o[1] = bf_hi(p1.x) - lam * bf_hi(p2.x); o[2] = bf_lo(p1.y) - lam * bf_lo(p2.y); o[3] = bf_hi(p1.y) - lam * bf_hi(p2.y);
        o[4] = bf_lo(p1.z) - lam * bf_lo(p2.z); o[5] = bf_hi(p1.z) - lam * bf_hi(p2.z); o[6] = bf_lo(p1.w) - lam * bf_lo(p2.w); o[7] = bf_hi(p1.w) - lam * bf_hi(p2.w);
        float s = 0.f;
#pragma unroll
        for (int q = 0; q < 8; ++q) s += o[q] * o[q];
        s += __shfl_xor(s, 1); s += __shfl_xor(s, 2); s += __shfl_xor(s, 4); s += __shfl_xor(s, 8);
        const float sc = (1.f - LAMBDA_INIT) / sqrtf(s * (1.f / 128.f) + RMS_EPS);
        v4u w; w.x = pk2(o[0] * sc * g0[0], o[1] * sc * g0[1]); w.y = pk2(o[2] * sc * g0[2], o[3] * sc * g0[3]); w.z = pk2(o[4] * sc * g1[0], o[5] * sc * g1[1]); w.w = pk2(o[6] * sc * g1[2], o[7] * sc * g1[3]);
        *(GAS v4u*)(AC + (size_t)m * 1024 + h * 128 + d0) = w;
    }
}
__device__ __forceinline__ void pn_glunorm(Frame& F, const Args& a) {
    int lane = mk_lane(); asm volatile("" : "+v"(lane));
    const int gw = F.vcu * NWAVES + F.wave, NGW = F.G * NWAVES;
    const bf16* GL = (const bf16*)(a.ws + WS_GLU); bf16* AC = (bf16*)(a.ws + WS_ACAT); const float* ng = INF(a, 19);
    const f32x4 g0 = *(const f32x4*)(ng + lane * 8), g1 = *(const f32x4*)(ng + lane * 8 + 4);
    for (int m = gw; m < T; m += NGW) {
        const v4u p = *(const GAS v4u*)(GL + (size_t)m * 512 + lane * 8);
        float o[8] = {bf_lo(p.x), bf_hi(p.x), bf_lo(p.y), bf_hi(p.y), bf_lo(p.z), bf_hi(p.z), bf_lo(p.w), bf_hi(p.w)};
        float s = 0.f;
#pragma unroll
        for (int q = 0; q < 8; ++q) s += o[q] * o[q];
        const float sc = 1.f / sqrtf(wave_sum(s) * (1.f / 512.f) + RMS_EPS);
        v4u w; w.x = pk2(o[0] * sc * g0[0], o[1] * sc * g0[1]); w.y = pk2(o[2] * sc * g0[2], o[3] * sc * g0[3]); w.z = pk2(o[4] * sc * g1[0], o[5] * sc * g1[1]); w.w = pk2(o[6] * sc * g1[2], o[7] * sc * g1[3]);
        *(GAS v4u*)(AC + (size_t)m * 1024 + 512 + lane * 8) = w;
    }
}
constexpr int NS5 = 64, CW_BAR2 = 8192;
__device__ __forceinline__ void glunorm_sub(Frame& F, const Args& a, const int rank) {
    int lane = mk_lane(); asm volatile("" : "+v"(lane));
    const bf16* GL = (const bf16*)(a.ws + WS_GLU); bf16* AC = (bf16*)(a.ws + WS_ACAT); const float* ng = INF(a, 19);
    const f32x4 g0 = *(const f32x4*)(ng + lane * 8), g1 = *(const f32x4*)(ng + lane * 8 + 4);
    const int r0 = rank * 512 + F.wave * 64;
#pragma unroll 1
    for (int m0 = r0; m0 < r0 + 64; m0 += 8) {
        v4u p[8];
#pragma unroll
        for (int q = 0; q < 8; ++q) p[q] = *(const GAS v4u*)(GL + (size_t)(m0 + q) * 512 + lane * 8);
#pragma unroll
        for (int q = 0; q < 8; ++q) {
            float o[8] = {bf_lo(p[q].x), bf_hi(p[q].x), bf_lo(p[q].y), bf_hi(p[q].y), bf_lo(p[q].z), bf_hi(p[q].z), bf_lo(p[q].w), bf_hi(p[q].w)};
            float s = 0.f;
#pragma unroll
            for (int k = 0; k < 8; ++k) s += o[k] * o[k];
            const float sc = 1.f / sqrtf(wave_sum(s) * (1.f / 512.f) + RMS_EPS);
            v4u w; w.x = pk2(o[0] * sc * g0[0], o[1] * sc * g0[1]); w.y = pk2(o[2] * sc * g0[2], o[3] * sc * g0[3]); w.z = pk2(o[4] * sc * g1[0], o[5] * sc * g1[1]); w.w = pk2(o[6] * sc * g1[2], o[7] * sc * g1[3]);
            *(GAS v4u*)(AC + (size_t)(m0 + q) * 1024 + 512 + lane * 8) = w;
        }
    }
}
__device__ const unsigned char ATT_DEAL[32][8] = {
  {48, 255, 255, 255, 255, 255, 255, 255},
  {27, 36, 35, 255, 255, 255, 255, 255},
  {59, 4, 3, 255, 255, 255, 255, 255},
  {62, 37, 34, 255, 255, 255, 255, 255},
  {16, 255, 255, 255, 255, 255, 255, 255},
  {30, 5, 2, 255, 255, 255, 255, 255},
  {61, 38, 33, 255, 255, 255, 255, 255},
  {29, 6, 1, 255, 255, 255, 255, 255},
  {47, 255, 255, 255, 255, 255, 255, 255},
  {60, 40, 32, 255, 255, 255, 255, 255},
  {28, 8, 0, 255, 255, 255, 255, 255},
  {31, 39, 255, 255, 255, 255, 255, 255},
  {15, 255, 255, 255, 255, 255, 255, 255},
  {63, 7, 255, 255, 255, 255, 255, 255},
  {58, 41, 255, 255, 255, 255, 255, 255},
  {26, 9, 255, 255, 255, 255, 255, 255},
  {46, 255, 255, 255, 255, 255, 255, 255},
  {57, 42, 255, 255, 255, 255, 255, 255},
  {25, 10, 255, 255, 255, 255, 255, 255},
  {56, 43, 255, 255, 255, 255, 255, 255},
  {14, 255, 255, 255, 255, 255, 255, 255},
  {24, 11, 255, 255, 255, 255, 255, 255},
  {55, 44, 255, 255, 255, 255, 255, 255},
  {23, 12, 255, 255, 255, 255, 255, 255},
  {45, 255, 255, 255, 255, 255, 255, 255},
  {54, 49, 255, 255, 255, 255, 255, 255},
  {22, 17, 255, 255, 255, 255, 255, 255},
  {53, 50, 255, 255, 255, 255, 255, 255},
  {13, 255, 255, 255, 255, 255, 255, 255},
  {21, 18, 255, 255, 255, 255, 255, 255},
  {52, 51, 255, 255, 255, 255, 255, 255},
  {20, 19, 255, 255, 255, 255, 255, 255}
};
__device__ __forceinline__ void pr_router(Frame& F, const Args& a) {
    LAS float* WP = (LAS float*)F.lds;
    { const GAS f32x4* src = (const GAS f32x4*)(a.ws + WS_SMALL + SM_WR); for (int i = FTID(F); i < 1024 * 36 / 4; i += NWAVES * 64) ((LAS f32x4*)WP)[i] = src[i]; }
    LAS int* cntL = (LAS int*)(F.lds + RT_OFF); LAS int* baseL = cntL + 32;
    LAS int* stA = (LAS int*)(F.lds + ST_OFF); LAS int* stE = stA + 512; LAS float* stG = (LAS float*)(stE + 512);
    if (FTID(F) < 32) cntL[FTID(F)] = 0;
    __syncthreads();
    int lane = mk_lane(); asm volatile("" : "+v"(lane));
    const int gw = F.vcu * NWAVES + F.wave;
    const float* X = INF(a, 0); const bf16* MIX = (const bf16*)(a.ws + WS_MIX); unsigned char* XN8 = (unsigned char*)(a.ws + WS_XN); const float* gf = INF(a, 21);
    const int e_me = lane >> 1; const float brt = INF(a, 23)[e_me];
    for (int rp = 0; rp < NREP(8); ++rp) { if (rp) { __syncthreads(); if (FTID(F) < 32) cntL[FTID(F)] = 0; __syncthreads(); }
    f32x4 xnx[4]; unsigned long long mnx[4];
    { const GAS f32x4* xr = (const GAS f32x4*)(X + (size_t)gw * 1024) + lane; const GAS unsigned long long* mr = (const GAS unsigned long long*)(MIX + (size_t)gw * 1024) + lane;
#pragma unroll
      for (int j = 0; j < 4; ++j) { xnx[j] = __builtin_nontemporal_load(xr + 64 * j); mnx[j] = __builtin_nontemporal_load(mr + 64 * j); } }
#pragma unroll 1
    for (int it = 0; it < 16; ++it) {
        const int m = gw + it * (256 * NWAVES);
        f32x4 xcur[4]; unsigned long long mcur[4];
#pragma unroll
        for (int j = 0; j < 4; ++j) { xcur[j] = xnx[j]; mcur[j] = mnx[j]; }
        { const int mn = gw + (it < 15 ? it + 1 : it) * (256 * NWAVES);
          const GAS f32x4* xr = (const GAS f32x4*)(X + (size_t)mn * 1024) + lane; const GAS unsigned long long* mr = (const GAS unsigned long long*)(MIX + (size_t)mn * 1024) + lane;
#pragma unroll
          for (int j = 0; j < 4; ++j) { xnx[j] = __builtin_nontemporal_load(xr + 64 * j); mnx[j] = __builtin_nontemporal_load(mr + 64 * j); } }
        f32x4 hv[4]; float ss = 0.f;
#pragma unroll
        for (int j = 0; j < 4; ++j) { const f32x4 xv = xcur[j]; const unsigned long long w = mcur[j]; const unsigned lo = (unsigned)w, hi = (unsigned)(w >> 32);
            hv[j] = (f32x4){xv.x + bf_lo(lo), xv.y + bf_hi(lo), xv.z + bf_lo(hi), xv.w + bf_hi(hi)};
            ss += (hv[j].x * hv[j].x + hv[j].y * hv[j].y) + (hv[j].z * hv[j].z + hv[j].w * hv[j].w); }
        const float rstd = 1.f / sqrtf(wave_sum(ss) * (1.f / D) + RMS_EPS);
        f32x2 p2[16];
#pragma unroll
        for (int e = 0; e < 16; ++e) p2[e] = (f32x2){0.f, 0.f};
#pragma unroll
        for (int j = 0; j < 4; ++j)
#pragma unroll
            for (int i = 0; i < 4; ++i) { const float hk = hv[j][i]; const f32x2 hk2 = {hk, hk}; const LAS float* wrow = WP + ((i + 4 * j) * 64 + lane) * 36;
#pragma unroll
                for (int e4 = 0; e4 < 8; ++e4) { const f32x4 w = *(const LAS f32x4*)(wrow + 4 * e4);
                    p2[2 * e4] = __builtin_elementwise_fma(hk2, (f32x2){w[0], w[1]}, p2[2 * e4]); p2[2 * e4 + 1] = __builtin_elementwise_fma(hk2, (f32x2){w[2], w[3]}, p2[2 * e4 + 1]); } }
        float p[32];
#pragma unroll
        for (int e = 0; e < 16; ++e) { p[2 * e] = p2[e].x; p[2 * e + 1] = p2[e].y; }
        float q16[16], q8[8], q4[4], q2[2];
        { const bool up = (lane & 32) != 0;
#pragma unroll
          for (int i = 0; i < 16; ++i) { const float keep = up ? p[16 + i] : p[i], send = up ? p[i] : p[16 + i]; q16[i] = keep + __shfl_xor(send, 32); } }
        { const bool up = (lane & 16) != 0;
#pragma unroll
          for (int i = 0; i < 8; ++i) { const float keep = up ? q16[8 + i] : q16[i], send = up ? q16[i] : q16[8 + i]; q8[i] = keep + __shfl_xor(send, 16); } }
        { const bool up = (lane & 8) != 0;
#pragma unroll
          for (int i = 0; i < 4; ++i) { const float keep = up ? q8[4 + i] : q8[i], send = up ? q8[i] : q8[4 + i]; q4[i] = keep + __shfl_xor(send, 8); } }
        { const bool up = (lane & 4) != 0;
#pragma unroll
          for (int i = 0; i < 2; ++i) { const float keep = up ? q4[2 + i] : q4[i], send = up ? q4[i] : q4[2 + i]; q2[i] = keep + __shfl_xor(send, 4); } }
        float q1; { const bool up = (lane & 2) != 0; const float keep = up ? q2[1] : q2[0], send = up ? q2[0] : q2[1]; q1 = keep + __shfl_xor(send, 2); }
        const float raw = q1 + __shfl_xor(q1, 1);
        const float v = raw * rstd + brt;
        int rank = 0;
#pragma unroll
        for (int j = 0; j < 32; ++j) { const float vj = __int_as_float(__builtin_amdgcn_readlane(__float_as_int(v), 2 * j)); rank += (vj > v || (vj == v && j < e_me)) ? 1 : 0; }
        float vk[4]; int ek[4];
#pragma unroll
        for (int k = 0; k < 4; ++k) { const unsigned long long mk = __ballot(rank == k); const int lk = (int)__builtin_ctzll(mk); ek[k] = lk >> 1; vk[k] = __int_as_float(__builtin_amdgcn_readlane(__float_as_int(v), lk)); }
        float ex[4]; float den = 0.f;
#pragma unroll
        for (int k = 0; k < 4; ++k) { ex[k] = __expf(vk[k] - vk[0]); den += ex[k]; }
        const float rden = 1.f / den;
        if (lane < 4) {
            const int e = lane == 0 ? ek[0] : lane == 1 ? ek[1] : lane == 2 ? ek[2] : ek[3];
            const float gt = (lane == 0 ? ex[0] : lane == 1 ? ex[1] : lane == 2 ? ex[2] : ex[3]) * rden;
            const int sl = __hip_atomic_fetch_add(cntL + e, 1, __ATOMIC_RELAXED, __HIP_MEMORY_SCOPE_WORKGROUP);
            const int pos = F.wave * 64 + it * 4 + lane;
            stA[pos] = m * 4 + lane; stE[pos] = e | (sl << 8); stG[pos] = gt;
        }
        { const GAS f32x4* gr = (const GAS f32x4*)gf + lane; GAS unsigned* o4 = (GAS unsigned*)(XN8 + (size_t)m * 1024) + lane;
          GAS unsigned long long* h8 = (GAS unsigned long long*)((bf16*)(a.ws + WS_HB) + (size_t)m * 1024) + lane;
#pragma unroll
          for (int j = 0; j < 4; ++j) { const f32x4 gg = gr[64 * j];
              o4[64 * j] = pk_fp8x4(hv[j].x * rstd * gg.x, hv[j].y * rstd * gg.y, hv[j].z * rstd * gg.z, hv[j].w * rstd * gg.w);
              __builtin_nontemporal_store((unsigned long long)pk2(hv[j].x, hv[j].y) | ((unsigned long long)pk2(hv[j].z, hv[j].w) << 32), h8 + 64 * j); } }
    }
    }
    __syncthreads();
    if (FTID(F) < 32) baseL[FTID(F)] = (int)__hip_atomic_fetch_add(F.ctl + CW_ECNT + 16 * FTID(F), (unsigned)cntL[FTID(F)], __ATOMIC_RELAXED, __HIP_MEMORY_SCOPE_AGENT);
    __syncthreads();
    { const int pos = FTID(F); const int aid = stA[pos], ee = stE[pos], e = ee & 255, sl = ee >> 8;
      int* list = (int*)(a.ws + WS_LIST); float* gates = (float*)(a.ws + WS_GATES);
      list[(size_t)e * T + baseL[e] + sl] = aid; gates[(size_t)e * T + baseL[e] + sl] = stG[pos]; }
}
__device__ __forceinline__ void moe_tables(Frame& F) {
    LAS int* tpre = (LAS int*)(F.lds + MOE_OFF); LAS int* cntE = tpre + 40;
    __syncthreads();
    if (FTID(F) < 32) cntE[FTID(F)] = (int)__hip_atomic_load(F.ctl + CW_ECNT + 16 * FTID(F), RLX_AGENT);
    __syncthreads();
    if (FTID(F) == 0) { int acc = 0; for (int e = 0; e < 32; ++e) { tpre[e] = acc; acc += (cntE[e] + 255) >> 8; } tpre[32] = acc; }
    __syncthreads();
}
__device__ __forceinline__ void pf_final(Frame& F, const Args& a) {
    int lane = mk_lane(); asm volatile("" : "+v"(lane));
    const int gw = F.vcu * NWAVES + F.wave, NGW = F.G * NWAVES;
    const unsigned char* YB = (const unsigned char*)(a.ws + WS_YBUF); const float* gfin = INF(a, 28);
    for (int m = gw; m < T; m += NGW) {
        GAS f32x4* hr = (GAS f32x4*)(a.out + (size_t)m * 1024) + lane;
        const GAS unsigned long long* mr = (const GAS unsigned long long*)((const bf16*)(a.ws + WS_HB) + (size_t)m * 1024) + lane;
        f32x4 v[4];
#pragma unroll
        for (int j = 0; j < 4; ++j) { const unsigned long long w = __builtin_nontemporal_load(mr + 64 * j); const unsigned lo = (unsigned)w, hi = (unsigned)(w >> 32);
            v[j].x = bf_lo(lo); v[j].y = bf_hi(lo); v[j].z = bf_lo(hi); v[j].w = bf_hi(hi); }
#pragma unroll
        for (int k = 0; k < 4; ++k) { const GAS unsigned* yr = (const GAS unsigned*)(YB + ((size_t)m * 4 + k) * 1024) + lane;
#pragma unroll
            for (int j = 0; j < 4; ++j) { const unsigned w = __builtin_nontemporal_load(yr + 64 * j); const f32x2 lo = __builtin_amdgcn_cvt_pk_f32_fp8((int)w, false), hi = __builtin_amdgcn_cvt_pk_f32_fp8((int)w, true);
                v[j].x += lo.x * YB_INV; v[j].y += lo.y * YB_INV; v[j].z += hi.x * YB_INV; v[j].w += hi.y * YB_INV; } }
        float s = 0.f;
#pragma unroll
        for (int j = 0; j < 4; ++j) s += (v[j].x * v[j].x + v[j].y * v[j].y) + (v[j].z * v[j].z + v[j].w * v[j].w);
        const float rstd = 1.f / sqrtf(wave_sum(s) * (1.f / D) + RMS_EPS);
        const GAS f32x4* gr = (const GAS f32x4*)gfin + lane;
#pragma unroll
        for (int j = 0; j < 4; ++j) { const f32x4 gg = gr[64 * j]; __builtin_nontemporal_store(v[j] * rstd * gg, hr + 64 * j); }
    }
}

__global__ void __launch_bounds__(NWAVES * 64, 2) mk_fwd(Args args) {
    extern __shared__ __attribute__((aligned(16))) unsigned char lds[];
    Frame F;
    F.lds = (LAS unsigned char*)lds;
    F.MISC = (volatile LAS unsigned*)(F.lds + MISC_OFF);
    F.wave = __builtin_amdgcn_readfirstlane((int)(threadIdx.x >> 6));
    F.G = gridDim.x; { const int bx = blockIdx.x; F.vcu = (F.G % 8 == 0) ? (bx % 8) * (F.G / 8) + bx / 8 : bx; }
    unsigned char* ws = args.ws;
    F.ctl = (gu32*)(ws + WS_CTL);
    for (int u = FTID(F); u < (LDS_BYTES - LDSCTL_OFF) / 4; u += NWAVES * 64) ((LAS unsigned*)(F.lds + LDSCTL_OFF))[u] = 0u;
    __syncthreads();
    XcdBarrier bar; bar.bar = (unsigned*)(F.ctl + CW_BAR); bar.x = 0; bar.st = nullptr; bar.wave = F.wave; bar.G = gridDim.x;
    if (N_LAUNCHES == 1) bar = xcd_barrier_post((unsigned*)(F.ctl + CW_BAR), F.MISC + 8, F.wave, gridDim.x);
#define GRID_BAR() do { if (N_LAUNCHES == 1) xcd_barrier(bar); } while (0)
    const int lo = args.ph_lo, hi = args.ph_hi;
#define IN(k) (lo <= (k) && (k) < hi)
#ifndef PROBE_DUP
#define PROBE_DUP -1
#endif
#define REP(k, ...) do { __VA_ARGS__; if constexpr (PROBE_DUP == (k)) { __VA_ARGS__; } } while (0)
#define BOTH(k) (IN(k) && IN((k) + 1))
    LAS unsigned char* ring = F.lds + RING_OFF;

    if (IN(0)) { REP(0, p0_prologue(F, args)); if (BOTH(0)) GRID_BAR(); }
    if (IN(1)) {
        DenseOrder S; S.init(T, 2048, 1024, 1024, 1024, ws + WS_XN, ws + WS_WIN, F.G, (int)blockIdx.x);
        EpiInProj E{(bf16*)(ws + WS_Q), (bf16*)(ws + WS_K), (bf16*)(ws + WS_V), (bf16*)(ws + WS_AROW), (const float*)(ws + WS_ROPE), attn_body::C2};
        pg8::ALinear AO{2048};
        REP(1, pg8::gemm_phase<EpiInProj, DenseOrder, pg8::ALinear, true>(ring, 2048, S, AO, E, F.wave));
        if (BOTH(1)) GRID_BAR();
        if constexpr (PROBE_DUP == 40) { GRID_BAR(); GRID_BAR(); GRID_BAR(); GRID_BAR(); }
    }
    if (IN(2)) {
        if (F.G == 256) {
            if ((F.vcu & 3) == 0) {
                const int rank = F.vcu >> 2;
                const XcdBarrier sbar = xcd_barrier_post((unsigned*)(F.ctl + CW_BAR2), F.MISC + 12, F.wave, NS5);
                { XOrder S{NS5, rank, (const char*)(ws + WS_AROW), (const char*)(ws + WS_BTX)}; EpiX E{(float*)(ws + WS_XLOC)}; pg8::ALinear AO{AROW_P * 2};
                  REP(50, pg8::gemm_phase<EpiX, XOrder, pg8::ALinear, true>(ring, 1024, S, AO, E, F.wave)); }
                xcd_barrier(sbar);
                REP(51, if (F.wave < 2) s5_scan(args, rank * 2 + F.wave, mk_lane()));
                xcd_barrier(sbar);
                { YOrder S{NS5, rank, (const char*)(ws + WS_AROW), (const char*)(ws + WS_BTY)}; EpiY E{(bf16*)(ws + WS_YG)}; pg8::ALinear AO{AROW_P * 2};
                  REP(52, pg8::gemm_phase<EpiY, YOrder, pg8::ALinear, true>(ring, AROW_P * 2, S, AO, E, F.wave)); }
                xcd_barrier(sbar);
                { GluOrder S{rank, (const char*)(ws + WS_YG), (const char*)(ws + WS_WGLU)};
                  EpiGlu E{(const bf16*)(ws + WS_YG), (bf16*)(ws + WS_GLU), INF(args, 18)}; pg8::ALinear AO{1024};
                  REP(53, pg8::gemm_phase<EpiGlu, GluOrder, pg8::ALinear, true>(ring, 1024, S, AO, E, F.wave)); }
                asm volatile("s_waitcnt vmcnt(0)" ::: "memory"); __syncthreads();
                REP(54, glunorm_sub(F, args, rank));
                __syncthreads();
            }
            const int xcd = F.vcu >> 5, wl = F.vcu & 31;
            const float lam = *(const float*)(ws + WS_SMALL);
            for (int rp = 0; rp < NREP(2); ++rp)
            for (int i = 0; i < 8; ++i) {
                const int e = __builtin_amdgcn_readfirstlane((int)ATT_DEAL[wl][i]); if (e == 255) break;
                const int bh = xcd * 2 + (e >> 5), qb = e & 31, b = bh >> 2, h = bh & 3;
                for (int map = 0; map < 2; ++map) { const int hm = h * 2 + map;
                    attn_body::attn_unit<8>(b, hm * 64, hm * 64, h * 128, h * 128, qb,
                        (const attn_body::bf16*)(ws + WS_Q), (const attn_body::bf16*)(ws + WS_K), (const attn_body::bf16*)(ws + WS_V), (attn_body::bf16*)(ws + WS_O), (char*)lds + RING_OFF, F.wave,
                        map, (attn_body::bf16*)(ws + WS_ACAT), lam, INF(args, 8)); }
            }
        }
        if (IN(7)) GRID_BAR();
    }
    if (IN(7)) {
        DenseOrder S; S.init(T, 1024, 1024, 1024, 1024, ws + WS_ACAT, ws + WS_WOUT, F.G, (int)blockIdx.x);
        EpiMix E{(bf16*)(ws + WS_MIX)}; pg8::ALinear AO{2048};
        REP(7, pg8::gemm_phase<EpiMix, DenseOrder, pg8::ALinear, true>(ring, 2048, S, AO, E, F.wave));
        if (BOTH(7)) GRID_BAR();
    }
    if (IN(8)) { if (F.G == 256) pr_router(F, args); if (BOTH(8)) GRID_BAR(); }
    if (IN(9)) {
        moe_tables(F);
        const LAS int* tpre = (const LAS int*)(F.lds + MOE_OFF);
        MoeOrder<4, 8> S{F.G, F.vcu, tpre, tpre + 40, (const char*)(ws + WS_XN), (const char*)(ws + WS_WGU), (size_t)2048 * 1024, true, 8};
        EpiGU E{(unsigned char*)(ws + WS_ACT), INF(args, 25), F.lds + EPB_OFF}; AGather AO{(const int*)(ws + WS_LIST)};
        if constexpr (PROBE_DUP == 66) { EpiNullT<2> E0; pg8::gemm_phase<EpiNullT<2>, MoeOrder<4, 8>, AGather, true, true>(ring, 1024, S, AO, E0, F.wave, F.lds + ST_OFF); }
        if constexpr (PROBE_DUP == 61) { MoeOrder<4, 8> S2 = S; S2.ntk = 24; pg8::gemm_phase<EpiGU, MoeOrder<4, 8>, AGather, true, true>(ring, 1024, S2, AO, E, F.wave, F.lds + ST_OFF); }
        REP(9, pg8::gemm_phase<EpiGU, MoeOrder<4, 8>, AGather, true, true>(ring, 1024, S, AO, E, F.wave, F.lds + ST_OFF));
        if (BOTH(9)) GRID_BAR();
    }
    if (IN(10)) {
        moe_tables(F);
        const LAS int* tpre = (const LAS int*)(F.lds + MOE_OFF);
        MoeOrder<8, 4> S{F.G, F.vcu, tpre, tpre + 40, (const char*)(ws + WS_ACT), (const char*)(ws + WS_WD), (size_t)1024 * 1024, false, 8};
        EpiDown E{(unsigned char*)(ws + WS_YBUF), INF(args, 27), (const int*)(ws + WS_LIST), (const float*)(ws + WS_GATES), 1, F.lds + ST_OFF, F.lds + EPB_OFF}; pg8::ALinear AO{1024};
        if constexpr (PROBE_DUP == 64) { EpiDownT<1> E1{(unsigned char*)(ws + WS_YBUF), INF(args, 27), (const int*)(ws + WS_LIST), (const float*)(ws + WS_GATES), 1, F.lds + ST_OFF, F.lds + EPB_OFF}; pg8::gemm_phase<EpiDownT<1>, MoeOrder<8, 4>, pg8::ALinear, true, true>(ring, 1024, S, AO, E1, F.wave); }
        if constexpr (PROBE_DUP == 62) { EpiNull E0; pg8::gemm_phase<EpiNull, MoeOrder<8, 4>, pg8::ALinear, true, true>(ring, 1024, S, AO, E0, F.wave); }
        if constexpr (PROBE_DUP == 60) { MoeOrder<8, 4> S2 = S; S2.ntk = 24; pg8::gemm_phase<EpiDown, MoeOrder<8, 4>, pg8::ALinear, true, true>(ring, 1024, S2, AO, E, F.wave); }
        REP(10, pg8::gemm_phase<EpiDown, MoeOrder<8, 4>, pg8::ALinear, true, true>(ring, 1024, S, AO, E, F.wave));
        if (BOTH(10)) GRID_BAR();
    }
    if (IN(11)) { REP(11, pf_final(F, args)); }
#undef IN
#undef BOTH
}

extern "C" void kernel_launch(void* const* d_in, const int* in_sizes, int n_in, void* d_out, int out_size, void* d_ws, size_t ws_size, hipStream_t stream) {
    static int grid = 0;
    if (grid == 0) {
        if (n_in != 29 || in_sizes[0] != T * D || out_size != T * D || ws_size < WS_END) { fprintf(stderr, "kernel_launch: unexpected shapes / workspace (n_in %d, ws %zu)\n", n_in, ws_size); grid = -1; return; }
        int dev = 0, cus = 0, per_cu = 0;
        if (hipGetDevice(&dev) != hipSuccess || hipDeviceGetAttribute(&cus, hipDeviceAttributeMultiprocessorCount, dev) != hipSuccess) { grid = -1; return; }
        if (hipFuncSetAttribute((const void*)mk_fwd, hipFuncAttributeMaxDynamicSharedMemorySize, LDS_BYTES) != hipSuccess) { fprintf(stderr, "kernel_launch: hipFuncSetAttribute failed\n"); grid = -1; return; }
        if (hipOccupancyMaxActiveBlocksPerMultiprocessor(&per_cu, (const void*)mk_fwd, NWAVES * 64, LDS_BYTES) != hipSuccess || per_cu < 1) { fprintf(stderr, "kernel_launch: occupancy query says %d\n", per_cu); }
        (void)hipGetLastError();
        if (cus < 256) { fprintf(stderr, "kernel_launch: needs 256 CUs, device has %d\n", cus); grid = -1; return; }
        grid = 256;
    }
    if (grid < 0) return;
    if (hipMemsetAsync((char*)d_ws + WS_CTL, 0, CTL_ZERO_BYTES, stream) != hipSuccess) return;
    Args a{};
    for (int i = 0; i < 29; ++i) a.in[i] = d_in[i];
    a.out = (float*)d_out; a.ws = (unsigned char*)d_ws; a.pad = 0;
    for (int li = 0; li < N_LAUNCHES; ++li) {
        a.ph_lo = (N_LAUNCHES == NPH) ? li : 0; a.ph_hi = (N_LAUNCHES == NPH) ? li + 1 : NPH; a.li = li;
        hipLaunchKernelGGL(mk_fwd, dim3(grid), dim3(NWAVES * 64), LDS_BYTES, stream, a);
    }
}
```

```cpp
#include <hip/hip_runtime.h>
#include <hip/hip_bf16.h>
#include <cstdio>
#include <cstdint>
#include <cmath>
__device__ __forceinline__ int mk_lane() { int l; asm volatile("v_mbcnt_lo_u32_b32 %0, -1, 0\n\tv_mbcnt_hi_u32_b32 %0, -1, %0" : "=v"(l)); return l; }
namespace pg8 {
#define PG8_LAS __attribute__((address_space(3)))
typedef unsigned short bf16_t;
typedef short bf16x8 __attribute__((ext_vector_type(8)));
typedef float f32x4 __attribute__((ext_vector_type(4)));
typedef float f32x2 __attribute__((ext_vector_type(2)));
typedef unsigned u32x4 __attribute__((ext_vector_type(4)));
typedef unsigned u32x2 __attribute__((ext_vector_type(2)));
constexpr int BM = 256, BK = 64, HALF = 128, HTB = HALF * BK * 2  , STAGE_BYTES = 8 * HTB, NXCD = 8, WGM = 8;

__host__ __device__ __forceinline__ int lds_byte(int r, int c) { const int st = (r >> 4) * 2 + (c >> 5), rr = r & 15, cc = c & 31, ob = rr * 64 + cc * 2; return st * 1024 + (ob ^ (((ob >> 9) & 1) << 5)); }
__host__ __device__ __forceinline__ void stage_rc(int b, int& R, int& C) { const int st = b / 1024, sb = b % 1024, swz = sb ^ (((sb >> 9) & 1) << 5); R = (st >> 1) * 16 + swz / 64; C = (st & 1) * 32 + (swz % 64) / 2; }
__host__ __device__ __forceinline__ int perm32(int rho) { const int n = rho >> 4, i = rho & 15; return 8 * (i >> 2) + 4 * n + (i & 3); }

struct Unit { int pm, pn; const char* a; const char* b; int nt; int x0, x1; };

struct ALinear {
    static constexpr bool PER_UNIT = false;
    int lda;
    __device__ __forceinline__ void get(const Unit&, unsigned (&v)[2][2], const int (&R)[2], const int (&C)[2]) const {
#pragma unroll
        for (int h = 0; h < 2; ++h)
#pragma unroll
            for (int i = 0; i < 2; ++i) v[h][i] = (unsigned)(R[i] * lda + C[i] * 2);
    }
    __device__ __forceinline__ size_t hstep() const { return (size_t)HALF * lda; }
    __device__ __forceinline__ void issue_dma(const Unit&, const int (&)[2], unsigned) const {}
    __device__ __forceinline__ void finish(const int (&)[4], unsigned (&)[2][2], const int (&)[2]) const {}
};

__device__ __forceinline__ unsigned cvt_pk_bf16(float lo, float hi) { unsigned r; asm volatile("v_cvt_pk_bf16_f32 %0, %1, %2" : "=v"(r) : "v"(lo), "v"(hi)); return r; }
__device__ __forceinline__ f32x2 gelu_pk(f32x2 v) {
    const f32x2 av = __builtin_elementwise_abs(v), d = av * 0.2316418882f + 1.0f;
    f32x2 t; t.x = __builtin_amdgcn_rcpf(d.x); t.y = __builtin_amdgcn_rcpf(d.y);
    f32x2 q = t * 0.5307027145f + (-0.7265760135f); q = q * t + 0.7107068705f; q = q * t + (-0.142248368f); q = q * t + 0.127414796f; q = q * t;
    const f32x2 s = (v * v) * (-0.72134752044f);
    f32x2 e; e.x = __builtin_amdgcn_exp2f(s.x); e.y = __builtin_amdgcn_exp2f(s.y);
    const f32x2 m = v * (q * e), r = v - m;
    f32x2 o; o.x = v.x < 0.f ? m.x : r.x; o.y = v.y < 0.f ? m.y : r.y; return o;
}

typedef int v4i_t __attribute__((ext_vector_type(4)));
typedef int v8i_t __attribute__((ext_vector_type(8)));
template <int OFF> __device__ __forceinline__ void glds_sv(const char* sbase, unsigned voff, unsigned lds_w0) { unsigned keep;
    asm volatile("s_mov_b32 %0, m0\n\ts_add_u32 m0, %3, %4\n\ts_nop 0\n\tglobal_load_lds_dwordx4 %1, %2\n\ts_mov_b32 m0, %0" : "=&s"(keep) : "v"(voff), "s"(sbase), "s"(lds_w0), "i"(OFF) : "memory", "scc"); }
__device__ __forceinline__ void glds4_sv(const void* sbase, unsigned voff, unsigned lds_dst) { unsigned keep;
    asm volatile("s_mov_b32 %0, m0\n\ts_mov_b32 m0, %3\n\ts_nop 0\n\tglobal_load_lds_dword %1, %2\n\ts_mov_b32 m0, %0" : "=&s"(keep) : "v"(voff), "s"(sbase), "s"(lds_dst) : "memory"); }
template <int N> __device__ __forceinline__ void wait_vm_sel(int sel) { asm volatile("v_cmp_ne_u32_e32 vcc, 0, %0\n\ts_cbranch_vccz .Lw8_%=\n\ts_waitcnt vmcnt(%1)\n\ts_branch .Lwe_%=\n.Lw8_%=:\n\ts_waitcnt vmcnt(8)\n.Lwe_%=:" :: "v"(sel), "n"(N) : "memory", "vcc"); }
template <bool FP8> struct FragT;
template <> struct FragT<false> { struct A4 { bf16x8 v[4][2]; }; struct B2 { bf16x8 v[2][2]; }; };
template <> struct FragT<true> { struct A4 { v8i_t v[4]; }; struct B2 { v8i_t v[2]; }; };
template <class Epi, class Sched, class AOff, bool ALIGN_EPI = true, bool FP8 = false>
__device__ __forceinline__ void gemm_phase(PG8_LAS unsigned char* lds, const int ldb  , const Sched& S, const AOff& AO, const Epi& E, const int wave_  , PG8_LAS unsigned char* xlds = nullptr  ) {
    int tid_ = wave_ * 64 + mk_lane(); asm volatile("" : "+v"(tid_));
    const int tid = tid_, wid = __builtin_amdgcn_readfirstlane(tid >> 6), lane = tid & 63, wr = wid >> 2, wc = wid & 3, fr = lane & 15, fq = lane >> 4;
    unsigned voffB[2]; int RR[2], CC[2];
#pragma unroll
    for (int i = 0; i < 2; ++i) { int R, C; stage_rc(tid * 16 + i * 8192, R, C); RR[i] = R; CC[i] = C; const int Rp = (R & ~31) + perm32(R & 31); const int P32 = perm32(R & 31); const int Rb = Epi::BMODE == 0 ? R : Epi::BMODE == 1 ? Rp : Epi::BMODE == 2 ? 2 * Rp : 64 * (R >> 5) + 16 * (P32 >> 3) + (P32 & 7);
        voffB[i] = (unsigned)(Rb * ldb + C * 2); }
    const size_t kstep = (size_t)(BK * 2);
    const size_t hstepB = Epi::BMODE == 2 ? (size_t)ldb : Epi::BMODE == 3 ? (size_t)8 * ldb : (size_t)HALF * ldb;
    const size_t hstepA = AO.hstep();
    constexpr int AH1 = AOff::PER_UNIT ? 1 : 0;
    const unsigned ldsw0 = (unsigned)__builtin_amdgcn_readfirstlane((int)((unsigned)(uintptr_t)lds + (unsigned)wid * 1024u));
    const int aoff = lds_byte(wr * 64 + fr, fq * 8), boff = lds_byte(wc * 32 + fr, fq * 8);
#define PG8_SA(b, h) (((b) * 2 + (h)) * HTB)
#define PG8_SB(b, h) ((4 + (b) * 2 + (h)) * HTB)
#define PG8_STAGE(bufoff, gbase, voff) do { glds_sv<(bufoff)>((const char*)(gbase), (voff)[0], ldsw0); glds_sv<(bufoff) + 8192>((const char*)(gbase), (voff)[1], ldsw0); } while (0)
#define PG8_LD8(p) __builtin_shufflevector(*(const PG8_LAS v4i_t*)(p), *(const PG8_LAS v4i_t*)((p) + 1024), 0, 1, 2, 3, 4, 5, 6, 7)
#define PG8_LDA(dst, b, h) do { if constexpr (FP8) { _Pragma("unroll") for (int m = 0; m < 4; ++m) dst.v[m] = PG8_LD8(lds + PG8_SA(b, h) + aoff + m * 2048); } \
        else { _Pragma("unroll") for (int m = 0; m < 4; ++m) _Pragma("unroll") for (int k = 0; k < 2; ++k) dst.v[m][k] = *(const PG8_LAS bf16x8*)(lds + PG8_SA(b, h) + aoff + m * 2048 + k * 1024); } } while (0)
#define PG8_LDB(dst, b, h) do { if constexpr (FP8) { _Pragma("unroll") for (int n = 0; n < 2; ++n) dst.v[n] = PG8_LD8(lds + PG8_SB(b, h) + boff + n * 2048); } \
        else { _Pragma("unroll") for (int n = 0; n < 2; ++n) _Pragma("unroll") for (int k = 0; k < 2; ++k) dst.v[n][k] = *(const PG8_LAS bf16x8*)(lds + PG8_SB(b, h) + boff + n * 2048 + k * 1024); } } while (0)
#define PG8_MMA(ai, bj, At, Bt) do { __builtin_amdgcn_s_setprio(1); \
        if constexpr (FP8) { _Pragma("unroll") for (int m = 0; m < 4; ++m) _Pragma("unroll") for (int n = 0; n < 2; ++n) \
            acc[ai][bj][m][n] = __builtin_amdgcn_mfma_scale_f32_16x16x128_f8f6f4(Bt.v[n], At.v[m], acc[ai][bj][m][n], 0, 0, 0, 0, 0, 0); } \
        else { _Pragma("unroll") for (int m = 0; m < 4; ++m) _Pragma("unroll") for (int n = 0; n < 2; ++n) _Pragma("unroll") for (int k = 0; k < 2; ++k) \
            acc[ai][bj][m][n] = __builtin_amdgcn_mfma_f32_16x16x32_bf16(Bt.v[n][k], At.v[m][k], acc[ai][bj][m][n], 0, 0, 0); } \
        __builtin_amdgcn_s_setprio(0); } while (0)
#define PG8_WAIT_V(n) asm volatile("s_waitcnt vmcnt(" #n ")" ::: "memory")
#define PG8_WAIT_L(n) asm volatile("s_waitcnt lgkmcnt(" #n ")" ::: "memory")
#define PG8_BAR __builtin_amdgcn_s_barrier()
#define PG8_SCHED __builtin_amdgcn_sched_barrier(0)
    Unit cur, nxt; int ui = 0;
    if (!S.next(0, cur)) return;
    unsigned vAc[2][2];
    AO.get(cur, vAc, RR, CC);
    PG8_LAS unsigned* const xw = (PG8_LAS unsigned*)xlds + wid * 256 + lane;
    const unsigned xdst = (unsigned)__builtin_amdgcn_readfirstlane((int)((unsigned)(uintptr_t)xlds + (unsigned)wid * 1024u));
    f32x4 acc[2][2][4][2];
#pragma unroll
    for (int a = 0; a < 2; ++a)
#pragma unroll
        for (int b = 0; b < 2; ++b)
#pragma unroll
            for (int m = 0; m < 4; ++m)
#pragma unroll
                for (int n = 0; n < 2; ++n) acc[a][b][m][n] = (f32x4){0.f, 0.f, 0.f, 0.f};
    typedef typename FragT<FP8>::A4 FragA; typedef typename FragT<FP8>::B2 FragB;
    FragA At; FragB B0, B1;
    const char* cA = cur.a; const char* cB = cur.b; int nt = cur.nt; asm volatile("" : "+s"(nt));
    PG8_STAGE(PG8_SB(0, 0), cB, voffB); PG8_STAGE(PG8_SB(0, 1), cB + hstepB, voffB); PG8_STAGE(PG8_SA(0, 0), cA, vAc[0]); PG8_STAGE(PG8_SA(0, 1), cA + hstepA, vAc[AH1]);
    if (wr == 1) PG8_BAR;
    PG8_WAIT_V(2); PG8_BAR;
    PG8_STAGE(PG8_SB(1, 0), cB + kstep, voffB); PG8_STAGE(PG8_SA(1, 0), cA + kstep, vAc[0]); PG8_STAGE(PG8_SB(1, 1), cB + hstepB + kstep, voffB);
    PG8_WAIT_V(6); PG8_BAR;
    for (;;) {
        const bool has_next = S.next(ui + 1, nxt);
        if constexpr (AOff::PER_UNIT) { if (has_next) AO.issue_dma(nxt, RR, xdst); }
        if constexpr (Epi::PREFETCH) E.prefetch(cur, wid, wr, lane);
        const char* nA = has_next ? nxt.a : cA; const char* nB = has_next ? nxt.b : cB;
        for (int t = 0; t < nt; t += 2) {
            const bool last = (t == nt - 2);
            const int rlx = ((t == 0) && (ui > 0)) ? 1 : 0;
            const char* a1 = cA + (size_t)(t + 1) * kstep;
            const char* a2 = last ? nA : cA + (size_t)(t + 2) * kstep; const char* b2 = last ? nB : cB + (size_t)(t + 2) * kstep;
            const char* a3 = a2 + kstep; const char* b3 = b2 + kstep;

            PG8_LDB(B0, 0, 0); PG8_LDB(B1, 0, 1); PG8_SCHED; PG8_LDA(At, 0, 0); PG8_STAGE(PG8_SA(1, 1), a1 + hstepA, vAc[AH1]);
            if constexpr (AOff::PER_UNIT) { if (last && has_next) { int raw[4]; raw[0] = (int)xw[0]; raw[1] = (int)xw[64]; raw[2] = (int)xw[128]; raw[3] = (int)xw[192]; AO.finish(raw, vAc, CC); } }
            if constexpr (Epi::NSTORE + Epi::NPRE > 0) wait_vm_sel<8 + Epi::NSTORE + Epi::NPRE>(rlx); else PG8_WAIT_V(8);
            PG8_WAIT_L(0); PG8_BAR; PG8_MMA(0, 0, At, B0); PG8_MMA(0, 1, At, B1); PG8_BAR; PG8_SCHED;
            PG8_LDA(At, 0, 1); PG8_STAGE(PG8_SB(0, 0), b2, voffB); PG8_STAGE(PG8_SB(0, 1), b2 + hstepB, voffB); PG8_STAGE(PG8_SA(0, 0), a2, vAc[0]);
            if constexpr (Epi::NSTORE + Epi::NPRE > 0) wait_vm_sel<8 + Epi::NSTORE + Epi::NPRE>(rlx); else PG8_WAIT_V(8);
            PG8_WAIT_L(0); PG8_BAR; PG8_MMA(1, 0, At, B0); PG8_MMA(1, 1, At, B1); PG8_BAR; PG8_SCHED;
            PG8_LDB(B0, 1, 0); PG8_LDB(B1, 1, 1); PG8_SCHED; PG8_LDA(At, 1, 0); PG8_STAGE(PG8_SA(0, 1), a2 + hstepA, vAc[AH1]);
            PG8_WAIT_V(8); PG8_WAIT_L(0); PG8_BAR; PG8_MMA(0, 0, At, B0); PG8_MMA(0, 1, At, B1); PG8_BAR; PG8_SCHED;
            PG8_LDA(At, 1, 1); PG8_STAGE(PG8_SB(1, 0), b3, voffB); PG8_STAGE(PG8_SB(1, 1), b3 + hstepB, voffB); PG8_STAGE(PG8_SA(1, 0), a3, vAc[0]);
            PG8_WAIT_V(8); PG8_WAIT_L(0); PG8_BAR; PG8_MMA(1, 0, At, B0); PG8_MMA(1, 1, At, B1); PG8_BAR; PG8_SCHED;
        }
        if constexpr (ALIGN_EPI) { if (wr == 0) PG8_BAR; }
        { const int el = mk_lane(); const int efr = el & 15, efq = el >> 4;
          E(acc, cur, wr, wc, efr, efq); }
        if (!has_next) break;
#pragma unroll
        for (int a = 0; a < 2; ++a)
#pragma unroll
            for (int b = 0; b < 2; ++b)
#pragma unroll
                for (int m = 0; m < 4; ++m)
#pragma unroll
                    for (int n = 0; n < 2; ++n) acc[a][b][m][n] = (f32x4){0.f, 0.f, 0.f, 0.f};
        cur = nxt; cA = nA; cB = nB; nt = cur.nt; asm volatile("" : "+s"(nt)); ++ui;

        if constexpr (ALIGN_EPI) { if (wr == 1) PG8_BAR; }
    }
    PG8_WAIT_V(0);
    if constexpr (!ALIGN_EPI) { if (wr == 0) PG8_BAR; }
    PG8_BAR;
#undef PG8_SA
#undef PG8_SB
#undef PG8_STAGE
#undef PG8_LDA
#undef PG8_LDB
#undef PG8_MMA
#undef PG8_LD8
#undef PG8_WAIT_V
#undef PG8_WAIT_L
#undef PG8_BAR
#undef PG8_SCHED
}
}
namespace attn_body {
using bf16=__hip_bfloat16;
using bf16x8=__attribute__((ext_vector_type(8)))short;
using s16x4=__attribute__((ext_vector_type(4)))short;
using f32x16=__attribute__((ext_vector_type(16)))float;
using u32x4=__attribute__((ext_vector_type(4)))unsigned;
constexpr int SEQ=8192,D=64;
constexpr int PQ=512,PK=512,PV=512,PO=512,PA=1024;
constexpr int NW=8,QBLK=32,QB=QBLK*NW,KVBLK=64,NQB=SEQ/QB;
constexpr int ATTN_UNIT_ROWS=QB;
__device__ __forceinline__ int crow(int r,int hi){return (r&3)+8*(r>>2)+4*hi;}
#define SBAR() __builtin_amdgcn_sched_barrier(0)
__device__ __forceinline__ void cmask(f32x16&p0,f32x16&p1,int jb,int qrel,int hi){
  const float NEG=-INFINITY; int kb=64*jb+4*hi;
  #pragma unroll
  for(int r=0;r<16;++r){int kv=kb+(r&3)+8*(r>>2); if(kv>qrel)p0[r]=NEG; if(kv+32>qrel)p1[r]=NEG;}
}

constexpr int NSLOT=3, SLOTB=8192;
constexpr int LDS_K=0, LDS_V=NSLOT*SLOTB, LDS_WS=3*NSLOT*SLOTB, LDS_OST=LDS_WS+NW*64*4, LDS_BYTES=LDS_OST+NW*8192;
constexpr float C2=0.125f*1.4426950408889634f;
__device__ __forceinline__ void glds16(const void*sbase,unsigned voff,unsigned lds_dst){unsigned keep;
  asm volatile("s_mov_b32 %0, m0\n\ts_mov_b32 m0, %3\n\ts_nop 0\n\tglobal_load_lds_dwordx4 %1, %2\n\ts_mov_b32 m0, %0":"=&s"(keep):"v"(voff),"s"(sbase),"s"(lds_dst):"memory");}
__device__ __forceinline__ float max3f(float a,float b,float c){float r;asm("v_max3_f32 %0, %1, %2, %3":"=v"(r):"v"(a),"v"(b),"v"(c));return r;}
__device__ __forceinline__ float max2f(float a,float b){float r;asm("v_max_f32_e32 %0, %1, %2":"=v"(r):"v"(a),"v"(b));return r;}
__device__ __forceinline__ float fadd_s(float a,float b){float r;asm("v_add_f32_e32 %0, %1, %2":"=v"(r):"v"(a),"v"(b));return r;}
__device__ __forceinline__ float fsub_s(float a,float b){float r;asm("v_sub_f32_e32 %0, %1, %2":"=v"(r):"v"(a),"v"(b));return r;}
typedef float f32x2_t __attribute__((ext_vector_type(2))); typedef __bf16 bf16x2_t __attribute__((ext_vector_type(2)));
__device__ __forceinline__ unsigned cvtpk_s(float lo,float hi){f32x2_t v={lo,hi};bf16x2_t b=__builtin_convertvector(v,bf16x2_t);return __builtin_bit_cast(unsigned,b);}
#define WAIT_BAR(N) asm volatile("s_waitcnt vmcnt(" #N ") lgkmcnt(0)\n\ts_barrier":::"memory")

__device__ __forceinline__ void qkt(f32x16&p0,f32x16&p1,const char*Kslot,const bf16x8*qr,const f32x16&negm,int r32,int hi){
  const char*kb=Kslot+hi*1024+r32*16;
  #pragma unroll
  for(int d0=0;d0<4;++d0){
    const bf16x8 b0=*reinterpret_cast<const bf16x8*>(kb+d0*2048);
    const bf16x8 b1=*reinterpret_cast<const bf16x8*>(kb+d0*2048+512);
    if(d0==0){p0=__builtin_amdgcn_mfma_f32_32x32x16_bf16(b0,qr[0],negm,0,0,0);p1=__builtin_amdgcn_mfma_f32_32x32x16_bf16(b1,qr[0],negm,0,0,0);}
    else{p0=__builtin_amdgcn_mfma_f32_32x32x16_bf16(b0,qr[d0],p0,0,0,0);p1=__builtin_amdgcn_mfma_f32_32x32x16_bf16(b1,qr[d0],p1,0,0,0);}}
}
typedef __attribute__((address_space(3))) const char* lds_cptr;
typedef short v4i16_t __attribute__((ext_vector_type(4)));
__device__ __forceinline__ void kload8(bf16x8*kf,lds_cptr kp){
  kf[0]=*(const __attribute__((address_space(3))) bf16x8*)(kp);      kf[1]=*(const __attribute__((address_space(3))) bf16x8*)(kp+512);
  kf[2]=*(const __attribute__((address_space(3))) bf16x8*)(kp+2048); kf[3]=*(const __attribute__((address_space(3))) bf16x8*)(kp+2560);
  kf[4]=*(const __attribute__((address_space(3))) bf16x8*)(kp+4096); kf[5]=*(const __attribute__((address_space(3))) bf16x8*)(kp+4608);
  kf[6]=*(const __attribute__((address_space(3))) bf16x8*)(kp+6144); kf[7]=*(const __attribute__((address_space(3))) bf16x8*)(kp+6656);
}
__device__ __forceinline__ void kload2(bf16x8*kf,lds_cptr kp,int j){ kf[2*j]=*(const __attribute__((address_space(3))) bf16x8*)(kp+j*2048); kf[2*j+1]=*(const __attribute__((address_space(3))) bf16x8*)(kp+j*2048+512); }
__device__ __forceinline__ s16x4 vtr(lds_cptr p){ return __builtin_bit_cast(s16x4,__builtin_amdgcn_ds_read_tr16_b64_v4i16((__attribute__((address_space(3))) v4i16_t*)p)); }
__device__ __forceinline__ float rowmax(const f32x16&p0,const f32x16&p1){
  float a=max3f(p0[0],p0[1],p1[0]),b=max3f(p0[2],p0[3],p1[1]);a=max3f(a,p1[2],p1[3]);
  #pragma unroll
  for(int r=4;r<16;r+=4){a=max3f(a,p0[r],p0[r+1]);b=max3f(b,p0[r+2],p0[r+3]);a=max3f(a,p1[r],p1[r+1]);b=max3f(b,p1[r+2],p1[r+3]);}
  const float m=max2f(a,b);
  auto rr=__builtin_amdgcn_permlane32_swap(__float_as_uint(m),__float_as_uint(m),false,false);
  return max2f(__uint_as_float(rr[0]),__uint_as_float(rr[1]));
}
__device__ __forceinline__ void pv(f32x16*o,int vb,bf16x8 pa0,bf16x8 pa1,bf16x8 pa2,bf16x8 pa3){
  #pragma unroll
  for(int d0=0;d0<4;++d0){s16x4 lo[4],hi[4];
    #pragma unroll
    for(int ks=0;ks<4;++ks){
      asm volatile("ds_read_b64_tr_b16 %0,%1 offset:%c2":"=&v"(lo[ks]):"v"(vb),"i"(d0*4096+ks*1024):"memory");
      asm volatile("ds_read_b64_tr_b16 %0,%1 offset:%c2":"=&v"(hi[ks]):"v"(vb),"i"(d0*4096+ks*1024+512):"memory");}
    asm volatile("s_waitcnt lgkmcnt(0)":::"memory");SBAR();
    #define PK(k) (bf16x8){lo[k][0],lo[k][1],lo[k][2],lo[k][3],hi[k][0],hi[k][1],hi[k][2],hi[k][3]}
    o[d0]=__builtin_amdgcn_mfma_f32_32x32x16_bf16(pa0,PK(0),o[d0],0,0,0);
    o[d0]=__builtin_amdgcn_mfma_f32_32x32x16_bf16(pa1,PK(1),o[d0],0,0,0);
    o[d0]=__builtin_amdgcn_mfma_f32_32x32x16_bf16(pa2,PK(2),o[d0],0,0,0);
    o[d0]=__builtin_amdgcn_mfma_f32_32x32x16_bf16(pa3,PK(3),o[d0],0,0,0);
    #undef PK
  }
}

#ifndef ATTN_STORE16
#define ATTN_STORE16(p,v) (*(u32x4*)(p)=(v))
#endif
template<int THRL> __device__ __forceinline__ void attn_unit(int b,int qoff,int koff,int voff,int ooff,int qb,const bf16*Q,const bf16*__restrict__ K,const bf16*__restrict__ V,bf16*O,char*shm,const int wave_,const int map,bf16*AOUT,const float lam,const float*ng){
  const int lane=mk_lane(),r32=lane&31,hi=lane>>5; const int wid=__builtin_amdgcn_readfirstlane(wave_);
  const long rowbase=(long)b*SEQ; const int q0=qb*QB;
  const bf16*Qw=Q+(rowbase+q0+wid*QBLK)*PQ+qoff;
  const bf16*Kh=K+rowbase*PK+koff,*Vh=V+rowbase*PV+voff;
  const unsigned lds0=(unsigned)(uintptr_t)shm;
  float*wsf=(float*)(shm+LDS_WS)+wid*64;
  const unsigned kofs=(unsigned)(lane*PK+wid*8)*2u;
  const unsigned voffs=(unsigned)((16*(wid&3)+(lane>>2))*PV+(wid>>2)*32+(lane&3)*8)*2u;
  const unsigned kdst=lds0+LDS_K+wid*1024, vdst=lds0+LDS_V+wid*1024;
  #define DMA_K(t,slot) glds16(Kh+(long)(t)*KVBLK*PK,kofs,(unsigned)__builtin_amdgcn_readfirstlane(kdst+(slot)))
  #define DMA_V(t,slot) do{ glds16(Vh+(long)(t)*KVBLK*PV,voffs,(unsigned)__builtin_amdgcn_readfirstlane(vdst+2*(slot))); glds16(Vh+(long)(t)*KVBLK*PV+64,voffs,(unsigned)__builtin_amdgcn_readfirstlane(vdst+2*(slot)+8192)); }while(0)
  const int vb0=(int)(lds0+LDS_V)+((lane>>4)&1)*32+(lane&3)*8+(4*hi+((lane&15)>>2))*64;
  const char*Kbase=shm+LDS_K; bf16x8 kf[8];
  const lds_cptr shm3=(lds_cptr)shm; const lds_cptr kp0=shm3+LDS_K+hi*1024+r32*16; const lds_cptr vp0=shm3+LDS_V+((lane>>4)&1)*32+(lane&3)*8+(4*hi+((lane&15)>>2))*64;
  const int NT=(q0+QB)/KVBLK;
  DMA_K(0,0);DMA_V(0,0);DMA_K(1,SLOTB);
  bf16x8 qr[4];
  #pragma unroll
  for(int d0=0;d0<4;++d0)qr[d0]=*reinterpret_cast<const bf16x8*>(&Qw[(long)r32*PQ+d0*16+hi*8]);
  typedef __attribute__((address_space(3))) char* lds_wptr;
  const lds_cptr qp0=shm3+LDS_OST+wid*8192+hi*512+r32*16;
  { lds_wptr qw=(lds_wptr)shm+LDS_OST+wid*8192+hi*512+r32*16;
    _Pragma("unroll") for(int d0=0;d0<4;++d0)*(__attribute__((address_space(3))) bf16x8*)(qw+d0*1024)=qr[d0]; }
  float mhat=0.f,l_reg=0.f;f32x16 o[4];o[0]=f32x16{};o[1]=f32x16{};o[2]=f32x16{};o[3]=f32x16{};const f32x16 zero16=f32x16{};
  const int qrel=wid*QBLK+r32;
  #define CMASK(P0,P1,t) do{int jb_=(t)-(NT-4); if(jb_>=0)cmask(P0,P1,jb_,qrel,hi);}while(0)
  bool resc=false;
  #define START(P0,P1) do{ const float rm=rowmax(P0,P1); resc=false; mhat=rm; \
    _Pragma("unroll") for(int r=0;r<16;++r)P0[r]=__builtin_amdgcn_exp2f(P0[r]-mhat); }while(0)
  #define RESC() do{ if(resc){ asm volatile("s_waitcnt lgkmcnt(0)":::"memory"); \
      _Pragma("unroll") for(int d_=0;d_<4;++d_) _Pragma("unroll") for(int r=0;r<16;++r)o[d_][r]*=wsf[crow(r,hi)]; } }while(0)
  f32x16 pA0,pA1,pB0,pB1;
  int sl_prev=0,sl_cur=0,sl_next=SLOTB;
  #define ROT() do{sl_prev=sl_cur;sl_cur=sl_next;sl_next=(sl_next==(NSLOT-1)*SLOTB)?0:sl_next+SLOTB;}while(0)
  DMA_K(2,2*SLOTB);
  WAIT_BAR(4);
  qkt(pA0,pA1,Kbase,qr,zero16,r32,hi);asm volatile("s_nop 15\n\ts_nop 7":"+v"(pA0),"+v"(pA1));CMASK(pA0,pA1,0);
  START(pA0,pA1);
  _Pragma("unroll") for(int r=0;r<16;++r)pA1[r]=__builtin_amdgcn_exp2f(pA1[r]-mhat);
  WAIT_BAR(0);
  DMA_K(3,0);DMA_V(1,SLOTB);
  ROT();
  kload8(kf,kp0+sl_cur);
  WAIT_BAR(3);
  s16x4 vlo[3],vhi[3]; u32x4 pw0,pw1,pw2,pw3;
  #define PKW(P,B) cvtpk_s(P[B],P[B+1])
  #define PAF(k) __builtin_bit_cast(bf16x8,pw##k)
  #define VFS(s) (bf16x8){vlo[s][0],vlo[s][1],vlo[s][2],vlo[s][3],vhi[s][0],vhi[s][1],vhi[s][2],vhi[s][3]}
  #define PIN(x) asm volatile("":"+v"(x))
  #define MX3(a,b,c) __builtin_fmaxf(__builtin_fmaxf((a),(b)),(c))
  #define GAPA(MF,A0,A1,A2,A3,W0,W1,PW) do{ MF; sacc+=A0; sacc+=A1; sacc+=A2; sacc+=A3; PIN(sacc); W0; W1; PIN(PW); SBAR(); }while(0)
  #define EX(v) __builtin_amdgcn_exp2f(v)
  #define GAPB(MF,X,B) do{ MF; X[B]=EX(X[B]-mhat); X[B+1]=EX(X[B+1]-mhat); PIN(X); SBAR(); }while(0)
  #define VRDG(g) do{ vlo[(g)%3]=vtr(vp_+(((g)&3)*4096+((g)>>2)*1024)); vhi[(g)%3]=vtr(vp_+(((g)&3)*4096+((g)>>2)*1024+512)); SBAR(); }while(0)
  #define QRD(d0) (*(const __attribute__((address_space(3))) bf16x8*)(qp0+(d0)*1024))
  #define KRD(G,j) do{ if(G){ kload2(kf,kp0+sl_next,j); SBAR(); } }while(0)
  #define PVG(g,PF,X,B) GAPB(o[(g)&3]=__builtin_amdgcn_mfma_f32_32x32x16_bf16(PF,VFS((g)%3),o[(g)&3],0,0,0), X,B)
  #define STEP(C0,C1,P0,P1,t,GK,GV,GL) do{ SBAR(); \
    const lds_cptr vp_=vp0+2*sl_prev; \
    bf16x8 qa=QRD(0), qb=QRD(1); SBAR(); float sacc=(P0[0]+P0[1]); \
    GAPA(C0=__builtin_amdgcn_mfma_f32_32x32x16_bf16(kf[0],qa,zero16,0,0,0), P0[2],P0[3],P0[4],P0[5],     pw0[0]=PKW(P0,0), pw0[1]=PKW(P0,2), pw0); \
    GAPA(C1=__builtin_amdgcn_mfma_f32_32x32x16_bf16(kf[1],qa,zero16,0,0,0), P0[6],P0[7],P0[8],P0[9],     pw0[2]=PKW(P0,4), pw0[3]=PKW(P0,6), pw0); \
    qa=QRD(2); SBAR(); \
    GAPA(C0=__builtin_amdgcn_mfma_f32_32x32x16_bf16(kf[2],qb,C0,0,0,0),   P0[10],P0[11],P0[12],P0[13], pw1[0]=PKW(P0,8), pw1[1]=PKW(P0,10), pw1); \
    GAPA(C1=__builtin_amdgcn_mfma_f32_32x32x16_bf16(kf[3],qb,C1,0,0,0),   P0[14],P0[15],P1[0],P1[1],   pw1[2]=PKW(P0,12),pw1[3]=PKW(P0,14), pw1); \
    qb=QRD(3); SBAR(); \
    GAPA(C0=__builtin_amdgcn_mfma_f32_32x32x16_bf16(kf[4],qa,C0,0,0,0),   P1[2],P1[3],P1[4],P1[5],     pw2[0]=PKW(P1,0), pw2[1]=PKW(P1,2), pw2); \
    GAPA(C1=__builtin_amdgcn_mfma_f32_32x32x16_bf16(kf[5],qa,C1,0,0,0),   P1[6],P1[7],P1[8],P1[9],     pw2[2]=PKW(P1,4), pw2[3]=PKW(P1,6), pw2); \
    GAPA(C0=__builtin_amdgcn_mfma_f32_32x32x16_bf16(kf[6],qb,C0,0,0,0),   P1[10],P1[11],P1[12],P1[13], pw3[0]=PKW(P1,8), pw3[1]=PKW(P1,10), pw3); \
    GAPA(C1=__builtin_amdgcn_mfma_f32_32x32x16_bf16(kf[7],qb,C1,0,0,0),   P1[14],P1[15],0.f,0.f,       pw3[2]=PKW(P1,12),pw3[3]=PKW(P1,14), pw3); \
    l_reg+=sacc; \
    if(GK){DMA_K((t)+3,sl_cur);} if(GV){DMA_V((t)+1,sl_next);} \
    VRDG(0); VRDG(1); \
    CMASK(C0,C1,t); \
    { float a=MX3(C0[0],C0[1],C1[0]),b=MX3(C0[2],C0[3],C1[1]); a=MX3(a,C1[2],C1[3]); \
      _Pragma("unroll") for(int r=4;r<16;r+=4){a=MX3(a,C0[r],C0[r+1]);b=MX3(b,C0[r+2],C0[r+3]);a=MX3(a,C1[r],C1[r+1]);b=MX3(b,C1[r+2],C1[r+3]);} \
      float rm=__builtin_fmaxf(a,b); { auto rr=__builtin_amdgcn_permlane32_swap(__float_as_uint(rm),__float_as_uint(rm),false,false); rm=__builtin_fmaxf(__uint_as_float(rr[0]),__uint_as_float(rr[1])); } \
      rm-=mhat; resc=false; \
      if(__builtin_expect(__any(rm>(float)THRL),0)){ const float dl=__builtin_fmaxf(rm,0.f); mhat+=dl; \
        const float f=__builtin_amdgcn_exp2f(-dl); l_reg*=f; if(hi==0)wsf[r32]=f; resc=true; } } \
    SBAR(); \
    PVG(0,PAF(0),C0,0);  VRDG(2); \
    PVG(1,PAF(0),C0,2);  VRDG(3); \
    PVG(2,PAF(0),C0,4);  VRDG(4); \
    PVG(3,PAF(0),C0,6);  VRDG(5); \
    PVG(4,PAF(1),C0,8);  VRDG(6); \
    PVG(5,PAF(1),C0,10); VRDG(7); \
    PVG(6,PAF(1),C0,12); VRDG(8); \
    PVG(7,PAF(1),C0,14); VRDG(9); \
    PVG(8,PAF(2),C1,0);  VRDG(10); \
    PVG(9,PAF(2),C1,2);  VRDG(11); \
    PVG(10,PAF(2),C1,4); VRDG(12); \
    PVG(11,PAF(2),C1,6); VRDG(13); \
    PVG(12,PAF(3),C1,8); VRDG(14); KRD(GL,0); \
    PVG(13,PAF(3),C1,10); VRDG(15); KRD(GL,1); \
    PVG(14,PAF(3),C1,12); KRD(GL,2); \
    PVG(15,PAF(3),C1,14); KRD(GL,3); \
    }while(0)
  int t=1;
  #undef CMASK
  #define CMASK(P0,P1,t) do{}while(0)
  for(;t+5<NT;t+=2){
    STEP(pB0,pB1,pA0,pA1,t,true,true,true);     WAIT_BAR(3); RESC(); ROT();
    STEP(pA0,pA1,pB0,pB1,t+1,true,true,true);   WAIT_BAR(3); RESC(); ROT();
  }
  #undef CMASK
  #define CMASK(P0,P1,t) do{int jb_=(t)-(NT-4); if(jb_>=0)cmask(P0,P1,jb_,qrel,hi);}while(0)
  #define ENDW(tt) do{ if((tt)+3<NT){WAIT_BAR(3);} else if((tt)+2<NT){WAIT_BAR(2);} else {WAIT_BAR(0);} }while(0)
  for(;t+1<NT;t+=2){
    STEP(pB0,pB1,pA0,pA1,t,(t+3<NT),(t+1<NT),(t+1<NT));       ENDW(t);   RESC(); ROT();
    STEP(pA0,pA1,pB0,pB1,t+1,(t+4<NT),(t+2<NT),(t+2<NT));     ENDW(t+1); RESC(); ROT();
  }
  STEP(pB0,pB1,pA0,pA1,NT-1,false,false,false); RESC();
  { float sacc=pB0[0]+pB0[1]; _Pragma("unroll") for(int r=2;r<16;++r)sacc+=pB0[r]; _Pragma("unroll") for(int r=0;r<16;++r)sacc+=pB1[r]; l_reg+=sacc;
    pw0=(u32x4){PKW(pB0,0),PKW(pB0,2),PKW(pB0,4),PKW(pB0,6)};pw1=(u32x4){PKW(pB0,8),PKW(pB0,10),PKW(pB0,12),PKW(pB0,14)};pw2=(u32x4){PKW(pB1,0),PKW(pB1,2),PKW(pB1,4),PKW(pB1,6)};pw3=(u32x4){PKW(pB1,8),PKW(pB1,10),PKW(pB1,12),PKW(pB1,14)};
    SBAR(); pv(o,vb0+2*sl_cur,PAF(0),PAF(1),PAF(2),PAF(3)); }
  #undef PKW
  #undef PAF
  #undef VFS
  #undef VRDG
  #undef QRD
  #undef PVG
  #undef PIN
  #undef MX3
  #undef GAPA
  #undef GAPB
  #undef EX
  #undef KRD
  #undef STEP
  #undef ENDW
  { int lane_e=mk_lane(); asm volatile("":"+v"(lane_e)); const int lane=lane_e,r32=lane&31,hi=lane>>5;
  {auto rr=__builtin_amdgcn_permlane32_swap(__float_as_uint(l_reg),__float_as_uint(l_reg),false,false);l_reg=__uint_as_float(rr[0])+__uint_as_float(rr[1]);}
  if(hi==0)wsf[32+r32]=l_reg;asm volatile("s_waitcnt lgkmcnt(0)":::"memory");
  float rli[16];
  #pragma unroll
  for(int r=0;r<16;++r)rli[r]=__builtin_amdgcn_rcpf(wsf[32+crow(r,hi)]);
  bf16*Ow=O+(rowbase+q0+wid*QBLK)*PO+ooff;
  { bf16*stg=(bf16*)(shm+LDS_OST)+wid*4096;
    #pragma unroll
    for(int r=0;r<16;++r){const int orow=crow(r,hi);
      #pragma unroll
      for(int d0=0;d0<4;++d0)stg[orow*128+d0*32+r32]=__float2bfloat16(o[d0][r]*rli[r]);}
    asm volatile("s_waitcnt lgkmcnt(0)":::"memory");
    if(map==0){
      #pragma unroll
      for(int i=0;i<8;++i){const int row=i*4+(lane>>4),ch=lane&15; const u32x4 v=*(const u32x4*)(stg+row*128+ch*8); ATTN_STORE16(Ow+(long)row*PO+ch*8,v);}
    }else{
      const int ch=lane&15; const float4 g0=*reinterpret_cast<const float4*>(ng+ch*8),g1=*reinterpret_cast<const float4*>(ng+ch*8+4);
      bf16*Aw=AOUT+(rowbase+q0+wid*QBLK)*PA+ooff;
      #pragma unroll
      for(int i=0;i<8;++i){const int row=i*4+(lane>>4); const u32x4 v2=*(const u32x4*)(stg+row*128+ch*8); const u32x4 v1=*(const u32x4*)(Ow+(long)row*PO+ch*8);
        float d[8];
        #define BLO(w) __uint_as_float((w)<<16)
        #define BHI(w) __uint_as_float((w)&0xffff0000u)
        d[0]=BLO(v1[0])-lam*BLO(v2[0]);d[1]=BHI(v1[0])-lam*BHI(v2[0]);d[2]=BLO(v1[1])-lam*BLO(v2[1]);d[3]=BHI(v1[1])-lam*BHI(v2[1]);
        d[4]=BLO(v1[2])-lam*BLO(v2[2]);d[5]=BHI(v1[2])-lam*BHI(v2[2]);d[6]=BLO(v1[3])-lam*BLO(v2[3]);d[7]=BHI(v1[3])-lam*BHI(v2[3]);
        #undef BLO
        #undef BHI
        float ss=0.f;
        #pragma unroll
        for(int q=0;q<8;++q)ss+=d[q]*d[q];
        ss+=__shfl_xor(ss,1);ss+=__shfl_xor(ss,2);ss+=__shfl_xor(ss,4);ss+=__shfl_xor(ss,8);
        const float sc=0.8f/sqrtf(ss*(1.f/128.f)+1e-6f);
        u32x4 w; w[0]=cvtpk_s(d[0]*sc*g0.x,d[1]*sc*g0.y);w[1]=cvtpk_s(d[2]*sc*g0.z,d[3]*sc*g0.w);w[2]=cvtpk_s(d[4]*sc*g1.x,d[5]*sc*g1.y);w[3]=cvtpk_s(d[6]*sc*g1.z,d[7]*sc*g1.w);
        __builtin_nontemporal_store(w,(u32x4*)(Aw+(long)row*PA+ch*8));}
    } }
  }
  asm volatile("s_waitcnt lgkmcnt(0)\n\ts_barrier":::"memory");
  #undef DMA_K
  #undef DMA_V
  #undef CMASK
  #undef START
  #undef RESC
  #undef ROT
}
constexpr int ATTN_LDS_BYTES=LDS_BYTES;
#undef SBAR
#undef WAIT_BAR
}
#define GAS __attribute__((address_space(1)))
#define LAS __attribute__((address_space(3)))
typedef unsigned short bf16;
typedef unsigned v4u __attribute__((ext_vector_type(4)));
typedef float f32x4 __attribute__((ext_vector_type(4)));
typedef short bf16x8 __attribute__((ext_vector_type(8)));
typedef GAS unsigned gu32;
typedef GAS unsigned long long gu64;
#define RLX_AGENT __ATOMIC_RELAXED, __HIP_MEMORY_SCOPE_AGENT
#define LDS_WAIT() asm volatile("s_waitcnt lgkmcnt(0)" ::: "memory")
#define VM_WAIT() asm volatile("s_waitcnt vmcnt(0)" ::: "memory")
__device__ __forceinline__ unsigned long long rt() { return __builtin_amdgcn_s_memrealtime(); }
__device__ __forceinline__ unsigned f2bf(float f) { unsigned u = __builtin_bit_cast(unsigned, f); return (u + 0x7fffu + ((u >> 16) & 1u)) >> 16; }
__device__ __forceinline__ unsigned pk2(float lo, float hi) { return f2bf(lo) | (f2bf(hi) << 16); }

#define XB_TMO      128
#define XB_XCNT(j)  (256  + 64 * (j))
#define XB_XSUB(j)  (1280 + 64 * (j))
#define XB_XGEN(j)  (2304 + 64 * (j))
#define XB_TOP      3328
#define XB_TOPGEN   3392
#define XCD_BAR_WORDS 3456
#define XB_SPIN_CAP (1u << 18)

__device__ __forceinline__ unsigned xb_ld(unsigned* p)              { return __hip_atomic_load(p, __ATOMIC_RELAXED, __HIP_MEMORY_SCOPE_AGENT); }
__device__ __forceinline__ unsigned xb_add(unsigned* p, unsigned v) { return __hip_atomic_fetch_add(p, v, __ATOMIC_RELAXED, __HIP_MEMORY_SCOPE_AGENT); }
__device__ __forceinline__ unsigned xb_xcc_id() { return (unsigned)__builtin_amdgcn_s_getreg((3 << 11) | 20) & 0xFu; }
#define XB_SPIN(cond, bar) do { unsigned _sp = 0; while (cond) { __builtin_amdgcn_s_sleep(1); \
    if ((++_sp & 255u) == 0u) { if (xb_ld(&(bar)[XB_TMO])) break; if (_sp > XB_SPIN_CAP) { atomicAdd(&(bar)[XB_TMO], 1u); break; } } } } while (0)

struct XcdBarrier {
    unsigned* bar; unsigned x; int wave; unsigned G;
    volatile LAS unsigned* st;
};

__device__ __forceinline__ XcdBarrier xcd_barrier_post(unsigned* bar, volatile LAS unsigned* st, int wave, unsigned G) {
    XcdBarrier b; b.bar = bar; b.x = xb_xcc_id(); b.st = st; b.wave = wave; b.G = G;
    if (wave == 0 && mk_lane() == 0) (void)xb_add(&bar[XB_XCNT(b.x)], 1u);
    return b;
}
__device__ __forceinline__ void xcd_barrier_complete(unsigned* bar, unsigned x, unsigned& nloc, unsigned& nx, const unsigned G) {
    unsigned sum, cnt, mine, sp = 0u;
    for (;;) {
        sum = 0u; cnt = 0u; mine = 0u;
#pragma unroll
        for (unsigned j = 0; j < 16; ++j) { const unsigned c = xb_ld(&bar[XB_XCNT(j)]); sum += c; cnt += (c > 0u) ? 1u : 0u; mine = (j == x) ? c : mine; }
        if (sum == G) break;
        __builtin_amdgcn_s_sleep(1);
        if ((++sp & 255u) == 0u) { if (xb_ld(&bar[XB_TMO])) break; if (sp > XB_SPIN_CAP) { atomicAdd(&bar[XB_TMO], 1u); break; } }
    }
    nloc = mine > 0u ? mine : 1u; nx = cnt > 0u ? cnt : 1u;
}

__device__ __forceinline__ void xcd_barrier(const XcdBarrier& b) {
    asm volatile("s_waitcnt vmcnt(0)" ::: "memory");
    __syncthreads();
    if (b.wave == 0 && mk_lane() == 0) {
        unsigned* bar = b.bar;
        __builtin_amdgcn_s_waitcnt(0);
        unsigned nloc = b.st[0], nx = b.st[1];
        if (nloc == 0u) { xcd_barrier_complete(bar, b.x, nloc, nx, b.G); b.st[0] = nloc; b.st[1] = nx; }
        const unsigned old = xb_add(&bar[XB_XSUB(b.x)], 1u);
        const unsigned gen = old / nloc;
        if (old + 1u == (gen + 1u) * nloc) {
            __builtin_amdgcn_fence(__ATOMIC_RELEASE, "agent");
            asm volatile("s_waitcnt vmcnt(0)" ::: "memory");
            const unsigned og = xb_add(&bar[XB_TOP], 1u);
            const unsigned tg = og / nx;
            if (og + 1u == (tg + 1u) * nx) xb_add(&bar[XB_TOPGEN], 1u);
            else XB_SPIN(xb_ld(&bar[XB_TOPGEN]) == tg, bar);
            __builtin_amdgcn_fence(__ATOMIC_ACQUIRE, "agent");
            xb_add(&bar[XB_XGEN(b.x)], 1u);
            asm volatile("s_waitcnt vmcnt(0)" ::: "memory");
        } else {
            XB_SPIN(xb_ld(&bar[XB_XGEN(b.x)]) == gen, bar);
            __builtin_amdgcn_fence(__ATOMIC_ACQUIRE, "agent");
            asm volatile("s_waitcnt vmcnt(0)" ::: "memory");
        }
    }
    __syncthreads();
}
constexpr int NWAVES = 8;
#ifndef MK_N_LAUNCHES
#define MK_N_LAUNCHES 1
#endif
constexpr int NPH = 12;
constexpr int N_LAUNCHES = MK_N_LAUNCHES;
static_assert(N_LAUNCHES == 1 || N_LAUNCHES == NPH, "MK_N_LAUNCHES is 1 or 12");

constexpr int NB = 4, SEQ = 8192, T = NB * SEQ, D = 1024;
constexpr int NE = 32, TOPK = 4, NA = T * TOPK;
constexpr int SG = 32, SL = 32, AROW_P = 640;
constexpr float RMS_EPS = 1e-6f;
constexpr float SW_LIMIT = 7.0f, SW_ALPHA = 1.702f;
constexpr float LAMBDA_INIT = 0.2f;

constexpr size_t MiB = 1u << 20;
constexpr size_t WS_CTL = 0, CTL_ZERO_BYTES = 128 * 1024;
constexpr size_t WS_ROPE = 2 * MiB;
constexpr size_t WS_WIN = 4 * MiB;
constexpr size_t WS_WOUT = 8 * MiB;
constexpr size_t WS_WGLU = 10 * MiB;
constexpr size_t WS_SMALL = 11 * MiB;
constexpr size_t SM_AL = 1024, SM_WR = 32768;
constexpr size_t WS_BTY = 12 * MiB;
constexpr size_t WS_BTX = 32 * MiB;
constexpr size_t WS_WGU = 40 * MiB;
constexpr size_t WS_WD = 168 * MiB;
constexpr size_t WS_XN = 232 * MiB;
constexpr size_t WS_Q = 296 * MiB, WS_K = 328 * MiB, WS_V = 360 * MiB;
constexpr size_t WS_AROW = 392 * MiB;
constexpr size_t WS_XLOC = 432 * MiB;
constexpr size_t WS_O = 464 * MiB;
constexpr size_t WS_MIX = 464 * MiB;
constexpr size_t WS_ACAT = 528 * MiB;
constexpr size_t WS_HB = 528 * MiB;
constexpr size_t WS_YG = 592 * MiB;
constexpr size_t WS_GLU = 624 * MiB;
constexpr size_t WS_LIST = 656 * MiB;
constexpr size_t WS_GATES = 660 * MiB;
constexpr size_t WS_ACT = 296 * MiB;
constexpr size_t WS_YBUF = 664 * MiB;
constexpr size_t WS_END = 920 * MiB;
static_assert(WS_ACT + (size_t)(NA + 8192) * 1024 * 2 <= WS_YG, "Act overlay");
constexpr int CW_TMO = 0, CW_CODE = 1;
constexpr int CW_BAR = 4096;
constexpr int CW_ECNT = 16384;

constexpr int RING_OFF = 0, RING_BYTES = 131072;
constexpr int WRT_BYTES = 1024 * 36 * 4;
constexpr int LDSCTL_OFF = 147456, MISC_OFF = LDSCTL_OFF;
constexpr int MOE_OFF = LDSCTL_OFF + 256;
constexpr int RT_OFF = LDSCTL_OFF + 640;
constexpr int ST_OFF = LDSCTL_OFF + 1024;
constexpr int EPB_OFF = 131072;
constexpr int LDS_BYTES = 157696;
static_assert(ST_OFF + 8192 <= LDS_BYTES, "LDS map");

struct Args { const void* in[29]; float* out; unsigned char* ws; int ph_lo, ph_hi, li, pad; };
struct Frame {
    LAS unsigned char* lds;
    volatile LAS unsigned* MISC;
    gu32* ctl;
    int wave;
    int vcu, G;
};
#define INF(a, k) ((const float*)(a).in[k])
#define FTID(F) ((F).wave * 64 + mk_lane())
#ifndef PROBE_DUP
#define PROBE_DUP -1
#endif
#define NREP(k) ((PROBE_DUP == (k)) ? 2 : 1)

__device__ __forceinline__ unsigned pk_fp8x4_(float a, float b, float c, float d) { int w = 0; w = __builtin_amdgcn_cvt_pk_fp8_f32(a, b, w, false); w = __builtin_amdgcn_cvt_pk_fp8_f32(c, d, w, true); return (unsigned)w; }
__device__ __forceinline__ float wave_sum(float v) {
#pragma unroll
    for (int o = 1; o < 64; o <<= 1) v += __shfl_xor(v, o);
    return v;
}
template <bool FP8> __device__ __forceinline__ void p0_tr64(const float* W, int K, int N, void* WT, LAS float* scr, int item, int lane, float scale) {
    const int nblk = N / 64, kb = item / nblk, nb = item % nblk, k0 = 64 * kb, n0 = 64 * nb;
    f32x4 v[16];
#pragma unroll
    for (int i = 0; i < 16; ++i) v[i] = __builtin_nontemporal_load((const GAS f32x4*)(W + (size_t)(k0 + i * 4 + (lane >> 4)) * N + n0 + 4 * (lane & 15)));
#pragma unroll
    for (int i = 0; i < 16; ++i) *(LAS f32x4*)(scr + (i * 4 + (lane >> 4)) * 68 + 4 * (lane & 15)) = v[i];
    LDS_WAIT(); asm volatile("" ::: "memory");
    if constexpr (FP8) {
#pragma unroll
        for (int c = 0; c < 4; ++c) { const LAS float* s = scr + (16 * c) * 68 + lane; v4u o;
            o.x = pk_fp8x4_(s[0 * 68] * scale, s[1 * 68] * scale, s[2 * 68] * scale, s[3 * 68] * scale); o.y = pk_fp8x4_(s[4 * 68] * scale, s[5 * 68] * scale, s[6 * 68] * scale, s[7 * 68] * scale);
            o.z = pk_fp8x4_(s[8 * 68] * scale, s[9 * 68] * scale, s[10 * 68] * scale, s[11 * 68] * scale); o.w = pk_fp8x4_(s[12 * 68] * scale, s[13 * 68] * scale, s[14 * 68] * scale, s[15 * 68] * scale);
            *(GAS v4u*)((unsigned char*)WT + (size_t)(n0 + lane) * K + k0 + 16 * c) = o; }
    } else {
#pragma unroll
        for (int c = 0; c < 8; ++c) { const LAS float* s = scr + (8 * c) * 68 + lane;
            v4u o; o.x = pk2(s[0 * 68], s[1 * 68]); o.y = pk2(s[2 * 68], s[3 * 68]); o.z = pk2(s[4 * 68], s[5 * 68]); o.w = pk2(s[6 * 68], s[7 * 68]);
            *(GAS v4u*)((bf16*)WT + (size_t)(n0 + lane) * K + k0 + 8 * c) = o; }
    }
    LDS_WAIT(); asm volatile("" ::: "memory");
}
__device__ __forceinline__ void cv_wg_item(Frame& F, const Args& a, const int item, const int lane) {
    const float* W; unsigned char* WT; int N, n0, k0;
    if (item < 512) { const int e = item >> 4, r = item & 15; N = 2048; W = INF(a, 24) + (size_t)e * 1024 * 2048; WT = a.ws + WS_WGU + (size_t)e * 2048 * 1024; n0 = (r >> 3) * 1024; k0 = (r & 7) * 128; }
    else { const int i2 = item - 512, e = i2 >> 3; N = 1024; W = INF(a, 26) + (size_t)e * 1024 * 1024; WT = a.ws + WS_WD + (size_t)e * 1024 * 1024; n0 = 0; k0 = (i2 & 7) * 128; }
    LAS unsigned char* tile = F.lds;
    const float* wp = W + (size_t)(k0 + 16 * F.wave) * N + n0 + 4 * lane;
    f32x4 va[4][4], vb[4][4];
#define CVW_LOAD(v, grp) do { _Pragma("unroll") for (int ch = 0; ch < 4; ++ch) _Pragma("unroll") for (int q = 0; q < 4; ++q) v[ch][q] = __builtin_nontemporal_load((const GAS f32x4*)(wp + (size_t)(4 * (grp) + q) * N + ch * 256)); } while (0)
#define CVW_PUT(v, grp) do { _Pragma("unroll") for (int ch = 0; ch < 4; ++ch) _Pragma("unroll") for (int j = 0; j < 4; ++j) \
        *(LAS unsigned*)(tile + (ch * 256 + 4 * lane + j) * 144 + 16 * F.wave + 4 * (grp)) = pk_fp8x4_(v[ch][0][j] * 32.f, v[ch][1][j] * 32.f, v[ch][2][j] * 32.f, v[ch][3][j] * 32.f); } while (0)
    CVW_LOAD(va, 0); CVW_LOAD(vb, 1); CVW_PUT(va, 0); CVW_LOAD(va, 2); CVW_PUT(vb, 1); CVW_LOAD(vb, 3); CVW_PUT(va, 2); CVW_PUT(vb, 3);
#undef CVW_LOAD
#undef CVW_PUT
    __syncthreads();
#pragma unroll
    for (int i = 0; i < 16; ++i) { const int row = F.wave * 128 + i * 8 + (lane >> 3), c = lane & 7;
        const v4u val = *(const LAS v4u*)(tile + row * 144 + 16 * c);
        __builtin_nontemporal_store(val, (GAS v4u*)(WT + (size_t)(n0 + row) * 1024 + k0 + 16 * c)); }
    __syncthreads();
}
__device__ __forceinline__ void rms_row_to_bf16(int lane, const float* xrow, const float* g, bf16* orow) {
    const GAS f32x4* xr = (const GAS f32x4*)xrow + lane; const GAS f32x4* gr = (const GAS f32x4*)g + lane;
    f32x4 v[4]; float s = 0.f;
#pragma unroll
    for (int j = 0; j < 4; ++j) { v[j] = __builtin_nontemporal_load(xr + 64 * j); s += (v[j].x * v[j].x + v[j].y * v[j].y) + (v[j].z * v[j].z + v[j].w * v[j].w); }
    const float rstd = 1.f / sqrtf(wave_sum(s) * (1.f / D) + RMS_EPS);
    GAS unsigned long long* o8 = (GAS unsigned long long*)orow + lane;
#pragma unroll
    for (int j = 0; j < 4; ++j) { const f32x4 gg = gr[64 * j];
        o8[64 * j] = (unsigned long long)pk2(v[j].x * rstd * gg.x, v[j].y * rstd * gg.y) | ((unsigned long long)pk2(v[j].z * rstd * gg.z, v[j].w * rstd * gg.w) << 32); }
}

#define S5_SYNC() asm volatile("s_waitcnt lgkmcnt(0)\n\ts_barrier" ::: "memory")
template <int NT> __device__ __forceinline__ void s5_setup(Frame& F, const Args& a, int g, int sp) {
    LAS float* L = (LAS float*)F.lds;
    LAS float* APr = L, *APi = L + 2112, *BBr = L + 4224, *BBi = L + 5248, *CCr = L + 6272, *CCi = L + 7296, *KT = L + 8320;
    const int tid = FTID(F);
    if (tid < 64) {
        const int n = tid;
        const float dt = expf(INF(a, 16)[g]);
        const float lre = INF(a, 9)[g * 64 + n], lim = INF(a, 10)[g * 64 + n];
        const float mag = expf(lre * dt); float sn, cs; sincosf(lim * dt, &sn, &cs);
        const float ar = mag * cs, ai = mag * sn;
        const float nr = ar - 1.f, ni = ai, den = lre * lre + lim * lim;
        const float cr = (nr * lre + ni * lim) / den, ci = (ni * lre - nr * lim) / den;
        float pr = 1.f, pi = 0.f;
        for (int tau = 0; tau <= 32; ++tau) { APr[tau * 64 + n] = pr; APi[tau * 64 + n] = pi; const float t0 = pr * ar - pi * ai, t1 = pr * ai + pi * ar; pr = t0; pi = t1; }
        const float* bre = INF(a, 11) + (size_t)(g * 64 + n) * 16; const float* bim = INF(a, 12) + (size_t)(g * 64 + n) * 16;
        for (int c = 0; c < 16; ++c) { const float br = bre[c], bi = bim[c]; BBr[n * 16 + c] = cr * br - ci * bi; BBi[n * 16 + c] = cr * bi + ci * br; }
    }
    for (int i = tid; i < 1024; i += NT) { CCr[i] = INF(a, 13)[g * 1024 + i]; CCi[i] = INF(a, 14)[g * 1024 + i]; }
    S5_SYNC();
    {
        constexpr int NTAU = 32 * 256 / NT;
        const int pair = tid & 255, c = pair >> 4, cp = pair & 15, tau0 = (tid >> 8) * NTAU;
#pragma unroll 1
        for (int nh = 0; nh < 2; ++nh) {
            float zr[32], zi[32];
#pragma unroll
            for (int n = 0; n < 32; ++n) { const int nn = nh * 32 + n; const float cr_ = CCr[c * 64 + nn], ci_ = CCi[c * 64 + nn], br = BBr[nn * 16 + cp], bi = BBi[nn * 16 + cp]; zr[n] = cr_ * br - ci_ * bi; zi[n] = cr_ * bi + ci_ * br; }
#pragma unroll 1
            for (int tau = tau0; tau < tau0 + NTAU; ++tau) {
                const LAS f32x4* pr4 = (const LAS f32x4*)(APr + tau * 64 + nh * 32); const LAS f32x4* pi4 = (const LAS f32x4*)(APi + tau * 64 + nh * 32);
                float s0 = 0.f, s1 = 0.f;
#pragma unroll
                for (int q = 0; q < 8; ++q) { const f32x4 r4 = pr4[q], i4 = pi4[q];
                    s0 += zr[4 * q] * r4[0] - zi[4 * q] * i4[0]; s1 += zr[4 * q + 1] * r4[1] - zi[4 * q + 1] * i4[1];
                    s0 += zr[4 * q + 2] * r4[2] - zi[4 * q + 2] * i4[2]; s1 += zr[4 * q + 3] * r4[3] - zi[4 * q + 3] * i4[3]; }
                if (nh == 0) KT[tau * 256 + pair] = s0 + s1; else KT[tau * 256 + pair] += s0 + s1;
            }
        }
    }
    S5_SYNC();
    bf16* BtY = (bf16*)(a.ws + WS_BTY); bf16* BtX = (bf16*)(a.ws + WS_BTX);
    constexpr int NRB = NT / 80;
    if (tid < NRB * 80) {
        const int cg = tid % 80, rb = tid / 80;
        GAS v4u* dst = (GAS v4u*)(BtY + ((size_t)(g * 512 + 4 * sp * 16) * 640 + 8 * cg));
        if (cg < 16) {
            const int n0 = (8 * cg) & 63; const bool im = cg >= 8;
            for (int rl = rb; rl < 64; rl += NRB) { const int t = 4 * sp + (rl >> 4), c = rl & 15;
                const LAS f32x4* cr4 = (const LAS f32x4*)(CCr + c * 64 + n0); const LAS f32x4* ci4 = (const LAS f32x4*)(CCi + c * 64 + n0);
                const LAS f32x4* ar4 = (const LAS f32x4*)(APr + (t + 1) * 64 + n0); const LAS f32x4* ai4 = (const LAS f32x4*)(APi + (t + 1) * 64 + n0);
                v4u w;
#pragma unroll
                for (int h = 0; h < 2; ++h) { const f32x4 cr = cr4[h], ci = ci4[h], ar = ar4[h], ai = ai4[h];
                    const f32x4 v = im ? -(cr * ai + ci * ar) : (cr * ar - ci * ai);
                    if (h == 0) { w.x = pk2(v[0], v[1]); w.y = pk2(v[2], v[3]); } else { w.z = pk2(v[0], v[1]); w.w = pk2(v[2], v[3]); } }
                dst[(size_t)rl * 80] = w; }
        } else {
            const int col0 = 8 * cg - 128, s_ = col0 >> 4, cp0 = col0 & 15;
            for (int rl = rb; rl < 64; rl += NRB) { const int t = 4 * sp + (rl >> 4), c = rl & 15;
                f32x4 v0 = {0.f, 0.f, 0.f, 0.f}, v1 = v0;
                if (s_ <= t) { const LAS f32x4* k4 = (const LAS f32x4*)(KT + (t - s_) * 256 + c * 16 + cp0); v0 = k4[0]; v1 = k4[1];
                    if (s_ == t && (c >> 3) == (cp0 >> 3)) { const float dd = INF(a, 15)[g * 16 + c]; const int q = c & 7;
                        v0[0] += q == 0 ? dd : 0.f; v0[1] += q == 1 ? dd : 0.f; v0[2] += q == 2 ? dd : 0.f; v0[3] += q == 3 ? dd : 0.f;
                        v1[0] += q == 4 ? dd : 0.f; v1[1] += q == 5 ? dd : 0.f; v1[2] += q == 6 ? dd : 0.f; v1[3] += q == 7 ? dd : 0.f; } }
                v4u w; w.x = pk2(v0[0], v0[1]); w.y = pk2(v0[2], v0[3]); w.z = pk2(v1[0], v1[1]); w.w = pk2(v1[2], v1[3]);
                dst[(size_t)rl * 80] = w; }
        }
    }
    { const int cg = tid & 63, s_ = cg >> 1, cp0 = (cg & 1) * 8, rb = tid >> 6;
      GAS v4u* dst = (GAS v4u*)(BtX + ((size_t)(g * 256 + 32 * sp) * 512 + 8 * cg));
#pragma unroll
      for (int i = 0; i < 32 * 64 / NT; ++i) { const int r = rb + (NT / 64) * i, j = 32 * sp + r; f32x4 v0 = {0.f, 0.f, 0.f, 0.f}, v1 = v0;
          if (j < 128) { const int n = j & 63; const float apr = APr[(31 - s_) * 64 + n], api = APi[(31 - s_) * 64 + n];
              const LAS f32x4* br4 = (const LAS f32x4*)(BBr + n * 16 + cp0); const LAS f32x4* bi4 = (const LAS f32x4*)(BBi + n * 16 + cp0);
              const f32x4 br0 = br4[0], br1 = br4[1], bi0 = bi4[0], bi1 = bi4[1];
              if (j < 64) { v0 = br0 * apr - bi0 * api; v1 = br1 * apr - bi1 * api; } else { v0 = bi0 * apr + br0 * api; v1 = bi1 * apr + br1 * api; } }
          v4u w; w.x = pk2(v0[0], v0[1]); w.y = pk2(v0[2], v0[3]); w.z = pk2(v1[0], v1[1]); w.w = pk2(v1[2], v1[3]);
          dst[(size_t)r * 64] = w; } }
    if (sp == 0 && tid < 64) { float* AL = (float*)(a.ws + WS_SMALL + SM_AL); AL[(g * 64 + tid) * 2] = APr[32 * 64 + tid]; AL[(g * 64 + tid) * 2 + 1] = APi[32 * 64 + tid]; }
    S5_SYNC();
}

template <int NR> __device__ __forceinline__ void rms_rows_to_bf16(int lane, const float* x0, const float* g, bf16* o0) {
    const GAS f32x4* gr = (const GAS f32x4*)g + lane;
    f32x4 v[NR][4]; float ss[NR];
#pragma unroll
    for (int r = 0; r < NR; ++r)
#pragma unroll
        for (int j = 0; j < 4; ++j) v[r][j] = __builtin_nontemporal_load((const GAS f32x4*)(x0 + (size_t)r * D) + lane + 64 * j);
#pragma unroll
    for (int r = 0; r < NR; ++r) { float t = 0.f;
#pragma unroll
        for (int j = 0; j < 4; ++j) t += (v[r][j].x * v[r][j].x + v[r][j].y * v[r][j].y) + (v[r][j].z * v[r][j].z + v[r][j].w * v[r][j].w);
        ss[r] = 1.f / sqrtf(wave_sum(t) * (1.f / D) + RMS_EPS); }
#pragma unroll
    for (int j = 0; j < 4; ++j) { const f32x4 gg = gr[64 * j];
#pragma unroll
        for (int r = 0; r < NR; ++r) { GAS unsigned long long* p = (GAS unsigned long long*)(o0 + (size_t)r * D) + lane; const float rs = ss[r];
            p[64 * j] = (unsigned long long)pk2(v[r][j].x * rs * gg.x, v[r][j].y * rs * gg.y) | ((unsigned long long)pk2(v[r][j].z * rs * gg.z, v[r][j].w * rs * gg.w) << 32); } }
}
__device__ __forceinline__ void p0_prologue(Frame& F, const Args& a) {
    const bool split = (F.G == 256);
    if (split) {
        if (F.wave < 4) { s5_setup<256>(F, a, (int)blockIdx.x & 31, (int)blockIdx.x >> 5); }
        else { const int w4 = F.vcu * 4 + (F.wave - 4);
#pragma unroll 1
            for (int k = 0; k < 8; ++k) { const int m = w4 * 4 + 4096 * k;
                rms_rows_to_bf16<4>(mk_lane(), INF(a, 0) + (size_t)m * D, INF(a, 2), (bf16*)(a.ws + WS_XN) + (size_t)m * D);
                if (k == 0 || k == 4 || k == 6) __builtin_amdgcn_s_barrier(); } }
    } else {
        for (int item = blockIdx.x; item < 256; item += F.G) s5_setup<512>(F, a, item & 31, item >> 5);
    }
    const int PW = split ? 4 : NWAVES;
    const int gt = blockIdx.x * (PW * 64) + FTID(F), NGT = F.G * PW * 64;
    const bool mine = F.wave < PW;
    if (blockIdx.x == 0 && F.wave == 0) {
        const float p1 = wave_sum(INF(a, 4)[mk_lane()] * INF(a, 5)[mk_lane()]), p2 = wave_sum(INF(a, 6)[mk_lane()] * INF(a, 7)[mk_lane()]);
        if (mk_lane() == 0) *(float*)(a.ws + WS_SMALL) = expf(p1) - expf(p2) + LAMBDA_INIT;
    }
    if (mine) { float* WR = (float*)(a.ws + WS_SMALL + SM_WR);
      for (int i = gt; i < 1024 * 36; i += NGT) { const int k = i / 36, e = i % 36, p = ((k & 3) + 4 * (k >> 8)) * 64 + ((k >> 2) & 63);
          WR[p * 36 + e] = e < 32 ? INF(a, 21)[k] * INF(a, 22)[k * 32 + e] : 0.f; } }
    if (mine) { float* RP = (float*)(a.ws + WS_ROPE); const int* pos = (const int*)a.in[1];
      for (int i = gt; i < T * 8; i += NGT) { const int m = i >> 3, j = i & 7;
          const float invf = j == 0 ? 1.0f : j == 1 ? 1.9392274e-01f : j == 2 ? 3.7606031e-02f : j == 3 ? 7.2926646e-03f : j == 4 ? 1.4142136e-03f : j == 5 ? 2.7424819e-04f : j == 6 ? 5.3182961e-05f : 1.0313386e-05f;
          const float ang = (float)pos[m] * invf; float sn, cs; sincosf(ang, &sn, &cs); RP[m * 16 + j] = cs; RP[m * 16 + 8 + j] = sn; } }
    LAS float* scr = (LAS float*)(F.lds + RING_OFF + F.wave * 17408);
    const int gw = F.vcu * NWAVES + F.wave, NGW = F.G * NWAVES;
    constexpr int I_IN = 16 * 32, I_OUT = 16 * 16, I_GLU = 8 * 8;
    constexpr int NITEMS = I_IN + I_OUT + I_GLU;
    if (mine) for (int it = F.vcu * PW + F.wave; it < NITEMS; it += F.G * PW) {
        int r = it;
        if (r < I_IN) { p0_tr64<false>(INF(a, 3), 1024, 2048, a.ws + WS_WIN, scr, r, mk_lane(), 1.f); continue; } r -= I_IN;
        if (r < I_OUT) { p0_tr64<false>(INF(a, 20), 1024, 1024, a.ws + WS_WOUT, scr, r, mk_lane(), 1.f); continue; } r -= I_OUT;
        p0_tr64<false>(INF(a, 17), 512, 512, a.ws + WS_WGLU, scr, r, mk_lane(), 1.f);
    }
    __syncthreads();
    { int lane = mk_lane(); asm volatile("" : "+v"(lane));
      for (int rp = 0; rp < NREP(31); ++rp) for (int item = F.vcu; item < 768; item += F.G) cv_wg_item(F, a, item, lane); }
    if (!split) for (int m = gw; m < T; m += NGW) rms_row_to_bf16(mk_lane(), INF(a, 0) + (size_t)m * D, INF(a, 2), (bf16*)(a.ws + WS_XN) + (size_t)m * D);
}

struct DenseOrder {
    int nM, nN, nwg, G, c, nt; const char* A; const char* B; size_t strA, strB;
    __device__ __forceinline__ void init(int M, int N, int K, int lda, int ldb, const void* A_, const void* B_, int G_, int c_) {
        nM = M / 256; nN = N / 256; nwg = nM * nN; G = G_; c = c_; nt = K / 64; A = (const char*)A_; B = (const char*)B_; strA = (size_t)256 * lda * 2; strB = (size_t)256 * ldb * 2; }
    __device__ __forceinline__ bool next(int i, pg8::Unit& u) const {
        const long L = (long)i * G + c; if (L >= nwg) return false;
        int wgid = (int)L; { const int q = nwg / 8, r = nwg % 8, xcd = wgid % 8, off = wgid / 8; wgid = (xcd < r ? xcd * (q + 1) : r * (q + 1) + (xcd - r) * q) + off; }
        const int nig = 8 * nN, gid = wgid / nig, fm = gid * 8, gsz = (nM - fm) < 8 ? (nM - fm) : 8;
        u.pm = fm + ((wgid % nig) % gsz); u.pn = (wgid % nig) / gsz; u.a = A + (size_t)u.pm * strA; u.b = B + (size_t)u.pn * strB; u.nt = nt; u.x0 = 0; u.x1 = 0; return true;
    }
};
struct XOrder {
    int G, c; const char* AROW; const char* BTX;
    __device__ __forceinline__ bool next(int i, pg8::Unit& u) const {
        const int L = i * G + c; if (L >= 128) return false;
        const int g = L >> 2, pm = L & 3;
        u.pm = pm; u.pn = 0; u.x0 = g; u.x1 = 0; u.nt = 8;
        u.a = AROW + ((size_t)(g * 1024 + pm * 256) * AROW_P + 128) * 2; u.b = BTX + ((size_t)g * 256 * 512) * 2; return true;
    }
};
struct GluOrder {
    int rank; const char* A; const char* B;
    __device__ __forceinline__ bool next(int i, pg8::Unit& u) const {
        if (i >= 4) return false;
        u.pm = rank * 2 + (i >> 1); u.pn = i & 1; u.x0 = 0; u.x1 = 0; u.nt = 8;
        u.a = A + (size_t)u.pm * 256 * 1024; u.b = B + (size_t)u.pn * 256 * 1024; return true;
    }
};
struct YOrder {
    int G, c; const char* AROW; const char* BTY;
    __device__ __forceinline__ bool next(int i, pg8::Unit& u) const {
        const int L = i * G + c; if (L >= 256) return false;
        const int g = L >> 3, pm = (L >> 1) & 3, pn = L & 1;
        u.pm = pm; u.pn = pn; u.x0 = g; u.x1 = 0; u.nt = (128 + 256 * (pn + 1)) / 64;
        u.a = AROW + ((size_t)(g * 1024 + pm * 256) * AROW_P) * 2; u.b = BTY + ((size_t)(g * 512 + pn * 256) * AROW_P) * 2; return true;
    }
};
template <int RG  , int NC  >
struct MoeOrder {
    int G, c; const LAS int* tpre; const LAS int* cntE; const char* A; const char* B; size_t strBe;
    bool gatherA; int ntk;
    __device__ __forceinline__ bool next(int i, pg8::Unit& u) const {
        const int L = i * G + c, grp = L >> 5, w = L & 31, tt = grp * RG + (w % RG), pn = w / RG;
        const int NT = __builtin_amdgcn_readfirstlane(tpre[32]);
        if (tt >= NT) return false;
        const int e = __builtin_popcount((unsigned)__ballot(tpre[(mk_lane() & 31) + 1] <= tt));
        const int cnt = __builtin_amdgcn_readfirstlane(cntE[e]), t0 = __builtin_amdgcn_readfirstlane(tpre[e]);
        u.pm = tt; u.pn = pn; u.x0 = (tt - t0) * 256; u.x1 = e | (cnt << 8); u.nt = ntk;
        u.a = gatherA ? A : A + (size_t)tt * 256 * 1024; u.b = B + (size_t)e * strBe + (size_t)pn * 256 * 1024; return true;
    }
};
struct AGather {
    static constexpr bool PER_UNIT = true;
    const int* list;
    __device__ __forceinline__ void get(const pg8::Unit& u, unsigned (&v)[2][2], const int (&R)[2], const int (&C)[2]) const {
        const int e = u.x1 & 255, cnt = u.x1 >> 8;
#pragma unroll
        for (int h = 0; h < 2; ++h)
#pragma unroll
            for (int i = 0; i < 2; ++i) { const int slot = u.x0 + h * 128 + R[i]; const int sc = slot < cnt ? slot : 0;
                const int tok = list[(size_t)e * T + sc] >> 2; v[h][i] = (unsigned)(tok * 1024 + C[i] * 2); }
    }
    __device__ __forceinline__ size_t hstep() const { return 0; }
    __device__ __forceinline__ void issue_dma(const pg8::Unit& u, const int (&R)[2], const unsigned lds_dst) const {
        const int e = u.x1 & 255, cnt = u.x1 >> 8; const int* base = list + (size_t)e * T;
#pragma unroll
        for (int h = 0; h < 2; ++h)
#pragma unroll
            for (int i = 0; i < 2; ++i) { const int slot = u.x0 + h * 128 + R[i]; const unsigned so = (unsigned)(slot < cnt ? slot : 0) * 4u;
                pg8::glds4_sv(base, so, lds_dst + (unsigned)(2 * h + i) * 256u); }
    }
    __device__ __forceinline__ void finish(const int (&raw)[4], unsigned (&v)[2][2], const int (&C)[2]) const {
#pragma unroll
        for (int h = 0; h < 2; ++h)
#pragma unroll
            for (int i = 0; i < 2; ++i) v[h][i] = (unsigned)((raw[h * 2 + i] >> 2) * 1024 + C[i] * 2);
    }
};

using pg8::f32x2; using pg8::u32x4; using pg8::u32x2; using pg8::cvt_pk_bf16; using pg8::gelu_pk;
#define EPI_ARGS const f32x4 (&acc)[2][2][4][2], const pg8::Unit& u, int wr, int wc, int fr, int fq
__device__ __forceinline__ u32x4 pack8(const f32x4 v0, const f32x4 v1) { u32x4 w; w.x = cvt_pk_bf16(v0[0], v0[1]); w.y = cvt_pk_bf16(v0[2], v0[3]); w.z = cvt_pk_bf16(v1[0], v1[1]); w.w = cvt_pk_bf16(v1[2], v1[3]); return w; }
__device__ __forceinline__ float bf_lo(unsigned w) { return __uint_as_float(w << 16); }
__device__ __forceinline__ float bf_hi(unsigned w) { return __uint_as_float(w & 0xffff0000u); }

struct EpiInProj {
    static constexpr int BMODE = 1; static constexpr bool PREFETCH = false; static constexpr int NSTORE = 0, NPRE = 0;
    bf16 *Q, *K, *V, *AROW; const float* rope; float c2;
    __device__ __forceinline__ void operator()(EPI_ARGS) const {
        const int region = u.pn >> 1; const int colr = (u.pn & 1) * 256 + wc * 32 + 8 * fq;
        const bool dorope = (region <= 1) && ((wc & 1) == 0);
        const float sg = fq == 0 ? -1.f : 1.f; const bool rot = fq < 2;
#pragma unroll
        for (int ai = 0; ai < 2; ++ai) {
            f32x4 rp[4][4];
            if (dorope) {
#pragma unroll
                for (int m = 0; m < 4; ++m) { const f32x4* rr = (const f32x4*)(rope + (size_t)(u.pm * 256 + ai * 128 + wr * 64 + m * 16 + fr) * 16);
#pragma unroll
                    for (int q = 0; q < 4; ++q) rp[m][q] = rr[q]; }
            }
#pragma unroll
            for (int m = 0; m < 4; ++m) {
                const int row = u.pm * 256 + ai * 128 + wr * 64 + m * 16 + fr;
                f32x4 cs0 = {1.f, 1.f, 1.f, 1.f}, cs1 = cs0, sn0 = {0.f, 0.f, 0.f, 0.f}, sn1 = sn0;
                if (dorope) { cs0 = rot ? rp[m][0] : cs0; cs1 = rot ? rp[m][1] : cs1; sn0 = rot ? rp[m][2] * sg : sn0; sn1 = rot ? rp[m][3] * sg : sn1; }
#pragma unroll
                for (int bj = 0; bj < 2; ++bj) {
                    f32x4 v0 = acc[ai][bj][m][0], v1 = acc[ai][bj][m][1]; const int c = colr + bj * 128;
                    if (region <= 1) {
                        if (dorope) { f32x4 p0, p1;
#pragma unroll
                            for (int q = 0; q < 4; ++q) { p0[q] = __shfl_xor(v0[q], 16); p1[q] = __shfl_xor(v1[q], 16); }
                            v0 = v0 * cs0 + p0 * sn0; v1 = v1 * cs1 + p1 * sn1; }
                        if (region == 0) { v0 = v0 * c2; v1 = v1 * c2; }
                        *(u32x4*)((region == 0 ? Q : K) + (size_t)row * 512 + c) = pack8(v0, v1);
                    } else if (region == 2) {
                        *(u32x4*)(V + (size_t)row * 512 + c) = pack8(v0, v1);
                    } else {
                        const int g = c >> 4, cc = c & 15;
                        *(u32x4*)(AROW + ((size_t)(g * 1024 + (row >> 5)) * AROW_P + 128 + (row & 31) * 16 + cc)) = pack8(v0, v1);
                    }
                }
            }
        }
    }
};
struct EpiX {
    static constexpr int BMODE = 0; static constexpr bool PREFETCH = false; static constexpr int NSTORE = 0, NPRE = 0;
    float* X;
    __device__ __forceinline__ void operator()(EPI_ARGS) const {
        float* base = X + ((size_t)(u.x1 * 32 + u.x0) * 1024 + u.pm * 256) * 128;
#pragma unroll
        for (int ai = 0; ai < 2; ++ai)
#pragma unroll
            for (int m = 0; m < 4; ++m) { const int row = ai * 128 + wr * 64 + m * 16 + fr;
#pragma unroll
                for (int n = 0; n < 2; ++n) *(f32x4*)(base + (size_t)row * 128 + wc * 32 + 16 * n + 4 * fq) = acc[ai][0][m][n]; }
    }
};
struct EpiY {
    static constexpr int BMODE = 1; static constexpr bool PREFETCH = false; static constexpr int NSTORE = 0, NPRE = 0;
    bf16* YG;
    __device__ __forceinline__ void operator()(EPI_ARGS) const {
        const int g = u.x0;
#pragma unroll
        for (int ai = 0; ai < 2; ++ai)
#pragma unroll
            for (int m = 0; m < 4; ++m) { const int jj = u.pm * 256 + ai * 128 + wr * 64 + m * 16 + fr;
#pragma unroll
                for (int bj = 0; bj < 2; ++bj) { const int n0 = u.pn * 256 + bj * 128 + wc * 32 + 8 * fq, t = n0 >> 4, cc = n0 & 15;
                    const f32x4 v0 = acc[ai][bj][m][0], v1 = acc[ai][bj][m][1];
                    const f32x2 a = gelu_pk((f32x2){v0[0], v0[1]}), b = gelu_pk((f32x2){v0[2], v0[3]}), c = gelu_pk((f32x2){v1[0], v1[1]}), d = gelu_pk((f32x2){v1[2], v1[3]});
                    u32x4 w; w.x = cvt_pk_bf16(a.x, a.y); w.y = cvt_pk_bf16(b.x, b.y); w.z = cvt_pk_bf16(c.x, c.y); w.w = cvt_pk_bf16(d.x, d.y);
                    *(u32x4*)(YG + (size_t)(jj * 32 + t) * 512 + g * 16 + cc) = w; } }
    }
};
__device__ __forceinline__ float sigmoidf_(float z) { return __builtin_amdgcn_rcpf(1.f + __builtin_amdgcn_exp2f(-1.4426950408889634f * z)); }
struct EpiGlu {
    static constexpr int BMODE = 1; static constexpr bool PREFETCH = false; static constexpr int NSTORE = 0, NPRE = 0;
    const bf16* YG; bf16* GLU; const float* bias;
    __device__ __forceinline__ void operator()(EPI_ARGS) const {
        const int c00 = u.pn * 256 + wc * 32 + 8 * fq;
        f32x4 bv[2][2];
#pragma unroll
        for (int bj = 0; bj < 2; ++bj) { bv[bj][0] = *(const f32x4*)(bias + c00 + bj * 128); bv[bj][1] = *(const f32x4*)(bias + c00 + bj * 128 + 4); }
#pragma unroll
        for (int ai = 0; ai < 2; ++ai)
#pragma unroll
            for (int m = 0; m < 4; ++m) { const int row = u.pm * 256 + ai * 128 + wr * 64 + m * 16 + fr;
#pragma unroll
                for (int bj = 0; bj < 2; ++bj) { const int c = c00 + bj * 128;
                    const f32x4 z0 = acc[ai][bj][m][0] + bv[bj][0], z1 = acc[ai][bj][m][1] + bv[bj][1];
                    const u32x4 y = *(const u32x4*)(YG + (size_t)row * 512 + c);
                    f32x4 o0, o1;
                    o0[0] = bf_lo(y.x) * sigmoidf_(z0[0]); o0[1] = bf_hi(y.x) * sigmoidf_(z0[1]); o0[2] = bf_lo(y.y) * sigmoidf_(z0[2]); o0[3] = bf_hi(y.y) * sigmoidf_(z0[3]);
                    o1[0] = bf_lo(y.z) * sigmoidf_(z1[0]); o1[1] = bf_hi(y.z) * sigmoidf_(z1[1]); o1[2] = bf_lo(y.w) * sigmoidf_(z1[2]); o1[3] = bf_hi(y.w) * sigmoidf_(z1[3]);
                    *(u32x4*)(GLU + (size_t)row * 512 + c) = pack8(o0, o1); } }
    }
};
struct EpiMix {
    static constexpr int BMODE = 1; static constexpr bool PREFETCH = false; static constexpr int NSTORE = 0, NPRE = 0;
    bf16* MIX;
    __device__ __forceinline__ void operator()(EPI_ARGS) const {
#pragma unroll
        for (int ai = 0; ai < 2; ++ai)
#pragma unroll
            for (int m = 0; m < 4; ++m) { bf16* rowp = MIX + (size_t)(u.pm * 256 + ai * 128 + wr * 64 + m * 16 + fr) * 1024 + u.pn * 256 + wc * 32 + 8 * fq;
#pragma unroll
                for (int bj = 0; bj < 2; ++bj) *(u32x4*)(rowp + bj * 128) = pack8(acc[ai][bj][m][0], acc[ai][bj][m][1]); }
    }
};
__device__ __forceinline__ float swiglu_(float g, float up) {
    const float gc = fminf(g, SW_LIMIT), uc = __builtin_amdgcn_fmed3f(up, -SW_LIMIT, SW_LIMIT);
    const float t = gc * __builtin_amdgcn_rcpf(1.f + __builtin_amdgcn_exp2f(gc * (-SW_ALPHA * 1.4426950408889634f))); return fmaf(t, uc, t); }
__device__ __forceinline__ unsigned pk_fp8x4(float a, float b, float c, float d) { int w = 0; w = __builtin_amdgcn_cvt_pk_fp8_f32(a, b, w, false); w = __builtin_amdgcn_cvt_pk_fp8_f32(c, d, w, true); return (unsigned)w; }
constexpr float W8_SCALE = 32.f, W8_INV = 1.f / 32.f;
constexpr float YB_SCALE = 8.f, YB_INV = 1.f / 8.f;
__device__ __forceinline__ f32x2 swiglu2_(const f32x2 ga, const f32x2 ua, const f32x2 bg, const f32x2 bu) {
    const f32x2 inv = {W8_INV, W8_INV};
    const f32x2 G = __builtin_elementwise_fma(ga, inv, bg), U = __builtin_elementwise_fma(ua, inv, bu);
    f32x2 gc, uc; gc.x = fminf(G.x, SW_LIMIT); gc.y = fminf(G.y, SW_LIMIT); uc.x = __builtin_amdgcn_fmed3f(U.x, -SW_LIMIT, SW_LIMIT); uc.y = __builtin_amdgcn_fmed3f(U.y, -SW_LIMIT, SW_LIMIT);
    const f32x2 xs = gc * (-SW_ALPHA * 1.4426950408889634f);
    f32x2 ex; ex.x = __builtin_amdgcn_exp2f(xs.x); ex.y = __builtin_amdgcn_exp2f(xs.y);
    const f32x2 dn = ex + 1.0f;
    f32x2 rc; rc.x = __builtin_amdgcn_rcpf(dn.x); rc.y = __builtin_amdgcn_rcpf(dn.y);
    const f32x2 t = gc * rc;
    return __builtin_elementwise_fma(t, uc, t);
}
struct EpiGU {
    static constexpr int BMODE = 2; static constexpr bool PREFETCH = true; static constexpr int NSTORE = 0, NPRE = 0;
    unsigned char* ACT; const float* bias; LAS unsigned char* xb;
    __device__ __forceinline__ void prefetch(const pg8::Unit& u, const int wid, const int wr, const int lane) const {
        const int e = u.x1 & 255;
        const unsigned bdst = (unsigned)__builtin_amdgcn_readfirstlane((int)((unsigned)(uintptr_t)xb + (unsigned)wid * 256u));
        pg8::glds4_sv(bias + e * 2048 + 2 * (u.pn * 128 + (wid & 3) * 32), (unsigned)lane * 4u, bdst);
    }
    __device__ __forceinline__ void operator()(EPI_ARGS) const {
        const int e = u.x1 & 255, j0 = u.pn * 128 + wc * 32 + 8 * fq;
        const LAS f32x4* bp = (const LAS f32x4*)(xb + (wr * 4 + wc) * 256) + 4 * fq;
        f32x2 bg[4], bu[4];
#pragma unroll
        for (int i = 0; i < 4; ++i) { const f32x4 b = bp[i]; bg[i] = (f32x2){b[0], b[2]}; bu[i] = (f32x2){b[1], b[3]}; }
        const int jst = u.pn * 128 + wc * 32 + 8 * (fq & ~1);
#pragma unroll
        for (int ai = 0; ai < 2; ++ai)
#pragma unroll
            for (int mp = 0; mp < 2; ++mp) { u32x2 w[2];
#pragma unroll
                for (int k = 0; k < 2; ++k) { const int m = mp * 2 + k;
                    const f32x4 g0 = acc[ai][0][m][0], g1 = acc[ai][0][m][1], u0 = acc[ai][1][m][0], u1 = acc[ai][1][m][1];
                    const f32x2 o0 = swiglu2_((f32x2){g0[0], g0[1]}, (f32x2){u0[0], u0[1]}, bg[0], bu[0]), o1 = swiglu2_((f32x2){g0[2], g0[3]}, (f32x2){u0[2], u0[3]}, bg[1], bu[1]);
                    const f32x2 o2 = swiglu2_((f32x2){g1[0], g1[1]}, (f32x2){u1[0], u1[1]}, bg[2], bu[2]), o3 = swiglu2_((f32x2){g1[2], g1[3]}, (f32x2){u1[2], u1[3]}, bg[3], bu[3]);
                    w[k].x = pk_fp8x4(o0.x, o0.y, o1.x, o1.y); w[k].y = pk_fp8x4(o2.x, o2.y, o3.x, o3.y); }
                const auto rx = __builtin_amdgcn_permlane16_swap(w[0].x, w[1].x, false, false), ry = __builtin_amdgcn_permlane16_swap(w[0].y, w[1].y, false, false);
                const size_t row = (size_t)u.pm * 256 + ai * 128 + wr * 64 + (mp * 2 + (fq & 1)) * 16 + fr;
                u32x4 o; o.x = rx[0]; o.y = ry[0]; o.z = rx[1]; o.w = ry[1];
                *(u32x4*)(ACT + row * 1024 + jst) = o; }
    }
};
template <int MODE> struct EpiDownT {
    static constexpr int BMODE = 3; static constexpr bool PREFETCH = true; static constexpr int NSTORE = 0, NPRE = 0;
    unsigned char* YB; const float* bias; const int* list; const float* gates; int sel; LAS unsigned char* xl; LAS unsigned char* xb;
    __device__ __forceinline__ void prefetch(const pg8::Unit& u, const int wid, const int wr, const int lane) const {
        const int e = u.x1 & 255, cnt = u.x1 >> 8;
        const unsigned dst = (unsigned)__builtin_amdgcn_readfirstlane((int)((unsigned)(uintptr_t)xl + (unsigned)wid * 1024u));
#pragma unroll
        for (int k = 0; k < 2; ++k) { const int slot = u.x0 + k * 128 + wr * 64 + lane; const unsigned so = (unsigned)(slot < cnt ? slot : 0) * 4u;
            pg8::glds4_sv(list + (size_t)e * T, so, dst + (unsigned)k * 256u); pg8::glds4_sv(gates + (size_t)e * T, so, dst + 512u + (unsigned)k * 256u); }
        const unsigned bdst = (unsigned)__builtin_amdgcn_readfirstlane((int)((unsigned)(uintptr_t)xb + (unsigned)wid * 256u));
        pg8::glds4_sv(bias + e * 1024 + u.pn * 256 + (wid & 3) * 64, (unsigned)lane * 4u, bdst);
    }
    __device__ __forceinline__ void operator()(EPI_ARGS) const {
        const int e = u.x1 & 255, cnt = u.x1 >> 8, c0 = u.pn * 256 + wc * 64 + 16 * fq;
        f32x4 bv[2][2];
        { const LAS f32x4* bl = (const LAS f32x4*)(xb + (wr * 4 + wc) * 256) + 4 * fq; bv[0][0] = bl[0]; bv[0][1] = bl[1]; bv[1][0] = bl[2]; bv[1][1] = bl[3]; }
        int aidv[8]; float gtv[8];
        { const LAS int* xi = (const LAS int*)(xl + (wr * 4 + wc) * 1024) + fr; const LAS float* xg = (const LAS float*)xi + 128;
#pragma unroll
          for (int q = 0; q < 8; ++q) { aidv[q] = xi[(q >> 2) * 64 + (q & 3) * 16]; gtv[q] = xg[(q >> 2) * 64 + (q & 3) * 16] * YB_SCALE; } }
#pragma unroll
        for (int ai = 0; ai < 2; ++ai)
#pragma unroll
            for (int m = 0; m < 4; ++m) { const int slot = u.x0 + ai * 128 + wr * 64 + m * 16 + fr; const int aid = aidv[ai * 4 + m]; const float gt = gtv[ai * 4 + m];
                if (slot < cnt) {
                    const f32x4 z0 = (acc[ai][0][m][0] * W8_INV + bv[0][0]) * gt, z1 = (acc[ai][0][m][1] * W8_INV + bv[0][1]) * gt;
                    const f32x4 z2 = (acc[ai][1][m][0] * W8_INV + bv[1][0]) * gt, z3 = (acc[ai][1][m][1] * W8_INV + bv[1][1]) * gt;
                    u32x4 w8; w8.x = pk_fp8x4(z0[0], z0[1], z0[2], z0[3]); w8.y = pk_fp8x4(z1[0], z1[1], z1[2], z1[3]); w8.z = pk_fp8x4(z2[0], z2[1], z2[2], z2[3]); w8.w = pk_fp8x4(z3[0], z3[1], z3[2], z3[3]);
                    if constexpr (MODE == 1) { asm volatile("" :: "v"(w8)); } else { *(u32x4*)(YB + (size_t)aid * 1024 + c0) = w8; } } }
    }
};
typedef EpiDownT<0> EpiDown;

template <int BM_> struct EpiNullT {
    static constexpr int BMODE = BM_; static constexpr bool PREFETCH = false; static constexpr int NSTORE = 0, NPRE = 0;
    __device__ __forceinline__ void operator()(EPI_ARGS) const {
#pragma unroll
        for (int ai = 0; ai < 2; ++ai)
#pragma unroll
            for (int bj = 0; bj < 2; ++bj)
#pragma unroll
                for (int m = 0; m < 4; ++m)
#pragma unroll
                    for (int n = 0; n < 2; ++n) asm volatile("" :: "v"(acc[ai][bj][m][n]));
    }
};
typedef EpiNullT<1> EpiNull;
__device__ __forceinline__ void s5_scan(const Args& a, const int task, const int lane) {
    const int gw = task;
    {
        const int g = gw >> 2, b = gw & 3, n = lane;
        const float* AL = (const float*)(a.ws + WS_SMALL + SM_AL); const float ar = AL[(g * 64 + n) * 2], ai = AL[(g * 64 + n) * 2 + 1];
        const float* X0 = (const float*)(a.ws + WS_XLOC) + ((size_t)(0 * 32 + g) * 1024 + b * 256) * 128;
        const float* X1 = (const float*)(a.ws + WS_XLOC) + ((size_t)(1 * 32 + g) * 1024 + b * 256) * 128;
        bf16* AR = (bf16*)(a.ws + WS_AROW) + (size_t)(g * 1024 + b * 256) * AROW_P;
        float xr = 0.f, xi = 0.f;
        for (int j0 = 0; j0 < 256; j0 += 16) {
            float lr[16], li[16];
#pragma unroll
            for (int q = 0; q < 16; ++q) { const size_t o = (size_t)(j0 + q) * 128 + n; lr[q] = X0[o]; li[q] = X0[o + 64]; }
#pragma unroll
            for (int q = 0; q < 16; ++q) { bf16* row = AR + (size_t)(j0 + q) * AROW_P; row[n] = (bf16)f2bf(xr); row[64 + n] = (bf16)f2bf(xi);
                const float nr = ar * xr - ai * xi + lr[q], ni = ar * xi + ai * xr + li[q]; xr = nr; xi = ni; }
        }
    }
}
__device__ __forceinline__ void p3_post_scan(Frame& F, const Args& a) {
    int lane = mk_lane(); asm volatile("" : "+v"(lane));
    const int gw = F.vcu * NWAVES + F.wave, NGW = F.G * NWAVES;
    const float lam = *(const float*)(a.ws + WS_SMALL);
    const bf16* O = (const bf16*)(a.ws + WS_O); bf16* AC = (bf16*)(a.ws + WS_ACAT); const float* ng = INF(a, 8);
    const int h = lane >> 4, d0 = (lane & 15) * 8;
    const f32x4 g0 = *(const f32x4*)(ng + d0), g1 = *(const f32x4*)(ng + d0 + 4);
    for (int m = gw; m < T; m += NGW) {
        const bf16* orow = O + (size_t)m * 1024;
        const v4u p1 = *(const GAS v4u*)(orow + (h * 2 + 0) * 128 + d0), p2 = *(const GAS v4u*)(orow + (h * 2 + 1) * 128 + d0);
        float o[8];
        o[0] = bf_lo(p1.x) - lam * bf_lo(p2.x); o[1] = bf_hi(p1.x) - lam * bf_hi(p2.x); o[2] = bf_lo(p1.y) - lam * bf_lo(p2.y); o[3] = bf_hi(p1.y) - lam * bf_hi(p2.y);
        o[4] = bf_lo(p1.z) - lam * bf_lo(p2.z); o[5] = bf_hi(p1.z) - lam * bf_hi(p2.z); o[6] = bf_lo(p1.w) - lam * bf_lo(p2.w); o[7] = bf_hi(p1.w) - lam * bf_hi(p2.w);
        float s = 0.f;
#pragma unroll
        for (int q = 0; q < 8; ++q) s += o[q] * o[q];
        s += __shfl_xor(s, 1); s += __shfl_xor(s, 2); s += __shfl_xor(s, 4); s += __shfl_xor(s, 8);
        const float sc = (1.f - LAMBDA_INIT) / sqrtf(s * (1.f / 128.f) + RMS_EPS);
        v4u w; w.x = pk2(o[0] * sc * g0[0], o[1] * sc * g0[1]); w.y = pk2(o[2] * sc * g0[2], o[3] * sc * g0[3]); w.z = pk2(o[4] * sc * g1[0], o[5] * sc * g1[1]); w.w = pk2(o[6] * sc * g1[2], o[7] * sc * g1[3]);
        *(GAS v4u*)(AC + (size_t)m * 1024 + h * 128 + d0) = w;
    }
}
__device__ __forceinline__ void pn_glunorm(Frame& F, const Args& a) {
    int lane = mk_lane(); asm volatile("" : "+v"(lane));
    const int gw = F.vcu * NWAVES + F.wave, NGW = F.G * NWAVES;
    const bf16* GL = (const bf16*)(a.ws + WS_GLU); bf16* AC = (bf16*)(a.ws + WS_ACAT); const float* ng = INF(a, 19);
    const f32x4 g0 = *(const f32x4*)(ng + lane * 8), g1 = *(const f32x4*)(ng + lane * 8 + 4);
    for (int m = gw; m < T; m += NGW) {
        const v4u p = *(const GAS v4u*)(GL + (size_t)m * 512 + lane * 8);
        float o[8] = {bf_lo(p.x), bf_hi(p.x), bf_lo(p.y), bf_hi(p.y), bf_lo(p.z), bf_hi(p.z), bf_lo(p.w), bf_hi(p.w)};
        float s = 0.f;
#pragma unroll
        for (int q = 0; q < 8; ++q) s += o[q] * o[q];
        const float sc = 1.f / sqrtf(wave_sum(s) * (1.f / 512.f) + RMS_EPS);
        v4u w; w.x = pk2(o[0] * sc * g0[0], o[1] * sc * g0[1]); w.y = pk2(o[2] * sc * g0[2], o[3] * sc * g0[3]); w.z = pk2(o[4] * sc * g1[0], o[5] * sc * g1[1]); w.w = pk2(o[6] * sc * g1[2], o[7] * sc * g1[3]);
        *(GAS v4u*)(AC + (size_t)m * 1024 + 512 + lane * 8) = w;
    }
}
constexpr int NS5 = 64, CW_BAR2 = 8192;
__device__ __forceinline__ void glunorm_sub(Frame& F, const Args& a, const int rank) {
    int lane = mk_lane(); asm volatile("" : "+v"(lane));
    const bf16* GL = (const bf16*)(a.ws + WS_GLU); bf16* AC = (bf16*)(a.ws + WS_ACAT); const float* ng = INF(a, 19);
    const f32x4 g0 = *(const f32x4*)(ng + lane * 8), g1 = *(const f32x4*)(ng + lane * 8 + 4);
    const int r0 = rank * 512 + F.wave * 64;
#pragma unroll 1
    for (int m0 = r0; m0 < r0 + 64; m0 += 8) {
        v4u p[8];
#pragma unroll
        for (int q = 0; q < 8; ++q) p[q] = *(const GAS v4u*)(GL + (size_t)(m0 + q) * 512 + lane * 8);
#pragma unroll
        for (int q = 0; q < 8; ++q) {
            float o[8] = {bf_lo(p[q].x), bf_hi(p[q].x), bf_lo(p[q].y), bf_hi(p[q].y), bf_lo(p[q].z), bf_hi(p[q].z), bf_lo(p[q].w), bf_hi(p[q].w)};
            float s = 0.f;
#pragma unroll
            for (int k = 0; k < 8; ++k) s += o[k] * o[k];
            const float sc = 1.f / sqrtf(wave_sum(s) * (1.f / 512.f) + RMS_EPS);
            v4u w; w.x = pk2(o[0] * sc * g0[0], o[1] * sc * g0[1]); w.y = pk2(o[2] * sc * g0[2], o[3] * sc * g0[3]); w.z = pk2(o[4] * sc * g1[0], o[5] * sc * g1[1]); w.w = pk2(o[6] * sc * g1[2], o[7] * sc * g1[3]);
            *(GAS v4u*)(AC + (size_t)(m0 + q) * 1024 + 512 + lane * 8) = w;
        }
    }
}
__device__ const unsigned char ATT_DEAL[32][8] = {
  {48, 255, 255, 255, 255, 255, 255, 255},
  {27, 36, 35, 255, 255, 255, 255, 255},
  {59, 4, 3, 255, 255, 255, 255, 255},
  {62, 37, 34, 255, 255, 255, 255, 255},
  {16, 255, 255, 255, 255, 255, 255, 255},
  {30, 5, 2, 255, 255, 255, 255, 255},
  {61, 38, 33, 255, 255, 255, 255, 255},
  {29, 6, 1, 255, 255, 255, 255, 255},
  {47, 255, 255, 255, 255, 255, 255, 255},
  {60, 40, 32, 255, 255, 255, 255, 255},
  {28, 8, 0, 255, 255, 255, 255, 255},
  {31, 39, 255, 255, 255, 255, 255, 255},
  {15, 255, 255, 255, 255, 255, 255, 255},
  {63, 7, 255, 255, 255, 255, 255, 255},
  {58, 41, 255, 255, 255, 255, 255, 255},
  {26, 9, 255, 255, 255, 255, 255, 255},
  {46, 255, 255, 255, 255, 255, 255, 255},
  {57, 42, 255, 255, 255, 255, 255, 255},
  {25, 10, 255, 255, 255, 255, 255, 255},
  {56, 43, 255, 255, 255, 255, 255, 255},
  {14, 255, 255, 255, 255, 255, 255, 255},
  {24, 11, 255, 255, 255, 255, 255, 255},
  {55, 44, 255, 255, 255, 255, 255, 255},
  {23, 12, 255, 255, 255, 255, 255, 255},
  {45, 255, 255, 255, 255, 255, 255, 255},
  {54, 49, 255, 255, 255, 255, 255, 255},
  {22, 17, 255, 255, 255, 255, 255, 255},
  {53, 50, 255, 255, 255, 255, 255, 255},
  {13, 255, 255, 255, 255, 255, 255, 255},
  {21, 18, 255, 255, 255, 255, 255, 255},
  {52, 51, 255, 255, 255, 255, 255, 255},
  {20, 19, 255, 255, 255, 255, 255, 255}
};
__device__ __forceinline__ void pr_router(Frame& F, const Args& a) {
    LAS float* WP = (LAS float*)F.lds;
    { const GAS f32x4* src = (const GAS f32x4*)(a.ws + WS_SMALL + SM_WR); for (int i = FTID(F); i < 1024 * 36 / 4; i += NWAVES * 64) ((LAS f32x4*)WP)[i] = src[i]; }
    LAS int* cntL = (LAS int*)(F.lds + RT_OFF); LAS int* baseL = cntL + 32;
    LAS int* stA = (LAS int*)(F.lds + ST_OFF); LAS int* stE = stA + 512; LAS float* stG = (LAS float*)(stE + 512);
    if (FTID(F) < 32) cntL[FTID(F)] = 0;
    __syncthreads();
    int lane = mk_lane(); asm volatile("" : "+v"(lane));
    const int gw = F.vcu * NWAVES + F.wave;
    const float* X = INF(a, 0); const bf16* MIX = (const bf16*)(a.ws + WS_MIX); unsigned char* XN8 = (unsigned char*)(a.ws + WS_XN); const float* gf = INF(a, 21);
    const int e_me = lane >> 1; const float brt = INF(a, 23)[e_me];
    for (int rp = 0; rp < NREP(8); ++rp) { if (rp) { __syncthreads(); if (FTID(F) < 32) cntL[FTID(F)] = 0; __syncthreads(); }
    f32x4 xnx[4]; unsigned long long mnx[4];
    { const GAS f32x4* xr = (const GAS f32x4*)(X + (size_t)gw * 1024) + lane; const GAS unsigned long long* mr = (const GAS unsigned long long*)(MIX + (size_t)gw * 1024) + lane;
#pragma unroll
      for (int j = 0; j < 4; ++j) { xnx[j] = __builtin_nontemporal_load(xr + 64 * j); mnx[j] = __builtin_nontemporal_load(mr + 64 * j); } }
#pragma unroll 1
    for (int it = 0; it < 16; ++it) {
        const int m = gw + it * (256 * NWAVES);
        f32x4 xcur[4]; unsigned long long mcur[4];
#pragma unroll
        for (int j = 0; j < 4; ++j) { xcur[j] = xnx[j]; mcur[j] = mnx[j]; }
        { const int mn = gw + (it < 15 ? it + 1 : it) * (256 * NWAVES);
          const GAS f32x4* xr = (const GAS f32x4*)(X + (size_t)mn * 1024) + lane; const GAS unsigned long long* mr = (const GAS unsigned long long*)(MIX + (size_t)mn * 1024) + lane;
#pragma unroll
          for (int j = 0; j < 4; ++j) { xnx[j] = __builtin_nontemporal_load(xr + 64 * j); mnx[j] = __builtin_nontemporal_load(mr + 64 * j); } }
        f32x4 hv[4]; float ss = 0.f;
#pragma unroll
        for (int j = 0; j < 4; ++j) { const f32x4 xv = xcur[j]; const unsigned long long w = mcur[j]; const unsigned lo = (unsigned)w, hi = (unsigned)(w >> 32);
            hv[j] = (f32x4){xv.x + bf_lo(lo), xv.y + bf_hi(lo), xv.z + bf_lo(hi), xv.w + bf_hi(hi)};
            ss += (hv[j].x * hv[j].x + hv[j].y * hv[j].y) + (hv[j].z * hv[j].z + hv[j].w * hv[j].w); }
        const float rstd = 1.f / sqrtf(wave_sum(ss) * (1.f / D) + RMS_EPS);
        f32x2 p2[16];
#pragma unroll
        for (int e = 0; e < 16; ++e) p2[e] = (f32x2){0.f, 0.f};
#pragma unroll
        for (int j = 0; j < 4; ++j)
#pragma unroll
            for (int i = 0; i < 4; ++i) { const float hk = hv[j][i]; const f32x2 hk2 = {hk, hk}; const LAS float* wrow = WP + ((i + 4 * j) * 64 + lane) * 36;
#pragma unroll
                for (int e4 = 0; e4 < 8; ++e4) { const f32x4 w = *(const LAS f32x4*)(wrow + 4 * e4);
                    p2[2 * e4] = __builtin_elementwise_fma(hk2, (f32x2){w[0], w[1]}, p2[2 * e4]); p2[2 * e4 + 1] = __builtin_elementwise_fma(hk2, (f32x2){w[2], w[3]}, p2[2 * e4 + 1]); } }
        float p[32];
#pragma unroll
        for (int e = 0; e < 16; ++e) { p[2 * e] = p2[e].x; p[2 * e + 1] = p2[e].y; }
        float q16[16], q8[8], q4[4], q2[2];
        { const bool up = (lane & 32) != 0;
#pragma unroll
          for (int i = 0; i < 16; ++i) { const float keep = up ? p[16 + i] : p[i], send = up ? p[i] : p[16 + i]; q16[i] = keep + __shfl_xor(send, 32); } }
        { const bool up = (lane & 16) != 0;
#pragma unroll
          for (int i = 0; i < 8; ++i) { const float keep = up ? q16[8 + i] : q16[i], send = up ? q16[i] : q16[8 + i]; q8[i] = keep + __shfl_xor(send, 16); } }
        { const bool up = (lane & 8) != 0;
#pragma unroll
          for (int i = 0; i < 4; ++i) { const float keep = up ? q8[4 + i] : q8[i], send = up ? q8[i] : q8[4 + i]; q4[i] = keep + __shfl_xor(send, 8); } }
        { const bool up = (lane & 4) != 0;
#pragma unroll
          for (int i = 0; i < 2; ++i) { const float keep = up ? q4[2 + i] : q4[i], send = up ? q4[i] : q4[2 + i]; q2[i] = keep + __shfl_xor(send, 4); } }
        float q1; { const bool up = (lane & 2) != 0; const float keep = up ? q2[1] : q2[0], send = up ? q2[0] : q2[1]; q1 = keep + __shfl_xor(send, 2); }
        const float raw = q1 + __shfl_xor(q1, 1);
        const float v = raw * rstd + brt;
        int rank = 0;
#pragma unroll
        for (int j = 0; j < 32; ++j) { const float vj = __int_as_float(__builtin_amdgcn_readlane(__float_as_int(v), 2 * j)); rank += (vj > v || (vj == v && j < e_me)) ? 1 : 0; }
        float vk[4]; int ek[4];
#pragma unroll
        for (int k = 0; k < 4; ++k) { const unsigned long long mk = __ballot(rank == k); const int lk = (int)__builtin_ctzll(mk); ek[k] = lk >> 1; vk[k] = __int_as_float(__builtin_amdgcn_readlane(__float_as_int(v), lk)); }
        float ex[4]; float den = 0.f;
#pragma unroll
        for (int k = 0; k < 4; ++k) { ex[k] = __expf(vk[k] - vk[0]); den += ex[k]; }
        const float rden = 1.f / den;
        if (lane < 4) {
            const int e = lane == 0 ? ek[0] : lane == 1 ? ek[1] : lane == 2 ? ek[2] : ek[3];
            const float gt = (lane == 0 ? ex[0] : lane == 1 ? ex[1] : lane == 2 ? ex[2] : ex[3]) * rden;
            const int sl = __hip_atomic_fetch_add(cntL + e, 1, __ATOMIC_RELAXED, __HIP_MEMORY_SCOPE_WORKGROUP);
            const int pos = F.wave * 64 + it * 4 + lane;
            stA[pos] = m * 4 + lane; stE[pos] = e | (sl << 8); stG[pos] = gt;
        }
        { const GAS f32x4* gr = (const GAS f32x4*)gf + lane; GAS unsigned* o4 = (GAS unsigned*)(XN8 + (size_t)m * 1024) + lane;
          GAS unsigned long long* h8 = (GAS unsigned long long*)((bf16*)(a.ws + WS_HB) + (size_t)m * 1024) + lane;
#pragma unroll
          for (int j = 0; j < 4; ++j) { const f32x4 gg = gr[64 * j];
              o4[64 * j] = pk_fp8x4(hv[j].x * rstd * gg.x, hv[j].y * rstd * gg.y, hv[j].z * rstd * gg.z, hv[j].w * rstd * gg.w);
              __builtin_nontemporal_store((unsigned long long)pk2(hv[j].x, hv[j].y) | ((unsigned long long)pk2(hv[j].z, hv[j].w) << 32), h8 + 64 * j); } }
    }
    }
    __syncthreads();
    if (FTID(F) < 32) baseL[FTID(F)] = (int)__hip_atomic_fetch_add(F.ctl + CW_ECNT + 16 * FTID(F), (unsigned)cntL[FTID(F)], __ATOMIC_RELAXED, __HIP_MEMORY_SCOPE_AGENT);
    __syncthreads();
    { const int pos = FTID(F); const int aid = stA[pos], ee = stE[pos], e = ee & 255, sl = ee >> 8;
      int* list = (int*)(a.ws + WS_LIST); float* gates = (float*)(a.ws + WS_GATES);
      list[(size_t)e * T + baseL[e] + sl] = aid; gates[(size_t)e * T + baseL[e] + sl] = stG[pos]; }
}
__device__ __forceinline__ void moe_tables(Frame& F) {
    LAS int* tpre = (LAS int*)(F.lds + MOE_OFF); LAS int* cntE = tpre + 40;
    __syncthreads();
    if (FTID(F) < 32) cntE[FTID(F)] = (int)__hip_atomic_load(F.ctl + CW_ECNT + 16 * FTID(F), RLX_AGENT);
    __syncthreads();
    if (FTID(F) == 0) { int acc = 0; for (int e = 0; e < 32; ++e) { tpre[e] = acc; acc += (cntE[e] + 255) >> 8; } tpre[32] = acc; }
    __syncthreads();
}
__device__ __forceinline__ void pf_final(Frame& F, const Args& a) {
    int lane = mk_lane(); asm volatile("" : "+v"(lane));
    const int gw = F.vcu * NWAVES + F.wave, NGW = F.G * NWAVES;
    const unsigned char* YB = (const unsigned char*)(a.ws + WS_YBUF); const float* gfin = INF(a, 28);
    for (int m = gw; m < T; m += NGW) {
        GAS f32x4* hr = (GAS f32x4*)(a.out + (size_t)m * 1024) + lane;
        const GAS unsigned long long* mr = (const GAS unsigned long long*)((const bf16*)(a.ws + WS_HB) + (size_t)m * 1024) + lane;
        f32x4 v[4];
#pragma unroll
        for (int j = 0; j < 4; ++j) { const unsigned long long w = __builtin_nontemporal_load(mr + 64 * j); const unsigned lo = (unsigned)w, hi = (unsigned)(w >> 32);
            v[j].x = bf_lo(lo); v[j].y = bf_hi(lo); v[j].z = bf_lo(hi); v[j].w = bf_hi(hi); }
#pragma unroll
        for (int k = 0; k < 4; ++k) { const GAS unsigned* yr = (const GAS unsigned*)(YB + ((size_t)m * 4 + k) * 1024) + lane;
#pragma unroll
            for (int j = 0; j < 4; ++j) { const unsigned w = __builtin_nontemporal_load(yr + 64 * j); const f32x2 lo = __builtin_amdgcn_cvt_pk_f32_fp8((int)w, false), hi = __builtin_amdgcn_cvt_pk_f32_fp8((int)w, true);
                v[j].x += lo.x * YB_INV; v[j].y += lo.y * YB_INV; v[j].z += hi.x * YB_INV; v[j].w += hi.y * YB_INV; } }
        float s = 0.f;
#pragma unroll
        for (int j = 0; j < 4; ++j) s += (v[j].x * v[j].x + v[j].y * v[j].y) + (v[j].z * v[j].z + v[j].w * v[j].w);
        const float rstd = 1.f / sqrtf(wave_sum(s) * (1.f / D) + RMS_EPS);
        const GAS f32x4* gr = (const GAS f32x4*)gfin + lane;
#pragma unroll
        for (int j = 0; j < 4; ++j) { const f32x4 gg = gr[64 * j]; __builtin_nontemporal_store(v[j] * rstd * gg, hr + 64 * j); }
    }
}

__global__ void __launch_bounds__(NWAVES * 64, 2) mk_fwd(Args args) {
    extern __shared__ __attribute__((aligned(16))) unsigned char lds[];
    Frame F;
    F.lds = (LAS unsigned char*)lds;
    F.MISC = (volatile LAS unsigned*)(F.lds + MISC_OFF);
    F.wave = __builtin_amdgcn_readfirstlane((int)(threadIdx.x >> 6));
    F.G = gridDim.x; { const int bx = blockIdx.x; F.vcu = (F.G % 8 == 0) ? (bx % 8) * (F.G / 8) + bx / 8 : bx; }
    unsigned char* ws = args.ws;
    F.ctl = (gu32*)(ws + WS_CTL);
    for (int u = FTID(F); u < (LDS_BYTES - LDSCTL_OFF) / 4; u += NWAVES * 64) ((LAS unsigned*)(F.lds + LDSCTL_OFF))[u] = 0u;
    __syncthreads();
    XcdBarrier bar; bar.bar = (unsigned*)(F.ctl + CW_BAR); bar.x = 0; bar.st = nullptr; bar.wave = F.wave; bar.G = gridDim.x;
    if (N_LAUNCHES == 1) bar = xcd_barrier_post((unsigned*)(F.ctl + CW_BAR), F.MISC + 8, F.wave, gridDim.x);
#define GRID_BAR() do { if (N_LAUNCHES == 1) xcd_barrier(bar); } while (0)
    const int lo = args.ph_lo, hi = args.ph_hi;
#define IN(k) (lo <= (k) && (k) < hi)
#ifndef PROBE_DUP
#define PROBE_DUP -1
#endif
#define REP(k, ...) do { __VA_ARGS__; if constexpr (PROBE_DUP == (k)) { __VA_ARGS__; } } while (0)
#define BOTH(k) (IN(k) && IN((k) + 1))
    LAS unsigned char* ring = F.lds + RING_OFF;

    if (IN(0)) { REP(0, p0_prologue(F, args)); if (BOTH(0)) GRID_BAR(); }
    if (IN(1)) {
        DenseOrder S; S.init(T, 2048, 1024, 1024, 1024, ws + WS_XN, ws + WS_WIN, F.G, (int)blockIdx.x);
        EpiInProj E{(bf16*)(ws + WS_Q), (bf16*)(ws + WS_K), (bf16*)(ws + WS_V), (bf16*)(ws + WS_AROW), (const float*)(ws + WS_ROPE), attn_body::C2};
        pg8::ALinear AO{2048};
        REP(1, pg8::gemm_phase<EpiInProj, DenseOrder, pg8::ALinear, true>(ring, 2048, S, AO, E, F.wave));
        if (BOTH(1)) GRID_BAR();
        if constexpr (PROBE_DUP == 40) { GRID_BAR(); GRID_BAR(); GRID_BAR(); GRID_BAR(); }
    }
    if (IN(2)) {
        if (F.G == 256) {
            if ((F.vcu & 3) == 0) {
                const int rank = F.vcu >> 2;
                const XcdBarrier sbar = xcd_barrier_post((unsigned*)(F.ctl + CW_BAR2), F.MISC + 12, F.wave, NS5);
                { XOrder S{NS5, rank, (const char*)(ws + WS_AROW), (const char*)(ws + WS_BTX)}; EpiX E{(float*)(ws + WS_XLOC)}; pg8::ALinear AO{AROW_P * 2};
                  REP(50, pg8::gemm_phase<EpiX, XOrder, pg8::ALinear, true>(ring, 1024, S, AO, E, F.wave)); }
                xcd_barrier(sbar);
                REP(51, if (F.wave < 2) s5_scan(args, rank * 2 + F.wave, mk_lane()));
                xcd_barrier(sbar);
                { YOrder S{NS5, rank, (const char*)(ws + WS_AROW), (const char*)(ws + WS_BTY)}; EpiY E{(bf16*)(ws + WS_YG)}; pg8::ALinear AO{AROW_P * 2};
                  REP(52, pg8::gemm_phase<EpiY, YOrder, pg8::ALinear, true>(ring, AROW_P * 2, S, AO, E, F.wave)); }
                xcd_barrier(sbar);
                { GluOrder S{rank, (const char*)(ws + WS_YG), (const char*)(ws + WS_WGLU)};
                  EpiGlu E{(const bf16*)(ws + WS_YG), (bf16*)(ws + WS_GLU), INF(args, 18)}; pg8::ALinear AO{1024};
                  REP(53, pg8::gemm_phase<EpiGlu, GluOrder, pg8::ALinear, true>(ring, 1024, S, AO, E, F.wave)); }
                asm volatile("s_waitcnt vmcnt(0)" ::: "memory"); __syncthreads();
                REP(54, glunorm_sub(F, args, rank));
                __syncthreads();
            }
            const int xcd = F.vcu >> 5, wl = F.vcu & 31;
            const float lam = *(const float*)(ws + WS_SMALL);
            for (int rp = 0; rp < NREP(2); ++rp)
            for (int i = 0; i < 8; ++i) {
                const int e = __builtin_amdgcn_readfirstlane((int)ATT_DEAL[wl][i]); if (e == 255) break;
                const int bh = xcd * 2 + (e >> 5), qb = e & 31, b = bh >> 2, h = bh & 3;
                for (int map = 0; map < 2; ++map) { const int hm = h * 2 + map;
                    attn_body::attn_unit<8>(b, hm * 64, hm * 64, h * 128, h * 128, qb,
                        (const attn_body::bf16*)(ws + WS_Q), (const attn_body::bf16*)(ws + WS_K), (const attn_body::bf16*)(ws + WS_V), (attn_body::bf16*)(ws + WS_O), (char*)lds + RING_OFF, F.wave,
                        map, (attn_body::bf16*)(ws + WS_ACAT), lam, INF(args, 8)); }
            }
        }
        if (IN(7)) GRID_BAR();
    }
    if (IN(7)) {
        DenseOrder S; S.init(T, 1024, 1024, 1024, 1024, ws + WS_ACAT, ws + WS_WOUT, F.G, (int)blockIdx.x);
        EpiMix E{(bf16*)(ws + WS_MIX)}; pg8::ALinear AO{2048};
        REP(7, pg8::gemm_phase<EpiMix, DenseOrder, pg8::ALinear, true>(ring, 2048, S, AO, E, F.wave));
        if (BOTH(7)) GRID_BAR();
    }
    if (IN(8)) { if (F.G == 256) pr_router(F, args); if (BOTH(8)) GRID_BAR(); }
    if (IN(9)) {
        moe_tables(F);
        const LAS int* tpre = (const LAS int*)(F.lds + MOE_OFF);
        MoeOrder<4, 8> S{F.G, F.vcu, tpre, tpre + 40, (const char*)(ws + WS_XN), (const char*)(ws + WS_WGU), (size_t)2048 * 1024, true, 8};
        EpiGU E{(unsigned char*)(ws + WS_ACT), INF(args, 25), F.lds + EPB_OFF}; AGather AO{(const int*)(ws + WS_LIST)};
        if constexpr (PROBE_DUP == 66) { EpiNullT<2> E0; pg8::gemm_phase<EpiNullT<2>, MoeOrder<4, 8>, AGather, true, true>(ring, 1024, S, AO, E0, F.wave, F.lds + ST_OFF); }
        if constexpr (PROBE_DUP == 61) { MoeOrder<4, 8> S2 = S; S2.ntk = 24; pg8::gemm_phase<EpiGU, MoeOrder<4, 8>, AGather, true, true>(ring, 1024, S2, AO, E, F.wave, F.lds + ST_OFF); }
        REP(9, pg8::gemm_phase<EpiGU, MoeOrder<4, 8>, AGather, true, true>(ring, 1024, S, AO, E, F.wave, F.lds + ST_OFF));
        if (BOTH(9)) GRID_BAR();
    }
    if (IN(10)) {
        moe_tables(F);
        const LAS int* tpre = (const LAS int*)(F.lds + MOE_OFF);
        MoeOrder<8, 4> S{F.G, F.vcu, tpre, tpre + 40, (const char*)(ws + WS_ACT), (const char*)(ws + WS_WD), (size_t)1024 * 1024, false, 8};
        EpiDown E{(unsigned char*)(ws + WS_YBUF), INF(args, 27), (const int*)(ws + WS_LIST), (const float*)(ws + WS_GATES), 1, F.lds + ST_OFF, F.lds + EPB_OFF}; pg8::ALinear AO{1024};
        if constexpr (PROBE_DUP == 64) { EpiDownT<1> E1{(unsigned char*)(ws + WS_YBUF), INF(args, 27), (const int*)(ws + WS_LIST), (const float*)(ws + WS_GATES), 1, F.lds + ST_OFF, F.lds + EPB_OFF}; pg8::gemm_phase<EpiDownT<1>, MoeOrder<8, 4>, pg8::ALinear, true, true>(ring, 1024, S, AO, E1, F.wave); }
        if constexpr (PROBE_DUP == 62) { EpiNull E0; pg8::gemm_phase<EpiNull, MoeOrder<8, 4>, pg8::ALinear, true, true>(ring, 1024, S, AO, E0, F.wave); }
        if constexpr (PROBE_DUP == 60) { MoeOrder<8, 4> S2 = S; S2.ntk = 24; pg8::gemm_phase<EpiDown, MoeOrder<8, 4>, pg8::ALinear, true, true>(ring, 1024, S2, AO, E, F.wave); }
        REP(10, pg8::gemm_phase<EpiDown, MoeOrder<8, 4>, pg8::ALinear, true, true>(ring, 1024, S, AO, E, F.wave));
        if (BOTH(10)) GRID_BAR();
    }
    if (IN(11)) { REP(11, pf_final(F, args)); }
#undef IN
#undef BOTH
}

extern "C" void kernel_launch(void* const* d_in, const int* in_sizes, int n_in, void* d_out, int out_size, void* d_ws, size_t ws_size, hipStream_t stream) {
    static int grid = 0;
    if (grid == 0) {
        if (n_in != 29 || in_sizes[0] != T * D || out_size != T * D || ws_size < WS_END) { fprintf(stderr, "kernel_launch: unexpected shapes / workspace (n_in %d, ws %zu)\n", n_in, ws_size); grid = -1; return; }
        int dev = 0, cus = 0, per_cu = 0;
        if (hipGetDevice(&dev) != hipSuccess || hipDeviceGetAttribute(&cus, hipDeviceAttributeMultiprocessorCount, dev) != hipSuccess) { grid = -1; return; }
        if (hipFuncSetAttribute((const void*)mk_fwd, hipFuncAttributeMaxDynamicSharedMemorySize, LDS_BYTES) != hipSuccess) { fprintf(stderr, "kernel_launch: hipFuncSetAttribute failed\n"); grid = -1; return; }
        if (hipOccupancyMaxActiveBlocksPerMultiprocessor(&per_cu, (const void*)mk_fwd, NWAVES * 64, LDS_BYTES) != hipSuccess || per_cu < 1) { fprintf(stderr, "kernel_launch: occupancy query says %d\n", per_cu); }
        (void)hipGetLastError();
        if (cus < 256) { fprintf(stderr, "kernel_launch: needs 256 CUs, device has %d\n", cus); grid = -1; return; }
        grid = 256;
    }
    if (grid < 0) return;
    if (hipMemsetAsync((char*)d_ws + WS_CTL, 0, CTL_ZERO_BYTES, stream) != hipSuccess) return;
    Args a{};
    for (int i = 0; i < 29; ++i) a.in[i] = d_in[i];
    a.out = (float*)d_out; a.ws = (unsigned char*)d_ws; a.pad = 0;
    for (int li = 0; li < N_LAUNCHES; ++li) {
        a.ph_lo = (N_LAUNCHES == NPH) ? li : 0; a.ph_hi = (N_LAUNCHES == NPH) ? li + 1 : NPH; a.li = li;
        hipLaunchKernelGGL(mk_fwd, dim3(grid), dim3(NWAVES * 64), LDS_BYTES, stream, a);
    }
}
```
